# Optimizing an MI355X kernel written in HIP

```python
import jax, jax.numpy as jnp
from jax import lax
import numpy as np

D_MODEL = 1024
BATCH = 8
SEQ = 2048
DEPTH = 4

GRID_W = 64
N_HEADS = 16
HEAD_DIM = D_MODEL // N_HEADS
NA_ROWS = 8
NA_COLS = 16
NA_QCOLS = NA_COLS
NA_KCOLS = 2 * NA_COLS
GQA_KV_HEADS = 4
GQA_GROUP = N_HEADS // GQA_KV_HEADS
Q_BLOCK = 128
ROPE_THETA = 10000.0
ROPE_PAIRS = HEAD_DIM // 4
N_GROUPS = 4
EXPERTS_PER_GROUP = 8
N_EXPERTS = N_GROUPS * EXPERTS_PER_GROUP
TOP_K = 2
D_EXPERT = D_MODEL // 2
MOE_BLOCK = 128
N_MIXERS = 2
N_NA_LAYERS = (DEPTH + 1) // 2
N_GQA_LAYERS = DEPTH // 2
DEEPNORM_ALPHA = (2 * DEPTH) ** 0.25
DEEPNORM_BETA = (8 * DEPTH) ** -0.25
ADA_INIT = 0.2
LN_EPS = 1e-5
RMS_EPS = 1e-6

kernel_name = "hybrid_natten_gqa_hmoe_deepnorm"


def layer_norm(x, g, b):
    xf = x.astype(jnp.float32)
    mu = xf.mean(-1, keepdims=True)
    var = jnp.square(xf - mu).mean(-1, keepdims=True)
    return ((xf - mu) * lax.rsqrt(var + LN_EPS) * g.astype(jnp.float32) + b.astype(jnp.float32)).astype(x.dtype)


def rms_norm(x, g):
    xf = x.astype(jnp.float32)
    ms = jnp.square(xf).mean(-1, keepdims=True)
    return (xf * lax.rsqrt(ms + RMS_EPS) * g.astype(jnp.float32)).astype(x.dtype)


def neighbourhood_attention(q, k, v, rpb):
    B, S, H, hd = q.shape
    rows = S // GRID_W
    kr = min(NA_ROWS, rows)
    r = jnp.arange(rows, dtype=jnp.int32)
    row_start = jnp.clip(r - kr // 2, 0, rows - kr)
    key_rows = row_start[:, None] + jnp.arange(kr, dtype=jnp.int32)[None, :]
    dr = key_rows - r[:, None] + (NA_ROWS - 1)
    qg = q.reshape(B, rows, GRID_W, H, hd)
    kg = k.reshape(B, rows, GRID_W, H, hd)[:, key_rows]
    vg = v.reshape(B, rows, GRID_W, H, hd)[:, key_rows]
    outs = []
    for q0 in range(0, GRID_W, NA_QCOLS):
        b0 = min(max(q0 - NA_COLS // 2, 0), GRID_W - NA_KCOLS)
        qc = q0 + jnp.arange(NA_QCOLS, dtype=jnp.int32)
        kc = b0 + jnp.arange(NA_KCOLS, dtype=jnp.int32)
        win_start = jnp.clip(qc - NA_COLS // 2, 0, GRID_W - NA_COLS)
        valid = (kc[None, :] >= win_start[:, None]) & (kc[None, :] < win_start[:, None] + NA_COLS)
        dc = jnp.clip(kc[None, :] - qc[:, None] + NA_COLS - 1, 0, 2 * NA_COLS - 2)
        bias = rpb[:, dr[:, None, :, None], dc[None, :, None, :]]
        kb = kg[:, :, :, b0:b0 + NA_KCOLS]
        vb = vg[:, :, :, b0:b0 + NA_KCOLS]
        s = jnp.einsum('brqhd,brikhd->bhrqik', qg[:, :, q0:q0 + NA_QCOLS], kb).astype(jnp.float32)
        s = jnp.where(valid[:, None, :], s + bias.astype(jnp.float32), -jnp.inf)
        p = jax.nn.softmax(s.reshape(B, H, rows, NA_QCOLS, kr * NA_KCOLS), axis=-1)
        p = p.reshape(s.shape).astype(v.dtype)
        outs.append(jnp.einsum('bhrqik,brikhd->brqhd', p, vb))
    return jnp.concatenate(outs, axis=2).reshape(B, S, H, hd)


def neighbourhood_mixer(h, w_qkv, rpb, w_o):
    B, S, D = h.shape
    qkv = (h @ w_qkv).reshape(B, S, 3, N_HEADS, HEAD_DIM)
    q = qkv[:, :, 0] * (HEAD_DIM ** -0.5)
    o = neighbourhood_attention(q, qkv[:, :, 1], qkv[:, :, 2], rpb)
    return o.reshape(B, S, D) @ w_o


def axial_rope_tables(S):
    t = jnp.arange(S, dtype=jnp.int32)
    pos = jnp.stack([t // GRID_W, t % GRID_W], axis=-1).astype(jnp.float32)
    inv_freq = ROPE_THETA ** (-jnp.arange(ROPE_PAIRS, dtype=jnp.float32) / ROPE_PAIRS)
    ang = pos[:, :, None] * inv_freq
    return jnp.cos(ang), jnp.sin(ang)


def apply_axial_rope(x, cos, sin):
    B, S, H, hd = x.shape
    xr = x.astype(jnp.float32).reshape(B, S, H, 2, 2, ROPE_PAIRS)
    x1, x2 = xr[..., 0, :], xr[..., 1, :]
    c, s = cos[None, :, None], sin[None, :, None]
    out = jnp.stack([x1 * c - x2 * s, x2 * c + x1 * s], axis=-2)
    return out.reshape(B, S, H, hd).astype(x.dtype)


def block_gqa_attention(q, k, v):
    B, S, H, hd = q.shape
    nblk = S // Q_BLOCK
    qg = q.reshape(B, nblk, Q_BLOCK, GQA_KV_HEADS, GQA_GROUP, hd).transpose(1, 0, 2, 3, 4, 5)
    scale = HEAD_DIM ** -0.5

    def one_block(qb):
        s = jnp.einsum('bqkgd,bskd->bkgqs', qb, k).astype(jnp.float32) * scale
        p = jax.nn.softmax(s, axis=-1).astype(v.dtype)
        return jnp.einsum('bkgqs,bskd->bqkgd', p, v)

    o = lax.map(one_block, qg)
    return o.transpose(1, 0, 2, 3, 4, 5).reshape(B, S, H * hd)


def gqa_mixer(h, cos, sin, w_qkv, q_gain, k_gain, w_o):
    B, S, D = h.shape
    kvd = GQA_KV_HEADS * HEAD_DIM
    qkv = h @ w_qkv
    q = qkv[..., :D].reshape(B, S, N_HEADS, HEAD_DIM)
    k = qkv[..., D:D + kvd].reshape(B, S, GQA_KV_HEADS, HEAD_DIM)
    v = qkv[..., D + kvd:].reshape(B, S, GQA_KV_HEADS, HEAD_DIM)
    q = apply_axial_rope(rms_norm(q, q_gain), cos, sin)
    k = apply_axial_rope(rms_norm(k, k_gain), cos, sin)
    return block_gqa_attention(q, k, v) @ w_o


def hierarchical_moe(h, w_group, b_group, w_expert, b_expert, w_gate, w_up, w_down):
    B, S, D = h.shape
    N = B * S
    xt = h.reshape(N, D)
    pg = jax.nn.softmax((xt @ w_group).astype(jnp.float32) + b_group.astype(jnp.float32), axis=-1)
    g_prob, g_idx = lax.top_k(pg, 1)
    le = ((xt @ w_expert).astype(jnp.float32) + b_expert.astype(jnp.float32)).reshape(N, N_GROUPS, EXPERTS_PER_GROUP)
    le = le[jnp.arange(N), g_idx[:, 0]]
    e_prob, e_local = lax.top_k(jax.nn.softmax(le, axis=-1), TOP_K)
    e_prob = e_prob / e_prob.sum(-1, keepdims=True)
    gates = g_prob * e_prob
    experts = g_idx * EXPERTS_PER_GROUP + e_local
    A = N * TOP_K
    flat_e = experts.reshape(A).astype(jnp.int32)
    flat_tok = jnp.repeat(jnp.arange(N, dtype=jnp.int32), TOP_K)
    flat_gate = gates.reshape(A)
    order = jnp.argsort(flat_e)
    e_sorted = flat_e[order]
    counts = jnp.bincount(flat_e, length=N_EXPERTS).astype(jnp.int32)
    padded = (counts + MOE_BLOCK - 1) // MOE_BLOCK * MOE_BLOCK
    pad_end = jnp.cumsum(padded)
    pad_start = pad_end - padded
    seg_start = jnp.cumsum(counts) - counts
    dest = pad_start[e_sorted] + (jnp.arange(A, dtype=jnp.int32) - seg_start[e_sorted])
    n_blocks = -(-A // MOE_BLOCK) + N_EXPERTS
    n_rows = n_blocks * MOE_BLOCK
    row_tok = jnp.full((n_rows,), N, jnp.int32).at[dest].set(flat_tok[order])
    row_gate = jnp.zeros((n_rows,), jnp.float32).at[dest].set(flat_gate[order])
    block_expert = jnp.minimum(
        jnp.searchsorted(pad_end, jnp.arange(n_blocks, dtype=jnp.int32) * MOE_BLOCK, side='right'),
        N_EXPERTS - 1)
    x_pad = jnp.concatenate([xt, jnp.zeros((1, D), xt.dtype)], axis=0)
    xs = x_pad[row_tok].reshape(n_blocks, MOE_BLOCK, D)

    def expert_block(args):
        xb, e = args
        return (jax.nn.silu(xb @ w_gate[e]) * (xb @ w_up[e])) @ w_down[e]

    ys = lax.map(expert_block, (xs, block_expert)).reshape(n_rows, D)
    ys = ys * row_gate[:, None].astype(ys.dtype)
    out = jnp.zeros((N + 1, D), ys.dtype).at[row_tok].add(ys)[:N]
    return out.reshape(B, S, D)


def setup_inputs(seed: int = 0) -> dict:
    key = jax.random.key(seed)
    ks = jax.random.split(key, 20)
    f32 = jnp.float32
    D = D_MODEL
    inv = D ** -0.5
    kvd = GQA_KV_HEADS * HEAD_DIM

    def nrm(k, shape, scale):
        return jax.random.normal(k, shape, f32) * scale

    na_cols = jnp.concatenate([jnp.ones((2 * D,), f32), jnp.full((D,), DEEPNORM_BETA, f32)])
    gqa_cols = jnp.concatenate([jnp.ones((D + kvd,), f32), jnp.full((kvd,), DEEPNORM_BETA, f32)])
    return {
        "x": nrm(ks[0], (BATCH, SEQ, D), 1.0),
        "c": nrm(ks[1], (BATCH, D), 1.0),
        "ada_w": nrm(ks[2], (DEPTH, D, 6 * D), ADA_INIT * inv),
        "ada_b": nrm(ks[3], (DEPTH, 6 * D), 0.01),
        "ln_g": 1.0 + nrm(ks[4], (DEPTH, 2, D), 0.01),
        "ln_b": nrm(ks[5], (DEPTH, 2, D), 0.01),
        "na_w_qkv": nrm(ks[6], (N_NA_LAYERS, D, 3 * D), inv) * na_cols,
        "na_rpb": nrm(ks[7], (N_NA_LAYERS, N_HEADS, 2 * NA_ROWS - 1, 2 * NA_COLS - 1), 0.1),
        "na_w_o": nrm(ks[8], (N_NA_LAYERS, D, D), inv * DEEPNORM_BETA),
        "gqa_w_qkv": nrm(ks[9], (N_GQA_LAYERS, D, D + 2 * kvd), inv) * gqa_cols,
        "gqa_q_norm": 1.0 + nrm(ks[10], (N_GQA_LAYERS, HEAD_DIM), 0.01),
        "gqa_k_norm": 1.0 + nrm(ks[11], (N_GQA_LAYERS, HEAD_DIM), 0.01),
        "gqa_w_o": nrm(ks[12], (N_GQA_LAYERS, D, D), inv * DEEPNORM_BETA),
        "moe_w_group": nrm(ks[13], (DEPTH, D, N_GROUPS), inv),
        "moe_b_group": nrm(ks[14], (DEPTH, N_GROUPS), 0.01),
        "moe_w_expert": nrm(ks[15], (DEPTH, D, N_EXPERTS), inv),
        "moe_b_expert": nrm(ks[16], (DEPTH, N_EXPERTS), 0.01),
        "moe_w_gate": nrm(ks[17], (DEPTH, N_EXPERTS, D, D_EXPERT), inv),
        "moe_w_up": nrm(ks[18], (DEPTH, N_EXPERTS, D, D_EXPERT), inv),
        "moe_w_down": nrm(ks[19], (DEPTH, N_EXPERTS, D_EXPERT, D), (D_EXPERT ** -0.5) * DEEPNORM_BETA),
    }


def reference(x, c, ada_w, ada_b, ln_g, ln_b, na_w_qkv, na_rpb, na_w_o, gqa_w_qkv, gqa_q_norm,
              gqa_k_norm, gqa_w_o, moe_w_group, moe_b_group, moe_w_expert, moe_b_expert,
              moe_w_gate, moe_w_up, moe_w_down):
    B, S, D = x.shape
    cos, sin = axial_rope_tables(S)
    c_act = jax.nn.silu(c)
    for i in range(DEPTH):
        mod = c_act @ ada_w[i] + ada_b[i]
        sh1, sc1, g1, sh2, sc2, g2 = jnp.split(mod[:, None, :], 6, axis=-1)
        h = x * (1 + sc1) + sh1
        j = i // N_MIXERS
        if i % N_MIXERS == 0:
            y = neighbourhood_mixer(h, na_w_qkv[j], na_rpb[j], na_w_o[j])
        else:
            y = gqa_mixer(h, cos, sin, gqa_w_qkv[j], gqa_q_norm[j], gqa_k_norm[j], gqa_w_o[j])
        x = layer_norm(DEEPNORM_ALPHA * x + (1 + g1) * y, ln_g[i, 0], ln_b[i, 0])
        h = x * (1 + sc2) + sh2
        y = hierarchical_moe(h, moe_w_group[i], moe_b_group[i], moe_w_expert[i], moe_b_expert[i],
                             moe_w_gate[i], moe_w_up[i], moe_w_down[i])
        x = layer_norm(DEEPNORM_ALPHA * x + (1 + g2) * y, ln_g[i, 1], ln_b[i, 1])
    return x
```

```cpp
#include <hip/hip_runtime.h>
#include <stdint.h>

namespace orc {
constexpr int D = 1024, NB = 8, S = 2048, M = NB * S, DEPTH = 4, H = 16, HD = 64, GW = 64, ROWS = 32;
constexpr int KVH = 4, KVD = 256, NE = 32, NG = 4, EPG = 8, DE = 512, NQKV_NA = 3072, NQKV_GQA = 1536;
constexpr float ALPHA = 1.6817928305074290f;
constexpr float LN_EPS = 1e-5f, RMS_EPS = 1e-6f;

__device__ __forceinline__ float wsum(float v) {
#pragma unroll
    for (int o = 1; o < 64; o <<= 1) v += __shfl_xor(v, o);
    return v;
}
__device__ __forceinline__ float siluf(float v) { return v / (1.f + __expf(-v)); }

__global__ void __launch_bounds__(256) k_mod(const float* __restrict__ c, const float* __restrict__ w, const float* __restrict__ bias, float* __restrict__ mod) {
    __shared__ float ca[NB * D];
    for (int i = threadIdx.x; i < NB * D; i += 256) ca[i] = siluf(c[i]);
    __syncthreads();
    const int col = blockIdx.x * 256 + threadIdx.x;
    const int l = col / (6 * D), j = col % (6 * D);
    float acc[NB];
#pragma unroll
    for (int b = 0; b < NB; ++b) acc[b] = 0.f;
    const float* wp = w + (size_t)l * D * 6 * D + j;
    for (int k = 0; k < D; ++k) {
        const float wv = wp[(size_t)k * 6 * D];
#pragma unroll
        for (int b = 0; b < NB; ++b) acc[b] += ca[b * D + k] * wv;
    }
#pragma unroll
    for (int b = 0; b < NB; ++b) mod[((size_t)l * NB + b) * 6 * D + j] = acc[b] + bias[l * 6 * D + j];
}

__global__ void __launch_bounds__(256) k_modulate(const float* __restrict__ x, const float* __restrict__ modl, int sh_idx, int sc_idx, float* __restrict__ h) {
    const size_t i = (size_t)blockIdx.x * 256 + threadIdx.x;
    const int m = (int)(i / D), d = (int)(i % D), b = m / S;
    const float* mb = modl + (size_t)b * 6 * D;
    h[i] = x[i] * (1.f + mb[sc_idx * D + d]) + mb[sh_idx * D + d];
}

__global__ void __launch_bounds__(256) k_ln(const float* __restrict__ x, const float* __restrict__ y, const float* __restrict__ yc, const float* __restrict__ gates,
                                            const float* __restrict__ modl, int g_idx, const float* __restrict__ lng, const float* __restrict__ lnb, float* __restrict__ xo) {
    const int m = blockIdx.x * 4 + (threadIdx.x >> 6), lane = threadIdx.x & 63, b = m / S;
    const float* gb = modl + (size_t)b * 6 * D + g_idx * D;
    float v[16]; float s = 0.f;
#pragma unroll
    for (int j = 0; j < 16; ++j) {
        const int d = lane + 64 * j;
        float yy;
        if (yc) yy = gates[2 * m] * yc[(size_t)(2 * m) * D + d] + gates[2 * m + 1] * yc[(size_t)(2 * m + 1) * D + d];
        else yy = y[(size_t)m * D + d];
        v[j] = ALPHA * x[(size_t)m * D + d] + (1.f + gb[d]) * yy; s += v[j];
    }
    const float mean = wsum(s) * (1.f / D); float q = 0.f;
#pragma unroll
    for (int j = 0; j < 16; ++j) { v[j] -= mean; q += v[j] * v[j]; }
    const float rstd = rsqrtf(wsum(q) * (1.f / D) + LN_EPS);
#pragma unroll
    for (int j = 0; j < 16; ++j) { const int d = lane + 64 * j; xo[(size_t)m * D + d] = v[j] * rstd * lng[d] + lnb[d]; }
}

template <int EPI>
__global__ void __launch_bounds__(256) k_gemm(const float* __restrict__ A, const int* __restrict__ a_idx, int lda,
                                              const float* __restrict__ Bm, const float* __restrict__ B2m, int ldb, size_t strideB,
                                              float* __restrict__ C, const int* __restrict__ c_idx, int ldc,
                                              int Mrows, const int* __restrict__ cnt, const int* __restrict__ off, int K) {
    __shared__ float As[16][68];
    __shared__ float Bs[16][64];
    __shared__ float B2s[EPI ? 16 : 1][64];
    const int g = blockIdx.z, t = threadIdx.x;
    const int nrows = cnt ? cnt[g] : Mrows, rbase = cnt ? off[g] : 0;
    const int r0 = blockIdx.y * 64; if (r0 >= nrows) return;
    const int n0 = blockIdx.x * 64;
    const float* Bg = Bm + (size_t)g * strideB; const float* B2g = EPI ? B2m + (size_t)g * strideB : nullptr;
    const int lr = t >> 2, lk = (t & 3) * 4;
    const bool rv = (r0 + lr) < nrows;
    const int slot = rbase + r0 + lr;
    const size_t arow = rv ? (size_t)(a_idx ? a_idx[slot] : slot) : 0;
    const int bk = t >> 4, bn = (t & 15) * 4;
    const int ty = t >> 4, tx = t & 15;
    float acc[4][4], acc2[4][4];
#pragma unroll
    for (int i = 0; i < 4; ++i)
#pragma unroll
        for (int j = 0; j < 4; ++j) { acc[i][j] = 0.f; acc2[i][j] = 0.f; }
    for (int k0 = 0; k0 < K; k0 += 16) {
        float4 av = rv ? *(const float4*)(A + arow * lda + k0 + lk) : make_float4(0.f, 0.f, 0.f, 0.f);
        As[lk + 0][lr] = av.x; As[lk + 1][lr] = av.y; As[lk + 2][lr] = av.z; As[lk + 3][lr] = av.w;
        *(float4*)&Bs[bk][bn] = *(const float4*)(Bg + (size_t)(k0 + bk) * ldb + n0 + bn);
        if (EPI) *(float4*)&B2s[bk][bn] = *(const float4*)(B2g + (size_t)(k0 + bk) * ldb + n0 + bn);
        __syncthreads();
#pragma unroll
        for (int kk = 0; kk < 16; ++kk) {
            const float4 a4 = *(const float4*)&As[kk][ty * 4]; const float4 b4 = *(const float4*)&Bs[kk][tx * 4];
            const float a[4] = {a4.x, a4.y, a4.z, a4.w}, bb[4] = {b4.x, b4.y, b4.z, b4.w};
#pragma unroll
            for (int i = 0; i < 4; ++i)
#pragma unroll
                for (int j = 0; j < 4; ++j) acc[i][j] += a[i] * bb[j];
            if (EPI) {
                const float4 c4 = *(const float4*)&B2s[kk][tx * 4]; const float cc[4] = {c4.x, c4.y, c4.z, c4.w};
#pragma unroll
                for (int i = 0; i < 4; ++i)
#pragma unroll
                    for (int j = 0; j < 4; ++j) acc2[i][j] += a[i] * cc[j];
            }
        }
        __syncthreads();
    }
#pragma unroll
    for (int i = 0; i < 4; ++i) {
        const int rl = r0 + ty * 4 + i; if (rl >= nrows) continue;
        const int sl = rbase + rl; const size_t crow = (size_t)(c_idx ? c_idx[sl] : sl);
        float4 o;
        if (EPI) { o.x = siluf(acc[i][0]) * acc2[i][0]; o.y = siluf(acc[i][1]) * acc2[i][1]; o.z = siluf(acc[i][2]) * acc2[i][2]; o.w = siluf(acc[i][3]) * acc2[i][3]; }
        else { o.x = acc[i][0]; o.y = acc[i][1]; o.z = acc[i][2]; o.w = acc[i][3]; }
        *(float4*)(C + crow * ldc + n0 + tx * 4) = o;
    }
}

__global__ void __launch_bounds__(256) k_rope_tab(float* __restrict__ cs, float* __restrict__ sn) {
    const int i = blockIdx.x * 256 + threadIdx.x;
    const int t = i >> 5, a = (i >> 4) & 1, p = i & 15;
    const float pos = (float)(a == 0 ? t / GW : t % GW);
    const float inv = exp2f(-(float)p * (13.287712379549449f / 16.f));
    const float ang = pos * inv;
    const float kf = rintf(ang * 0.15915494309189535f);
    float r = fmaf(-kf, 6.2831854820251465f, ang); r = fmaf(-kf, -1.7484555314695172e-07f, r);
    cs[i] = __cosf(r); sn[i] = __sinf(r);
}

__global__ void __launch_bounds__(256) k_na_attn(const float* __restrict__ qkv, const float* __restrict__ rpb, float* __restrict__ o) {
    const int w = blockIdx.x * 4 + (threadIdx.x >> 6), lane = threadIdx.x & 63;
    const int m = w / H, h = w % H, b = m / S, t = m % S, r = t / GW, c = t % GW;
    const int rs = min(max(r - 4, 0), ROWS - 8), ws = min(max(c - 8, 0), GW - 16);
    const float q = qkv[(size_t)m * NQKV_NA + h * HD + lane] * 0.125f;
    float mx = -INFINITY, l = 0.f, acc = 0.f;
    for (int kr = 0; kr < 8; ++kr)
        for (int kc = 0; kc < 16; ++kc) {
            const int krow = rs + kr, kcol = ws + kc; const size_t tok = (size_t)b * S + krow * GW + kcol;
            const float kv = qkv[tok * NQKV_NA + D + h * HD + lane];
            const float vv = qkv[tok * NQKV_NA + 2 * D + h * HD + lane];
            const int dr = krow - r + 7, dc = min(max(kcol - c + 15, 0), 30);
            const float s = wsum(q * kv) + rpb[(h * 15 + dr) * 31 + dc];
            const float mn = fmaxf(mx, s), al = __expf(mx - mn), p = __expf(s - mn);
            l = l * al + p; acc = acc * al + p * vv; mx = mn;
        }
    o[(size_t)m * D + h * HD + lane] = acc / l;
}

__global__ void __launch_bounds__(256) k_gqa_prep(const float* __restrict__ qkv, const float* __restrict__ qn, const float* __restrict__ kn,
                                                  const float* __restrict__ cs, const float* __restrict__ sn, float* __restrict__ qh, float* __restrict__ kh) {
    const int w = blockIdx.x * 4 + (threadIdx.x >> 6), lane = threadIdx.x & 63;
    const int m = w / 20, hh = w % 20, t = m % S;
    const float x = qkv[(size_t)m * NQKV_GQA + hh * HD + lane];
    const float ms = wsum(x * x) * (1.f / HD);
    const float gain = hh < 16 ? qn[lane] : kn[lane];
    const float xn = x * rsqrtf(ms + RMS_EPS) * gain;
    const float xp = __shfl_xor(xn, 16);
    const int a = lane >> 5, half = (lane >> 4) & 1, p = lane & 15;
    const float cc = cs[t * 32 + a * 16 + p], ss = sn[t * 32 + a * 16 + p];
    const float out = half == 0 ? xn * cc - xp * ss : xn * cc + xp * ss;
    if (hh < 16) qh[(size_t)m * D + hh * HD + lane] = out; else kh[(size_t)m * KVD + (hh - 16) * HD + lane] = out;
}

__global__ void __launch_bounds__(256) k_gqa_attn(const float* __restrict__ qh, const float* __restrict__ kh, const float* __restrict__ qkv, float* __restrict__ o) {
    const int w = blockIdx.x * 4 + (threadIdx.x >> 6), lane = threadIdx.x & 63;
    const int m = w / H, h = w % H, b = m / S, kvh = h / 4;
    const float q = qh[(size_t)m * D + h * HD + lane] * 0.125f;
    float mx = -INFINITY, l = 0.f, acc = 0.f;
    const float* kp = kh + (size_t)b * S * KVD + kvh * HD + lane;
    const float* vp = qkv + (size_t)b * S * NQKV_GQA + D + KVD + kvh * HD + lane;
    for (int j = 0; j < S; ++j) {
        const float kv = kp[(size_t)j * KVD], vv = vp[(size_t)j * NQKV_GQA];
        const float s = wsum(q * kv);
        const float mn = fmaxf(mx, s), al = __expf(mx - mn), p = __expf(s - mn);
        l = l * al + p; acc = acc * al + p * vv; mx = mn;
    }
    o[(size_t)m * D + h * HD + lane] = acc / l;
}

__global__ void __launch_bounds__(256) k_router(const float* __restrict__ h, const float* __restrict__ wg, const float* __restrict__ bg,
                                                const float* __restrict__ we, const float* __restrict__ be, int* __restrict__ eid, float* __restrict__ gates, int* __restrict__ cnt) {
    const int m = blockIdx.x * 4 + (threadIdx.x >> 6), lane = threadIdx.x & 63;
    float hv[16];
#pragma unroll
    for (int j = 0; j < 16; ++j) hv[j] = h[(size_t)m * D + lane + 64 * j];
    float lg[NG];
#pragma unroll
    for (int g = 0; g < NG; ++g) { float s = 0.f;
#pragma unroll
        for (int j = 0; j < 16; ++j) s += hv[j] * wg[(size_t)(lane + 64 * j) * NG + g];
        lg[g] = wsum(s) + bg[g]; }
    int gi = 0; float gm = lg[0];
#pragma unroll
    for (int g = 1; g < NG; ++g) if (lg[g] > gm) { gm = lg[g]; gi = g; }
    float gs = 0.f;
#pragma unroll
    for (int g = 0; g < NG; ++g) gs += __expf(lg[g] - gm);
    const float gprob = 1.f / gs;
    float le[EPG];
#pragma unroll
    for (int e = 0; e < EPG; ++e) { float s = 0.f;
#pragma unroll
        for (int j = 0; j < 16; ++j) s += hv[j] * we[(size_t)(lane + 64 * j) * NE + gi * EPG + e];
        le[e] = wsum(s) + be[gi * EPG + e]; }
    int i0 = 0; float m0 = le[0];
#pragma unroll
    for (int e = 1; e < EPG; ++e) if (le[e] > m0) { m0 = le[e]; i0 = e; }
    int i1 = -1; float m1 = -INFINITY;
#pragma unroll
    for (int e = 0; e < EPG; ++e) if (e != i0 && le[e] > m1) { m1 = le[e]; i1 = e; }
    const float p1 = __expf(m1 - m0), den = 1.f + p1;
    if (lane == 0) {
        eid[2 * m] = gi * EPG + i0; eid[2 * m + 1] = gi * EPG + i1;
        gates[2 * m] = gprob / den; gates[2 * m + 1] = gprob * p1 / den;
        atomicAdd(&cnt[gi * EPG + i0], 1); atomicAdd(&cnt[gi * EPG + i1], 1);
    }
}
__global__ void k_prefix(const int* __restrict__ cnt, int* __restrict__ off, int* __restrict__ cur) {
    if (threadIdx.x == 0) { int s = 0; for (int e = 0; e < NE; ++e) { off[e] = s; cur[e] = 0; s += cnt[e]; } }
}
__global__ void __launch_bounds__(256) k_fill(const int* __restrict__ eid, const int* __restrict__ off, int* __restrict__ cur, int* __restrict__ slot_tok, int* __restrict__ slot_out) {
    const int a = blockIdx.x * 256 + threadIdx.x;
    const int e = eid[a]; const int pos = atomicAdd(&cur[e], 1); const int sl = off[e] + pos;
    slot_tok[sl] = a >> 1; slot_out[sl] = a;
}
}

extern "C" void kernel_launch(void* const* d_in, const int* in_sizes, int n_in, void* d_out, int out_size, void* d_ws, size_t ws_size, hipStream_t stream) {
    using namespace orc;
    const float* x = (const float*)d_in[0]; const float* c = (const float*)d_in[1];
    const float* ada_w = (const float*)d_in[2]; const float* ada_b = (const float*)d_in[3];
    const float* ln_g = (const float*)d_in[4]; const float* ln_b = (const float*)d_in[5];
    const float* na_wqkv = (const float*)d_in[6]; const float* na_rpb = (const float*)d_in[7]; const float* na_wo = (const float*)d_in[8];
    const float* gq_wqkv = (const float*)d_in[9]; const float* gq_qn = (const float*)d_in[10]; const float* gq_kn = (const float*)d_in[11]; const float* gq_wo = (const float*)d_in[12];
    const float* m_wg = (const float*)d_in[13]; const float* m_bg = (const float*)d_in[14]; const float* m_we = (const float*)d_in[15]; const float* m_be = (const float*)d_in[16];
    const float* m_gate = (const float*)d_in[17]; const float* m_up = (const float*)d_in[18]; const float* m_down = (const float*)d_in[19];
    float* out = (float*)d_out;
    char* ws = (char*)d_ws; size_t o = 0;
    auto carve = [&](size_t bytes) { char* p = ws + o; o += (bytes + 255) & ~(size_t)255; return p; };
    float* mod = (float*)carve((size_t)DEPTH * NB * 6 * D * 4);
    float* hb = (float*)carve((size_t)M * D * 4);
    float* qkv = (float*)carve((size_t)M * NQKV_NA * 4);
    float* ob = (float*)carve((size_t)M * D * 4);
    float* yb = (float*)carve((size_t)M * D * 4);
    float* xa = (float*)carve((size_t)M * D * 4);
    float* xb = (float*)carve((size_t)M * D * 4);
    float* qh = (float*)carve((size_t)M * D * 4);
    float* kh = (float*)carve((size_t)M * KVD * 4);
    float* cs = (float*)carve((size_t)S * 32 * 4);
    float* sn = (float*)carve((size_t)S * 32 * 4);
    int* eid = (int*)carve((size_t)M * 2 * 4);
    float* gates = (float*)carve((size_t)M * 2 * 4);
    int* cnt = (int*)carve(256); int* off = (int*)carve(256); int* cur = (int*)carve(256);
    int* slot_tok = (int*)carve((size_t)M * 2 * 4); int* slot_out = (int*)carve((size_t)M * 2 * 4);
    float* hmid = (float*)carve((size_t)M * 2 * DE * 4);
    float* yc = (float*)carve((size_t)M * 2 * D * 4);
    (void)ws_size; (void)in_sizes; (void)n_in; (void)out_size;

    k_mod<<<DEPTH * 6 * D / 256, 256, 0, stream>>>(c, ada_w, ada_b, mod);
    k_rope_tab<<<S * 32 / 256, 256, 0, stream>>>(cs, sn);
    const float* xcur = x;
    for (int i = 0; i < DEPTH; ++i) {
        const float* modl = mod + (size_t)i * NB * 6 * D; const int j = i / 2;
        float* x1 = xa; float* x2 = (i == DEPTH - 1) ? out : xb;
        k_modulate<<<M * D / 256, 256, 0, stream>>>(xcur, modl, 0, 1, hb);
        if (i % 2 == 0) {
            k_gemm<0><<<dim3(NQKV_NA / 64, M / 64, 1), 256, 0, stream>>>(hb, nullptr, D, na_wqkv + (size_t)j * D * NQKV_NA, nullptr, NQKV_NA, 0, qkv, nullptr, NQKV_NA, M, nullptr, nullptr, D);
            k_na_attn<<<M * H / 4, 256, 0, stream>>>(qkv, na_rpb + (size_t)j * H * 15 * 31, ob);
            k_gemm<0><<<dim3(D / 64, M / 64, 1), 256, 0, stream>>>(ob, nullptr, D, na_wo + (size_t)j * D * D, nullptr, D, 0, yb, nullptr, D, M, nullptr, nullptr, D);
        } else {
            k_gemm<0><<<dim3(NQKV_GQA / 64, M / 64, 1), 256, 0, stream>>>(hb, nullptr, D, gq_wqkv + (size_t)j * D * NQKV_GQA, nullptr, NQKV_GQA, 0, qkv, nullptr, NQKV_GQA, M, nullptr, nullptr, D);
            k_gqa_prep<<<M * 20 / 4, 256, 0, stream>>>(qkv, gq_qn + j * HD, gq_kn + j * HD, cs, sn, qh, kh);
            k_gqa_attn<<<M * H / 4, 256, 0, stream>>>(qh, kh, qkv, ob);
            k_gemm<0><<<dim3(D / 64, M / 64, 1), 256, 0, stream>>>(ob, nullptr, D, gq_wo + (size_t)j * D * D, nullptr, D, 0, yb, nullptr, D, M, nullptr, nullptr, D);
        }
        k_ln<<<M / 4, 256, 0, stream>>>(xcur, yb, nullptr, nullptr, modl, 2, ln_g + (size_t)(i * 2 + 0) * D, ln_b + (size_t)(i * 2 + 0) * D, x1);
        k_modulate<<<M * D / 256, 256, 0, stream>>>(x1, modl, 3, 4, hb);
        hipMemsetAsync(cnt, 0, 256, stream);
        k_router<<<M / 4, 256, 0, stream>>>(hb, m_wg + (size_t)i * D * NG, m_bg + i * NG, m_we + (size_t)i * D * NE, m_be + i * NE, eid, gates, cnt);
        k_prefix<<<1, 64, 0, stream>>>(cnt, off, cur);
        k_fill<<<M * 2 / 256, 256, 0, stream>>>(eid, off, cur, slot_tok, slot_out);
        k_gemm<1><<<dim3(DE / 64, M / 64, NE), 256, 0, stream>>>(hb, slot_tok, D, m_gate + (size_t)i * NE * D * DE, m_up + (size_t)i * NE * D * DE, DE, (size_t)D * DE,
                                                                   hmid, nullptr, DE, 0, cnt, off, D);
        k_gemm<0><<<dim3(D / 64, M / 64, NE), 256, 0, stream>>>(hmid, nullptr, DE, m_down + (size_t)i * NE * DE * D, nullptr, D, (size_t)DE * D,
                                                                  yc, slot_out, D, 0, cnt, off, DE);
        k_ln<<<M / 4, 256, 0, stream>>>(x1, nullptr, yc, gates, modl, 5, ln_g + (size_t)(i * 2 + 1) * D, ln_b + (size_t)(i * 2 + 1) * D, x2);
        xcur = x2;
    }
}
```

```cpp
#include <hip/hip_runtime.h>
#include <hip/hip_cooperative_groups.h>
#include <cstdio>
#include <cstdint>
namespace cg = cooperative_groups;
namespace pg8 {
#define PG8_LAS __attribute__((address_space(3)))
typedef unsigned short bf16_t;
typedef short bf16x8 __attribute__((ext_vector_type(8)));
typedef float f32x4 __attribute__((ext_vector_type(4)));
typedef unsigned u32x4 __attribute__((ext_vector_type(4)));
constexpr int BM = 256, BK = 64, HALF = 128, HTB = HALF * BK * 2  , STAGE_BYTES = 8 * HTB, NXCD = 8, WGM = 8;

__host__ __device__ __forceinline__ int lds_byte(int r, int c) { const int st = (r >> 4) * 2 + (c >> 5), rr = r & 15, cc = c & 31, ob = rr * 64 + cc * 2; return st * 1024 + (ob ^ (((ob >> 9) & 1) << 5)); }
__host__ __device__ __forceinline__ void stage_rc(int b, int& R, int& C) { const int st = b / 1024, sb = b % 1024, swz = sb ^ (((sb >> 9) & 1) << 5); R = (st >> 1) * 16 + swz / 64; C = (st & 1) * 32 + (swz % 64) / 2; }
__host__ __device__ __forceinline__ int perm32(int rho) { const int n = rho >> 4, i = rho & 15; return 8 * (i >> 2) + 4 * n + (i & 3); }

struct Unit { int pm, pn; };
struct Gemm { const bf16_t* A; const bf16_t* Bt; int M, N, K; };

struct StaticOrder {
    int nM, nN, nwg, G, c;
    __host__ __device__ void init(int M, int N, int G_, int c_) { nM = M / BM; nN = N / BM; nwg = nM * nN; G = G_; c = c_; }
    __host__ __device__ bool next(int i, Unit& u) const {
        const long L = (long)i * G + c; if (L >= nwg) return false;
        int wgid = (int)L; { const int q = nwg / NXCD, r = nwg % NXCD, xcd = wgid % NXCD, off = wgid / NXCD; wgid = (xcd < r ? xcd * (q + 1) : r * (q + 1) + (xcd - r) * q) + off; }
        const int nig = WGM * nN, gid = wgid / nig, fm = gid * WGM, gsz = (nM - fm) < WGM ? (nM - fm) : WGM;
        u.pm = fm + ((wgid % nig) % gsz); u.pn = (wgid % nig) / gsz; return true;
    }
    __device__ __forceinline__ void a_ready(const Unit&) const {}
    __device__ __forceinline__ void done(const Unit&) const {}
};

__device__ __forceinline__ unsigned cvt_pk_bf16(float lo, float hi) { unsigned r; asm volatile("v_cvt_pk_bf16_f32 %0, %1, %2" : "=v"(r) : "v"(lo), "v"(hi)); return r; }
__device__ __forceinline__ u32x4 pack8(const f32x4& a, const f32x4& b) { u32x4 w; w.x = cvt_pk_bf16(a[0], a[1]); w.y = cvt_pk_bf16(a[2], a[3]); w.z = cvt_pk_bf16(b[0], b[1]); w.w = cvt_pk_bf16(b[2], b[3]); return w; }

struct EpiStore8 {
    static constexpr bool PERM = false, AFTER_DRAIN = false;
    bf16_t* O; int ldc; int split_cols; size_t split_stride; float scale0; int pn_mask;
    __device__ __forceinline__ void operator()(const f32x4 (&acc)[2][2][4][2], const Unit& u, int wr, int wc, int fr, int fq) const {
        const int row0 = u.pm * BM + wr * 64 + fr; int colt = (u.pn & pn_mask) * BM; bf16_t* base = O;
        float sc = 1.f; if (split_cols) { const int t = colt / split_cols; base += (size_t)t * split_stride; colt -= t * split_cols; if (t == 0) sc = scale0; }
        const int col0 = colt + wc * 32 + 8 * fq;
#pragma unroll
        for (int ai = 0; ai < 2; ++ai)
#pragma unroll
            for (int m = 0; m < 4; ++m) { bf16_t* rowp = base + (size_t)(row0 + ai * HALF + m * 16) * ldc + col0;
#pragma unroll
                for (int bj = 0; bj < 2; ++bj) { const f32x4 v0 = acc[ai][bj][m][0] * sc, v1 = acc[ai][bj][m][1] * sc; *(u32x4*)(rowp + bj * HALF) = pack8(v0, v1); } }
    }
};
__device__ __forceinline__ float silu_f(float g) { return g * __builtin_amdgcn_rcpf(1.f + __expf(-g)); }
struct EpiSwiglu {
    static constexpr bool PERM = false, AFTER_DRAIN = false;
    bf16_t* O;
    __device__ __forceinline__ void operator()(const f32x4 (&acc)[2][2][4][2], const Unit& u, int wr, int wc, int fr, int fq) const {
        const int row0 = u.pm * BM + wr * 64 + fr; const int col0 = (u.pn & 3) * 128 + wc * 32 + 8 * fq;
#pragma unroll
        for (int ai = 0; ai < 2; ++ai)
#pragma unroll
            for (int m = 0; m < 4; ++m) { bf16_t* rowp = O + (size_t)(row0 + ai * HALF + m * 16) * 512 + col0; f32x4 h[2];
#pragma unroll
                for (int n = 0; n < 2; ++n) { const f32x4 g = acc[ai][0][m][n], up = acc[ai][1][m][n];
                    h[n] = (f32x4){silu_f(g[0]) * up[0], silu_f(g[1]) * up[1], silu_f(g[2]) * up[2], silu_f(g[3]) * up[3]}; }
                *(u32x4*)rowp = pack8(h[0], h[1]); }
    }
};
struct EpiGqaQkv {
    static constexpr bool PERM = false, AFTER_DRAIN = false;
    bf16_t *Q, *K, *V; const float* qn; const float* kn; const float* cs; const float* sn; float qscale;
    __device__ __forceinline__ void operator()(const f32x4 (&acc)[2][2][4][2], const Unit& u, int wr, int wc, int fr, int fq) const {
        const int row0 = u.pm * BM + wr * 64 + fr; const int pn = u.pn;
        const int type = pn < 4 ? 0 : (pn == 4 ? 1 : 2);
        bf16_t* base = type == 0 ? Q + (4 * pn + wc) * 64 : (type == 1 ? K : V) + wc * 64; const int ldc = type == 0 ? 1024 : 256;
        const int dlo = 32 * (fq >> 1) + 8 * (fq & 1);
        const int tlo = (fq >> 1) * 16 + 8 * (fq & 1);
        const float* gain = type == 0 ? qn : kn; const float sc = type == 0 ? qscale : 1.f;
        f32x4 gv[2][2];
#pragma unroll
        for (int bj = 0; bj < 2; ++bj)
#pragma unroll
            for (int n = 0; n < 2; ++n) gv[bj][n] = *(const f32x4*)(gain + dlo + 16 * bj + 4 * n) * sc;
#pragma unroll
        for (int ai = 0; ai < 2; ++ai)
#pragma unroll
            for (int m = 0; m < 4; ++m) { const int row = row0 + ai * HALF + m * 16; bf16_t* rowp = base + (size_t)row * ldc + dlo; f32x4 o[2][2];
                if (type < 2) {
                    float ss = 0.f;
#pragma unroll
                    for (int bj = 0; bj < 2; ++bj)
#pragma unroll
                        for (int n = 0; n < 2; ++n) { const f32x4 x = acc[ai][bj][m][n]; ss += (x[0] * x[0] + x[1] * x[1]) + (x[2] * x[2] + x[3] * x[3]); }
                    ss += __shfl_xor(ss, 16); ss += __shfl_xor(ss, 32);
                    const float rinv = rsqrtf(ss * (1.f / 64.f) + 1e-6f);
                    const int t = row & 2047;
#pragma unroll
                    for (int n = 0; n < 2; ++n) { const f32x4 c4 = *(const f32x4*)(cs + t * 32 + tlo + 4 * n), s4 = *(const f32x4*)(sn + t * 32 + tlo + 4 * n);
                        const f32x4 x1 = acc[ai][0][m][n] * rinv * gv[0][n], x2 = acc[ai][1][m][n] * rinv * gv[1][n];
                        o[0][n] = x1 * c4 - x2 * s4; o[1][n] = x2 * c4 + x1 * s4; }
                } else {
#pragma unroll
                    for (int bj = 0; bj < 2; ++bj)
#pragma unroll
                        for (int n = 0; n < 2; ++n) o[bj][n] = acc[ai][bj][m][n];
                }
#pragma unroll
                for (int bj = 0; bj < 2; ++bj) *(u32x4*)(rowp + 16 * bj) = pack8(o[bj][0], o[bj][1]); }
    }
};
template <class Epi, class Sched, bool ALIGN_EPI = false, bool SP2 = false>
__device__ __forceinline__ void gemm_phase(PG8_LAS unsigned char* lds, const Gemm g, const Sched& S, const Epi& E) {
    int tid_ = threadIdx.x; asm volatile("" : "+v"(tid_)); const int tid = tid_, wid = __builtin_amdgcn_readfirstlane(tid >> 6), lane = tid & 63, wr = wid >> 2, wc = wid & 3, fr = lane & 15, fq = lane >> 4;
    const int K = g.K, nt = K / BK;
    unsigned voffA[2], voffB[2];
#pragma unroll
    for (int i = 0; i < 2; ++i) { int R, C; stage_rc(tid * 16 + i * 8192, R, C); const int Rb = Epi::PERM ? ((R & ~31) + perm32(R & 31)) : R;
        voffA[i] = (unsigned)(R * K + C) * 2u; voffB[i] = (unsigned)(Rb * K + C) * 2u; }
    const size_t kstep = (size_t)(BK * 2);
    const size_t hstep = (size_t)HALF * K * 2;
    const size_t tstep = 2 * hstep;
    const unsigned ldsw = (unsigned)wid * 1024u;
    const int aoff = lds_byte(wr * 64 + fr, fq * 8), boff = lds_byte(wc * 32 + fr, fq * 8);
#define PG8_SA(b, h) (((b) * 2 + (h)) * HTB)
#define PG8_SB(b, h) ((4 + (b) * 2 + (h)) * HTB)
#define PG8_STAGE(bufoff, gbase, voff) do { _Pragma("unroll") for (int _i = 0; _i < 2; ++_i) \
        __builtin_amdgcn_global_load_lds((const unsigned*)((const char*)(gbase) + (voff)[_i]), (PG8_LAS unsigned*)(lds + (bufoff) + ldsw + _i * 8192), 16, 0, 0); } while (0)
#define PG8_LDA(dst, b, h) do { _Pragma("unroll") for (int m = 0; m < 4; ++m) _Pragma("unroll") for (int k = 0; k < 2; ++k) dst[m][k] = *(const PG8_LAS bf16x8*)(lds + PG8_SA(b, h) + aoff + m * 2048 + k * 1024); } while (0)
#define PG8_LDB(dst, b, h) do { _Pragma("unroll") for (int n = 0; n < 2; ++n) _Pragma("unroll") for (int k = 0; k < 2; ++k) dst[n][k] = *(const PG8_LAS bf16x8*)(lds + PG8_SB(b, h) + boff + n * 2048 + k * 1024); } while (0)
#define PG8_MMA(ai, bj, At, Bt) do { __builtin_amdgcn_s_setprio(1); _Pragma("unroll") for (int m = 0; m < 4; ++m) _Pragma("unroll") for (int n = 0; n < 2; ++n) _Pragma("unroll") for (int k = 0; k < 2; ++k) \
        acc[ai][bj][m][n] = __builtin_amdgcn_mfma_f32_16x16x32_bf16(Bt[n][k], At[m][k], acc[ai][bj][m][n], 0, 0, 0); __builtin_amdgcn_s_setprio(0); } while (0)
#define PG8_WAIT_V(n) asm volatile("s_waitcnt vmcnt(" #n ")" ::: "memory")
#define PG8_WAIT_L(n) asm volatile("s_waitcnt lgkmcnt(" #n ")" ::: "memory")
#define PG8_BAR __builtin_amdgcn_s_barrier()
#define PG8_SCHED __builtin_amdgcn_sched_barrier(0)
    Unit cur, nxt; int ui = 0;
    if (!S.next(0, cur)) return;
    f32x4 acc[2][2][4][2];
#pragma unroll
    for (int a = 0; a < 2; ++a)
#pragma unroll
        for (int b = 0; b < 2; ++b)
#pragma unroll
            for (int m = 0; m < 4; ++m)
#pragma unroll
                for (int n = 0; n < 2; ++n) acc[a][b][m][n] = (f32x4){0.f, 0.f, 0.f, 0.f};
    bf16x8 At[4][2], B0[2][2], B1[2][2];
    const char* cA = (const char*)g.A + (size_t)cur.pm * tstep; const char* cB = (const char*)g.Bt + (size_t)cur.pn * tstep;
    S.a_ready(cur);
    if constexpr (SP2) {
        PG8_STAGE(PG8_SB(0, 0), cB, voffB); PG8_STAGE(PG8_SB(0, 1), cB + hstep, voffB); PG8_STAGE(PG8_SA(0, 0), cA, voffA); PG8_STAGE(PG8_SA(0, 1), cA + hstep, voffA);
        if (wr == 1) PG8_BAR;
        PG8_WAIT_V(2); PG8_BAR;
        PG8_STAGE(PG8_SB(1, 0), cB + kstep, voffB); PG8_STAGE(PG8_SA(1, 0), cA + kstep, voffA); PG8_STAGE(PG8_SB(1, 1), cB + hstep + kstep, voffB);
        PG8_WAIT_V(6); PG8_BAR;
    } else {
        PG8_STAGE(PG8_SB(0, 0), cB, voffB); PG8_STAGE(PG8_SA(0, 0), cA, voffA); PG8_STAGE(PG8_SB(0, 1), cB + hstep, voffB); PG8_STAGE(PG8_SA(0, 1), cA + hstep, voffA);
        if (wr == 1) PG8_BAR;
        PG8_WAIT_V(4); PG8_BAR;
        PG8_STAGE(PG8_SB(1, 0), cB + kstep, voffB); PG8_STAGE(PG8_SA(1, 0), cA + kstep, voffA); PG8_STAGE(PG8_SB(1, 1), cB + hstep + kstep, voffB);
        PG8_WAIT_V(6); PG8_BAR;
    }
    for (;;) {
        const bool has_next = S.next(ui + 1, nxt);
        const char* nA = has_next ? (const char*)g.A + (size_t)nxt.pm * tstep : cA; const char* nB = has_next ? (const char*)g.Bt + (size_t)nxt.pn * tstep : cB;
        for (int t = 0; t < nt; t += 2) {
            const bool last = (t == nt - 2);
            const char* a1 = cA + (size_t)(t + 1) * kstep;
            const char* a2 = last ? nA : cA + (size_t)(t + 2) * kstep; const char* b2 = last ? nB : cB + (size_t)(t + 2) * kstep;
            const char* a3 = a2 + kstep; const char* b3 = b2 + kstep;
            if (last && has_next) S.a_ready(nxt);
            if constexpr (SP2) {
            PG8_LDB(B0, 0, 0); PG8_LDB(B1, 0, 1); PG8_SCHED; PG8_LDA(At, 0, 0); PG8_STAGE(PG8_SA(1, 1), a1 + hstep, voffA);
            PG8_WAIT_V(8); PG8_WAIT_L(0); PG8_BAR; PG8_MMA(0, 0, At, B0); PG8_MMA(0, 1, At, B1); PG8_BAR; PG8_SCHED;
            PG8_LDA(At, 0, 1); PG8_STAGE(PG8_SB(0, 0), b2, voffB); PG8_STAGE(PG8_SB(0, 1), b2 + hstep, voffB); PG8_STAGE(PG8_SA(0, 0), a2, voffA);
            PG8_WAIT_V(8); PG8_WAIT_L(0); PG8_BAR; PG8_MMA(1, 0, At, B0); PG8_MMA(1, 1, At, B1); PG8_BAR; PG8_SCHED;
            PG8_LDB(B0, 1, 0); PG8_LDB(B1, 1, 1); PG8_SCHED; PG8_LDA(At, 1, 0); PG8_STAGE(PG8_SA(0, 1), a2 + hstep, voffA);
            PG8_WAIT_V(8); PG8_WAIT_L(0); PG8_BAR; PG8_MMA(0, 0, At, B0); PG8_MMA(0, 1, At, B1); PG8_BAR; PG8_SCHED;
            PG8_LDA(At, 1, 1); PG8_STAGE(PG8_SB(1, 0), b3, voffB); PG8_STAGE(PG8_SB(1, 1), b3 + hstep, voffB); PG8_STAGE(PG8_SA(1, 0), a3, voffA);
            PG8_WAIT_V(8); PG8_WAIT_L(0); PG8_BAR; PG8_MMA(1, 0, At, B0); PG8_MMA(1, 1, At, B1); PG8_BAR; PG8_SCHED;
            } else {
            PG8_LDB(B0, 0, 0); PG8_SCHED; PG8_LDA(At, 0, 0); PG8_STAGE(PG8_SA(1, 1), a1 + hstep, voffA);
            PG8_WAIT_L(8); PG8_BAR; PG8_WAIT_L(0); PG8_MMA(0, 0, At, B0); PG8_BAR; PG8_SCHED;
            PG8_LDB(B1, 0, 1); PG8_STAGE(PG8_SB(0, 0), b2, voffB);
            PG8_BAR; PG8_WAIT_L(0); PG8_MMA(0, 1, At, B1); PG8_BAR;
            PG8_LDA(At, 0, 1); PG8_STAGE(PG8_SA(0, 0), a2, voffA);
            PG8_BAR; PG8_WAIT_L(0); PG8_MMA(1, 0, At, B0); PG8_BAR; PG8_SCHED;
            PG8_STAGE(PG8_SB(0, 1), b2 + hstep, voffB);
            PG8_WAIT_V(6); PG8_BAR; PG8_MMA(1, 1, At, B1); PG8_BAR;
            PG8_LDB(B0, 1, 0); PG8_SCHED; PG8_LDA(At, 1, 0); PG8_STAGE(PG8_SA(0, 1), a2 + hstep, voffA);
            PG8_WAIT_L(8); PG8_BAR; PG8_WAIT_L(0); PG8_MMA(0, 0, At, B0); PG8_BAR; PG8_SCHED;
            PG8_LDB(B1, 1, 1); PG8_STAGE(PG8_SB(1, 0), b3, voffB);
            PG8_BAR; PG8_WAIT_L(0); PG8_MMA(0, 1, At, B1); PG8_BAR;
            PG8_LDA(At, 1, 1); PG8_STAGE(PG8_SA(1, 0), a3, voffA);
            PG8_BAR; PG8_WAIT_L(0); PG8_MMA(1, 0, At, B0); PG8_BAR; PG8_SCHED;
            PG8_STAGE(PG8_SB(1, 1), b3 + hstep, voffB);
            PG8_WAIT_V(6); PG8_BAR; PG8_MMA(1, 1, At, B1); PG8_BAR;
            }
        }
        if constexpr (ALIGN_EPI) { if (wr == 0) PG8_BAR; }
        if constexpr (!Epi::AFTER_DRAIN) { E(acc, cur, wr, wc, fr, fq); S.done(cur); }
        if (!has_next) break;
#pragma unroll
        for (int a = 0; a < 2; ++a)
#pragma unroll
            for (int b = 0; b < 2; ++b)
#pragma unroll
                for (int m = 0; m < 4; ++m)
#pragma unroll
                    for (int n = 0; n < 2; ++n) acc[a][b][m][n] = (f32x4){0.f, 0.f, 0.f, 0.f};
        cur = nxt; cA = nA; cB = nB; ++ui;
        if constexpr (ALIGN_EPI) { if (wr == 1) PG8_BAR; }
    }
    PG8_WAIT_V(0);
    if constexpr (!ALIGN_EPI) { if (wr == 0) PG8_BAR; }
    PG8_BAR;
    if constexpr (Epi::AFTER_DRAIN) { E.fused(acc, cur, wr, wc, fr, fq, lds, wid, lane); S.done(cur); }
#undef PG8_SA
#undef PG8_SB
#undef PG8_STAGE
#undef PG8_LDA
#undef PG8_LDB
#undef PG8_MMA
#undef PG8_WAIT_V
#undef PG8_WAIT_L
#undef PG8_BAR
#undef PG8_SCHED
}
}
constexpr int NWAVES = 8, NTHREADS = 512;
constexpr int D = 1024, NB = 8, S = 2048, M = NB * S, DEPTH = 4, NH = 16, HD = 64, GW = 64, ROWS = 32;
constexpr int KVD = 256, NE = 32, NG = 4, EPG = 8, DE = 512, NQKV_NA = 3072, NQKV_GQ = 1536, NRT = 36;
constexpr float ALPHA = 1.6817928305074290f, LN_EPS = 1e-5f;
constexpr float LOG2E = 1.4426950408889634f, C2 = 0.125f * 1.4426950408889634f;
constexpr int MAXTILES = 160;

constexpr size_t MiB = 1u << 20;
constexpr size_t WS_CTL = 0, CTL_ZERO_BYTES = 1 * MiB;
constexpr size_t WS_MOD = 1 * MiB, WS_ROPE = 2 * MiB, WS_WRT = 3 * MiB;
constexpr size_t WS_WQKV_NA = 4 * MiB, WS_WO_NA = 16 * MiB, WS_WQKV_GQ = 20 * MiB, WS_WO_GQ = 26 * MiB;
constexpr size_t WS_WGU = 32 * MiB, WS_WDN = 96 * MiB;
constexpr size_t WS_X1 = 128 * MiB, WS_X2 = 192 * MiB, WS_H = 256 * MiB, WS_Q = 288 * MiB, WS_K = 320 * MiB, WS_V = 352 * MiB, WS_Y = 384 * MiB;
constexpr size_t WS_XS = 416 * MiB, WS_HMID = 496 * MiB, WS_YS = 536 * MiB, WS_ROUTE = 616 * MiB, WS_END = 620 * MiB;
constexpr int CW_CNT = 8192;

constexpr int RING_BYTES = 131072, MISC_OFF = RING_BYTES, LDS_BYTES = 147456;

#define LAS __attribute__((address_space(3)))
typedef unsigned short bf16;
typedef unsigned v4u __attribute__((ext_vector_type(4)));
typedef unsigned v2u __attribute__((ext_vector_type(2)));
typedef float f32x4 __attribute__((ext_vector_type(4)));
#define RLX_AGENT __ATOMIC_RELAXED, __HIP_MEMORY_SCOPE_AGENT
__device__ __forceinline__ unsigned f2bf(float f) { unsigned u = __builtin_bit_cast(unsigned, f); return (u + 0x7fffu + ((u >> 16) & 1u)) >> 16; }
__device__ __forceinline__ unsigned pk2(float lo, float hi) { return f2bf(lo) | (f2bf(hi) << 16); }
__device__ __forceinline__ float bflo(unsigned w) { return __uint_as_float(w << 16); }
__device__ __forceinline__ float bfhi(unsigned w) { return __uint_as_float(w & 0xffff0000u); }
__device__ __forceinline__ float bf2f(bf16 v) { return __uint_as_float((unsigned)v << 16); }
__device__ __forceinline__ float wave_sum(float v) {
#pragma unroll
    for (int o = 1; o < 64; o <<= 1) v += __shfl_xor(v, o);
    return v;
}

struct Args { const float* in[20]; float* out; unsigned char* ws; };

__device__ __forceinline__ int rho_p8(int cc) { return (cc & 128) + (cc & 96) + 16 * ((cc >> 2) & 1) + 4 * ((cc >> 3) & 3) + (cc & 3); }
__device__ __forceinline__ int rho_head(int cc) { const int wc = cc >> 6, fq = 2 * ((cc >> 5) & 1) + ((cc >> 3) & 1), bj = (cc >> 4) & 1; return 128 * bj + 32 * wc + 16 * ((cc >> 2) & 1) + 4 * fq + (cc & 3); }
__device__ __forceinline__ int dest_row(int mode, int c) {
    if (mode == 0) return (c & ~255) + rho_p8(c & 255);
    if (mode == 1) return (c & ~255) + rho_head(c & 255);
    const int jj = c & 127; return (c >> 7) * 256 + (mode == 3 ? 128 : 0) + (jj & 96) + 16 * ((jj >> 2) & 1) + 4 * ((jj >> 3) & 3) + (jj & 3);
}
__device__ __forceinline__ void transpose_item(const float* __restrict__ W, int K, int N, bf16* __restrict__ WT, int mode, LAS float* scr, int item, int lane) {
    const int nblk = N / 32, kb = item / nblk, nb = item % nblk, k0 = 64 * kb, n0 = 32 * nb;
#pragma unroll 8
    for (int i = 0; i < 32; ++i) { const int kk = 2 * i + (lane >> 5); scr[kk * 33 + (lane & 31)] = W[(size_t)(k0 + kk) * N + n0 + (lane & 31)]; }
    asm volatile("s_waitcnt lgkmcnt(0)" ::: "memory");
    const int c = lane & 7;
#pragma unroll
    for (int j = 0; j < 4; ++j) { const int n = (lane >> 3) + 8 * j; const LAS float* s = scr + (8 * c) * 33 + n;
        v4u o; o.x = pk2(s[0 * 33], s[1 * 33]); o.y = pk2(s[2 * 33], s[3 * 33]); o.z = pk2(s[4 * 33], s[5 * 33]); o.w = pk2(s[6 * 33], s[7 * 33]);
        *(v4u*)(WT + (size_t)dest_row(mode, n0 + n) * K + k0 + 8 * c) = o; }
    asm volatile("s_waitcnt lgkmcnt(0)" ::: "memory");
}
__device__ __forceinline__ void moe_weight_items(const float* __restrict__ wgate, const float* __restrict__ wup, const float* __restrict__ wdown, int layer,
                                                 bf16* __restrict__ Wgu, bf16* __restrict__ Wdn, LAS float* scr, int gw, int NGW, int lane) {
    for (int it = gw; it < NE * 768; it += NGW) {
        const int e = it / 768, r = it % 768, which = r >> 8, sub = r & 255; const size_t le = (size_t)layer * NE + e;
        if (which == 0) transpose_item(wgate + le * D * DE, D, DE, Wgu + (size_t)e * D * D, 2, scr, sub, lane);
        else if (which == 1) transpose_item(wup + le * D * DE, D, DE, Wgu + (size_t)e * D * D, 3, scr, sub, lane);
        else transpose_item(wdown + le * DE * D, DE, D, Wdn + (size_t)e * D * DE, 0, scr, sub, lane);
    }
}

struct MoeOrder {
    int nunits, G, c; const LAS int* tile_e;
    __device__ __forceinline__ bool next(int i, pg8::Unit& u) const {
        const long L = (long)i * G + c; if (L >= nunits) return false;
        const int pm = (int)(L >> 2); u.pm = pm; u.pn = __builtin_amdgcn_readfirstlane(tile_e[pm]) * 4 + (int)(L & 3); return true;
    }
    __device__ __forceinline__ void a_ready(const pg8::Unit&) const {}
    __device__ __forceinline__ void done(const pg8::Unit&) const {}
};
__device__ __forceinline__ void build_tiles(const unsigned* cnt, LAS int* misc, int tid) {
    if (tid == 0) { int s = 0;
        for (int e = 0; e < NE; ++e) { misc[e] = s; const int c = (int)__hip_atomic_load(cnt + e, RLX_AGENT); const int nt = (c + 255) >> 8;
            for (int t = 0; t < nt; ++t) if (s + t < MAXTILES) misc[64 + s + t] = e; s += nt; }
        misc[32] = s; misc[33] = s < MAXTILES ? s : MAXTILES; }
    __syncthreads();
}

__device__ __forceinline__ void na_attn_simple(const bf16* Qb, const bf16* Kb, const bf16* Vb, bf16* Ob, const float* __restrict__ rpb, int gw, int NGW, int lane) {
    for (int w = gw; w < M * NH; w += NGW) {
        const int m = w >> 4, h = w & 15, b = m >> 11, t = m & 2047, r = t >> 6, c = t & 63;
        const int rs = min(max(r - 4, 0), ROWS - 8), wsx = min(max(c - 8, 0), GW - 16);
        const float q = bf2f(Qb[(size_t)m * D + h * HD + lane]);
        float mx = -INFINITY, l = 0.f, acc = 0.f;
        for (int kr = 0; kr < 8; ++kr)
            for (int kc = 0; kc < 16; ++kc) {
                const int krow = rs + kr, kcol = wsx + kc; const size_t tok = (size_t)b * S + krow * GW + kcol;
                const float kv = bf2f(Kb[tok * D + h * HD + lane]), vv = bf2f(Vb[tok * D + h * HD + lane]);
                const int dr = krow - r + 7, dc = min(max(kcol - c + 15, 0), 30);
                const float s = wave_sum(q * kv) + rpb[(h * 15 + dr) * 31 + dc] * LOG2E;
                const float mn = fmaxf(mx, s), al = __builtin_amdgcn_exp2f(mx - mn), p = __builtin_amdgcn_exp2f(s - mn);
                l = l * al + p; acc = acc * al + p * vv; mx = mn;
            }
        Ob[(size_t)m * D + h * HD + lane] = (bf16)f2bf(acc / l);
    }
}
__device__ __forceinline__ void gqa_attn_simple(const bf16* Qb, const bf16* Kb, const bf16* Vb, bf16* Ob, int gw, int NGW, int lane) {
    for (int w = gw; w < M * NH; w += NGW) {
        const int m = w >> 4, h = w & 15, b = m >> 11, kvh = h >> 2;
        const float q = bf2f(Qb[(size_t)m * D + h * HD + lane]);
        float mx = -INFINITY, l = 0.f, acc = 0.f;
        const bf16* kp = Kb + (size_t)b * S * KVD + kvh * HD + lane; const bf16* vp = Vb + (size_t)b * S * KVD + kvh * HD + lane;
        for (int j = 0; j < S; ++j) {
            const float kv = bf2f(kp[(size_t)j * KVD]), vv = bf2f(vp[(size_t)j * KVD]);
            const float s = wave_sum(q * kv);
            const float mn = fmaxf(mx, s), al = __builtin_amdgcn_exp2f(mx - mn), p = __builtin_amdgcn_exp2f(s - mn);
            l = l * al + p; acc = acc * al + p * vv; mx = mn;
        }
        Ob[(size_t)m * D + h * HD + lane] = (bf16)f2bf(acc / l);
    }
}
__device__ __forceinline__ unsigned char* ldptr(const LAS unsigned* ptab, int i) {
    const unsigned lo = (unsigned)__builtin_amdgcn_readfirstlane((int)ptab[2 * i]), hi = (unsigned)__builtin_amdgcn_readfirstlane((int)ptab[2 * i + 1]);
    return (unsigned char*)(__attribute__((address_space(1))) unsigned char*)(((unsigned long long)hi << 32) | lo);
}
#define GRID_SYNC() do { cg::this_grid().sync(); asm volatile("" ::: "memory"); } while (0)
#define PH_BEGIN \
    unsigned ldsb_ = (unsigned)(uintptr_t)lds_raw; asm volatile("" : "+s"(ldsb_)); \
    LAS unsigned char* lds = (LAS unsigned char*)ldsb_; LAS int* misc = (LAS int*)(lds + MISC_OFF); LAS unsigned* ptab = (LAS unsigned*)(lds + MISC_OFF + 1024); (void)misc; \
    int tid = threadIdx.x; asm volatile("" : "+v"(tid)); \
    const int lane = tid & 63, wave = __builtin_amdgcn_readfirstlane(tid >> 6); \
    int G = gridDim.x, bid = blockIdx.x; asm volatile("" : "+s"(G), "+s"(bid)); const int gw = bid * NWAVES + wave, NGW = G * NWAVES; \
    unsigned char* ws = ldptr(ptab, 21); (void)lane; (void)gw; (void)NGW; (void)ws;
#define INP(i) ((const float*)ldptr(ptab, (i)))

__global__ void __launch_bounds__(NTHREADS, 2) mk_fwd(Args args) {
    extern __shared__ __attribute__((aligned(16))) unsigned char lds_raw[];
    { LAS unsigned* ptab = (LAS unsigned*)((LAS unsigned char*)lds_raw + MISC_OFF + 1024);
    if (threadIdx.x < 22) { const unsigned long long p = threadIdx.x < 20 ? (unsigned long long)args.in[threadIdx.x] : (threadIdx.x == 20 ? (unsigned long long)args.out : (unsigned long long)args.ws);
        ptab[2 * threadIdx.x] = (unsigned)p; ptab[2 * threadIdx.x + 1] = (unsigned)(p >> 32); } }
    __syncthreads();

    {
        PH_BEGIN
        const float* c_in = INP(1); const float* ada_w = INP(2); const float* ada_b = INP(3);
        float* mod = (float*)(ws + WS_MOD); float* ropec = (float*)(ws + WS_ROPE); float* ropes = ropec + S * 32; float* wrt = (float*)(ws + WS_WRT);
        LAS float* ca = (LAS float*)lds;
        LAS float* red = (LAS float*)(lds + 32768);
        for (int i = tid; i < NB * D; i += NTHREADS) { const float v = c_in[i]; ca[i] = v / (1.f + __expf(-v)); }
        __syncthreads();
        for (int it = bid; it < DEPTH * 192; it += G) {
            const int l = it / 192, col0 = (it % 192) * 32, cl = tid & 31, ks = tid >> 5;
            const float* wp = ada_w + ((size_t)l * D + 64 * ks) * (6 * D) + col0 + cl;
            float acc[NB];
#pragma unroll
            for (int b = 0; b < NB; ++b) acc[b] = 0.f;
#pragma unroll 16
            for (int kk = 0; kk < 64; ++kk) { const float wv = wp[(size_t)kk * (6 * D)];
#pragma unroll
                for (int b = 0; b < NB; ++b) acc[b] += ca[b * D + 64 * ks + kk] * wv; }
#pragma unroll
            for (int b = 0; b < NB; ++b) red[(ks * NB + b) * 32 + cl] = acc[b];
            __syncthreads();
            if (tid < 256) { const int b = tid >> 5; float s = 0.f;
#pragma unroll
                for (int k2 = 0; k2 < 16; ++k2) s += red[(k2 * NB + b) * 32 + cl];
                mod[((size_t)l * NB + b) * (6 * D) + col0 + cl] = s + ada_b[l * 6 * D + col0 + cl]; }
            __syncthreads();
        }
        for (int i = bid * NTHREADS + tid; i < S * 32; i += G * NTHREADS) {
            const int t = i >> 5, a = (i >> 4) & 1, p = i & 15;
            const float pos = (float)(a == 0 ? t / GW : t % GW);
            const float ang = pos * exp2f(-(float)p * (13.287712379549449f / 16.f));
            const float kf = rintf(ang * 0.15915494309189535f);
            float r = fmaf(-kf, 6.2831854820251465f, ang); r = fmaf(-kf, -1.7484555314695172e-07f, r);
            ropec[i] = __cosf(r); ropes[i] = __sinf(r);
        }
        { const float* m_wg = INP(13); const float* m_we = INP(15);
          for (int i = bid * NTHREADS + tid; i < DEPTH * NRT * D; i += G * NTHREADS) {
            const int l = i / (NRT * D), o = (i / D) % NRT, k = i % D;
            wrt[i] = o < NG ? m_wg[((size_t)l * D + k) * NG + o] : m_we[((size_t)l * D + k) * NE + (o - NG)];
          } }
        LAS float* scr = (LAS float*)(lds + 49152 + wave * 8704);
        { const float* na_wqkv = INP(6); const float* na_wo = INP(8); const float* gq_wqkv = INP(9); const float* gq_wo = INP(12);
          bf16* Wqkv_na = (bf16*)(ws + WS_WQKV_NA); bf16* Wo_na = (bf16*)(ws + WS_WO_NA); bf16* Wqkv_gq = (bf16*)(ws + WS_WQKV_GQ); bf16* Wo_gq = (bf16*)(ws + WS_WO_GQ);
          constexpr int I_NQ = 16 * 96, I_O = 16 * 32, I_GQ = 16 * 48, I_DENSE = 2 * (I_NQ + I_O + I_GQ + I_O);
          for (int it = gw; it < I_DENSE; it += NGW) {
            int r = it; const int j = r / (I_DENSE / 2); r %= (I_DENSE / 2);
            if (r < I_NQ) { transpose_item(na_wqkv + (size_t)j * D * NQKV_NA, D, NQKV_NA, Wqkv_na + (size_t)j * NQKV_NA * D, 0, scr, r, lane); continue; } r -= I_NQ;
            if (r < I_O) { transpose_item(na_wo + (size_t)j * D * D, D, D, Wo_na + (size_t)j * D * D, 0, scr, r, lane); continue; } r -= I_O;
            if (r < I_GQ) { transpose_item(gq_wqkv + (size_t)j * D * NQKV_GQ, D, NQKV_GQ, Wqkv_gq + (size_t)j * NQKV_GQ * D, 1, scr, r, lane); continue; } r -= I_GQ;
            transpose_item(gq_wo + (size_t)j * D * D, D, D, Wo_gq + (size_t)j * D * D, 0, scr, r, lane);
          } }
        moe_weight_items(INP(17), INP(18), INP(19), 0, (bf16*)(ws + WS_WGU), (bf16*)(ws + WS_WDN), scr, gw, NGW, lane);
    }
    GRID_SYNC();
    {
        PH_BEGIN
        const float* x_in = INP(0); const float* mod = (const float*)(ws + WS_MOD); bf16* Hb = (bf16*)(ws + WS_H);
        for (int m = gw; m < M; m += NGW) {
            const float* mb = mod + (size_t)(m >> 11) * (6 * D);
#pragma unroll
            for (int j = 0; j < 4; ++j) { const int d = 4 * lane + 256 * j;
                const f32x4 xv = *(const f32x4*)(x_in + (size_t)m * D + d), sh = *(const f32x4*)(mb + d), sc = *(const f32x4*)(mb + D + d);
                const f32x4 hv = xv * (1.f + sc) + sh; v2u o; o.x = pk2(hv[0], hv[1]); o.y = pk2(hv[2], hv[3]);
                *(v2u*)(Hb + (size_t)m * D + d) = o; }
        }
    }
    GRID_SYNC();

    for (int layer = 0; layer < DEPTH; ++layer) {
        {
            PH_BEGIN
            const int j2 = layer >> 1;
            bf16* Hb = (bf16*)(ws + WS_H); bf16* Qb = (bf16*)(ws + WS_Q);
            if ((layer & 1) == 0) {
                pg8::Gemm g{Hb, (bf16*)(ws + WS_WQKV_NA) + (size_t)j2 * NQKV_NA * D, M, NQKV_NA, D}; pg8::StaticOrder So; So.init(M, NQKV_NA, G, bid);
                pg8::EpiStore8 E{Qb, D, D, (size_t)(WS_K - WS_Q) / 2, C2, 0x7fffffff};
                pg8::gemm_phase<pg8::EpiStore8, pg8::StaticOrder, true, true>(lds, g, So, E);
            } else {
                pg8::Gemm g{Hb, (bf16*)(ws + WS_WQKV_GQ) + (size_t)j2 * NQKV_GQ * D, M, NQKV_GQ, D}; pg8::StaticOrder So; So.init(M, NQKV_GQ, G, bid);
                const float* ropec = (const float*)(ws + WS_ROPE);
                pg8::EpiGqaQkv E{Qb, (bf16*)(ws + WS_K), (bf16*)(ws + WS_V), INP(10) + j2 * HD, INP(11) + j2 * HD, ropec, ropec + S * 32, C2};
                pg8::gemm_phase<pg8::EpiGqaQkv, pg8::StaticOrder, true, true>(lds, g, So, E);
            }
        }
        GRID_SYNC();
        {
            PH_BEGIN
            bf16* Qb = (bf16*)(ws + WS_Q); const bf16* Kb = (const bf16*)(ws + WS_K); const bf16* Vb = (const bf16*)(ws + WS_V);
            if ((layer & 1) == 0) na_attn_simple(Qb, Kb, Vb, Qb, INP(7) + (size_t)(layer >> 1) * NH * 15 * 31, gw, NGW, lane);
            else gqa_attn_simple(Qb, Kb, Vb, Qb, gw, NGW, lane);
        }
        GRID_SYNC();
        {
            PH_BEGIN
            const bf16* Wo = (const bf16*)(ws + ((layer & 1) == 0 ? WS_WO_NA : WS_WO_GQ)) + (size_t)(layer >> 1) * D * D;
            pg8::Gemm g{(const bf16*)(ws + WS_Q), Wo, M, D, D}; pg8::StaticOrder So; So.init(M, D, G, bid);
            pg8::EpiStore8 E{(bf16*)(ws + WS_Y), D, 0, 0, 1.f, 0x7fffffff};
            pg8::gemm_phase<pg8::EpiStore8, pg8::StaticOrder, true, true>(lds, g, So, E);
        }
        GRID_SYNC();
        {
            PH_BEGIN
            const float* xcur = layer == 0 ? INP(0) : (const float*)(ws + WS_X2);
            const float* modl = (const float*)(ws + WS_MOD) + (size_t)layer * NB * 6 * D;
            unsigned* cnt = (unsigned*)(ws + WS_CTL) + CW_CNT + 64 * layer;
            float* X1 = (float*)(ws + WS_X1); bf16* Hb = (bf16*)(ws + WS_H); const bf16* Yb = (const bf16*)(ws + WS_Y);
            int* r_eid = (int*)(ws + WS_ROUTE); int* r_pos = r_eid + 2 * M; float* r_gate = (float*)(r_pos + 2 * M);
            LAS int* hist = (LAS int*)lds; LAS int* basee = hist + 32; LAS int* rt_e = hist + 64; LAS int* rt_lp = rt_e + 128; LAS float* rt_g = (LAS float*)(rt_lp + 128);
            const float* lg = INP(4) + (size_t)(layer * 2) * D; const float* lb = INP(5) + (size_t)(layer * 2) * D;
            const float* wr = (const float*)(ws + WS_WRT) + (size_t)layer * NRT * D; const float* bgp = INP(14) + layer * NG; const float* bep = INP(16) + layer * NE;
            for (int ch = bid; ch < M / 64; ch += G) {
                if (tid < 32) hist[tid] = 0;
                __syncthreads();
                for (int ti = 0; ti < 8; ++ti) {
                    const int tl = wave * 8 + ti, m = ch * 64 + tl; const float* mb = modl + (size_t)(m >> 11) * (6 * D);
                    f32x4 v[4]; float s = 0.f;
#pragma unroll
                    for (int j = 0; j < 4; ++j) { const int d = 4 * lane + 256 * j;
                        const f32x4 xv = *(const f32x4*)(xcur + (size_t)m * D + d), g1 = *(const f32x4*)(mb + 2 * D + d);
                        const v2u yw = *(const v2u*)(Yb + (size_t)m * D + d); const f32x4 yv = {bflo(yw.x), bfhi(yw.x), bflo(yw.y), bfhi(yw.y)};
                        v[j] = ALPHA * xv + (1.f + g1) * yv; s += (v[j][0] + v[j][1]) + (v[j][2] + v[j][3]); }
                    const float mean = wave_sum(s) * (1.f / D); float q = 0.f;
#pragma unroll
                    for (int j = 0; j < 4; ++j) { v[j] = v[j] - mean; q += (v[j][0] * v[j][0] + v[j][1] * v[j][1]) + (v[j][2] * v[j][2] + v[j][3] * v[j][3]); }
                    const float rstd = rsqrtf(wave_sum(q) * (1.f / D) + LN_EPS);
#pragma unroll
                    for (int j = 0; j < 4; ++j) { const int d = 4 * lane + 256 * j;
                        const f32x4 x1 = v[j] * rstd * *(const f32x4*)(lg + d) + *(const f32x4*)(lb + d);
                        *(f32x4*)(X1 + (size_t)m * D + d) = x1;
                        const f32x4 h2 = x1 * (1.f + *(const f32x4*)(mb + 4 * D + d)) + *(const f32x4*)(mb + 3 * D + d);
                        v2u o; o.x = pk2(h2[0], h2[1]); o.y = pk2(h2[2], h2[3]); *(v2u*)(Hb + (size_t)m * D + d) = o;
                        v[j] = h2; }
                    float lgp[NG];
#pragma unroll
                    for (int o = 0; o < NG; ++o) { float a = 0.f;
#pragma unroll
                        for (int j = 0; j < 4; ++j) { const f32x4 w4 = *(const f32x4*)(wr + (size_t)o * D + 4 * lane + 256 * j); a += (v[j][0] * w4[0] + v[j][1] * w4[1]) + (v[j][2] * w4[2] + v[j][3] * w4[3]); }
                        lgp[o] = wave_sum(a) + bgp[o]; }
                    int gi = 0; float gm = lgp[0];
#pragma unroll
                    for (int o = 1; o < NG; ++o) if (lgp[o] > gm) { gm = lgp[o]; gi = o; }
                    float gs = 0.f;
#pragma unroll
                    for (int o = 0; o < NG; ++o) gs += __expf(lgp[o] - gm);
                    const float gprob = 1.f / gs;
                    gi = __builtin_amdgcn_readfirstlane(gi);
                    float le[EPG];
#pragma unroll
                    for (int e = 0; e < EPG; ++e) { float a = 0.f; const float* wp = wr + (size_t)(NG + gi * EPG + e) * D;
#pragma unroll
                        for (int j = 0; j < 4; ++j) { const f32x4 w4 = *(const f32x4*)(wp + 4 * lane + 256 * j); a += (v[j][0] * w4[0] + v[j][1] * w4[1]) + (v[j][2] * w4[2] + v[j][3] * w4[3]); }
                        le[e] = wave_sum(a) + bep[gi * EPG + e]; }
                    int i0 = 0; float m0 = le[0];
#pragma unroll
                    for (int e = 1; e < EPG; ++e) if (le[e] > m0) { m0 = le[e]; i0 = e; }
                    int i1 = 0; float m1 = -INFINITY;
#pragma unroll
                    for (int e = 0; e < EPG; ++e) if (e != i0 && le[e] > m1) { m1 = le[e]; i1 = e; }
                    const float p1 = __expf(m1 - m0), den = 1.f + p1;
                    if (lane == 0) { const int e0 = gi * EPG + i0, e1 = gi * EPG + i1;
                        rt_e[2 * tl] = e0; rt_e[2 * tl + 1] = e1; rt_g[2 * tl] = gprob / den; rt_g[2 * tl + 1] = gprob * p1 / den;
                        rt_lp[2 * tl] = atomicAdd((int*)&hist[e0], 1); rt_lp[2 * tl + 1] = atomicAdd((int*)&hist[e1], 1); }
                }
                __syncthreads();
                if (tid < 32) { const int c = hist[tid]; basee[tid] = c ? (int)__hip_atomic_fetch_add(cnt + tid, (unsigned)c, RLX_AGENT) : 0; }
                __syncthreads();
                if (tid < 128) { const int e = rt_e[tid], A = ch * 128 + tid; r_eid[A] = e; r_pos[A] = basee[e] + rt_lp[tid]; r_gate[A] = rt_g[tid]; }
                __syncthreads();
            }
        }
        GRID_SYNC();
        {
            PH_BEGIN
            const unsigned* cnt = (const unsigned*)(ws + WS_CTL) + CW_CNT + 64 * layer;
            const bf16* Hb = (const bf16*)(ws + WS_H); bf16* XS = (bf16*)(ws + WS_XS);
            const int* r_eid = (const int*)(ws + WS_ROUTE); const int* r_pos = r_eid + 2 * M;
            build_tiles(cnt, misc, tid);
            for (int m = gw; m < M; m += NGW) {
                const v4u a0 = *(const v4u*)(Hb + (size_t)m * D + 8 * lane), a1 = *(const v4u*)(Hb + (size_t)m * D + 512 + 8 * lane);
#pragma unroll
                for (int k = 0; k < 2; ++k) { const int e = r_eid[2 * m + k], slot = misc[e] * 256 + r_pos[2 * m + k];
                    *(v4u*)(XS + (size_t)slot * D + 8 * lane) = a0; *(v4u*)(XS + (size_t)slot * D + 512 + 8 * lane) = a1; }
            }
        }
        GRID_SYNC();
        {
            PH_BEGIN
            const int ntiles = __builtin_amdgcn_readfirstlane(misc[33]);
            pg8::Gemm g{(const bf16*)(ws + WS_XS), (const bf16*)(ws + WS_WGU), ntiles * 256, NE * D, D}; MoeOrder So{ntiles * 4, G, bid, misc + 64};
            pg8::EpiSwiglu E{(bf16*)(ws + WS_HMID)};
            pg8::gemm_phase<pg8::EpiSwiglu, MoeOrder, true, true>(lds, g, So, E);
        }
        GRID_SYNC();
        {
            PH_BEGIN
            const int ntiles = __builtin_amdgcn_readfirstlane(misc[33]);
            pg8::Gemm g{(const bf16*)(ws + WS_HMID), (const bf16*)(ws + WS_WDN), ntiles * 256, NE * D, DE}; MoeOrder So{ntiles * 4, G, bid, misc + 64};
            pg8::EpiStore8 E{(bf16*)(ws + WS_YS), D, 0, 0, 1.f, 3};
            pg8::gemm_phase<pg8::EpiStore8, MoeOrder, true, true>(lds, g, So, E);
        }
        GRID_SYNC();
        {
            PH_BEGIN
            const float* lg = INP(4) + (size_t)(layer * 2 + 1) * D; const float* lb = INP(5) + (size_t)(layer * 2 + 1) * D;
            const bool last = layer == DEPTH - 1; float* xo = last ? (float*)ldptr(ptab, 20) : (float*)(ws + WS_X2);
            const float* modl = (const float*)(ws + WS_MOD) + (size_t)layer * NB * 6 * D; const float* modn = modl + (size_t)NB * 6 * D;
            const float* X1 = (const float*)(ws + WS_X1); bf16* Hb = (bf16*)(ws + WS_H); const bf16* YS = (const bf16*)(ws + WS_YS);
            const int* r_eid = (const int*)(ws + WS_ROUTE); const int* r_pos = r_eid + 2 * M; const float* r_gate = (const float*)(r_pos + 2 * M);
            for (int m = gw; m < M; m += NGW) {
                const float* mb = modl + (size_t)(m >> 11) * (6 * D); const float* mn = modn + (size_t)(m >> 11) * (6 * D);
                const int s0 = misc[r_eid[2 * m]] * 256 + r_pos[2 * m], s1 = misc[r_eid[2 * m + 1]] * 256 + r_pos[2 * m + 1];
                const float g0 = r_gate[2 * m], g1v = r_gate[2 * m + 1];
                f32x4 v[4]; float s = 0.f;
#pragma unroll
                for (int j = 0; j < 4; ++j) { const int d = 4 * lane + 256 * j;
                    const f32x4 xv = *(const f32x4*)(X1 + (size_t)m * D + d), g2 = *(const f32x4*)(mb + 5 * D + d);
                    const v2u ya = *(const v2u*)(YS + (size_t)s0 * D + d), yb = *(const v2u*)(YS + (size_t)s1 * D + d);
                    const f32x4 y0 = {bflo(ya.x), bfhi(ya.x), bflo(ya.y), bfhi(ya.y)}, y1 = {bflo(yb.x), bfhi(yb.x), bflo(yb.y), bfhi(yb.y)};
                    v[j] = ALPHA * xv + (1.f + g2) * (g0 * y0 + g1v * y1); s += (v[j][0] + v[j][1]) + (v[j][2] + v[j][3]); }
                const float mean = wave_sum(s) * (1.f / D); float q = 0.f;
#pragma unroll
                for (int j = 0; j < 4; ++j) { v[j] = v[j] - mean; q += (v[j][0] * v[j][0] + v[j][1] * v[j][1]) + (v[j][2] * v[j][2] + v[j][3] * v[j][3]); }
                const float rstd = rsqrtf(wave_sum(q) * (1.f / D) + LN_EPS);
#pragma unroll
                for (int j = 0; j < 4; ++j) { const int d = 4 * lane + 256 * j;
                    const f32x4 x2 = v[j] * rstd * *(const f32x4*)(lg + d) + *(const f32x4*)(lb + d);
                    *(f32x4*)(xo + (size_t)m * D + d) = x2;
                    if (!last) { const f32x4 hn = x2 * (1.f + *(const f32x4*)(mn + D + d)) + *(const f32x4*)(mn + d);
                        v2u o; o.x = pk2(hn[0], hn[1]); o.y = pk2(hn[2], hn[3]); *(v2u*)(Hb + (size_t)m * D + d) = o; } }
            }
            if (!last) { LAS float* scr = (LAS float*)(lds + wave * 8704); moe_weight_items(INP(17), INP(18), INP(19), layer + 1, (bf16*)(ws + WS_WGU), (bf16*)(ws + WS_WDN), scr, gw, NGW, lane); }
        }
        if (layer != DEPTH - 1) GRID_SYNC();
    }
}

extern "C" void kernel_launch(void* const* d_in, const int* in_sizes, int n_in, void* d_out, int out_size, void* d_ws, size_t ws_size, hipStream_t stream) {
    static int grid = 0;
    if (grid == 0) {
        if (n_in != 20 || ws_size < WS_END) { fprintf(stderr, "kernel_launch: unexpected inputs (n_in %d, ws %zu)\n", n_in, ws_size); grid = -1; return; }
        int dev = 0, cus = 0, per_cu = 0;
        if (hipGetDevice(&dev) != hipSuccess || hipDeviceGetAttribute(&cus, hipDeviceAttributeMultiprocessorCount, dev) != hipSuccess) { grid = -1; return; }
        if (hipFuncSetAttribute((const void*)mk_fwd, hipFuncAttributeMaxDynamicSharedMemorySize, LDS_BYTES) != hipSuccess) { fprintf(stderr, "kernel_launch: hipFuncSetAttribute failed\n"); grid = -1; return; }
        if (hipOccupancyMaxActiveBlocksPerMultiprocessor(&per_cu, (const void*)mk_fwd, NTHREADS, LDS_BYTES) != hipSuccess || per_cu < 1) { fprintf(stderr, "kernel_launch: occupancy query failed (%d)\n", per_cu); per_cu = 1; }
        (void)hipGetLastError();
        grid = cus * (per_cu < 1 ? 1 : 1);
    }
    if (grid < 0) return;
    (void)in_sizes; (void)out_size;
    if (hipMemsetAsync((char*)d_ws + WS_CTL, 0, CTL_ZERO_BYTES, stream) != hipSuccess) { fprintf(stderr, "kernel_launch: memset failed\n"); return; }
    Args a{};
    for (int i = 0; i < 20; ++i) a.in[i] = (const float*)d_in[i];
    a.out = (float*)d_out; a.ws = (unsigned char*)d_ws;
    void* kargs[] = {&a};
    hipError_t e = hipLaunchCooperativeKernel((const void*)mk_fwd, dim3(grid), dim3(NTHREADS), kargs, LDS_BYTES, stream);
    if (e != hipSuccess) fprintf(stderr, "kernel_launch: cooperative launch failed: %s (grid %d)\n", hipGetErrorString(e), grid);
}
```

```cpp
#include <hip/hip_runtime.h>
#include <hip/hip_cooperative_groups.h>
#include <cstdio>
#include <cstdint>
namespace cg = cooperative_groups;
namespace pg8 {
#define PG8_LAS __attribute__((address_space(3)))
typedef unsigned short bf16_t;
typedef short bf16x8 __attribute__((ext_vector_type(8)));
typedef float f32x4 __attribute__((ext_vector_type(4)));
typedef unsigned u32x4 __attribute__((ext_vector_type(4)));
constexpr int BM = 256, BK = 64, HALF = 128, HTB = HALF * BK * 2  , STAGE_BYTES = 8 * HTB, NXCD = 8, WGM = 8;

__host__ __device__ __forceinline__ int lds_byte(int r, int c) { const int st = (r >> 4) * 2 + (c >> 5), rr = r & 15, cc = c & 31, ob = rr * 64 + cc * 2; return st * 1024 + (ob ^ (((ob >> 9) & 1) << 5)); }
__host__ __device__ __forceinline__ void stage_rc(int b, int& R, int& C) { const int st = b / 1024, sb = b % 1024, swz = sb ^ (((sb >> 9) & 1) << 5); R = (st >> 1) * 16 + swz / 64; C = (st & 1) * 32 + (swz % 64) / 2; }
__host__ __device__ __forceinline__ int perm32(int rho) { const int n = rho >> 4, i = rho & 15; return 8 * (i >> 2) + 4 * n + (i & 3); }

struct Unit { int pm, pn; };
struct Gemm { const bf16_t* A; const bf16_t* Bt; int M, N, K; };

struct StaticOrder {
    int nM, nN, nwg, G, c;
    __host__ __device__ void init(int M, int N, int G_, int c_) { nM = M / BM; nN = N / BM; nwg = nM * nN; G = G_; c = c_; }
    __host__ __device__ bool next(int i, Unit& u) const {
        const long L = (long)i * G + c; if (L >= nwg) return false;
        int wgid = (int)L; { const int q = nwg / NXCD, r = nwg % NXCD, xcd = wgid % NXCD, off = wgid / NXCD; wgid = (xcd < r ? xcd * (q + 1) : r * (q + 1) + (xcd - r) * q) + off; }
        const int nig = WGM * nN, gid = wgid / nig, fm = gid * WGM, gsz = (nM - fm) < WGM ? (nM - fm) : WGM;
        u.pm = fm + ((wgid % nig) % gsz); u.pn = (wgid % nig) / gsz; return true;
    }
    __device__ __forceinline__ void a_ready(const Unit&) const {}
    __device__ __forceinline__ void done(const Unit&) const {}
};

__device__ __forceinline__ unsigned cvt_pk_bf16(float lo, float hi) { unsigned r; asm volatile("v_cvt_pk_bf16_f32 %0, %1, %2" : "=v"(r) : "v"(lo), "v"(hi)); return r; }
__device__ __forceinline__ u32x4 pack8(const f32x4& a, const f32x4& b) { u32x4 w; w.x = cvt_pk_bf16(a[0], a[1]); w.y = cvt_pk_bf16(a[2], a[3]); w.z = cvt_pk_bf16(b[0], b[1]); w.w = cvt_pk_bf16(b[2], b[3]); return w; }

struct EpiStore8 {
    static constexpr bool PERM = false, AFTER_DRAIN = false;
    bf16_t* O; int ldc; int split_cols; size_t split_stride; float scale0; int pn_mask;
    __device__ __forceinline__ void operator()(const f32x4 (&acc)[2][2][4][2], const Unit& u, int wr, int wc, int fr, int fq) const {
        const int row0 = u.pm * BM + wr * 64 + fr; int colt = (u.pn & pn_mask) * BM; bf16_t* base = O;
        float sc = 1.f; if (split_cols) { const int t = colt / split_cols; base += (size_t)t * split_stride; colt -= t * split_cols; if (t == 0) sc = scale0; }
        const int col0 = colt + wc * 32 + 8 * fq;
#pragma unroll
        for (int ai = 0; ai < 2; ++ai)
#pragma unroll
            for (int m = 0; m < 4; ++m) { bf16_t* rowp = base + (size_t)(row0 + ai * HALF + m * 16) * ldc + col0;
#pragma unroll
                for (int bj = 0; bj < 2; ++bj) { const f32x4 v0 = acc[ai][bj][m][0] * sc, v1 = acc[ai][bj][m][1] * sc; *(u32x4*)(rowp + bj * HALF) = pack8(v0, v1); } }
    }
};
__device__ __forceinline__ float silu_f(float g) { return g * __builtin_amdgcn_rcpf(1.f + __expf(-g)); }
struct EpiSwiglu {
    static constexpr bool PERM = false, AFTER_DRAIN = false;
    bf16_t* O;
    __device__ __forceinline__ void operator()(const f32x4 (&acc)[2][2][4][2], const Unit& u, int wr, int wc, int fr, int fq) const {
        const int row0 = u.pm * BM + wr * 64 + fr; const int col0 = (u.pn & 3) * 128 + wc * 32 + 8 * fq;
#pragma unroll
        for (int ai = 0; ai < 2; ++ai)
#pragma unroll
            for (int m = 0; m < 4; ++m) { bf16_t* rowp = O + (size_t)(row0 + ai * HALF + m * 16) * 512 + col0; f32x4 h[2];
#pragma unroll
                for (int n = 0; n < 2; ++n) { const f32x4 g = acc[ai][0][m][n], up = acc[ai][1][m][n];
                    h[n] = (f32x4){silu_f(g[0]) * up[0], silu_f(g[1]) * up[1], silu_f(g[2]) * up[2], silu_f(g[3]) * up[3]}; }
                *(u32x4*)rowp = pack8(h[0], h[1]); }
    }
};
struct EpiGqaQkv {
    static constexpr bool PERM = false, AFTER_DRAIN = false;
    bf16_t *Q, *K, *V; const float* qn; const float* kn; const float* cs; const float* sn; float qscale;
    __device__ __forceinline__ void operator()(const f32x4 (&acc)[2][2][4][2], const Unit& u, int wr, int wc, int fr, int fq) const {
        const int row0 = u.pm * BM + wr * 64 + fr; const int pn = u.pn;
        const int type = pn < 4 ? 0 : (pn == 4 ? 1 : 2);
        bf16_t* base = type == 0 ? Q + (4 * pn + wc) * 64 : (type == 1 ? K : V) + wc * 64; const int ldc = type == 0 ? 1024 : 256;
        const int dlo = 32 * (fq >> 1) + 8 * (fq & 1);
        const int tlo = (fq >> 1) * 16 + 8 * (fq & 1);
        const float* gain = type == 0 ? qn : kn; const float sc = type == 0 ? qscale : 1.f;
        f32x4 gv[2][2];
#pragma unroll
        for (int bj = 0; bj < 2; ++bj)
#pragma unroll
            for (int n = 0; n < 2; ++n) gv[bj][n] = *(const f32x4*)(gain + dlo + 16 * bj + 4 * n) * sc;
#pragma unroll
        for (int ai = 0; ai < 2; ++ai)
#pragma unroll
            for (int m = 0; m < 4; ++m) { const int row = row0 + ai * HALF + m * 16; bf16_t* rowp = base + (size_t)row * ldc + dlo; f32x4 o[2][2];
                if (type < 2) {
                    float ss = 0.f;
#pragma unroll
                    for (int bj = 0; bj < 2; ++bj)
#pragma unroll
                        for (int n = 0; n < 2; ++n) { const f32x4 x = acc[ai][bj][m][n]; ss += (x[0] * x[0] + x[1] * x[1]) + (x[2] * x[2] + x[3] * x[3]); }
                    ss += __shfl_xor(ss, 16); ss += __shfl_xor(ss, 32);
                    const float rinv = rsqrtf(ss * (1.f / 64.f) + 1e-6f);
                    const int t = row & 2047;
#pragma unroll
                    for (int n = 0; n < 2; ++n) { const f32x4 c4 = *(const f32x4*)(cs + t * 32 + tlo + 4 * n), s4 = *(const f32x4*)(sn + t * 32 + tlo + 4 * n);
                        const f32x4 x1 = acc[ai][0][m][n] * rinv * gv[0][n], x2 = acc[ai][1][m][n] * rinv * gv[1][n];
                        o[0][n] = x1 * c4 - x2 * s4; o[1][n] = x2 * c4 + x1 * s4; }
                } else {
#pragma unroll
                    for (int bj = 0; bj < 2; ++bj)
#pragma unroll
                        for (int n = 0; n < 2; ++n) o[bj][n] = acc[ai][bj][m][n];
                }
#pragma unroll
                for (int bj = 0; bj < 2; ++bj) *(u32x4*)(rowp + 16 * bj) = pack8(o[bj][0], o[bj][1]); }
    }
};
template <class Epi, class Sched, bool ALIGN_EPI = false, bool SP2 = false>
__device__ __forceinline__ void gemm_phase(PG8_LAS unsigned char* lds, const Gemm g, const Sched& S, const Epi& E) {
    int tid_ = threadIdx.x; asm volatile("" : "+v"(tid_)); const int tid = tid_, wid = __builtin_amdgcn_readfirstlane(tid >> 6), lane = tid & 63, wr = wid >> 2, wc = wid & 3, fr = lane & 15, fq = lane >> 4;
    const int K = g.K, nt = K / BK;
    unsigned voffA[2], voffB[2];
#pragma unroll
    for (int i = 0; i < 2; ++i) { int R, C; stage_rc(tid * 16 + i * 8192, R, C); const int Rb = Epi::PERM ? ((R & ~31) + perm32(R & 31)) : R;
        voffA[i] = (unsigned)(R * K + C) * 2u; voffB[i] = (unsigned)(Rb * K + C) * 2u; }
    const size_t kstep = (size_t)(BK * 2);
    const size_t hstep = (size_t)HALF * K * 2;
    const size_t tstep = 2 * hstep;
    const unsigned ldsw = (unsigned)wid * 1024u;
    const int aoff = lds_byte(wr * 64 + fr, fq * 8), boff = lds_byte(wc * 32 + fr, fq * 8);
#define PG8_SA(b, h) (((b) * 2 + (h)) * HTB)
#define PG8_SB(b, h) ((4 + (b) * 2 + (h)) * HTB)
#define PG8_STAGE(bufoff, gbase, voff) do { _Pragma("unroll") for (int _i = 0; _i < 2; ++_i) \
        __builtin_amdgcn_global_load_lds((const unsigned*)((const char*)(gbase) + (voff)[_i]), (PG8_LAS unsigned*)(lds + (bufoff) + ldsw + _i * 8192), 16, 0, 0); } while (0)
#define PG8_LDA(dst, b, h) do { _Pragma("unroll") for (int m = 0; m < 4; ++m) _Pragma("unroll") for (int k = 0; k < 2; ++k) dst[m][k] = *(const PG8_LAS bf16x8*)(lds + PG8_SA(b, h) + aoff + m * 2048 + k * 1024); } while (0)
#define PG8_LDB(dst, b, h) do { _Pragma("unroll") for (int n = 0; n < 2; ++n) _Pragma("unroll") for (int k = 0; k < 2; ++k) dst[n][k] = *(const PG8_LAS bf16x8*)(lds + PG8_SB(b, h) + boff + n * 2048 + k * 1024); } while (0)
#define PG8_MMA(ai, bj, At, Bt) do { __builtin_amdgcn_s_setprio(1); _Pragma("unroll") for (int m = 0; m < 4; ++m) _Pragma("unroll") for (int n = 0; n < 2; ++n) _Pragma("unroll") for (int k = 0; k < 2; ++k) \
        acc[ai][bj][m][n] = __builtin_amdgcn_mfma_f32_16x16x32_bf16(Bt[n][k], At[m][k], acc[ai][bj][m][n], 0, 0, 0); __builtin_amdgcn_s_setprio(0); } while (0)
#define PG8_WAIT_V(n) asm volatile("s_waitcnt vmcnt(" #n ")" ::: "memory")
#define PG8_WAIT_L(n) asm volatile("s_waitcnt lgkmcnt(" #n ")" ::: "memory")
#define PG8_BAR __builtin_amdgcn_s_barrier()
#define PG8_SCHED __builtin_amdgcn_sched_barrier(0)
    Unit cur, nxt; int ui = 0;
    if (!S.next(0, cur)) return;
    f32x4 acc[2][2][4][2];
#pragma unroll
    for (int a = 0; a < 2; ++a)
#pragma unroll
        for (int b = 0; b < 2; ++b)
#pragma unroll
            for (int m = 0; m < 4; ++m)
#pragma unroll
                for (int n = 0; n < 2; ++n) acc[a][b][m][n] = (f32x4){0.f, 0.f, 0.f, 0.f};
    bf16x8 At[4][2], B0[2][2], B1[2][2];
    const char* cA = (const char*)g.A + (size_t)cur.pm * tstep; const char* cB = (const char*)g.Bt + (size_t)cur.pn * tstep;
    S.a_ready(cur);
    if constexpr (SP2) {
        PG8_STAGE(PG8_SB(0, 0), cB, voffB); PG8_STAGE(PG8_SB(0, 1), cB + hstep, voffB); PG8_STAGE(PG8_SA(0, 0), cA, voffA); PG8_STAGE(PG8_SA(0, 1), cA + hstep, voffA);
        if (wr == 1) PG8_BAR;
        PG8_WAIT_V(2); PG8_BAR;
        PG8_STAGE(PG8_SB(1, 0), cB + kstep, voffB); PG8_STAGE(PG8_SA(1, 0), cA + kstep, voffA); PG8_STAGE(PG8_SB(1, 1), cB + hstep + kstep, voffB);
        PG8_WAIT_V(6); PG8_BAR;
    } else {
        PG8_STAGE(PG8_SB(0, 0), cB, voffB); PG8_STAGE(PG8_SA(0, 0), cA, voffA); PG8_STAGE(PG8_SB(0, 1), cB + hstep, voffB); PG8_STAGE(PG8_SA(0, 1), cA + hstep, voffA);
        if (wr == 1) PG8_BAR;
        PG8_WAIT_V(4); PG8_BAR;
        PG8_STAGE(PG8_SB(1, 0), cB + kstep, voffB); PG8_STAGE(PG8_SA(1, 0), cA + kstep, voffA); PG8_STAGE(PG8_SB(1, 1), cB + hstep + kstep, voffB);
        PG8_WAIT_V(6); PG8_BAR;
    }
    for (;;) {
        const bool has_next = S.next(ui + 1, nxt);
        const char* nA = has_next ? (const char*)g.A + (size_t)nxt.pm * tstep : cA; const char* nB = has_next ? (const char*)g.Bt + (size_t)nxt.pn * tstep : cB;
        for (int t = 0; t < nt; t += 2) {
            const bool last = (t == nt - 2);
            const char* a1 = cA + (size_t)(t + 1) * kstep;
            const char* a2 = last ? nA : cA + (size_t)(t + 2) * kstep; const char* b2 = last ? nB : cB + (size_t)(t + 2) * kstep;
            const char* a3 = a2 + kstep; const char* b3 = b2 + kstep;
            if (last && has_next) S.a_ready(nxt);
            if constexpr (SP2) {
            PG8_LDB(B0, 0, 0); PG8_LDB(B1, 0, 1); PG8_SCHED; PG8_LDA(At, 0, 0); PG8_STAGE(PG8_SA(1, 1), a1 + hstep, voffA);
            PG8_WAIT_V(8); PG8_WAIT_L(0); PG8_BAR; PG8_MMA(0, 0, At, B0); PG8_MMA(0, 1, At, B1); PG8_BAR; PG8_SCHED;
            PG8_LDA(At, 0, 1); PG8_STAGE(PG8_SB(0, 0), b2, voffB); PG8_STAGE(PG8_SB(0, 1), b2 + hstep, voffB); PG8_STAGE(PG8_SA(0, 0), a2, voffA);
            PG8_WAIT_V(8); PG8_WAIT_L(0); PG8_BAR; PG8_MMA(1, 0, At, B0); PG8_MMA(1, 1, At, B1); PG8_BAR; PG8_SCHED;
            PG8_LDB(B0, 1, 0); PG8_LDB(B1, 1, 1); PG8_SCHED; PG8_LDA(At, 1, 0); PG8_STAGE(PG8_SA(0, 1), a2 + hstep, voffA);
            PG8_WAIT_V(8); PG8_WAIT_L(0); PG8_BAR; PG8_MMA(0, 0, At, B0); PG8_MMA(0, 1, At, B1); PG8_BAR; PG8_SCHED;
            PG8_LDA(At, 1, 1); PG8_STAGE(PG8_SB(1, 0), b3, voffB); PG8_STAGE(PG8_SB(1, 1), b3 + hstep, voffB); PG8_STAGE(PG8_SA(1, 0), a3, voffA);
            PG8_WAIT_V(8); PG8_WAIT_L(0); PG8_BAR; PG8_MMA(1, 0, At, B0); PG8_MMA(1, 1, At, B1); PG8_BAR; PG8_SCHED;
            } else {
            PG8_LDB(B0, 0, 0); PG8_SCHED; PG8_LDA(At, 0, 0); PG8_STAGE(PG8_SA(1, 1), a1 + hstep, voffA);
            PG8_WAIT_L(8); PG8_BAR; PG8_WAIT_L(0); PG8_MMA(0, 0, At, B0); PG8_BAR; PG8_SCHED;
            PG8_LDB(B1, 0, 1); PG8_STAGE(PG8_SB(0, 0), b2, voffB);
            PG8_BAR; PG8_WAIT_L(0); PG8_MMA(0, 1, At, B1); PG8_BAR;
            PG8_LDA(At, 0, 1); PG8_STAGE(PG8_SA(0, 0), a2, voffA);
            PG8_BAR; PG8_WAIT_L(0); PG8_MMA(1, 0, At, B0); PG8_BAR; PG8_SCHED;
            PG8_STAGE(PG8_SB(0, 1), b2 + hstep, voffB);
            PG8_WAIT_V(6); PG8_BAR; PG8_MMA(1, 1, At, B1); PG8_BAR;
            PG8_LDB(B0, 1, 0); PG8_SCHED; PG8_LDA(At, 1, 0); PG8_STAGE(PG8_SA(0, 1), a2 + hstep, voffA);
            PG8_WAIT_L(8); PG8_BAR; PG8_WAIT_L(0); PG8_MMA(0, 0, At, B0); PG8_BAR; PG8_SCHED;
            PG8_LDB(B1, 1, 1); PG8_STAGE(PG8_SB(1, 0), b3, voffB);
            PG8_BAR; PG8_WAIT_L(0); PG8_MMA(0, 1, At, B1); PG8_BAR;
            PG8_LDA(At, 1, 1); PG8_STAGE(PG8_SA(1, 0), a3, voffA);
            PG8_BAR; PG8_WAIT_L(0); PG8_MMA(1, 0, At, B0); PG8_BAR; PG8_SCHED;
            PG8_STAGE(PG8_SB(1, 1), b3 + hstep, voffB);
            PG8_WAIT_V(6); PG8_BAR; PG8_MMA(1, 1, At, B1); PG8_BAR;
            }
        }
        if constexpr (ALIGN_EPI) { if (wr == 0) PG8_BAR; }
        if constexpr (!Epi::AFTER_DRAIN) { E(acc, cur, wr, wc, fr, fq); S.done(cur); }
        if (!has_next) break;
#pragma unroll
        for (int a = 0; a < 2; ++a)
#pragma unroll
            for (int b = 0; b < 2; ++b)
#pragma unroll
                for (int m = 0; m < 4; ++m)
#pragma unroll
                    for (int n = 0; n < 2; ++n) acc[a][b][m][n] = (f32x4){0.f, 0.f, 0.f, 0.f};
        cur = nxt; cA = nA; cB = nB; ++ui;
        if constexpr (ALIGN_EPI) { if (wr == 1) PG8_BAR; }
    }
    PG8_WAIT_V(0);
    if constexpr (!ALIGN_EPI) { if (wr == 0) PG8_BAR; }
    PG8_BAR;
    if constexpr (Epi::AFTER_DRAIN) { E.fused(acc, cur, wr, wc, fr, fq, lds, wid, lane); S.done(cur); }
#undef PG8_SA
#undef PG8_SB
#undef PG8_STAGE
#undef PG8_LDA
#undef PG8_LDB
#undef PG8_MMA
#undef PG8_WAIT_V
#undef PG8_WAIT_L
#undef PG8_BAR
#undef PG8_SCHED
}
}
#include <hip/hip_bf16.h>
#include <cmath>
namespace attn_body {
using bf16=__hip_bfloat16;
using bf16x8=__attribute__((ext_vector_type(8)))short;
using s16x4=__attribute__((ext_vector_type(4)))short;
using f32x16=__attribute__((ext_vector_type(16)))float;
using u32x4=__attribute__((ext_vector_type(4)))unsigned;
constexpr int BATCH=8,NHEAD=16,SEQ=2048,D=64,DM=NHEAD*D,KVP=256;
constexpr int NW=8,QBLK=32,QB=QBLK*NW,KVBLK=64,NQB=SEQ/QB;
constexpr int ATTN_PITCH=DM, ATTN_UNIT_ROWS=QB;
__device__ __forceinline__ int crow(int r,int hi){return (r&3)+8*(r>>2)+4*hi;}
#define SBAR() __builtin_amdgcn_sched_barrier(0)
__device__ __forceinline__ void cmask(f32x16&p0,f32x16&p1,int jb,int qrel,int hi){
  const float NEG=-INFINITY; int kb=64*jb+4*hi;
  #pragma unroll
  for(int r=0;r<16;++r){int kv=kb+(r&3)+8*(r>>2); if(kv>qrel)p0[r]=NEG; if(kv+32>qrel)p1[r]=NEG;}
}

constexpr int NSLOT=3, SLOTB=8192;
constexpr int LDS_K=0, LDS_V=NSLOT*SLOTB, LDS_WS=2*NSLOT*SLOTB, LDS_OST=LDS_WS+NW*64*4, LDS_BYTES=LDS_OST+NW*4096;
constexpr float C2=0.125f*1.4426950408889634f;
__device__ __forceinline__ void glds16(const void*gsrc,unsigned lds_dst){unsigned keep;
  asm volatile("s_mov_b32 %0, m0\n\ts_mov_b32 m0, %2\n\ts_nop 0\n\tglobal_load_lds_dwordx4 %1, off\n\ts_mov_b32 m0, %0":"=&s"(keep):"v"(gsrc),"s"(lds_dst):"memory");}
__device__ __forceinline__ float max3f(float a,float b,float c){float r;asm("v_max3_f32 %0, %1, %2, %3":"=v"(r):"v"(a),"v"(b),"v"(c));return r;}
__device__ __forceinline__ float max2f(float a,float b){float r;asm("v_max_f32_e32 %0, %1, %2":"=v"(r):"v"(a),"v"(b));return r;}
__device__ __forceinline__ float fadd_s(float a,float b){float r;asm("v_add_f32_e32 %0, %1, %2":"=v"(r):"v"(a),"v"(b));return r;}
__device__ __forceinline__ float fsub_s(float a,float b){float r;asm("v_sub_f32_e32 %0, %1, %2":"=v"(r):"v"(a),"v"(b));return r;}
typedef float f32x2_t __attribute__((ext_vector_type(2))); typedef __bf16 bf16x2_t __attribute__((ext_vector_type(2)));
__device__ __forceinline__ unsigned cvtpk_s(float lo,float hi){f32x2_t v={lo,hi};bf16x2_t b=__builtin_convertvector(v,bf16x2_t);return __builtin_bit_cast(unsigned,b);}
#define WAIT_BAR(N) asm volatile("s_waitcnt vmcnt(" #N ") lgkmcnt(0)\n\ts_barrier":::"memory")

__device__ __forceinline__ void qkt(f32x16&p0,f32x16&p1,const char*Kslot,const bf16x8*qr,const f32x16&negm,int r32,int hi){
  const char*kb=Kslot+hi*1024+r32*16;
  #pragma unroll
  for(int d0=0;d0<4;++d0){
    const bf16x8 b0=*reinterpret_cast<const bf16x8*>(kb+d0*2048);
    const bf16x8 b1=*reinterpret_cast<const bf16x8*>(kb+d0*2048+512);
    if(d0==0){p0=__builtin_amdgcn_mfma_f32_32x32x16_bf16(b0,qr[0],negm,0,0,0);p1=__builtin_amdgcn_mfma_f32_32x32x16_bf16(b1,qr[0],negm,0,0,0);}
    else{p0=__builtin_amdgcn_mfma_f32_32x32x16_bf16(b0,qr[d0],p0,0,0,0);p1=__builtin_amdgcn_mfma_f32_32x32x16_bf16(b1,qr[d0],p1,0,0,0);}}
}
typedef __attribute__((address_space(3))) const char* lds_cptr;
typedef short v4i16_t __attribute__((ext_vector_type(4)));
__device__ __forceinline__ void kload8(bf16x8*kf,lds_cptr kp){
  kf[0]=*(const __attribute__((address_space(3))) bf16x8*)(kp);      kf[1]=*(const __attribute__((address_space(3))) bf16x8*)(kp+512);
  kf[2]=*(const __attribute__((address_space(3))) bf16x8*)(kp+2048); kf[3]=*(const __attribute__((address_space(3))) bf16x8*)(kp+2560);
  kf[4]=*(const __attribute__((address_space(3))) bf16x8*)(kp+4096); kf[5]=*(const __attribute__((address_space(3))) bf16x8*)(kp+4608);
  kf[6]=*(const __attribute__((address_space(3))) bf16x8*)(kp+6144); kf[7]=*(const __attribute__((address_space(3))) bf16x8*)(kp+6656);
}
__device__ __forceinline__ void kload2(bf16x8*kf,lds_cptr kp,int j){ kf[2*j]=*(const __attribute__((address_space(3))) bf16x8*)(kp+j*2048); kf[2*j+1]=*(const __attribute__((address_space(3))) bf16x8*)(kp+j*2048+512); }
__device__ __forceinline__ s16x4 vtr(lds_cptr p){ return __builtin_bit_cast(s16x4,__builtin_amdgcn_ds_read_tr16_b64_v4i16((__attribute__((address_space(3))) v4i16_t*)p)); }
__device__ __forceinline__ float rowmax(const f32x16&p0,const f32x16&p1){
  float a=max3f(p0[0],p0[1],p1[0]),b=max3f(p0[2],p0[3],p1[1]);a=max3f(a,p1[2],p1[3]);
  #pragma unroll
  for(int r=4;r<16;r+=4){a=max3f(a,p0[r],p0[r+1]);b=max3f(b,p0[r+2],p0[r+3]);a=max3f(a,p1[r],p1[r+1]);b=max3f(b,p1[r+2],p1[r+3]);}
  const float m=max2f(a,b);
  auto rr=__builtin_amdgcn_permlane32_swap(__float_as_uint(m),__float_as_uint(m),false,false);
  return max2f(__uint_as_float(rr[0]),__uint_as_float(rr[1]));
}
__device__ __forceinline__ void pv(f32x16*o,int vb,bf16x8 pa0,bf16x8 pa1,bf16x8 pa2,bf16x8 pa3){
  #pragma unroll
  for(int d0=0;d0<2;++d0){s16x4 lo[4],hi[4];
    #pragma unroll
    for(int ks=0;ks<4;++ks){
      asm volatile("ds_read_b64_tr_b16 %0,%1 offset:%c2":"=&v"(lo[ks]):"v"(vb),"i"(d0*4096+ks*1024):"memory");
      asm volatile("ds_read_b64_tr_b16 %0,%1 offset:%c2":"=&v"(hi[ks]):"v"(vb),"i"(d0*4096+ks*1024+512):"memory");}
    asm volatile("s_waitcnt lgkmcnt(0)":::"memory");SBAR();
    #define PK(k) (bf16x8){lo[k][0],lo[k][1],lo[k][2],lo[k][3],hi[k][0],hi[k][1],hi[k][2],hi[k][3]}
    o[d0]=__builtin_amdgcn_mfma_f32_32x32x16_bf16(pa0,PK(0),o[d0],0,0,0);
    o[d0]=__builtin_amdgcn_mfma_f32_32x32x16_bf16(pa1,PK(1),o[d0],0,0,0);
    o[d0]=__builtin_amdgcn_mfma_f32_32x32x16_bf16(pa2,PK(2),o[d0],0,0,0);
    o[d0]=__builtin_amdgcn_mfma_f32_32x32x16_bf16(pa3,PK(3),o[d0],0,0,0);
    #undef PK
  }
}

#ifndef ATTN_STORE16
#define ATTN_STORE16(p,v) (*(u32x4*)(p)=(v))
#endif
template<int THRL> __device__ __forceinline__ void attn_unit(int b,int h,int qb,const bf16*Q,const bf16*__restrict__ K,const bf16*__restrict__ V,bf16*O,char*shm){
  int tid_=threadIdx.x; asm volatile("":"+v"(tid_)); const int tid=tid_,lane=tid&63,r32=lane&31,hi=lane>>5; const int wid=__builtin_amdgcn_readfirstlane(tid>>6);
  const long rowbase=(long)b*SEQ; const int q0=qb*QB;
  const bf16*Qw=Q+(rowbase+q0+wid*QBLK)*DM+h*D;
  const bf16*Kh=K+rowbase*KVP+(h>>2)*D,*Vh=V+rowbase*KVP+(h>>2)*D;
  const unsigned lds0=(unsigned)(uintptr_t)shm;
  float*wsf=(float*)(shm+LDS_WS)+wid*64;
  const bf16*ksrc=Kh+(long)lane*KVP+wid*8;
  const bf16*vsrc=Vh+(long)(16*(wid&3)+(lane>>2))*KVP+(wid>>2)*32+(lane&3)*8;
  const unsigned kdst=lds0+LDS_K+wid*1024, vdst=lds0+LDS_V+wid*1024;
  #define DMA_K(t,slot) glds16(ksrc+(long)(t)*KVBLK*KVP,(unsigned)__builtin_amdgcn_readfirstlane(kdst+(slot)))
  #define DMA_V(t,slot) glds16(vsrc+(long)(t)*KVBLK*KVP,(unsigned)__builtin_amdgcn_readfirstlane(vdst+(slot)))
  const int vb0=(int)(lds0+LDS_V)+((lane>>4)&1)*32+(lane&3)*8+(4*hi+((lane&15)>>2))*64;
  const char*Kbase=shm+LDS_K; bf16x8 kf[8];
  const lds_cptr shm3=(lds_cptr)shm; const lds_cptr kp0=shm3+LDS_K+hi*1024+r32*16; const lds_cptr vp0=shm3+LDS_V+((lane>>4)&1)*32+(lane&3)*8+(4*hi+((lane&15)>>2))*64;
  const int NT=SEQ/KVBLK;
  DMA_K(0,0);DMA_V(0,0);DMA_K(1,SLOTB);
  bf16x8 qr[4];
  #pragma unroll
  for(int d0=0;d0<4;++d0)qr[d0]=*reinterpret_cast<const bf16x8*>(&Qw[(long)r32*DM+d0*16+hi*8]);
  float mhat=0.f,l_reg=0.f;f32x16 o[2];o[0]=f32x16{};o[1]=f32x16{};f32x16 negm=f32x16{};asm volatile("":"+v"(negm));
  const int qrel=wid*QBLK+r32;
  #define CMASK(P0,P1,t) do{}while(0)
  bool resc=false;
  #define START(P0,P1) do{ const float rm=rowmax(P0,P1); resc=false; \
    { const float dl=rm; mhat=fadd_s(mhat,dl); \
      _Pragma("unroll") for(int r=0;r<16;++r){P0[r]=fsub_s(P0[r],dl);P1[r]=fsub_s(P1[r],dl);} \
      _Pragma("unroll") for(int r=0;r<16;++r)negm[r]=-mhat; asm volatile("":"+v"(negm)); } \
    _Pragma("unroll") for(int r=0;r<16;++r)P0[r]=__builtin_amdgcn_exp2f(P0[r]); }while(0)
  #define RESC() do{ if(resc){ asm volatile("s_waitcnt lgkmcnt(0)":::"memory"); \
      _Pragma("unroll") for(int d_=0;d_<2;++d_) _Pragma("unroll") for(int r=0;r<16;++r)o[d_][r]*=wsf[crow(r,hi)]; } }while(0)
  f32x16 pA0,pA1,pB0,pB1;
  int sl_prev=0,sl_cur=0,sl_next=SLOTB;
  #define ROT() do{sl_prev=sl_cur;sl_cur=sl_next;sl_next=(sl_next==(NSLOT-1)*SLOTB)?0:sl_next+SLOTB;}while(0)
  DMA_K(2,2*SLOTB);
  WAIT_BAR(3);
  qkt(pA0,pA1,Kbase,qr,negm,r32,hi);asm volatile("s_nop 15\n\ts_nop 7":"+v"(pA0),"+v"(pA1));CMASK(pA0,pA1,0);
  START(pA0,pA1);
  _Pragma("unroll") for(int r=0;r<16;++r)pA1[r]=__builtin_amdgcn_exp2f(pA1[r]);
  WAIT_BAR(0);
  DMA_K(3,0);DMA_V(1,SLOTB);
  ROT();
  kload8(kf,kp0+sl_cur);
  WAIT_BAR(2);
  s16x4 vlo[8],vhi[8]; u32x4 pw0,pw1,pw2,pw3;
  #define PKW(P,B) cvtpk_s(P[B],P[B+1])
  #define PAF(k) __builtin_bit_cast(bf16x8,pw##k)
  #define VFR(i) (bf16x8){vlo[i][0],vlo[i][1],vlo[i][2],vlo[i][3],vhi[i][0],vhi[i][1],vhi[i][2],vhi[i][3]}
  #define PIN(x) asm volatile("":"+v"(x))
  #define MX3(a,b,c) __builtin_fmaxf(__builtin_fmaxf((a),(b)),(c))
  #define GAPA(MF,A0,A1,A2,A3,W0,W1,PW) do{ MF; sacc+=A0; sacc+=A1; sacc+=A2; sacc+=A3; PIN(sacc); W0; W1; PIN(PW); SBAR(); }while(0)
  #define EX(v) __builtin_amdgcn_exp2f(v)
  #define GAPB(MF,X,B) do{ MF; X[B]=EX(X[B]); X[B+1]=EX(X[B+1]); X[B+2]=EX(X[B+2]); X[B+3]=EX(X[B+3]); PIN(X); SBAR(); }while(0)
  #define VRD(i) do{ vlo[i]=vtr(vp_+(((i)>>2)*4096+((i)&3)*1024)); vhi[i]=vtr(vp_+(((i)>>2)*4096+((i)&3)*1024+512)); }while(0)
  #define KRD(G,j) do{ if(G){ kload2(kf,kp0+sl_next,j); SBAR(); } }while(0)
  #define STEP(C0,C1,P0,P1,t,GK,GV,GL) do{ SBAR(); \
    const lds_cptr vp_=vp0+sl_prev; \
    VRD(0); SBAR(); float sacc=(P0[0]+P0[1]); \
    GAPA(C0=__builtin_amdgcn_mfma_f32_32x32x16_bf16(kf[0],qr[0],negm,0,0,0), P0[2],P0[3],P0[4],P0[5],     pw0[0]=PKW(P0,0), pw0[1]=PKW(P0,2), pw0); \
    VRD(4); SBAR(); GAPA(C1=__builtin_amdgcn_mfma_f32_32x32x16_bf16(kf[1],qr[0],negm,0,0,0), P0[6],P0[7],P0[8],P0[9],     pw0[2]=PKW(P0,4), pw0[3]=PKW(P0,6), pw0); \
    VRD(1); SBAR(); GAPA(C0=__builtin_amdgcn_mfma_f32_32x32x16_bf16(kf[2],qr[1],C0,0,0,0),   P0[10],P0[11],P0[12],P0[13], pw1[0]=PKW(P0,8), pw1[1]=PKW(P0,10), pw1); \
    VRD(5); SBAR(); GAPA(C1=__builtin_amdgcn_mfma_f32_32x32x16_bf16(kf[3],qr[1],C1,0,0,0),   P0[14],P0[15],P1[0],P1[1],   pw1[2]=PKW(P0,12),pw1[3]=PKW(P0,14), pw1); \
    VRD(2); SBAR(); GAPA(C0=__builtin_amdgcn_mfma_f32_32x32x16_bf16(kf[4],qr[2],C0,0,0,0),   P1[2],P1[3],P1[4],P1[5],     pw2[0]=PKW(P1,0), pw2[1]=PKW(P1,2), pw2); \
    VRD(6); SBAR(); GAPA(C1=__builtin_amdgcn_mfma_f32_32x32x16_bf16(kf[5],qr[2],C1,0,0,0),   P1[6],P1[7],P1[8],P1[9],     pw2[2]=PKW(P1,4), pw2[3]=PKW(P1,6), pw2); \
    VRD(3); SBAR(); GAPA(C0=__builtin_amdgcn_mfma_f32_32x32x16_bf16(kf[6],qr[3],C0,0,0,0),   P1[10],P1[11],P1[12],P1[13], pw3[0]=PKW(P1,8), pw3[1]=PKW(P1,10), pw3); \
    VRD(7); SBAR(); GAPA(C1=__builtin_amdgcn_mfma_f32_32x32x16_bf16(kf[7],qr[3],C1,0,0,0),   P1[14],P1[15],0.f,0.f,       pw3[2]=PKW(P1,12),pw3[3]=PKW(P1,14), pw3); \
    l_reg+=sacc; \
    if(GK){DMA_K((t)+3,sl_cur);} if(GV){DMA_V((t)+1,sl_next);} \
    CMASK(C0,C1,t); \
    { float a=MX3(C0[0],C0[1],C1[0]),b=MX3(C0[2],C0[3],C1[1]); a=MX3(a,C1[2],C1[3]); \
      _Pragma("unroll") for(int r=4;r<16;r+=4){a=MX3(a,C0[r],C0[r+1]);b=MX3(b,C0[r+2],C0[r+3]);a=MX3(a,C1[r],C1[r+1]);b=MX3(b,C1[r+2],C1[r+3]);} \
      float rm=__builtin_fmaxf(a,b); { auto rr=__builtin_amdgcn_permlane32_swap(__float_as_uint(rm),__float_as_uint(rm),false,false); rm=__builtin_fmaxf(__uint_as_float(rr[0]),__uint_as_float(rr[1])); } \
      resc=false; \
      if(__builtin_expect(__any(rm>(float)THRL),0)){ const float dl=__builtin_fmaxf(rm,0.f); mhat+=dl; \
        _Pragma("unroll") for(int r=0;r<16;++r){C0[r]-=dl;C1[r]-=dl;} \
        _Pragma("unroll") for(int r=0;r<16;++r)negm[r]=-mhat; asm volatile("":"+v"(negm)); \
        const float f=__builtin_amdgcn_exp2f(-dl); l_reg*=f; if(hi==0)wsf[r32]=f; resc=true; } } \
    SBAR(); \
    GAPB(o[0]=__builtin_amdgcn_mfma_f32_32x32x16_bf16(PAF(0),VFR(0),o[0],0,0,0), C0,0); \
    GAPB(o[1]=__builtin_amdgcn_mfma_f32_32x32x16_bf16(PAF(0),VFR(4),o[1],0,0,0), C0,4); \
    KRD(GL,0); GAPB(o[0]=__builtin_amdgcn_mfma_f32_32x32x16_bf16(PAF(1),VFR(1),o[0],0,0,0), C0,8); \
    KRD(GL,1); GAPB(o[1]=__builtin_amdgcn_mfma_f32_32x32x16_bf16(PAF(1),VFR(5),o[1],0,0,0), C0,12); \
    KRD(GL,2); GAPB(o[0]=__builtin_amdgcn_mfma_f32_32x32x16_bf16(PAF(2),VFR(2),o[0],0,0,0), C1,0); \
    KRD(GL,3); GAPB(o[1]=__builtin_amdgcn_mfma_f32_32x32x16_bf16(PAF(2),VFR(6),o[1],0,0,0), C1,4); \
    GAPB(o[0]=__builtin_amdgcn_mfma_f32_32x32x16_bf16(PAF(3),VFR(3),o[0],0,0,0), C1,8); \
    GAPB(o[1]=__builtin_amdgcn_mfma_f32_32x32x16_bf16(PAF(3),VFR(7),o[1],0,0,0), C1,12); \
    }while(0)
  int t=1;
  #undef CMASK
  #define CMASK(P0,P1,t) do{}while(0)
  for(;t+5<NT;t+=2){
    STEP(pB0,pB1,pA0,pA1,t,true,true,true);     WAIT_BAR(2); RESC(); ROT();
    STEP(pA0,pA1,pB0,pB1,t+1,true,true,true);   WAIT_BAR(2); RESC(); ROT();
  }
  #undef CMASK
  #define CMASK(P0,P1,t) do{}while(0)
  #define ENDW(tt) do{ if((tt)+3<NT){WAIT_BAR(2);} else if((tt)+2<NT){WAIT_BAR(1);} else {WAIT_BAR(0);} }while(0)
  for(;t+1<NT;t+=2){
    STEP(pB0,pB1,pA0,pA1,t,(t+3<NT),(t+1<NT),(t+1<NT));       ENDW(t);   RESC(); ROT();
    STEP(pA0,pA1,pB0,pB1,t+1,(t+4<NT),(t+2<NT),(t+2<NT));     ENDW(t+1); RESC(); ROT();
  }
  STEP(pB0,pB1,pA0,pA1,NT-1,false,false,false); RESC();
  { float sacc=pB0[0]+pB0[1]; _Pragma("unroll") for(int r=2;r<16;++r)sacc+=pB0[r]; _Pragma("unroll") for(int r=0;r<16;++r)sacc+=pB1[r]; l_reg+=sacc;
    pw0=(u32x4){PKW(pB0,0),PKW(pB0,2),PKW(pB0,4),PKW(pB0,6)};pw1=(u32x4){PKW(pB0,8),PKW(pB0,10),PKW(pB0,12),PKW(pB0,14)};pw2=(u32x4){PKW(pB1,0),PKW(pB1,2),PKW(pB1,4),PKW(pB1,6)};pw3=(u32x4){PKW(pB1,8),PKW(pB1,10),PKW(pB1,12),PKW(pB1,14)};
    SBAR(); pv(o,vb0+sl_cur,PAF(0),PAF(1),PAF(2),PAF(3)); }
  #undef PKW
  #undef PAF
  #undef VFR
  #undef PIN
  #undef MX3
  #undef GAPA
  #undef GAPB
  #undef EX
  #undef VRD
  #undef KRD
  #undef STEP
  #undef ENDW
  {auto rr=__builtin_amdgcn_permlane32_swap(__float_as_uint(l_reg),__float_as_uint(l_reg),false,false);l_reg=__uint_as_float(rr[0])+__uint_as_float(rr[1]);}
  if(hi==0)wsf[32+r32]=l_reg;asm volatile("s_waitcnt lgkmcnt(0)":::"memory");
  float rli[16];
  #pragma unroll
  for(int r=0;r<16;++r)rli[r]=__builtin_amdgcn_rcpf(wsf[32+crow(r,hi)]);
  bf16*Ow=O+(rowbase+q0+wid*QBLK)*DM+h*D;
  { bf16*stg=(bf16*)(shm+LDS_OST)+wid*2048;
    #pragma unroll
    for(int r=0;r<16;++r){const int orow=crow(r,hi);
      #pragma unroll
      for(int d0=0;d0<2;++d0)stg[orow*64+d0*32+r32]=__float2bfloat16(o[d0][r]*rli[r]);}
    asm volatile("s_waitcnt lgkmcnt(0)":::"memory");
    #pragma unroll
    for(int i=0;i<4;++i){const int row=i*8+(lane>>3),ch=lane&7; const u32x4 v=*(const u32x4*)(stg+row*64+ch*8); ATTN_STORE16(Ow+(long)row*DM+ch*8,v);} }
  asm volatile("s_waitcnt lgkmcnt(0)\n\ts_barrier":::"memory");
  #undef DMA_K
  #undef DMA_V
  #undef CMASK
  #undef START
  #undef RESC
  #undef ROT
}
constexpr int ATTN_LDS_BYTES=LDS_BYTES;
struct AttnTensors { const bf16* Q; const bf16* K; const bf16* V; bf16* O; };
struct AttnUnit { int bh; int qb; };
struct StaticOrder {
  int vcu,G;
  __device__ __forceinline__ explicit StaticOrder(int grid,int block):vcu((grid%8==0)?(block%8)*(grid/8)+block/8:block),G(grid){}
  __device__ __forceinline__ bool next(int i,AttnUnit&u)const{ const int L=i*G+vcu; if(L>=1024)return false; const int xg=L>>5,w=L&31; const int grp=(xg&7)*4+(xg>>3); u.bh=(grp>>2)*NHEAD+(grp&3)*4+(w>>3); u.qb=w&7; return true; }
  __device__ __forceinline__ void a_ready(const AttnUnit&)const{}
  __device__ __forceinline__ void done(const AttnUnit&)const{}
};
template<class Sched,int THRL=8> __device__ __forceinline__ void attn_phase(char*lds,const AttnTensors&T,const Sched&S){
  AttnUnit u;
  for(int i=0;S.next(i,u);++i){ S.a_ready(u); attn_unit<THRL>(u.bh/NHEAD,u.bh%NHEAD,u.qb,T.Q,T.K,T.V,T.O,lds); S.done(u); }
}
#undef SBAR
#undef WAIT_BAR
}
constexpr int NWAVES = 8, NTHREADS = 512;
constexpr int D = 1024, NB = 8, S = 2048, M = NB * S, DEPTH = 4, NH = 16, HD = 64, GW = 64, ROWS = 32;
constexpr int KVD = 256, NE = 32, NG = 4, EPG = 8, DE = 512, NQKV_NA = 3072, NQKV_GQ = 1536, NRT = 36;
constexpr float ALPHA = 1.6817928305074290f, LN_EPS = 1e-5f;
constexpr float LOG2E = 1.4426950408889634f, C2 = 0.125f * 1.4426950408889634f;
constexpr int MAXTILES = 160;

constexpr size_t MiB = 1u << 20;
constexpr size_t WS_CTL = 0, CTL_ZERO_BYTES = 1 * MiB;
constexpr size_t WS_MOD = 1 * MiB, WS_ROPE = 2 * MiB, WS_WRT = 3 * MiB;
constexpr size_t WS_WQKV_NA = 4 * MiB, WS_WO_NA = 16 * MiB, WS_WQKV_GQ = 20 * MiB, WS_WO_GQ = 26 * MiB;
constexpr size_t WS_WGU = 32 * MiB, WS_WDN = 96 * MiB;
constexpr size_t WS_X1 = 128 * MiB, WS_X2 = 192 * MiB, WS_H = 256 * MiB, WS_Q = 288 * MiB, WS_K = 320 * MiB, WS_V = 352 * MiB, WS_Y = 384 * MiB;
constexpr size_t WS_XS = 416 * MiB, WS_HMID = 496 * MiB, WS_YS = 536 * MiB, WS_ROUTE = 616 * MiB, WS_END = 620 * MiB;
constexpr int CW_CNT = 8192;

constexpr int RING_BYTES = 131072, MISC_OFF = RING_BYTES, LDS_BYTES = 147456;

#define LAS __attribute__((address_space(3)))
typedef unsigned short bf16;
typedef unsigned v4u __attribute__((ext_vector_type(4)));
typedef unsigned v2u __attribute__((ext_vector_type(2)));
typedef float f32x4 __attribute__((ext_vector_type(4)));
#define RLX_AGENT __ATOMIC_RELAXED, __HIP_MEMORY_SCOPE_AGENT
__device__ __forceinline__ unsigned f2bf(float f) { unsigned u = __builtin_bit_cast(unsigned, f); return (u + 0x7fffu + ((u >> 16) & 1u)) >> 16; }
__device__ __forceinline__ unsigned pk2(float lo, float hi) { return f2bf(lo) | (f2bf(hi) << 16); }
__device__ __forceinline__ float bflo(unsigned w) { return __uint_as_float(w << 16); }
__device__ __forceinline__ float bfhi(unsigned w) { return __uint_as_float(w & 0xffff0000u); }
__device__ __forceinline__ float bf2f(bf16 v) { return __uint_as_float((unsigned)v << 16); }
__device__ __forceinline__ float wave_sum(float v) {
#pragma unroll
    for (int o = 1; o < 64; o <<= 1) v += __shfl_xor(v, o);
    return v;
}

struct Args { const float* in[20]; float* out; unsigned char* ws; };

__device__ __forceinline__ int rho_p8(int cc) { return (cc & 128) + (cc & 96) + 16 * ((cc >> 2) & 1) + 4 * ((cc >> 3) & 3) + (cc & 3); }
__device__ __forceinline__ int rho_head(int cc) { const int wc = cc >> 6, fq = 2 * ((cc >> 5) & 1) + ((cc >> 3) & 1), bj = (cc >> 4) & 1; return 128 * bj + 32 * wc + 16 * ((cc >> 2) & 1) + 4 * fq + (cc & 3); }
__device__ __forceinline__ int dest_row(int mode, int c) {
    if (mode == 0) return (c & ~255) + rho_p8(c & 255);
    if (mode == 1) return (c & ~255) + rho_head(c & 255);
    const int jj = c & 127; return (c >> 7) * 256 + (mode == 3 ? 128 : 0) + (jj & 96) + 16 * ((jj >> 2) & 1) + 4 * ((jj >> 3) & 3) + (jj & 3);
}
__device__ __forceinline__ void transpose_item(const float* __restrict__ W, int K, int N, bf16* __restrict__ WT, int mode, LAS float* scr, int item, int lane) {
    const int nblk = N / 32, kb = item / nblk, nb = item % nblk, k0 = 64 * kb, n0 = 32 * nb;
#pragma unroll 8
    for (int i = 0; i < 32; ++i) { const int kk = 2 * i + (lane >> 5); scr[kk * 33 + (lane & 31)] = W[(size_t)(k0 + kk) * N + n0 + (lane & 31)]; }
    asm volatile("s_waitcnt lgkmcnt(0)" ::: "memory");
    const int c = lane & 7;
#pragma unroll
    for (int j = 0; j < 4; ++j) { const int n = (lane >> 3) + 8 * j; const LAS float* s = scr + (8 * c) * 33 + n;
        v4u o; o.x = pk2(s[0 * 33], s[1 * 33]); o.y = pk2(s[2 * 33], s[3 * 33]); o.z = pk2(s[4 * 33], s[5 * 33]); o.w = pk2(s[6 * 33], s[7 * 33]);
        *(v4u*)(WT + (size_t)dest_row(mode, n0 + n) * K + k0 + 8 * c) = o; }
    asm volatile("s_waitcnt lgkmcnt(0)" ::: "memory");
}
__device__ __forceinline__ void moe_weight_items(const float* __restrict__ wgate, const float* __restrict__ wup, const float* __restrict__ wdown, int layer,
                                                 bf16* __restrict__ Wgu, bf16* __restrict__ Wdn, LAS float* scr, int gw, int NGW, int lane) {
    for (int it = gw; it < NE * 768; it += NGW) {
        const int e = it / 768, r = it % 768, which = r >> 8, sub = r & 255; const size_t le = (size_t)layer * NE + e;
        if (which == 0) transpose_item(wgate + le * D * DE, D, DE, Wgu + (size_t)e * D * D, 2, scr, sub, lane);
        else if (which == 1) transpose_item(wup + le * D * DE, D, DE, Wgu + (size_t)e * D * D, 3, scr, sub, lane);
        else transpose_item(wdown + le * DE * D, DE, D, Wdn + (size_t)e * D * DE, 0, scr, sub, lane);
    }
}

struct MoeOrder {
    int nunits, G, c; const LAS int* tile_e;
    __device__ __forceinline__ bool next(int i, pg8::Unit& u) const {
        const long L = (long)i * G + c; if (L >= nunits) return false;
        const int pm = (int)(L >> 2); u.pm = pm; u.pn = __builtin_amdgcn_readfirstlane(tile_e[pm]) * 4 + (int)(L & 3); return true;
    }
    __device__ __forceinline__ void a_ready(const pg8::Unit&) const {}
    __device__ __forceinline__ void done(const pg8::Unit&) const {}
};
__device__ __forceinline__ void build_tiles(const unsigned* cnt, LAS int* misc, int tid) {
    if (tid == 0) { int s = 0;
        for (int e = 0; e < NE; ++e) { misc[e] = s; const int c = (int)__hip_atomic_load(cnt + e, RLX_AGENT); const int nt = (c + 255) >> 8;
            for (int t = 0; t < nt; ++t) if (s + t < MAXTILES) misc[64 + s + t] = e; s += nt; }
        misc[32] = s; misc[33] = s < MAXTILES ? s : MAXTILES; }
    __syncthreads();
}

__device__ __forceinline__ void na_attn_simple(const bf16* Qb, const bf16* Kb, const bf16* Vb, bf16* Ob, const float* __restrict__ rpb, int gw, int NGW, int lane) {
    for (int w = gw; w < M * NH; w += NGW) {
        const int m = w >> 4, h = w & 15, b = m >> 11, t = m & 2047, r = t >> 6, c = t & 63;
        const int rs = min(max(r - 4, 0), ROWS - 8), wsx = min(max(c - 8, 0), GW - 16);
        const float q = bf2f(Qb[(size_t)m * D + h * HD + lane]);
        float mx = -INFINITY, l = 0.f, acc = 0.f;
        for (int kr = 0; kr < 8; ++kr)
            for (int kc = 0; kc < 16; ++kc) {
                const int krow = rs + kr, kcol = wsx + kc; const size_t tok = (size_t)b * S + krow * GW + kcol;
                const float kv = bf2f(Kb[tok * D + h * HD + lane]), vv = bf2f(Vb[tok * D + h * HD + lane]);
                const int dr = krow - r + 7, dc = min(max(kcol - c + 15, 0), 30);
                const float s = wave_sum(q * kv) + rpb[(h * 15 + dr) * 31 + dc] * LOG2E;
                const float mn = fmaxf(mx, s), al = __builtin_amdgcn_exp2f(mx - mn), p = __builtin_amdgcn_exp2f(s - mn);
                l = l * al + p; acc = acc * al + p * vv; mx = mn;
            }
        Ob[(size_t)m * D + h * HD + lane] = (bf16)f2bf(acc / l);
    }
}
__device__ __forceinline__ void gqa_attn_simple(const bf16* Qb, const bf16* Kb, const bf16* Vb, bf16* Ob, int gw, int NGW, int lane) {
    for (int w = gw; w < M * NH; w += NGW) {
        const int m = w >> 4, h = w & 15, b = m >> 11, kvh = h >> 2;
        const float q = bf2f(Qb[(size_t)m * D + h * HD + lane]);
        float mx = -INFINITY, l = 0.f, acc = 0.f;
        const bf16* kp = Kb + (size_t)b * S * KVD + kvh * HD + lane; const bf16* vp = Vb + (size_t)b * S * KVD + kvh * HD + lane;
        for (int j = 0; j < S; ++j) {
            const float kv = bf2f(kp[(size_t)j * KVD]), vv = bf2f(vp[(size_t)j * KVD]);
            const float s = wave_sum(q * kv);
            const float mn = fmaxf(mx, s), al = __builtin_amdgcn_exp2f(mx - mn), p = __builtin_amdgcn_exp2f(s - mn);
            l = l * al + p; acc = acc * al + p * vv; mx = mn;
        }
        Ob[(size_t)m * D + h * HD + lane] = (bf16)f2bf(acc / l);
    }
}
__device__ __forceinline__ unsigned char* ldptr(const LAS unsigned* ptab, int i) {
    const unsigned lo = (unsigned)__builtin_amdgcn_readfirstlane((int)ptab[2 * i]), hi = (unsigned)__builtin_amdgcn_readfirstlane((int)ptab[2 * i + 1]);
    return (unsigned char*)(__attribute__((address_space(1))) unsigned char*)(((unsigned long long)hi << 32) | lo);
}
#define GRID_SYNC() do { cg::this_grid().sync(); asm volatile("" ::: "memory"); } while (0)
#define PH_BEGIN \
    unsigned ldsb_ = (unsigned)(uintptr_t)lds_raw; asm volatile("" : "+s"(ldsb_)); \
    LAS unsigned char* lds = (LAS unsigned char*)ldsb_; LAS int* misc = (LAS int*)(lds + MISC_OFF); LAS unsigned* ptab = (LAS unsigned*)(lds + MISC_OFF + 1024); (void)misc; \
    int tid = threadIdx.x; asm volatile("" : "+v"(tid)); \
    const int lane = tid & 63, wave = __builtin_amdgcn_readfirstlane(tid >> 6); \
    int G = gridDim.x, bid = blockIdx.x; asm volatile("" : "+s"(G), "+s"(bid)); const int gw = bid * NWAVES + wave, NGW = G * NWAVES; \
    unsigned char* ws = ldptr(ptab, 21); (void)lane; (void)gw; (void)NGW; (void)ws;
#define INP(i) ((const float*)ldptr(ptab, (i)))

__global__ void __launch_bounds__(NTHREADS, 2) mk_fwd(Args args) {
    extern __shared__ __attribute__((aligned(16))) unsigned char lds_raw[];
    { LAS unsigned* ptab = (LAS unsigned*)((LAS unsigned char*)lds_raw + MISC_OFF + 1024);
    if (threadIdx.x < 22) { const unsigned long long p = threadIdx.x < 20 ? (unsigned long long)args.in[threadIdx.x] : (threadIdx.x == 20 ? (unsigned long long)args.out : (unsigned long long)args.ws);
        ptab[2 * threadIdx.x] = (unsigned)p; ptab[2 * threadIdx.x + 1] = (unsigned)(p >> 32); } }
    __syncthreads();

    {
        PH_BEGIN
        const float* c_in = INP(1); const float* ada_w = INP(2); const float* ada_b = INP(3);
        float* mod = (float*)(ws + WS_MOD); float* ropec = (float*)(ws + WS_ROPE); float* ropes = ropec + S * 32; float* wrt = (float*)(ws + WS_WRT);
        LAS float* ca = (LAS float*)lds;
        LAS float* red = (LAS float*)(lds + 32768);
        for (int i = tid; i < NB * D; i += NTHREADS) { const float v = c_in[i]; ca[i] = v / (1.f + __expf(-v)); }
        __syncthreads();
        for (int it = bid; it < DEPTH * 192; it += G) {
            const int l = it / 192, col0 = (it % 192) * 32, cl = tid & 31, ks = tid >> 5;
            const float* wp = ada_w + ((size_t)l * D + 64 * ks) * (6 * D) + col0 + cl;
            float acc[NB];
#pragma unroll
            for (int b = 0; b < NB; ++b) acc[b] = 0.f;
#pragma unroll 16
            for (int kk = 0; kk < 64; ++kk) { const float wv = wp[(size_t)kk * (6 * D)];
#pragma unroll
                for (int b = 0; b < NB; ++b) acc[b] += ca[b * D + 64 * ks + kk] * wv; }
#pragma unroll
            for (int b = 0; b < NB; ++b) red[(ks * NB + b) * 32 + cl] = acc[b];
            __syncthreads();
            if (tid < 256) { const int b = tid >> 5; float s = 0.f;
#pragma unroll
                for (int k2 = 0; k2 < 16; ++k2) s += red[(k2 * NB + b) * 32 + cl];
                mod[((size_t)l * NB + b) * (6 * D) + col0 + cl] = s + ada_b[l * 6 * D + col0 + cl]; }
            __syncthreads();
        }
        for (int i = bid * NTHREADS + tid; i < S * 32; i += G * NTHREADS) {
            const int t = i >> 5, a = (i >> 4) & 1, p = i & 15;
            const float pos = (float)(a == 0 ? t / GW : t % GW);
            const float ang = pos * exp2f(-(float)p * (13.287712379549449f / 16.f));
            const float kf = rintf(ang * 0.15915494309189535f);
            float r = fmaf(-kf, 6.2831854820251465f, ang); r = fmaf(-kf, -1.7484555314695172e-07f, r);
            ropec[i] = __cosf(r); ropes[i] = __sinf(r);
        }
        { const float* m_wg = INP(13); const float* m_we = INP(15);
          for (int i = bid * NTHREADS + tid; i < DEPTH * NRT * D; i += G * NTHREADS) {
            const int l = i / (NRT * D), o = (i / D) % NRT, k = i % D;
            wrt[i] = o < NG ? m_wg[((size_t)l * D + k) * NG + o] : m_we[((size_t)l * D + k) * NE + (o - NG)];
          } }
        LAS float* scr = (LAS float*)(lds + 49152 + wave * 8704);
        { const float* na_wqkv = INP(6); const float* na_wo = INP(8); const float* gq_wqkv = INP(9); const float* gq_wo = INP(12);
          bf16* Wqkv_na = (bf16*)(ws + WS_WQKV_NA); bf16* Wo_na = (bf16*)(ws + WS_WO_NA); bf16* Wqkv_gq = (bf16*)(ws + WS_WQKV_GQ); bf16* Wo_gq = (bf16*)(ws + WS_WO_GQ);
          constexpr int I_NQ = 16 * 96, I_O = 16 * 32, I_GQ = 16 * 48, I_DENSE = 2 * (I_NQ + I_O + I_GQ + I_O);
          for (int it = gw; it < I_DENSE; it += NGW) {
            int r = it; const int j = r / (I_DENSE / 2); r %= (I_DENSE / 2);
            if (r < I_NQ) { transpose_item(na_wqkv + (size_t)j * D * NQKV_NA, D, NQKV_NA, Wqkv_na + (size_t)j * NQKV_NA * D, 0, scr, r, lane); continue; } r -= I_NQ;
            if (r < I_O) { transpose_item(na_wo + (size_t)j * D * D, D, D, Wo_na + (size_t)j * D * D, 0, scr, r, lane); continue; } r -= I_O;
            if (r < I_GQ) { transpose_item(gq_wqkv + (size_t)j * D * NQKV_GQ, D, NQKV_GQ, Wqkv_gq + (size_t)j * NQKV_GQ * D, 1, scr, r, lane); continue; } r -= I_GQ;
            transpose_item(gq_wo + (size_t)j * D * D, D, D, Wo_gq + (size_t)j * D * D, 0, scr, r, lane);
          } }
        moe_weight_items(INP(17), INP(18), INP(19), 0, (bf16*)(ws + WS_WGU), (bf16*)(ws + WS_WDN), scr, gw, NGW, lane);
    }
    GRID_SYNC();
    {
        PH_BEGIN
        const float* x_in = INP(0); const float* mod = (const float*)(ws + WS_MOD); bf16* Hb = (bf16*)(ws + WS_H);
        for (int m = gw; m < M; m += NGW) {
            const float* mb = mod + (size_t)(m >> 11) * (6 * D);
#pragma unroll
            for (int j = 0; j < 4; ++j) { const int d = 4 * lane + 256 * j;
                const f32x4 xv = *(const f32x4*)(x_in + (size_t)m * D + d), sh = *(const f32x4*)(mb + d), sc = *(const f32x4*)(mb + D + d);
                const f32x4 hv = xv * (1.f + sc) + sh; v2u o; o.x = pk2(hv[0], hv[1]); o.y = pk2(hv[2], hv[3]);
                *(v2u*)(Hb + (size_t)m * D + d) = o; }
        }
    }
    GRID_SYNC();

    for (int layer = 0; layer < DEPTH; ++layer) {
        {
            PH_BEGIN
            const int j2 = layer >> 1;
            bf16* Hb = (bf16*)(ws + WS_H); bf16* Qb = (bf16*)(ws + WS_Q);
            if ((layer & 1) == 0) {
                pg8::Gemm g{Hb, (bf16*)(ws + WS_WQKV_NA) + (size_t)j2 * NQKV_NA * D, M, NQKV_NA, D}; pg8::StaticOrder So; So.init(M, NQKV_NA, G, bid);
                pg8::EpiStore8 E{Qb, D, D, (size_t)(WS_K - WS_Q) / 2, C2, 0x7fffffff};
                pg8::gemm_phase<pg8::EpiStore8, pg8::StaticOrder, true, true>(lds, g, So, E);
            } else {
                pg8::Gemm g{Hb, (bf16*)(ws + WS_WQKV_GQ) + (size_t)j2 * NQKV_GQ * D, M, NQKV_GQ, D}; pg8::StaticOrder So; So.init(M, NQKV_GQ, G, bid);
                const float* ropec = (const float*)(ws + WS_ROPE);
                pg8::EpiGqaQkv E{Qb, (bf16*)(ws + WS_K), (bf16*)(ws + WS_V), INP(10) + j2 * HD, INP(11) + j2 * HD, ropec, ropec + S * 32, C2};
                pg8::gemm_phase<pg8::EpiGqaQkv, pg8::StaticOrder, true, true>(lds, g, So, E);
            }
        }
        GRID_SYNC();
        {
            PH_BEGIN
            bf16* Qb = (bf16*)(ws + WS_Q); const bf16* Kb = (const bf16*)(ws + WS_K); const bf16* Vb = (const bf16*)(ws + WS_V);
            if ((layer & 1) == 0) na_attn_simple(Qb, Kb, Vb, Qb, INP(7) + (size_t)(layer >> 1) * NH * 15 * 31, gw, NGW, lane);
            else {
                const attn_body::AttnTensors AT{(const attn_body::bf16*)Qb, (const attn_body::bf16*)Kb, (const attn_body::bf16*)Vb, (attn_body::bf16*)Qb};
                const attn_body::StaticOrder So(G, bid);
                attn_body::attn_phase<attn_body::StaticOrder>((char*)lds, AT, So);
            }
        }
        GRID_SYNC();
        {
            PH_BEGIN
            const bf16* Wo = (const bf16*)(ws + ((layer & 1) == 0 ? WS_WO_NA : WS_WO_GQ)) + (size_t)(layer >> 1) * D * D;
            pg8::Gemm g{(const bf16*)(ws + WS_Q), Wo, M, D, D}; pg8::StaticOrder So; So.init(M, D, G, bid);
            pg8::EpiStore8 E{(bf16*)(ws + WS_Y), D, 0, 0, 1.f, 0x7fffffff};
            pg8::gemm_phase<pg8::EpiStore8, pg8::StaticOrder, true, true>(lds, g, So, E);
        }
        GRID_SYNC();
        {
            PH_BEGIN
            const float* xcur = layer == 0 ? INP(0) : (const float*)(ws + WS_X2);
            const float* modl = (const float*)(ws + WS_MOD) + (size_t)layer * NB * 6 * D;
            unsigned* cnt = (unsigned*)(ws + WS_CTL) + CW_CNT + 64 * layer;
            float* X1 = (float*)(ws + WS_X1); bf16* Hb = (bf16*)(ws + WS_H); const bf16* Yb = (const bf16*)(ws + WS_Y);
            int* r_eid = (int*)(ws + WS_ROUTE); int* r_pos = r_eid + 2 * M; float* r_gate = (float*)(r_pos + 2 * M);
            LAS int* hist = (LAS int*)lds; LAS int* basee = hist + 32; LAS int* rt_e = hist + 64; LAS int* rt_lp = rt_e + 128; LAS float* rt_g = (LAS float*)(rt_lp + 128);
            const float* lg = INP(4) + (size_t)(layer * 2) * D; const float* lb = INP(5) + (size_t)(layer * 2) * D;
            const float* wr = (const float*)(ws + WS_WRT) + (size_t)layer * NRT * D; const float* bgp = INP(14) + layer * NG; const float* bep = INP(16) + layer * NE;
            for (int ch = bid; ch < M / 64; ch += G) {
                if (tid < 32) hist[tid] = 0;
                __syncthreads();
                for (int ti = 0; ti < 8; ++ti) {
                    const int tl = wave * 8 + ti, m = ch * 64 + tl; const float* mb = modl + (size_t)(m >> 11) * (6 * D);
                    f32x4 v[4]; float s = 0.f;
#pragma unroll
                    for (int j = 0; j < 4; ++j) { const int d = 4 * lane + 256 * j;
                        const f32x4 xv = *(const f32x4*)(xcur + (size_t)m * D + d), g1 = *(const f32x4*)(mb + 2 * D + d);
                        const v2u yw = *(const v2u*)(Yb + (size_t)m * D + d); const f32x4 yv = {bflo(yw.x), bfhi(yw.x), bflo(yw.y), bfhi(yw.y)};
                        v[j] = ALPHA * xv + (1.f + g1) * yv; s += (v[j][0] + v[j][1]) + (v[j][2] + v[j][3]); }
                    const float mean = wave_sum(s) * (1.f / D); float q = 0.f;
#pragma unroll
                    for (int j = 0; j < 4; ++j) { v[j] = v[j] - mean; q += (v[j][0] * v[j][0] + v[j][1] * v[j][1]) + (v[j][2] * v[j][2] + v[j][3] * v[j][3]); }
                    const float rstd = rsqrtf(wave_sum(q) * (1.f / D) + LN_EPS);
#pragma unroll
                    for (int j = 0; j < 4; ++j) { const int d = 4 * lane + 256 * j;
                        const f32x4 x1 = v[j] * rstd * *(const f32x4*)(lg + d) + *(const f32x4*)(lb + d);
                        *(f32x4*)(X1 + (size_t)m * D + d) = x1;
                        const f32x4 h2 = x1 * (1.f + *(const f32x4*)(mb + 4 * D + d)) + *(const f32x4*)(mb + 3 * D + d);
                        v2u o; o.x = pk2(h2[0], h2[1]); o.y = pk2(h2[2], h2[3]); *(v2u*)(Hb + (size_t)m * D + d) = o;
                        v[j] = h2; }
                    float lgp[NG];
#pragma unroll
                    for (int o = 0; o < NG; ++o) { float a = 0.f;
#pragma unroll
                        for (int j = 0; j < 4; ++j) { const f32x4 w4 = *(const f32x4*)(wr + (size_t)o * D + 4 * lane + 256 * j); a += (v[j][0] * w4[0] + v[j][1] * w4[1]) + (v[j][2] * w4[2] + v[j][3] * w4[3]); }
                        lgp[o] = wave_sum(a) + bgp[o]; }
                    int gi = 0; float gm = lgp[0];
#pragma unroll
                    for (int o = 1; o < NG; ++o) if (lgp[o] > gm) { gm = lgp[o]; gi = o; }
                    float gs = 0.f;
#pragma unroll
                    for (int o = 0; o < NG; ++o) gs += __expf(lgp[o] - gm);
                    const float gprob = 1.f / gs;
                    gi = __builtin_amdgcn_readfirstlane(gi);
                    float le[EPG];
#pragma unroll
                    for (int e = 0; e < EPG; ++e) { float a = 0.f; const float* wp = wr + (size_t)(NG + gi * EPG + e) * D;
#pragma unroll
                        for (int j = 0; j < 4; ++j) { const f32x4 w4 = *(const f32x4*)(wp + 4 * lane + 256 * j); a += (v[j][0] * w4[0] + v[j][1] * w4[1]) + (v[j][2] * w4[2] + v[j][3] * w4[3]); }
                        le[e] = wave_sum(a) + bep[gi * EPG + e]; }
                    int i0 = 0; float m0 = le[0];
#pragma unroll
                    for (int e = 1; e < EPG; ++e) if (le[e] > m0) { m0 = le[e]; i0 = e; }
                    int i1 = 0; float m1 = -INFINITY;
#pragma unroll
                    for (int e = 0; e < EPG; ++e) if (e != i0 && le[e] > m1) { m1 = le[e]; i1 = e; }
                    const float p1 = __expf(m1 - m0), den = 1.f + p1;
                    if (lane == 0) { const int e0 = gi * EPG + i0, e1 = gi * EPG + i1;
                        rt_e[2 * tl] = e0; rt_e[2 * tl + 1] = e1; rt_g[2 * tl] = gprob / den; rt_g[2 * tl + 1] = gprob * p1 / den;
                        rt_lp[2 * tl] = atomicAdd((int*)&hist[e0], 1); rt_lp[2 * tl + 1] = atomicAdd((int*)&hist[e1], 1); }
                }
                __syncthreads();
                if (tid < 32) { const int c = hist[tid]; basee[tid] = c ? (int)__hip_atomic_fetch_add(cnt + tid, (unsigned)c, RLX_AGENT) : 0; }
                __syncthreads();
                if (tid < 128) { const int e = rt_e[tid], A = ch * 128 + tid; r_eid[A] = e; r_pos[A] = basee[e] + rt_lp[tid]; r_gate[A] = rt_g[tid]; }
                __syncthreads();
            }
        }
        GRID_SYNC();
        {
            PH_BEGIN
            const unsigned* cnt = (const unsigned*)(ws + WS_CTL) + CW_CNT + 64 * layer;
            const bf16* Hb = (const bf16*)(ws + WS_H); bf16* XS = (bf16*)(ws + WS_XS);
            const int* r_eid = (const int*)(ws + WS_ROUTE); const int* r_pos = r_eid + 2 * M;
            build_tiles(cnt, misc, tid);
            for (int m = gw; m < M; m += NGW) {
                const v4u a0 = *(const v4u*)(Hb + (size_t)m * D + 8 * lane), a1 = *(const v4u*)(Hb + (size_t)m * D + 512 + 8 * lane);
#pragma unroll
                for (int k = 0; k < 2; ++k) { const int e = r_eid[2 * m + k], slot = misc[e] * 256 + r_pos[2 * m + k];
                    *(v4u*)(XS + (size_t)slot * D + 8 * lane) = a0; *(v4u*)(XS + (size_t)slot * D + 512 + 8 * lane) = a1; }
            }
        }
        GRID_SYNC();
        {
            PH_BEGIN
            const int ntiles = __builtin_amdgcn_readfirstlane(misc[33]);
            pg8::Gemm g{(const bf16*)(ws + WS_XS), (const bf16*)(ws + WS_WGU), ntiles * 256, NE * D, D}; MoeOrder So{ntiles * 4, G, bid, misc + 64};
            pg8::EpiSwiglu E{(bf16*)(ws + WS_HMID)};
            pg8::gemm_phase<pg8::EpiSwiglu, MoeOrder, true, true>(lds, g, So, E);
        }
        GRID_SYNC();
        {
            PH_BEGIN
            const int ntiles = __builtin_amdgcn_readfirstlane(misc[33]);
            pg8::Gemm g{(const bf16*)(ws + WS_HMID), (const bf16*)(ws + WS_WDN), ntiles * 256, NE * D, DE}; MoeOrder So{ntiles * 4, G, bid, misc + 64};
            pg8::EpiStore8 E{(bf16*)(ws + WS_YS), D, 0, 0, 1.f, 3};
            pg8::gemm_phase<pg8::EpiStore8, MoeOrder, true, true>(lds, g, So, E);
        }
        GRID_SYNC();
        {
            PH_BEGIN
            const float* lg = INP(4) + (size_t)(layer * 2 + 1) * D; const float* lb = INP(5) + (size_t)(layer * 2 + 1) * D;
            const bool last = layer == DEPTH - 1; float* xo = last ? (float*)ldptr(ptab, 20) : (float*)(ws + WS_X2);
            const float* modl = (const float*)(ws + WS_MOD) + (size_t)layer * NB * 6 * D; const float* modn = modl + (size_t)NB * 6 * D;
            const float* X1 = (const float*)(ws + WS_X1); bf16* Hb = (bf16*)(ws + WS_H); const bf16* YS = (const bf16*)(ws + WS_YS);
            const int* r_eid = (const int*)(ws + WS_ROUTE); const int* r_pos = r_eid + 2 * M; const float* r_gate = (const float*)(r_pos + 2 * M);
            for (int m = gw; m < M; m += NGW) {
                const float* mb = modl + (size_t)(m >> 11) * (6 * D); const float* mn = modn + (size_t)(m >> 11) * (6 * D);
                const int s0 = misc[r_eid[2 * m]] * 256 + r_pos[2 * m], s1 = misc[r_eid[2 * m + 1]] * 256 + r_pos[2 * m + 1];
                const float g0 = r_gate[2 * m], g1v = r_gate[2 * m + 1];
                f32x4 v[4]; float s = 0.f;
#pragma unroll
                for (int j = 0; j < 4; ++j) { const int d = 4 * lane + 256 * j;
                    const f32x4 xv = *(const f32x4*)(X1 + (size_t)m * D + d), g2 = *(const f32x4*)(mb + 5 * D + d);
                    const v2u ya = *(const v2u*)(YS + (size_t)s0 * D + d), yb = *(const v2u*)(YS + (size_t)s1 * D + d);
                    const f32x4 y0 = {bflo(ya.x), bfhi(ya.x), bflo(ya.y), bfhi(ya.y)}, y1 = {bflo(yb.x), bfhi(yb.x), bflo(yb.y), bfhi(yb.y)};
                    v[j] = ALPHA * xv + (1.f + g2) * (g0 * y0 + g1v * y1); s += (v[j][0] + v[j][1]) + (v[j][2] + v[j][3]); }
                const float mean = wave_sum(s) * (1.f / D); float q = 0.f;
#pragma unroll
                for (int j = 0; j < 4; ++j) { v[j] = v[j] - mean; q += (v[j][0] * v[j][0] + v[j][1] * v[j][1]) + (v[j][2] * v[j][2] + v[j][3] * v[j][3]); }
                const float rstd = rsqrtf(wave_sum(q) * (1.f / D) + LN_EPS);
#pragma unroll
                for (int j = 0; j < 4; ++j) { const int d = 4 * lane + 256 * j;
                    const f32x4 x2 = v[j] * rstd * *(const f32x4*)(lg + d) + *(const f32x4*)(lb + d);
                    *(f32x4*)(xo + (size_t)m * D + d) = x2;
                    if (!last) { const f32x4 hn = x2 * (1.f + *(const f32x4*)(mn + D + d)) + *(const f32x4*)(mn + d);
                        v2u o; o.x = pk2(hn[0], hn[1]); o.y = pk2(hn[2], hn[3]); *(v2u*)(Hb + (size_t)m * D + d) = o; } }
            }
            if (!last) { LAS float* scr = (LAS float*)(lds + wave * 8704); moe_weight_items(INP(17), INP(18), INP(19), layer + 1, (bf16*)(ws + WS_WGU), (bf16*)(ws + WS_WDN), scr, gw, NGW, lane); }
        }
        if (layer != DEPTH - 1) GRID_SYNC();
    }
}

extern "C" void kernel_launch(void* const* d_in, const int* in_sizes, int n_in, void* d_out, int out_size, void* d_ws, size_t ws_size, hipStream_t stream) {
    static int grid = 0;
    if (grid == 0) {
        if (n_in != 20 || ws_size < WS_END) { fprintf(stderr, "kernel_launch: unexpected inputs (n_in %d, ws %zu)\n", n_in, ws_size); grid = -1; return; }
        int dev = 0, cus = 0, per_cu = 0;
        if (hipGetDevice(&dev) != hipSuccess || hipDeviceGetAttribute(&cus, hipDeviceAttributeMultiprocessorCount, dev) != hipSuccess) { grid = -1; return; }
        if (hipFuncSetAttribute((const void*)mk_fwd, hipFuncAttributeMaxDynamicSharedMemorySize, LDS_BYTES) != hipSuccess) { fprintf(stderr, "kernel_launch: hipFuncSetAttribute failed\n"); grid = -1; return; }
        if (hipOccupancyMaxActiveBlocksPerMultiprocessor(&per_cu, (const void*)mk_fwd, NTHREADS, LDS_BYTES) != hipSuccess || per_cu < 1) { fprintf(stderr, "kernel_launch: occupancy query failed (%d)\n", per_cu); per_cu = 1; }
        (void)hipGetLastError();
        grid = cus * (per_cu < 1 ? 1 : 1);
    }
    if (grid < 0) return;
    (void)in_sizes; (void)out_size;
    if (hipMemsetAsync((char*)d_ws + WS_CTL, 0, CTL_ZERO_BYTES, stream) != hipSuccess) { fprintf(stderr, "kernel_launch: memset failed\n"); return; }
    Args a{};
    for (int i = 0; i < 20; ++i) a.in[i] = (const float*)d_in[i];
    a.out = (float*)d_out; a.ws = (unsigned char*)d_ws;
    void* kargs[] = {&a};
    hipError_t e = hipLaunchCooperativeKernel((const void*)mk_fwd, dim3(grid), dim3(NTHREADS), kargs, LDS_BYTES, stream);
    if (e != hipSuccess) fprintf(stderr, "kernel_launch: cooperative launch failed: %s (grid %d)\n", hipGetErrorString(e), grid);
}
```

```cpp
#include <hip/hip_runtime.h>
#include <hip/hip_cooperative_groups.h>
#include <cstdio>
#include <cstdint>
namespace cg = cooperative_groups;
namespace pg8 {
#define PG8_LAS __attribute__((address_space(3)))
typedef unsigned short bf16_t;
typedef short bf16x8 __attribute__((ext_vector_type(8)));
typedef float f32x4 __attribute__((ext_vector_type(4)));
typedef unsigned u32x4 __attribute__((ext_vector_type(4)));
constexpr int BM = 256, BK = 64, HALF = 128, HTB = HALF * BK * 2  , STAGE_BYTES = 8 * HTB, NXCD = 8, WGM = 8;

__host__ __device__ __forceinline__ int lds_byte(int r, int c) { const int st = (r >> 4) * 2 + (c >> 5), rr = r & 15, cc = c & 31, ob = rr * 64 + cc * 2; return st * 1024 + (ob ^ (((ob >> 9) & 1) << 5)); }
__host__ __device__ __forceinline__ void stage_rc(int b, int& R, int& C) { const int st = b / 1024, sb = b % 1024, swz = sb ^ (((sb >> 9) & 1) << 5); R = (st >> 1) * 16 + swz / 64; C = (st & 1) * 32 + (swz % 64) / 2; }
__host__ __device__ __forceinline__ int perm32(int rho) { const int n = rho >> 4, i = rho & 15; return 8 * (i >> 2) + 4 * n + (i & 3); }

struct Unit { int pm, pn; };
struct Gemm { const bf16_t* A; const bf16_t* Bt; int M, N, K; };

struct StaticOrder {
    int nM, nN, nwg, G, c;
    __host__ __device__ void init(int M, int N, int G_, int c_) { nM = M / BM; nN = N / BM; nwg = nM * nN; G = G_; c = c_; }
    __host__ __device__ bool next(int i, Unit& u) const {
        const long L = (long)i * G + c; if (L >= nwg) return false;
        int wgid = (int)L; { const int q = nwg / NXCD, r = nwg % NXCD, xcd = wgid % NXCD, off = wgid / NXCD; wgid = (xcd < r ? xcd * (q + 1) : r * (q + 1) + (xcd - r) * q) + off; }
        const int nig = WGM * nN, gid = wgid / nig, fm = gid * WGM, gsz = (nM - fm) < WGM ? (nM - fm) : WGM;
        u.pm = fm + ((wgid % nig) % gsz); u.pn = (wgid % nig) / gsz; return true;
    }
    __device__ __forceinline__ void a_ready(const Unit&) const {}
    __device__ __forceinline__ void done(const Unit&) const {}
};

__device__ __forceinline__ unsigned cvt_pk_bf16(float lo, float hi) { unsigned r; asm volatile("v_cvt_pk_bf16_f32 %0, %1, %2" : "=v"(r) : "v"(lo), "v"(hi)); return r; }
__device__ __forceinline__ u32x4 pack8(const f32x4& a, const f32x4& b) { u32x4 w; w.x = cvt_pk_bf16(a[0], a[1]); w.y = cvt_pk_bf16(a[2], a[3]); w.z = cvt_pk_bf16(b[0], b[1]); w.w = cvt_pk_bf16(b[2], b[3]); return w; }

struct EpiStore8 {
    static constexpr bool PERM = false, AFTER_DRAIN = false;
    bf16_t* O; int ldc; int split_cols; size_t split_stride; float scale0; int pn_mask;
    __device__ __forceinline__ void operator()(const f32x4 (&acc)[2][2][4][2], const Unit& u, int wr, int wc, int fr, int fq) const {
        const int row0 = u.pm * BM + wr * 64 + fr; int colt = (u.pn & pn_mask) * BM; bf16_t* base = O;
        float sc = 1.f; if (split_cols) { const int t = colt / split_cols; base += (size_t)t * split_stride; colt -= t * split_cols; if (t == 0) sc = scale0; }
        const int col0 = colt + wc * 32 + 8 * fq;
#pragma unroll
        for (int ai = 0; ai < 2; ++ai)
#pragma unroll
            for (int m = 0; m < 4; ++m) { bf16_t* rowp = base + (size_t)(row0 + ai * HALF + m * 16) * ldc + col0;
#pragma unroll
                for (int bj = 0; bj < 2; ++bj) { const f32x4 v0 = acc[ai][bj][m][0] * sc, v1 = acc[ai][bj][m][1] * sc; *(u32x4*)(rowp + bj * HALF) = pack8(v0, v1); } }
    }
};
__device__ __forceinline__ float silu_f(float g) { return g * __builtin_amdgcn_rcpf(1.f + __expf(-g)); }
struct EpiSwiglu {
    static constexpr bool PERM = false, AFTER_DRAIN = false;
    bf16_t* O;
    __device__ __forceinline__ void operator()(const f32x4 (&acc)[2][2][4][2], const Unit& u, int wr, int wc, int fr, int fq) const {
        const int row0 = u.pm * BM + wr * 64 + fr; const int col0 = (u.pn & 3) * 128 + wc * 32 + 8 * fq;
#pragma unroll
        for (int ai = 0; ai < 2; ++ai)
#pragma unroll
            for (int m = 0; m < 4; ++m) { bf16_t* rowp = O + (size_t)(row0 + ai * HALF + m * 16) * 512 + col0; f32x4 h[2];
#pragma unroll
                for (int n = 0; n < 2; ++n) { const f32x4 g = acc[ai][0][m][n], up = acc[ai][1][m][n];
                    h[n] = (f32x4){silu_f(g[0]) * up[0], silu_f(g[1]) * up[1], silu_f(g[2]) * up[2], silu_f(g[3]) * up[3]}; }
                *(u32x4*)rowp = pack8(h[0], h[1]); }
    }
};
struct EpiGqaQkv {
    static constexpr bool PERM = false, AFTER_DRAIN = false;
    bf16_t *Q, *K, *V; const float* qn; const float* kn; const float* cs; const float* sn; float qscale;
    __device__ __forceinline__ void operator()(const f32x4 (&acc)[2][2][4][2], const Unit& u, int wr, int wc, int fr, int fq) const {
        const int row0 = u.pm * BM + wr * 64 + fr; const int pn = u.pn;
        const int type = pn < 4 ? 0 : (pn == 4 ? 1 : 2);
        bf16_t* base = type == 0 ? Q + (4 * pn + wc) * 64 : (type == 1 ? K : V) + wc * 64; const int ldc = type == 0 ? 1024 : 256;
        const int dlo = 32 * (fq >> 1) + 8 * (fq & 1);
        const int tlo = (fq >> 1) * 16 + 8 * (fq & 1);
        const float* gain = type == 0 ? qn : kn; const float sc = type == 0 ? qscale : 1.f;
        f32x4 gv[2][2];
#pragma unroll
        for (int bj = 0; bj < 2; ++bj)
#pragma unroll
            for (int n = 0; n < 2; ++n) gv[bj][n] = *(const f32x4*)(gain + dlo + 16 * bj + 4 * n) * sc;
#pragma unroll
        for (int ai = 0; ai < 2; ++ai)
#pragma unroll
            for (int m = 0; m < 4; ++m) { const int row = row0 + ai * HALF + m * 16; bf16_t* rowp = base + (size_t)row * ldc + dlo; f32x4 o[2][2];
                if (type < 2) {
                    float ss = 0.f;
#pragma unroll
                    for (int bj = 0; bj < 2; ++bj)
#pragma unroll
                        for (int n = 0; n < 2; ++n) { const f32x4 x = acc[ai][bj][m][n]; ss += (x[0] * x[0] + x[1] * x[1]) + (x[2] * x[2] + x[3] * x[3]); }
                    ss += __shfl_xor(ss, 16); ss += __shfl_xor(ss, 32);
                    const float rinv = rsqrtf(ss * (1.f / 64.f) + 1e-6f);
                    const int t = row & 2047;
#pragma unroll
                    for (int n = 0; n < 2; ++n) { const f32x4 c4 = *(const f32x4*)(cs + t * 32 + tlo + 4 * n), s4 = *(const f32x4*)(sn + t * 32 + tlo + 4 * n);
                        const f32x4 x1 = acc[ai][0][m][n] * rinv * gv[0][n], x2 = acc[ai][1][m][n] * rinv * gv[1][n];
                        o[0][n] = x1 * c4 - x2 * s4; o[1][n] = x2 * c4 + x1 * s4; }
                } else {
#pragma unroll
                    for (int bj = 0; bj < 2; ++bj)
#pragma unroll
                        for (int n = 0; n < 2; ++n) o[bj][n] = acc[ai][bj][m][n];
                }
#pragma unroll
                for (int bj = 0; bj < 2; ++bj) *(u32x4*)(rowp + 16 * bj) = pack8(o[bj][0], o[bj][1]); }
    }
};
template <class Epi, class Sched, bool ALIGN_EPI = false, bool SP2 = false>
__device__ __forceinline__ void gemm_phase(PG8_LAS unsigned char* lds, const Gemm g, const Sched& S, const Epi& E) {
    int tid_ = threadIdx.x; asm volatile("" : "+v"(tid_)); const int tid = tid_, wid = __builtin_amdgcn_readfirstlane(tid >> 6), lane = tid & 63, wr = wid >> 2, wc = wid & 3, fr = lane & 15, fq = lane >> 4;
    const int K = g.K, nt = K / BK;
    unsigned voffA[2], voffB[2];
#pragma unroll
    for (int i = 0; i < 2; ++i) { int R, C; stage_rc(tid * 16 + i * 8192, R, C); const int Rb = Epi::PERM ? ((R & ~31) + perm32(R & 31)) : R;
        voffA[i] = (unsigned)(R * K + C) * 2u; voffB[i] = (unsigned)(Rb * K + C) * 2u; }
    const size_t kstep = (size_t)(BK * 2);
    const size_t hstep = (size_t)HALF * K * 2;
    const size_t tstep = 2 * hstep;
    const unsigned ldsw = (unsigned)wid * 1024u;
    const int aoff = lds_byte(wr * 64 + fr, fq * 8), boff = lds_byte(wc * 32 + fr, fq * 8);
#define PG8_SA(b, h) (((b) * 2 + (h)) * HTB)
#define PG8_SB(b, h) ((4 + (b) * 2 + (h)) * HTB)
#define PG8_STAGE(bufoff, gbase, voff) do { _Pragma("unroll") for (int _i = 0; _i < 2; ++_i) \
        __builtin_amdgcn_global_load_lds((const unsigned*)((const char*)(gbase) + (voff)[_i]), (PG8_LAS unsigned*)(lds + (bufoff) + ldsw + _i * 8192), 16, 0, 0); } while (0)
#define PG8_LDA(dst, b, h) do { _Pragma("unroll") for (int m = 0; m < 4; ++m) _Pragma("unroll") for (int k = 0; k < 2; ++k) dst[m][k] = *(const PG8_LAS bf16x8*)(lds + PG8_SA(b, h) + aoff + m * 2048 + k * 1024); } while (0)
#define PG8_LDB(dst, b, h) do { _Pragma("unroll") for (int n = 0; n < 2; ++n) _Pragma("unroll") for (int k = 0; k < 2; ++k) dst[n][k] = *(const PG8_LAS bf16x8*)(lds + PG8_SB(b, h) + boff + n * 2048 + k * 1024); } while (0)
#define PG8_MMA(ai, bj, At, Bt) do { __builtin_amdgcn_s_setprio(1); _Pragma("unroll") for (int m = 0; m < 4; ++m) _Pragma("unroll") for (int n = 0; n < 2; ++n) _Pragma("unroll") for (int k = 0; k < 2; ++k) \
        acc[ai][bj][m][n] = __builtin_amdgcn_mfma_f32_16x16x32_bf16(Bt[n][k], At[m][k], acc[ai][bj][m][n], 0, 0, 0); __builtin_amdgcn_s_setprio(0); } while (0)
#define PG8_WAIT_V(n) asm volatile("s_waitcnt vmcnt(" #n ")" ::: "memory")
#define PG8_WAIT_L(n) asm volatile("s_waitcnt lgkmcnt(" #n ")" ::: "memory")
#define PG8_BAR __builtin_amdgcn_s_barrier()
#define PG8_SCHED __builtin_amdgcn_sched_barrier(0)
    Unit cur, nxt; int ui = 0;
    if (!S.next(0, cur)) return;
    f32x4 acc[2][2][4][2];
#pragma unroll
    for (int a = 0; a < 2; ++a)
#pragma unroll
        for (int b = 0; b < 2; ++b)
#pragma unroll
            for (int m = 0; m < 4; ++m)
#pragma unroll
                for (int n = 0; n < 2; ++n) acc[a][b][m][n] = (f32x4){0.f, 0.f, 0.f, 0.f};
    bf16x8 At[4][2], B0[2][2], B1[2][2];
    const char* cA = (const char*)g.A + (size_t)cur.pm * tstep; const char* cB = (const char*)g.Bt + (size_t)cur.pn * tstep;
    S.a_ready(cur);
    if constexpr (SP2) {
        PG8_STAGE(PG8_SB(0, 0), cB, voffB); PG8_STAGE(PG8_SB(0, 1), cB + hstep, voffB); PG8_STAGE(PG8_SA(0, 0), cA, voffA); PG8_STAGE(PG8_SA(0, 1), cA + hstep, voffA);
        if (wr == 1) PG8_BAR;
        PG8_WAIT_V(2); PG8_BAR;
        PG8_STAGE(PG8_SB(1, 0), cB + kstep, voffB); PG8_STAGE(PG8_SA(1, 0), cA + kstep, voffA); PG8_STAGE(PG8_SB(1, 1), cB + hstep + kstep, voffB);
        PG8_WAIT_V(6); PG8_BAR;
    } else {
        PG8_STAGE(PG8_SB(0, 0), cB, voffB); PG8_STAGE(PG8_SA(0, 0), cA, voffA); PG8_STAGE(PG8_SB(0, 1), cB + hstep, voffB); PG8_STAGE(PG8_SA(0, 1), cA + hstep, voffA);
        if (wr == 1) PG8_BAR;
        PG8_WAIT_V(4); PG8_BAR;
        PG8_STAGE(PG8_SB(1, 0), cB + kstep, voffB); PG8_STAGE(PG8_SA(1, 0), cA + kstep, voffA); PG8_STAGE(PG8_SB(1, 1), cB + hstep + kstep, voffB);
        PG8_WAIT_V(6); PG8_BAR;
    }
    for (;;) {
        const bool has_next = S.next(ui + 1, nxt);
        const char* nA = has_next ? (const char*)g.A + (size_t)nxt.pm * tstep : cA; const char* nB = has_next ? (const char*)g.Bt + (size_t)nxt.pn * tstep : cB;
        for (int t = 0; t < nt; t += 2) {
            const bool last = (t == nt - 2);
            const char* a1 = cA + (size_t)(t + 1) * kstep;
            const char* a2 = last ? nA : cA + (size_t)(t + 2) * kstep; const char* b2 = last ? nB : cB + (size_t)(t + 2) * kstep;
            const char* a3 = a2 + kstep; const char* b3 = b2 + kstep;
            if (last && has_next) S.a_ready(nxt);
            if constexpr (SP2) {
            PG8_LDB(B0, 0, 0); PG8_LDB(B1, 0, 1); PG8_SCHED; PG8_LDA(At, 0, 0); PG8_STAGE(PG8_SA(1, 1), a1 + hstep, voffA);
            PG8_WAIT_V(8); PG8_WAIT_L(0); PG8_BAR; PG8_MMA(0, 0, At, B0); PG8_MMA(0, 1, At, B1); PG8_BAR; PG8_SCHED;
            PG8_LDA(At, 0, 1); PG8_STAGE(PG8_SB(0, 0), b2, voffB); PG8_STAGE(PG8_SB(0, 1), b2 + hstep, voffB); PG8_STAGE(PG8_SA(0, 0), a2, voffA);
            PG8_WAIT_V(8); PG8_WAIT_L(0); PG8_BAR; PG8_MMA(1, 0, At, B0); PG8_MMA(1, 1, At, B1); PG8_BAR; PG8_SCHED;
            PG8_LDB(B0, 1, 0); PG8_LDB(B1, 1, 1); PG8_SCHED; PG8_LDA(At, 1, 0); PG8_STAGE(PG8_SA(0, 1), a2 + hstep, voffA);
            PG8_WAIT_V(8); PG8_WAIT_L(0); PG8_BAR; PG8_MMA(0, 0, At, B0); PG8_MMA(0, 1, At, B1); PG8_BAR; PG8_SCHED;
            PG8_LDA(At, 1, 1); PG8_STAGE(PG8_SB(1, 0), b3, voffB); PG8_STAGE(PG8_SB(1, 1), b3 + hstep, voffB); PG8_STAGE(PG8_SA(1, 0), a3, voffA);
            PG8_WAIT_V(8); PG8_WAIT_L(0); PG8_BAR; PG8_MMA(1, 0, At, B0); PG8_MMA(1, 1, At, B1); PG8_BAR; PG8_SCHED;
            } else {
            PG8_LDB(B0, 0, 0); PG8_SCHED; PG8_LDA(At, 0, 0); PG8_STAGE(PG8_SA(1, 1), a1 + hstep, voffA);
            PG8_WAIT_L(8); PG8_BAR; PG8_WAIT_L(0); PG8_MMA(0, 0, At, B0); PG8_BAR; PG8_SCHED;
            PG8_LDB(B1, 0, 1); PG8_STAGE(PG8_SB(0, 0), b2, voffB);
            PG8_BAR; PG8_WAIT_L(0); PG8_MMA(0, 1, At, B1); PG8_BAR;
            PG8_LDA(At, 0, 1); PG8_STAGE(PG8_SA(0, 0), a2, voffA);
            PG8_BAR; PG8_WAIT_L(0); PG8_MMA(1, 0, At, B0); PG8_BAR; PG8_SCHED;
            PG8_STAGE(PG8_SB(0, 1), b2 + hstep, voffB);
            PG8_WAIT_V(6); PG8_BAR; PG8_MMA(1, 1, At, B1); PG8_BAR;
            PG8_LDB(B0, 1, 0); PG8_SCHED; PG8_LDA(At, 1, 0); PG8_STAGE(PG8_SA(0, 1), a2 + hstep, voffA);
            PG8_WAIT_L(8); PG8_BAR; PG8_WAIT_L(0); PG8_MMA(0, 0, At, B0); PG8_BAR; PG8_SCHED;
            PG8_LDB(B1, 1, 1); PG8_STAGE(PG8_SB(1, 0), b3, voffB);
            PG8_BAR; PG8_WAIT_L(0); PG8_MMA(0, 1, At, B1); PG8_BAR;
            PG8_LDA(At, 1, 1); PG8_STAGE(PG8_SA(1, 0), a3, voffA);
            PG8_BAR; PG8_WAIT_L(0); PG8_MMA(1, 0, At, B0); PG8_BAR; PG8_SCHED;
            PG8_STAGE(PG8_SB(1, 1), b3 + hstep, voffB);
            PG8_WAIT_V(6); PG8_BAR; PG8_MMA(1, 1, At, B1); PG8_BAR;
            }
        }
        if constexpr (ALIGN_EPI) { if (wr == 0) PG8_BAR; }
        if constexpr (!Epi::AFTER_DRAIN) { E(acc, cur, wr, wc, fr, fq); S.done(cur); }
        if (!has_next) break;
#pragma unroll
        for (int a = 0; a < 2; ++a)
#pragma unroll
            for (int b = 0; b < 2; ++b)
#pragma unroll
                for (int m = 0; m < 4; ++m)
#pragma unroll
                    for (int n = 0; n < 2; ++n) acc[a][b][m][n] = (f32x4){0.f, 0.f, 0.f, 0.f};
        cur = nxt; cA = nA; cB = nB; ++ui;
        if constexpr (ALIGN_EPI) { if (wr == 1) PG8_BAR; }
    }
    PG8_WAIT_V(0);
    if constexpr (!ALIGN_EPI) { if (wr == 0) PG8_BAR; }
    PG8_BAR;
    if constexpr (Epi::AFTER_DRAIN) { E.fused(acc, cur, wr, wc, fr, fq, lds, wid, lane); S.done(cur); }
#undef PG8_SA
#undef PG8_SB
#undef PG8_STAGE
#undef PG8_LDA
#undef PG8_LDB
#undef PG8_MMA
#undef PG8_WAIT_V
#undef PG8_WAIT_L
#undef PG8_BAR
#undef PG8_SCHED
}
}
#include <hip/hip_bf16.h>
#include <cmath>
namespace attn_body {
using bf16=__hip_bfloat16;
using bf16x8=__attribute__((ext_vector_type(8)))short;
using s16x4=__attribute__((ext_vector_type(4)))short;
using f32x16=__attribute__((ext_vector_type(16)))float;
using u32x4=__attribute__((ext_vector_type(4)))unsigned;
constexpr int BATCH=8,NHEAD=16,SEQ=2048,D=64,DM=NHEAD*D,KVP=256;
constexpr int NW=8,QBLK=32,QB=QBLK*NW,KVBLK=64,NQB=SEQ/QB;
constexpr int ATTN_PITCH=DM, ATTN_UNIT_ROWS=QB;
__device__ __forceinline__ int crow(int r,int hi){return (r&3)+8*(r>>2)+4*hi;}
#define SBAR() __builtin_amdgcn_sched_barrier(0)
__device__ __forceinline__ void cmask(f32x16&p0,f32x16&p1,int jb,int qrel,int hi){
  const float NEG=-INFINITY; int kb=64*jb+4*hi;
  #pragma unroll
  for(int r=0;r<16;++r){int kv=kb+(r&3)+8*(r>>2); if(kv>qrel)p0[r]=NEG; if(kv+32>qrel)p1[r]=NEG;}
}

constexpr int NSLOT=3, SLOTB=8192;
constexpr int LDS_K=0, LDS_V=NSLOT*SLOTB, LDS_WS=2*NSLOT*SLOTB, LDS_OST=LDS_WS+NW*64*4, LDS_BYTES=LDS_OST+NW*4096;
constexpr float C2=0.125f*1.4426950408889634f;
__device__ __forceinline__ void glds16(const void*gsrc,unsigned lds_dst){unsigned keep;
  asm volatile("s_mov_b32 %0, m0\n\ts_mov_b32 m0, %2\n\ts_nop 0\n\tglobal_load_lds_dwordx4 %1, off\n\ts_mov_b32 m0, %0":"=&s"(keep):"v"(gsrc),"s"(lds_dst):"memory");}
__device__ __forceinline__ float max3f(float a,float b,float c){float r;asm("v_max3_f32 %0, %1, %2, %3":"=v"(r):"v"(a),"v"(b),"v"(c));return r;}
__device__ __forceinline__ float max2f(float a,float b){float r;asm("v_max_f32_e32 %0, %1, %2":"=v"(r):"v"(a),"v"(b));return r;}
__device__ __forceinline__ float fadd_s(float a,float b){float r;asm("v_add_f32_e32 %0, %1, %2":"=v"(r):"v"(a),"v"(b));return r;}
__device__ __forceinline__ float fsub_s(float a,float b){float r;asm("v_sub_f32_e32 %0, %1, %2":"=v"(r):"v"(a),"v"(b));return r;}
typedef float f32x2_t __attribute__((ext_vector_type(2))); typedef __bf16 bf16x2_t __attribute__((ext_vector_type(2)));
__device__ __forceinline__ unsigned cvtpk_s(float lo,float hi){f32x2_t v={lo,hi};bf16x2_t b=__builtin_convertvector(v,bf16x2_t);return __builtin_bit_cast(unsigned,b);}
#define WAIT_BAR(N) asm volatile("s_waitcnt vmcnt(" #N ") lgkmcnt(0)\n\ts_barrier":::"memory")

__device__ __forceinline__ void qkt(f32x16&p0,f32x16&p1,const char*Kslot,const bf16x8*qr,const f32x16&negm,int r32,int hi){
  const char*kb=Kslot+hi*1024+r32*16;
  #pragma unroll
  for(int d0=0;d0<4;++d0){
    const bf16x8 b0=*reinterpret_cast<const bf16x8*>(kb+d0*2048);
    const bf16x8 b1=*reinterpret_cast<const bf16x8*>(kb+d0*2048+512);
    if(d0==0){p0=__builtin_amdgcn_mfma_f32_32x32x16_bf16(b0,qr[0],negm,0,0,0);p1=__builtin_amdgcn_mfma_f32_32x32x16_bf16(b1,qr[0],negm,0,0,0);}
    else{p0=__builtin_amdgcn_mfma_f32_32x32x16_bf16(b0,qr[d0],p0,0,0,0);p1=__builtin_amdgcn_mfma_f32_32x32x16_bf16(b1,qr[d0],p1,0,0,0);}}
}
typedef __attribute__((address_space(3))) const char* lds_cptr;
typedef short v4i16_t __attribute__((ext_vector_type(4)));
__device__ __forceinline__ void kload8(bf16x8*kf,lds_cptr kp){
  kf[0]=*(const __attribute__((address_space(3))) bf16x8*)(kp);      kf[1]=*(const __attribute__((address_space(3))) bf16x8*)(kp+512);
  kf[2]=*(const __attribute__((address_space(3))) bf16x8*)(kp+2048); kf[3]=*(const __attribute__((address_space(3))) bf16x8*)(kp+2560);
  kf[4]=*(const __attribute__((address_space(3))) bf16x8*)(kp+4096); kf[5]=*(const __attribute__((address_space(3))) bf16x8*)(kp+4608);
  kf[6]=*(const __attribute__((address_space(3))) bf16x8*)(kp+6144); kf[7]=*(const __attribute__((address_space(3))) bf16x8*)(kp+6656);
}
__device__ __forceinline__ void kload2(bf16x8*kf,lds_cptr kp,int j){ kf[2*j]=*(const __attribute__((address_space(3))) bf16x8*)(kp+j*2048); kf[2*j+1]=*(const __attribute__((address_space(3))) bf16x8*)(kp+j*2048+512); }
__device__ __forceinline__ s16x4 vtr(lds_cptr p){ return __builtin_bit_cast(s16x4,__builtin_amdgcn_ds_read_tr16_b64_v4i16((__attribute__((address_space(3))) v4i16_t*)p)); }
__device__ __forceinline__ float rowmax(const f32x16&p0,const f32x16&p1){
  float a=max3f(p0[0],p0[1],p1[0]),b=max3f(p0[2],p0[3],p1[1]);a=max3f(a,p1[2],p1[3]);
  #pragma unroll
  for(int r=4;r<16;r+=4){a=max3f(a,p0[r],p0[r+1]);b=max3f(b,p0[r+2],p0[r+3]);a=max3f(a,p1[r],p1[r+1]);b=max3f(b,p1[r+2],p1[r+3]);}
  const float m=max2f(a,b);
  auto rr=__builtin_amdgcn_permlane32_swap(__float_as_uint(m),__float_as_uint(m),false,false);
  return max2f(__uint_as_float(rr[0]),__uint_as_float(rr[1]));
}
__device__ __forceinline__ void pv(f32x16*o,int vb,bf16x8 pa0,bf16x8 pa1,bf16x8 pa2,bf16x8 pa3){
  #pragma unroll
  for(int d0=0;d0<2;++d0){s16x4 lo[4],hi[4];
    #pragma unroll
    for(int ks=0;ks<4;++ks){
      asm volatile("ds_read_b64_tr_b16 %0,%1 offset:%c2":"=&v"(lo[ks]):"v"(vb),"i"(d0*4096+ks*1024):"memory");
      asm volatile("ds_read_b64_tr_b16 %0,%1 offset:%c2":"=&v"(hi[ks]):"v"(vb),"i"(d0*4096+ks*1024+512):"memory");}
    asm volatile("s_waitcnt lgkmcnt(0)":::"memory");SBAR();
    #define PK(k) (bf16x8){lo[k][0],lo[k][1],lo[k][2],lo[k][3],hi[k][0],hi[k][1],hi[k][2],hi[k][3]}
    o[d0]=__builtin_amdgcn_mfma_f32_32x32x16_bf16(pa0,PK(0),o[d0],0,0,0);
    o[d0]=__builtin_amdgcn_mfma_f32_32x32x16_bf16(pa1,PK(1),o[d0],0,0,0);
    o[d0]=__builtin_amdgcn_mfma_f32_32x32x16_bf16(pa2,PK(2),o[d0],0,0,0);
    o[d0]=__builtin_amdgcn_mfma_f32_32x32x16_bf16(pa3,PK(3),o[d0],0,0,0);
    #undef PK
  }
}

#ifndef ATTN_STORE16
#define ATTN_STORE16(p,v) (*(u32x4*)(p)=(v))
#endif
template<int THRL> __device__ __forceinline__ void attn_unit(int b,int h,int qb,const bf16*Q,const bf16*__restrict__ K,const bf16*__restrict__ V,bf16*O,char*shm){
  int tid_=threadIdx.x; asm volatile("":"+v"(tid_)); const int tid=tid_,lane=tid&63,r32=lane&31,hi=lane>>5; const int wid=__builtin_amdgcn_readfirstlane(tid>>6);
  const long rowbase=(long)b*SEQ; const int q0=qb*QB;
  const bf16*Qw=Q+(rowbase+q0+wid*QBLK)*DM+h*D;
  const bf16*Kh=K+rowbase*KVP+(h>>2)*D,*Vh=V+rowbase*KVP+(h>>2)*D;
  const unsigned lds0=(unsigned)(uintptr_t)shm;
  float*wsf=(float*)(shm+LDS_WS)+wid*64;
  const bf16*ksrc=Kh+(long)lane*KVP+wid*8;
  const bf16*vsrc=Vh+(long)(16*(wid&3)+(lane>>2))*KVP+(wid>>2)*32+(lane&3)*8;
  const unsigned kdst=lds0+LDS_K+wid*1024, vdst=lds0+LDS_V+wid*1024;
  #define DMA_K(t,slot) glds16(ksrc+(long)(t)*KVBLK*KVP,(unsigned)__builtin_amdgcn_readfirstlane(kdst+(slot)))
  #define DMA_V(t,slot) glds16(vsrc+(long)(t)*KVBLK*KVP,(unsigned)__builtin_amdgcn_readfirstlane(vdst+(slot)))
  const int vb0=(int)(lds0+LDS_V)+((lane>>4)&1)*32+(lane&3)*8+(4*hi+((lane&15)>>2))*64;
  const char*Kbase=shm+LDS_K; bf16x8 kf[8];
  const lds_cptr shm3=(lds_cptr)shm; const lds_cptr kp0=shm3+LDS_K+hi*1024+r32*16; const lds_cptr vp0=shm3+LDS_V+((lane>>4)&1)*32+(lane&3)*8+(4*hi+((lane&15)>>2))*64;
  const int NT=SEQ/KVBLK;
  DMA_K(0,0);DMA_V(0,0);DMA_K(1,SLOTB);
  bf16x8 qr[4];
  #pragma unroll
  for(int d0=0;d0<4;++d0)qr[d0]=*reinterpret_cast<const bf16x8*>(&Qw[(long)r32*DM+d0*16+hi*8]);
  float mhat=0.f,l_reg=0.f;f32x16 o[2];o[0]=f32x16{};o[1]=f32x16{};f32x16 negm=f32x16{};asm volatile("":"+v"(negm));
  const int qrel=wid*QBLK+r32;
  #define CMASK(P0,P1,t) do{}while(0)
  bool resc=false;
  #define START(P0,P1) do{ const float rm=rowmax(P0,P1); resc=false; \
    { const float dl=rm; mhat=fadd_s(mhat,dl); \
      _Pragma("unroll") for(int r=0;r<16;++r){P0[r]=fsub_s(P0[r],dl);P1[r]=fsub_s(P1[r],dl);} \
      _Pragma("unroll") for(int r=0;r<16;++r)negm[r]=-mhat; asm volatile("":"+v"(negm)); } \
    _Pragma("unroll") for(int r=0;r<16;++r)P0[r]=__builtin_amdgcn_exp2f(P0[r]); }while(0)
  #define RESC() do{ if(resc){ asm volatile("s_waitcnt lgkmcnt(0)":::"memory"); \
      _Pragma("unroll") for(int d_=0;d_<2;++d_) _Pragma("unroll") for(int r=0;r<16;++r)o[d_][r]*=wsf[crow(r,hi)]; } }while(0)
  f32x16 pA0,pA1,pB0,pB1;
  int sl_prev=0,sl_cur=0,sl_next=SLOTB;
  #define ROT() do{sl_prev=sl_cur;sl_cur=sl_next;sl_next=(sl_next==(NSLOT-1)*SLOTB)?0:sl_next+SLOTB;}while(0)
  DMA_K(2,2*SLOTB);
  WAIT_BAR(3);
  qkt(pA0,pA1,Kbase,qr,negm,r32,hi);asm volatile("s_nop 15\n\ts_nop 7":"+v"(pA0),"+v"(pA1));CMASK(pA0,pA1,0);
  START(pA0,pA1);
  _Pragma("unroll") for(int r=0;r<16;++r)pA1[r]=__builtin_amdgcn_exp2f(pA1[r]);
  WAIT_BAR(0);
  DMA_K(3,0);DMA_V(1,SLOTB);
  ROT();
  kload8(kf,kp0+sl_cur);
  WAIT_BAR(2);
  s16x4 vlo[8],vhi[8]; u32x4 pw0,pw1,pw2,pw3;
  #define PKW(P,B) cvtpk_s(P[B],P[B+1])
  #define PAF(k) __builtin_bit_cast(bf16x8,pw##k)
  #define VFR(i) (bf16x8){vlo[i][0],vlo[i][1],vlo[i][2],vlo[i][3],vhi[i][0],vhi[i][1],vhi[i][2],vhi[i][3]}
  #define PIN(x) asm volatile("":"+v"(x))
  #define MX3(a,b,c) __builtin_fmaxf(__builtin_fmaxf((a),(b)),(c))
  #define GAPA(MF,A0,A1,A2,A3,W0,W1,PW) do{ MF; sacc+=A0; sacc+=A1; sacc+=A2; sacc+=A3; PIN(sacc); W0; W1; PIN(PW); SBAR(); }while(0)
  #define EX(v) __builtin_amdgcn_exp2f(v)
  #define GAPB(MF,X,B) do{ MF; X[B]=EX(X[B]); X[B+1]=EX(X[B+1]); X[B+2]=EX(X[B+2]); X[B+3]=EX(X[B+3]); PIN(X); SBAR(); }while(0)
  #define VRD(i) do{ vlo[i]=vtr(vp_+(((i)>>2)*4096+((i)&3)*1024)); vhi[i]=vtr(vp_+(((i)>>2)*4096+((i)&3)*1024+512)); }while(0)
  #define KRD(G,j) do{ if(G){ kload2(kf,kp0+sl_next,j); SBAR(); } }while(0)
  #define STEP(C0,C1,P0,P1,t,GK,GV,GL) do{ SBAR(); \
    const lds_cptr vp_=vp0+sl_prev; \
    VRD(0); SBAR(); float sacc=(P0[0]+P0[1]); \
    GAPA(C0=__builtin_amdgcn_mfma_f32_32x32x16_bf16(kf[0],qr[0],negm,0,0,0), P0[2],P0[3],P0[4],P0[5],     pw0[0]=PKW(P0,0), pw0[1]=PKW(P0,2), pw0); \
    VRD(4); SBAR(); GAPA(C1=__builtin_amdgcn_mfma_f32_32x32x16_bf16(kf[1],qr[0],negm,0,0,0), P0[6],P0[7],P0[8],P0[9],     pw0[2]=PKW(P0,4), pw0[3]=PKW(P0,6), pw0); \
    VRD(1); SBAR(); GAPA(C0=__builtin_amdgcn_mfma_f32_32x32x16_bf16(kf[2],qr[1],C0,0,0,0),   P0[10],P0[11],P0[12],P0[13], pw1[0]=PKW(P0,8), pw1[1]=PKW(P0,10), pw1); \
    VRD(5); SBAR(); GAPA(C1=__builtin_amdgcn_mfma_f32_32x32x16_bf16(kf[3],qr[1],C1,0,0,0),   P0[14],P0[15],P1[0],P1[1],   pw1[2]=PKW(P0,12),pw1[3]=PKW(P0,14), pw1); \
    VRD(2); SBAR(); GAPA(C0=__builtin_amdgcn_mfma_f32_32x32x16_bf16(kf[4],qr[2],C0,0,0,0),   P1[2],P1[3],P1[4],P1[5],     pw2[0]=PKW(P1,0), pw2[1]=PKW(P1,2), pw2); \
    VRD(6); SBAR(); GAPA(C1=__builtin_amdgcn_mfma_f32_32x32x16_bf16(kf[5],qr[2],C1,0,0,0),   P1[6],P1[7],P1[8],P1[9],     pw2[2]=PKW(P1,4), pw2[3]=PKW(P1,6), pw2); \
    VRD(3); SBAR(); GAPA(C0=__builtin_amdgcn_mfma_f32_32x32x16_bf16(kf[6],qr[3],C0,0,0,0),   P1[10],P1[11],P1[12],P1[13], pw3[0]=PKW(P1,8), pw3[1]=PKW(P1,10), pw3); \
    VRD(7); SBAR(); GAPA(C1=__builtin_amdgcn_mfma_f32_32x32x16_bf16(kf[7],qr[3],C1,0,0,0),   P1[14],P1[15],0.f,0.f,       pw3[2]=PKW(P1,12),pw3[3]=PKW(P1,14), pw3); \
    l_reg+=sacc; \
    if(GK){DMA_K((t)+3,sl_cur);} if(GV){DMA_V((t)+1,sl_next);} \
    CMASK(C0,C1,t); \
    { float a=MX3(C0[0],C0[1],C1[0]),b=MX3(C0[2],C0[3],C1[1]); a=MX3(a,C1[2],C1[3]); \
      _Pragma("unroll") for(int r=4;r<16;r+=4){a=MX3(a,C0[r],C0[r+1]);b=MX3(b,C0[r+2],C0[r+3]);a=MX3(a,C1[r],C1[r+1]);b=MX3(b,C1[r+2],C1[r+3]);} \
      float rm=__builtin_fmaxf(a,b); { auto rr=__builtin_amdgcn_permlane32_swap(__float_as_uint(rm),__float_as_uint(rm),false,false); rm=__builtin_fmaxf(__uint_as_float(rr[0]),__uint_as_float(rr[1])); } \
      resc=false; \
      if(__builtin_expect(__any(rm>(float)THRL),0)){ const float dl=__builtin_fmaxf(rm,0.f); mhat+=dl; \
        _Pragma("unroll") for(int r=0;r<16;++r){C0[r]-=dl;C1[r]-=dl;} \
        _Pragma("unroll") for(int r=0;r<16;++r)negm[r]=-mhat; asm volatile("":"+v"(negm)); \
        const float f=__builtin_amdgcn_exp2f(-dl); l_reg*=f; if(hi==0)wsf[r32]=f; resc=true; } } \
    SBAR(); \
    GAPB(o[0]=__builtin_amdgcn_mfma_f32_32x32x16_bf16(PAF(0),VFR(0),o[0],0,0,0), C0,0); \
    GAPB(o[1]=__builtin_amdgcn_mfma_f32_32x32x16_bf16(PAF(0),VFR(4),o[1],0,0,0), C0,4); \
    KRD(GL,0); GAPB(o[0]=__builtin_amdgcn_mfma_f32_32x32x16_bf16(PAF(1),VFR(1),o[0],0,0,0), C0,8); \
    KRD(GL,1); GAPB(o[1]=__builtin_amdgcn_mfma_f32_32x32x16_bf16(PAF(1),VFR(5),o[1],0,0,0), C0,12); \
    KRD(GL,2); GAPB(o[0]=__builtin_amdgcn_mfma_f32_32x32x16_bf16(PAF(2),VFR(2),o[0],0,0,0), C1,0); \
    KRD(GL,3); GAPB(o[1]=__builtin_amdgcn_mfma_f32_32x32x16_bf16(PAF(2),VFR(6),o[1],0,0,0), C1,4); \
    GAPB(o[0]=__builtin_amdgcn_mfma_f32_32x32x16_bf16(PAF(3),VFR(3),o[0],0,0,0), C1,8); \
    GAPB(o[1]=__builtin_amdgcn_mfma_f32_32x32x16_bf16(PAF(3),VFR(7),o[1],0,0,0), C1,12); \
    }while(0)
  int t=1;
  #undef CMASK
  #define CMASK(P0,P1,t) do{}while(0)
  for(;t+5<NT;t+=2){
    STEP(pB0,pB1,pA0,pA1,t,true,true,true);     WAIT_BAR(2); RESC(); ROT();
    STEP(pA0,pA1,pB0,pB1,t+1,true,true,true);   WAIT_BAR(2); RESC(); ROT();
  }
  #undef CMASK
  #define CMASK(P0,P1,t) do{}while(0)
  #define ENDW(tt) do{ if((tt)+3<NT){WAIT_BAR(2);} else if((tt)+2<NT){WAIT_BAR(1);} else {WAIT_BAR(0);} }while(0)
  for(;t+1<NT;t+=2){
    STEP(pB0,pB1,pA0,pA1,t,(t+3<NT),(t+1<NT),(t+1<NT));       ENDW(t);   RESC(); ROT();
    STEP(pA0,pA1,pB0,pB1,t+1,(t+4<NT),(t+2<NT),(t+2<NT));     ENDW(t+1); RESC(); ROT();
  }
  STEP(pB0,pB1,pA0,pA1,NT-1,false,false,false); RESC();
  { float sacc=pB0[0]+pB0[1]; _Pragma("unroll") for(int r=2;r<16;++r)sacc+=pB0[r]; _Pragma("unroll") for(int r=0;r<16;++r)sacc+=pB1[r]; l_reg+=sacc;
    pw0=(u32x4){PKW(pB0,0),PKW(pB0,2),PKW(pB0,4),PKW(pB0,6)};pw1=(u32x4){PKW(pB0,8),PKW(pB0,10),PKW(pB0,12),PKW(pB0,14)};pw2=(u32x4){PKW(pB1,0),PKW(pB1,2),PKW(pB1,4),PKW(pB1,6)};pw3=(u32x4){PKW(pB1,8),PKW(pB1,10),PKW(pB1,12),PKW(pB1,14)};
    SBAR(); pv(o,vb0+sl_cur,PAF(0),PAF(1),PAF(2),PAF(3)); }
  #undef PKW
  #undef PAF
  #undef VFR
  #undef PIN
  #undef MX3
  #undef GAPA
  #undef GAPB
  #undef EX
  #undef VRD
  #undef KRD
  #undef STEP
  #undef ENDW
  {auto rr=__builtin_amdgcn_permlane32_swap(__float_as_uint(l_reg),__float_as_uint(l_reg),false,false);l_reg=__uint_as_float(rr[0])+__uint_as_float(rr[1]);}
  if(hi==0)wsf[32+r32]=l_reg;asm volatile("s_waitcnt lgkmcnt(0)":::"memory");
  float rli[16];
  #pragma unroll
  for(int r=0;r<16;++r)rli[r]=__builtin_amdgcn_rcpf(wsf[32+crow(r,hi)]);
  bf16*Ow=O+(rowbase+q0+wid*QBLK)*DM+h*D;
  { bf16*stg=(bf16*)(shm+LDS_OST)+wid*2048;
    #pragma unroll
    for(int r=0;r<16;++r){const int orow=crow(r,hi);
      #pragma unroll
      for(int d0=0;d0<2;++d0)stg[orow*64+d0*32+r32]=__float2bfloat16(o[d0][r]*rli[r]);}
    asm volatile("s_waitcnt lgkmcnt(0)":::"memory");
    #pragma unroll
    for(int i=0;i<4;++i){const int row=i*8+(lane>>3),ch=lane&7; const u32x4 v=*(const u32x4*)(stg+row*64+ch*8); ATTN_STORE16(Ow+(long)row*DM+ch*8,v);} }
  asm volatile("s_waitcnt lgkmcnt(0)\n\ts_barrier":::"memory");
  #undef DMA_K
  #undef DMA_V
  #undef CMASK
  #undef START
  #undef RESC
  #undef ROT
}
constexpr int ATTN_LDS_BYTES=LDS_BYTES;
struct AttnTensors { const bf16* Q; const bf16* K; const bf16* V; bf16* O; };
struct AttnUnit { int bh; int qb; };
struct StaticOrder {
  int vcu,G;
  __device__ __forceinline__ explicit StaticOrder(int grid,int block):vcu((grid%8==0)?(block%8)*(grid/8)+block/8:block),G(grid){}
  __device__ __forceinline__ bool next(int i,AttnUnit&u)const{ const int L=i*G+vcu; if(L>=1024)return false; const int xg=L>>5,w=L&31; const int grp=(xg&7)*4+(xg>>3); u.bh=(grp>>2)*NHEAD+(grp&3)*4+(w>>3); u.qb=w&7; return true; }
  __device__ __forceinline__ void a_ready(const AttnUnit&)const{}
  __device__ __forceinline__ void done(const AttnUnit&)const{}
};
template<class Sched,int THRL=8> __device__ __forceinline__ void attn_phase(char*lds,const AttnTensors&T,const Sched&S){
  AttnUnit u;
  for(int i=0;S.next(i,u);++i){ S.a_ready(u); attn_unit<THRL>(u.bh/NHEAD,u.bh%NHEAD,u.qb,T.Q,T.K,T.V,T.O,lds); S.done(u); }
}
#undef SBAR
#undef WAIT_BAR
}
namespace na_body {
typedef short bf16x8 __attribute__((ext_vector_type(8)));
typedef short s16x4 __attribute__((ext_vector_type(4)));
typedef float f32x4 __attribute__((ext_vector_type(4)));
typedef unsigned u32x4 __attribute__((ext_vector_type(4)));
typedef unsigned u32x2 __attribute__((ext_vector_type(2)));
#define NA_LAS __attribute__((address_space(3)))
constexpr int VROW = 160, LDS_V = 0, LDS_BIAS = 9 * 64 * VROW, NA_LDS_BYTES = LDS_BIAS + 15 * 64 * 4;
__device__ __forceinline__ unsigned cvtpk(float lo, float hi) { typedef float f2 __attribute__((ext_vector_type(2))); typedef __bf16 b2 __attribute__((ext_vector_type(2))); f2 v = {lo, hi}; b2 b = __builtin_convertvector(v, b2); return __builtin_bit_cast(unsigned, b); }
__device__ __forceinline__ s16x4 vtr(const NA_LAS char* p) { typedef short v4i16_t __attribute__((ext_vector_type(4))); return __builtin_bit_cast(s16x4, __builtin_amdgcn_ds_read_tr16_b64_v4i16((NA_LAS v4i16_t*)p)); }

__device__ __forceinline__ void na_phase(NA_LAS char* lds, const unsigned short* Qg, const unsigned short* Kg, const unsigned short* Vg, unsigned short* Og, const float* __restrict__ rpb, int G, int bid) {
    int tid_ = threadIdx.x; asm volatile("" : "+v"(tid_));
    const int tid = tid_, lane = tid & 63, wave = __builtin_amdgcn_readfirstlane(tid >> 6), fr = lane & 15, fq = lane >> 4;
    const int vcu = (G % 8 == 0) ? (bid % 8) * (G / 8) + bid / 8 : bid;
    constexpr int NUNITS = 8 * 16 * 16;
    const int per = (NUNITS + G - 1) / G, u_lo = vcu * per, u_hi = (u_lo + per < NUNITS) ? u_lo + per : NUNITS;
    if (u_lo >= u_hi) return;
    u32x4 vr[9];
#define NA_PREFETCH(U) do { const int b_ = (U) >> 8, h_ = ((U) >> 4) & 15, r0_ = 2 * ((U) & 15); const int R0_ = min(max(r0_ - 4, 0), 24); const int ntok_ = min(9, 32 - R0_) * 64; \
        const unsigned short* src_ = Vg + ((size_t)(b_ * 2048 + R0_ * 64)) * 1024 + h_ * 64; \
        _Pragma("unroll") for (int i_ = 0; i_ < 9; ++i_) { const int idx_ = tid + 512 * i_; if ((idx_ >> 3) < ntok_) vr[i_] = *(const u32x4*)(src_ + (size_t)(idx_ >> 3) * 1024 + (idx_ & 7) * 8); } } while (0)
    NA_PREFETCH(u_lo);
    for (int U = u_lo; U < u_hi; ++U) {
        const int b = U >> 8, h = (U >> 4) & 15, r0 = 2 * (U & 15); const int R0 = min(max(r0 - 4, 0), 24);
        if (U != u_lo) __syncthreads();
#pragma unroll
        for (int i = 0; i < 9; ++i) { const int idx = tid + 512 * i; *(NA_LAS u32x4*)(lds + LDS_V + (idx >> 3) * VROW + (idx & 7) * 16) = vr[i]; }
        for (int i = tid; i < 15 * 64; i += 512) { const int dr = i >> 6, dc = (i & 63) - 16; ((NA_LAS float*)(lds + LDS_BIAS))[i] = (dc >= 0 && dc < 31) ? rpb[(h * 15 + dr) * 31 + dc] * 1.4426950408889634f : 0.f; }
        __syncthreads();
        if (U + 1 < u_hi) NA_PREFETCH(U + 1);
        const int r = r0 + (wave >> 2), q0 = 16 * (wave & 3), qcol = q0 + fr;
        const int rs = min(max(r - 4, 0), 24), b0 = min(max(q0 - 8, 0), 32), winlo = min(max(qcol - 8, 0), 48);
        const size_t tokq = (size_t)b * 2048 + r * 64 + qcol;
        bf16x8 qf[2];
#pragma unroll
        for (int ks = 0; ks < 2; ++ks) qf[ks] = *(const bf16x8*)(Qg + tokq * 1024 + h * 64 + 32 * ks + 8 * fq);
        f32x4 am[2];
#pragma unroll
        for (int t = 0; t < 2; ++t)
#pragma unroll
            for (int i = 0; i < 4; ++i) am[t][i] = ((unsigned)(b0 + 16 * t + 4 * fq + i - winlo) < 16u) ? 0.f : -INFINITY;
        const unsigned short* kbase = Kg + ((size_t)b * 2048 + b0 + fr) * 1024 + h * 64 + 8 * fq;
        const NA_LAS char* bias_l = lds + LDS_BIAS + (b0 - qcol + 15 + 16 + 4 * fq) * 4;
        const NA_LAS char* v_l = lds + LDS_V + (b0 + 4 * fq + (fr >> 2)) * VROW + (fr & 3) * 8;
        float m = -INFINITY, lsum = 0.f; f32x4 oacc[4];
#pragma unroll
        for (int dt = 0; dt < 4; ++dt) oacc[dt] = (f32x4){0.f, 0.f, 0.f, 0.f};
        bf16x8 kf[2][2], kn[2][2];
#pragma unroll
        for (int t = 0; t < 2; ++t)
#pragma unroll
            for (int ks = 0; ks < 2; ++ks) kf[t][ks] = *(const bf16x8*)(kbase + (size_t)rs * 65536 + t * 16384 + ks * 32);
#pragma unroll
        for (int kr = 0; kr < 8; ++kr) {
            const int krow = rs + kr;
            if (kr < 7) {
#pragma unroll
                for (int t = 0; t < 2; ++t)
#pragma unroll
                    for (int ks = 0; ks < 2; ++ks) kn[t][ks] = *(const bf16x8*)(kbase + (size_t)(krow + 1) * 65536 + t * 16384 + ks * 32);
            }
            f32x4 s[2];
#pragma unroll
            for (int t = 0; t < 2; ++t) { s[t] = __builtin_amdgcn_mfma_f32_16x16x32_bf16(kf[t][0], qf[0], am[t], 0, 0, 0); s[t] = __builtin_amdgcn_mfma_f32_16x16x32_bf16(kf[t][1], qf[1], s[t], 0, 0, 0); }
            const NA_LAS float* bl = (const NA_LAS float*)(bias_l + (krow - r + 7) * 256);
#pragma unroll
            for (int t = 0; t < 2; ++t)
#pragma unroll
                for (int i = 0; i < 4; ++i) s[t][i] += bl[16 * t + i];
            float mx = fmaxf(fmaxf(fmaxf(s[0][0], s[0][1]), fmaxf(s[0][2], s[0][3])), fmaxf(fmaxf(s[1][0], s[1][1]), fmaxf(s[1][2], s[1][3])));
            mx = fmaxf(mx, __shfl_xor(mx, 16)); mx = fmaxf(mx, __shfl_xor(mx, 32));
            const float mn = fmaxf(m, mx), al = __builtin_amdgcn_exp2f(m - mn); m = mn;
            float ps = 0.f;
#pragma unroll
            for (int t = 0; t < 2; ++t)
#pragma unroll
                for (int i = 0; i < 4; ++i) { s[t][i] = __builtin_amdgcn_exp2f(s[t][i] - mn); ps += s[t][i]; }
            lsum = lsum * al + ps;
            u32x4 pw; pw.x = cvtpk(s[0][0], s[0][1]); pw.y = cvtpk(s[0][2], s[0][3]); pw.z = cvtpk(s[1][0], s[1][1]); pw.w = cvtpk(s[1][2], s[1][3]);
            const bf16x8 pb = __builtin_bit_cast(bf16x8, pw);
            const NA_LAS char* vp = v_l + (krow - R0) * 64 * VROW;
#pragma unroll
            for (int dt = 0; dt < 4; ++dt) {
                const s16x4 lo = vtr(vp + dt * 32), hi = vtr(vp + 16 * VROW + dt * 32);
                const bf16x8 vf = {lo[0], lo[1], lo[2], lo[3], hi[0], hi[1], hi[2], hi[3]};
                oacc[dt] = oacc[dt] * al;
                oacc[dt] = __builtin_amdgcn_mfma_f32_16x16x32_bf16(vf, pb, oacc[dt], 0, 0, 0);
            }
#pragma unroll
            for (int t = 0; t < 2; ++t)
#pragma unroll
                for (int ks = 0; ks < 2; ++ks) kf[t][ks] = kn[t][ks];
        }
        lsum += __shfl_xor(lsum, 16); lsum += __shfl_xor(lsum, 32);
        const float rl = 1.f / lsum;
        unsigned short* op = Og + tokq * 1024 + h * 64 + 4 * fq;
#pragma unroll
        for (int dt = 0; dt < 4; ++dt) { u32x2 w; w.x = cvtpk(oacc[dt][0] * rl, oacc[dt][1] * rl); w.y = cvtpk(oacc[dt][2] * rl, oacc[dt][3] * rl); *(u32x2*)(op + 16 * dt) = w; }
    }
#undef NA_PREFETCH
}
}
constexpr int NWAVES = 8, NTHREADS = 512;
constexpr int D = 1024, NB = 8, S = 2048, M = NB * S, DEPTH = 4, NH = 16, HD = 64, GW = 64, ROWS = 32;
constexpr int KVD = 256, NE = 32, NG = 4, EPG = 8, DE = 512, NQKV_NA = 3072, NQKV_GQ = 1536, NRT = 36;
constexpr float ALPHA = 1.6817928305074290f, LN_EPS = 1e-5f;
constexpr float LOG2E = 1.4426950408889634f, C2 = 0.125f * 1.4426950408889634f;
constexpr int MAXTILES = 160;

constexpr size_t MiB = 1u << 20;
constexpr size_t WS_CTL = 0, CTL_ZERO_BYTES = 1 * MiB;
constexpr size_t WS_MOD = 1 * MiB, WS_ROPE = 2 * MiB, WS_WRT = 3 * MiB;
constexpr size_t WS_WQKV_NA = 4 * MiB, WS_WO_NA = 16 * MiB, WS_WQKV_GQ = 20 * MiB, WS_WO_GQ = 26 * MiB;
constexpr size_t WS_WGU = 32 * MiB, WS_WDN = 96 * MiB;
constexpr size_t WS_X1 = 128 * MiB, WS_X2 = 192 * MiB, WS_H = 256 * MiB, WS_Q = 288 * MiB, WS_K = 320 * MiB, WS_V = 352 * MiB, WS_Y = 384 * MiB;
constexpr size_t WS_XS = 416 * MiB, WS_HMID = 496 * MiB, WS_YS = 536 * MiB, WS_ROUTE = 616 * MiB, WS_END = 620 * MiB;
constexpr int CW_CNT = 8192;

constexpr int RING_BYTES = 131072, MISC_OFF = RING_BYTES, LDS_BYTES = 147456;

#define LAS __attribute__((address_space(3)))
typedef unsigned short bf16;
typedef unsigned v4u __attribute__((ext_vector_type(4)));
typedef unsigned v2u __attribute__((ext_vector_type(2)));
typedef float f32x4 __attribute__((ext_vector_type(4)));
#define RLX_AGENT __ATOMIC_RELAXED, __HIP_MEMORY_SCOPE_AGENT
__device__ __forceinline__ unsigned f2bf(float f) { unsigned u = __builtin_bit_cast(unsigned, f); return (u + 0x7fffu + ((u >> 16) & 1u)) >> 16; }
__device__ __forceinline__ unsigned pk2(float lo, float hi) { return f2bf(lo) | (f2bf(hi) << 16); }
__device__ __forceinline__ float bflo(unsigned w) { return __uint_as_float(w << 16); }
__device__ __forceinline__ float bfhi(unsigned w) { return __uint_as_float(w & 0xffff0000u); }
__device__ __forceinline__ float bf2f(bf16 v) { return __uint_as_float((unsigned)v << 16); }
__device__ __forceinline__ float wave_sum(float v) {
#pragma unroll
    for (int o = 1; o < 64; o <<= 1) v += __shfl_xor(v, o);
    return v;
}

struct Args { const float* in[20]; float* out; unsigned char* ws; };

__device__ __forceinline__ int rho_p8(int cc) { return (cc & 128) + (cc & 96) + 16 * ((cc >> 2) & 1) + 4 * ((cc >> 3) & 3) + (cc & 3); }
__device__ __forceinline__ int rho_head(int cc) { const int wc = cc >> 6, fq = 2 * ((cc >> 5) & 1) + ((cc >> 3) & 1), bj = (cc >> 4) & 1; return 128 * bj + 32 * wc + 16 * ((cc >> 2) & 1) + 4 * fq + (cc & 3); }
__device__ __forceinline__ int dest_row(int mode, int c) {
    if (mode == 0) return (c & ~255) + rho_p8(c & 255);
    if (mode == 1) return (c & ~255) + rho_head(c & 255);
    const int jj = c & 127; return (c >> 7) * 256 + (mode == 3 ? 128 : 0) + (jj & 96) + 16 * ((jj >> 2) & 1) + 4 * ((jj >> 3) & 3) + (jj & 3);
}
__device__ __forceinline__ void transpose_item(const float* __restrict__ W, int K, int N, bf16* __restrict__ WT, int mode, LAS float* scr, int item, int lane) {
    const int nblk = N / 32, kb = item / nblk, nb = item % nblk, k0 = 64 * kb, n0 = 32 * nb;
#pragma unroll 8
    for (int i = 0; i < 32; ++i) { const int kk = 2 * i + (lane >> 5); scr[kk * 33 + (lane & 31)] = W[(size_t)(k0 + kk) * N + n0 + (lane & 31)]; }
    asm volatile("s_waitcnt lgkmcnt(0)" ::: "memory");
    const int c = lane & 7;
#pragma unroll
    for (int j = 0; j < 4; ++j) { const int n = (lane >> 3) + 8 * j; const LAS float* s = scr + (8 * c) * 33 + n;
        v4u o; o.x = pk2(s[0 * 33], s[1 * 33]); o.y = pk2(s[2 * 33], s[3 * 33]); o.z = pk2(s[4 * 33], s[5 * 33]); o.w = pk2(s[6 * 33], s[7 * 33]);
        *(v4u*)(WT + (size_t)dest_row(mode, n0 + n) * K + k0 + 8 * c) = o; }
    asm volatile("s_waitcnt lgkmcnt(0)" ::: "memory");
}
__device__ __forceinline__ void moe_weight_items(const float* __restrict__ wgate, const float* __restrict__ wup, const float* __restrict__ wdown, int layer,
                                                 bf16* __restrict__ Wgu, bf16* __restrict__ Wdn, LAS float* scr, int gw, int NGW, int lane) {
    for (int it = gw; it < NE * 768; it += NGW) {
        const int e = it / 768, r = it % 768, which = r >> 8, sub = r & 255; const size_t le = (size_t)layer * NE + e;
        if (which == 0) transpose_item(wgate + le * D * DE, D, DE, Wgu + (size_t)e * D * D, 2, scr, sub, lane);
        else if (which == 1) transpose_item(wup + le * D * DE, D, DE, Wgu + (size_t)e * D * D, 3, scr, sub, lane);
        else transpose_item(wdown + le * DE * D, DE, D, Wdn + (size_t)e * D * DE, 0, scr, sub, lane);
    }
}

struct MoeOrder {
    int nunits, G, c; const LAS int* tile_e;
    __device__ __forceinline__ bool next(int i, pg8::Unit& u) const {
        const long L = (long)i * G + c; if (L >= nunits) return false;
        const int pm = (int)(L >> 2); u.pm = pm; u.pn = __builtin_amdgcn_readfirstlane(tile_e[pm]) * 4 + (int)(L & 3); return true;
    }
    __device__ __forceinline__ void a_ready(const pg8::Unit&) const {}
    __device__ __forceinline__ void done(const pg8::Unit&) const {}
};
__device__ __forceinline__ void build_tiles(const unsigned* cnt, LAS int* misc, int tid) {
    if (tid == 0) { int s = 0;
        for (int e = 0; e < NE; ++e) { misc[e] = s; const int c = (int)__hip_atomic_load(cnt + e, RLX_AGENT); const int nt = (c + 255) >> 8;
            for (int t = 0; t < nt; ++t) if (s + t < MAXTILES) misc[64 + s + t] = e; s += nt; }
        misc[32] = s; misc[33] = s < MAXTILES ? s : MAXTILES; }
    __syncthreads();
}

__device__ __forceinline__ void na_attn_simple(const bf16* Qb, const bf16* Kb, const bf16* Vb, bf16* Ob, const float* __restrict__ rpb, int gw, int NGW, int lane) {
    for (int w = gw; w < M * NH; w += NGW) {
        const int m = w >> 4, h = w & 15, b = m >> 11, t = m & 2047, r = t >> 6, c = t & 63;
        const int rs = min(max(r - 4, 0), ROWS - 8), wsx = min(max(c - 8, 0), GW - 16);
        const float q = bf2f(Qb[(size_t)m * D + h * HD + lane]);
        float mx = -INFINITY, l = 0.f, acc = 0.f;
        for (int kr = 0; kr < 8; ++kr)
            for (int kc = 0; kc < 16; ++kc) {
                const int krow = rs + kr, kcol = wsx + kc; const size_t tok = (size_t)b * S + krow * GW + kcol;
                const float kv = bf2f(Kb[tok * D + h * HD + lane]), vv = bf2f(Vb[tok * D + h * HD + lane]);
                const int dr = krow - r + 7, dc = min(max(kcol - c + 15, 0), 30);
                const float s = wave_sum(q * kv) + rpb[(h * 15 + dr) * 31 + dc] * LOG2E;
                const float mn = fmaxf(mx, s), al = __builtin_amdgcn_exp2f(mx - mn), p = __builtin_amdgcn_exp2f(s - mn);
                l = l * al + p; acc = acc * al + p * vv; mx = mn;
            }
        Ob[(size_t)m * D + h * HD + lane] = (bf16)f2bf(acc / l);
    }
}
__device__ __forceinline__ void gqa_attn_simple(const bf16* Qb, const bf16* Kb, const bf16* Vb, bf16* Ob, int gw, int NGW, int lane) {
    for (int w = gw; w < M * NH; w += NGW) {
        const int m = w >> 4, h = w & 15, b = m >> 11, kvh = h >> 2;
        const float q = bf2f(Qb[(size_t)m * D + h * HD + lane]);
        float mx = -INFINITY, l = 0.f, acc = 0.f;
        const bf16* kp = Kb + (size_t)b * S * KVD + kvh * HD + lane; const bf16* vp = Vb + (size_t)b * S * KVD + kvh * HD + lane;
        for (int j = 0; j < S; ++j) {
            const float kv = bf2f(kp[(size_t)j * KVD]), vv = bf2f(vp[(size_t)j * KVD]);
            const float s = wave_sum(q * kv);
            const float mn = fmaxf(mx, s), al = __builtin_amdgcn_exp2f(mx - mn), p = __builtin_amdgcn_exp2f(s - mn);
            l = l * al + p; acc = acc * al + p * vv; mx = mn;
        }
        Ob[(size_t)m * D + h * HD + lane] = (bf16)f2bf(acc / l);
    }
}
__device__ __forceinline__ unsigned char* ldptr(const LAS unsigned* ptab, int i) {
    const unsigned lo = (unsigned)__builtin_amdgcn_readfirstlane((int)ptab[2 * i]), hi = (unsigned)__builtin_amdgcn_readfirstlane((int)ptab[2 * i + 1]);
    return (unsigned char*)(__attribute__((address_space(1))) unsigned char*)(((unsigned long long)hi << 32) | lo);
}
#define GRID_SYNC() do { cg::this_grid().sync(); asm volatile("" ::: "memory"); } while (0)
#define PH_BEGIN \
    unsigned ldsb_ = (unsigned)(uintptr_t)lds_raw; asm volatile("" : "+s"(ldsb_)); \
    LAS unsigned char* lds = (LAS unsigned char*)ldsb_; LAS int* misc = (LAS int*)(lds + MISC_OFF); LAS unsigned* ptab = (LAS unsigned*)(lds + MISC_OFF + 1024); (void)misc; \
    int tid = threadIdx.x; asm volatile("" : "+v"(tid)); \
    const int lane = tid & 63, wave = __builtin_amdgcn_readfirstlane(tid >> 6); \
    int G = gridDim.x, bid = blockIdx.x; asm volatile("" : "+s"(G), "+s"(bid)); const int gw = bid * NWAVES + wave, NGW = G * NWAVES; \
    unsigned char* ws = ldptr(ptab, 21); (void)lane; (void)gw; (void)NGW; (void)ws;
#define INP(i) ((const float*)ldptr(ptab, (i)))

__global__ void __launch_bounds__(NTHREADS, 2) mk_fwd(Args args) {
    extern __shared__ __attribute__((aligned(16))) unsigned char lds_raw[];
    { LAS unsigned* ptab = (LAS unsigned*)((LAS unsigned char*)lds_raw + MISC_OFF + 1024);
    if (threadIdx.x < 22) { const unsigned long long p = threadIdx.x < 20 ? (unsigned long long)args.in[threadIdx.x] : (threadIdx.x == 20 ? (unsigned long long)args.out : (unsigned long long)args.ws);
        ptab[2 * threadIdx.x] = (unsigned)p; ptab[2 * threadIdx.x + 1] = (unsigned)(p >> 32); } }
    __syncthreads();

    {
        PH_BEGIN
        const float* c_in = INP(1); const float* ada_w = INP(2); const float* ada_b = INP(3);
        float* mod = (float*)(ws + WS_MOD); float* ropec = (float*)(ws + WS_ROPE); float* ropes = ropec + S * 32; float* wrt = (float*)(ws + WS_WRT);
        LAS float* ca = (LAS float*)lds;
        LAS float* red = (LAS float*)(lds + 32768);
        for (int i = tid; i < NB * D; i += NTHREADS) { const float v = c_in[i]; ca[i] = v / (1.f + __expf(-v)); }
        __syncthreads();
        for (int it = bid; it < DEPTH * 192; it += G) {
            const int l = it / 192, col0 = (it % 192) * 32, cl = tid & 31, ks = tid >> 5;
            const float* wp = ada_w + ((size_t)l * D + 64 * ks) * (6 * D) + col0 + cl;
            float acc[NB];
#pragma unroll
            for (int b = 0; b < NB; ++b) acc[b] = 0.f;
#pragma unroll 16
            for (int kk = 0; kk < 64; ++kk) { const float wv = wp[(size_t)kk * (6 * D)];
#pragma unroll
                for (int b = 0; b < NB; ++b) acc[b] += ca[b * D + 64 * ks + kk] * wv; }
#pragma unroll
            for (int b = 0; b < NB; ++b) red[(ks * NB + b) * 32 + cl] = acc[b];
            __syncthreads();
            if (tid < 256) { const int b = tid >> 5; float s = 0.f;
#pragma unroll
                for (int k2 = 0; k2 < 16; ++k2) s += red[(k2 * NB + b) * 32 + cl];
                mod[((size_t)l * NB + b) * (6 * D) + col0 + cl] = s + ada_b[l * 6 * D + col0 + cl]; }
            __syncthreads();
        }
        for (int i = bid * NTHREADS + tid; i < S * 32; i += G * NTHREADS) {
            const int t = i >> 5, a = (i >> 4) & 1, p = i & 15;
            const float pos = (float)(a == 0 ? t / GW : t % GW);
            const float ang = pos * exp2f(-(float)p * (13.287712379549449f / 16.f));
            const float kf = rintf(ang * 0.15915494309189535f);
            float r = fmaf(-kf, 6.2831854820251465f, ang); r = fmaf(-kf, -1.7484555314695172e-07f, r);
            ropec[i] = __cosf(r); ropes[i] = __sinf(r);
        }
        { const float* m_wg = INP(13); const float* m_we = INP(15);
          for (int i = bid * NTHREADS + tid; i < DEPTH * NRT * D; i += G * NTHREADS) {
            const int l = i / (NRT * D), o = (i / D) % NRT, k = i % D;
            wrt[i] = o < NG ? m_wg[((size_t)l * D + k) * NG + o] : m_we[((size_t)l * D + k) * NE + (o - NG)];
          } }
        LAS float* scr = (LAS float*)(lds + 49152 + wave * 8704);
        { const float* na_wqkv = INP(6); const float* na_wo = INP(8); const float* gq_wqkv = INP(9); const float* gq_wo = INP(12);
          bf16* Wqkv_na = (bf16*)(ws + WS_WQKV_NA); bf16* Wo_na = (bf16*)(ws + WS_WO_NA); bf16* Wqkv_gq = (bf16*)(ws + WS_WQKV_GQ); bf16* Wo_gq = (bf16*)(ws + WS_WO_GQ);
          constexpr int I_NQ = 16 * 96, I_O = 16 * 32, I_GQ = 16 * 48, I_DENSE = 2 * (I_NQ + I_O + I_GQ + I_O);
          for (int it = gw; it < I_DENSE; it += NGW) {
            int r = it; const int j = r / (I_DENSE / 2); r %= (I_DENSE / 2);
            if (r < I_NQ) { transpose_item(na_wqkv + (size_t)j * D * NQKV_NA, D, NQKV_NA, Wqkv_na + (size_t)j * NQKV_NA * D, 0, scr, r, lane); continue; } r -= I_NQ;
            if (r < I_O) { transpose_item(na_wo + (size_t)j * D * D, D, D, Wo_na + (size_t)j * D * D, 0, scr, r, lane); continue; } r -= I_O;
            if (r < I_GQ) { transpose_item(gq_wqkv + (size_t)j * D * NQKV_GQ, D, NQKV_GQ, Wqkv_gq + (size_t)j * NQKV_GQ * D, 1, scr, r, lane); continue; } r -= I_GQ;
            transpose_item(gq_wo + (size_t)j * D * D, D, D, Wo_gq + (size_t)j * D * D, 0, scr, r, lane);
          } }
        moe_weight_items(INP(17), INP(18), INP(19), 0, (bf16*)(ws + WS_WGU), (bf16*)(ws + WS_WDN), scr, gw, NGW, lane);
    }
    GRID_SYNC();
    {
        PH_BEGIN
        const float* x_in = INP(0); const float* mod = (const float*)(ws + WS_MOD); bf16* Hb = (bf16*)(ws + WS_H);
        for (int m = gw; m < M; m += NGW) {
            const float* mb = mod + (size_t)(m >> 11) * (6 * D);
#pragma unroll
            for (int j = 0; j < 4; ++j) { const int d = 4 * lane + 256 * j;
                const f32x4 xv = *(const f32x4*)(x_in + (size_t)m * D + d), sh = *(const f32x4*)(mb + d), sc = *(const f32x4*)(mb + D + d);
                const f32x4 hv = xv * (1.f + sc) + sh; v2u o; o.x = pk2(hv[0], hv[1]); o.y = pk2(hv[2], hv[3]);
                *(v2u*)(Hb + (size_t)m * D + d) = o; }
        }
    }
    GRID_SYNC();

    for (int layer = 0; layer < DEPTH; ++layer) {
        {
            PH_BEGIN
            const int j2 = layer >> 1;
            bf16* Hb = (bf16*)(ws + WS_H); bf16* Qb = (bf16*)(ws + WS_Q);
            if ((layer & 1) == 0) {
                pg8::Gemm g{Hb, (bf16*)(ws + WS_WQKV_NA) + (size_t)j2 * NQKV_NA * D, M, NQKV_NA, D}; pg8::StaticOrder So; So.init(M, NQKV_NA, G, bid);
                pg8::EpiStore8 E{Qb, D, D, (size_t)(WS_K - WS_Q) / 2, C2, 0x7fffffff};
                pg8::gemm_phase<pg8::EpiStore8, pg8::StaticOrder, true, true>(lds, g, So, E);
            } else {
                pg8::Gemm g{Hb, (bf16*)(ws + WS_WQKV_GQ) + (size_t)j2 * NQKV_GQ * D, M, NQKV_GQ, D}; pg8::StaticOrder So; So.init(M, NQKV_GQ, G, bid);
                const float* ropec = (const float*)(ws + WS_ROPE);
                pg8::EpiGqaQkv E{Qb, (bf16*)(ws + WS_K), (bf16*)(ws + WS_V), INP(10) + j2 * HD, INP(11) + j2 * HD, ropec, ropec + S * 32, C2};
                pg8::gemm_phase<pg8::EpiGqaQkv, pg8::StaticOrder, true, true>(lds, g, So, E);
            }
        }
        GRID_SYNC();
        {
            PH_BEGIN
            bf16* Qb = (bf16*)(ws + WS_Q); const bf16* Kb = (const bf16*)(ws + WS_K); const bf16* Vb = (const bf16*)(ws + WS_V);
            if ((layer & 1) == 0) na_body::na_phase((LAS char*)lds, Qb, Kb, Vb, Qb, INP(7) + (size_t)(layer >> 1) * NH * 15 * 31, G, bid);
            else {
                const attn_body::AttnTensors AT{(const attn_body::bf16*)Qb, (const attn_body::bf16*)Kb, (const attn_body::bf16*)Vb, (attn_body::bf16*)Qb};
                const attn_body::StaticOrder So(G, bid);
                attn_body::attn_phase<attn_body::StaticOrder>((char*)lds, AT, So);
            }
        }
        GRID_SYNC();
        {
            PH_BEGIN
            const bf16* Wo = (const bf16*)(ws + ((layer & 1) == 0 ? WS_WO_NA : WS_WO_GQ)) + (size_t)(layer >> 1) * D * D;
            pg8::Gemm g{(const bf16*)(ws + WS_Q), Wo, M, D, D}; pg8::StaticOrder So; So.init(M, D, G, bid);
            pg8::EpiStore8 E{(bf16*)(ws + WS_Y), D, 0, 0, 1.f, 0x7fffffff};
            pg8::gemm_phase<pg8::EpiStore8, pg8::StaticOrder, true, true>(lds, g, So, E);
        }
        GRID_SYNC();
        {
            PH_BEGIN
            const float* xcur = layer == 0 ? INP(0) : (const float*)(ws + WS_X2);
            const float* modl = (const float*)(ws + WS_MOD) + (size_t)layer * NB * 6 * D;
            unsigned* cnt = (unsigned*)(ws + WS_CTL) + CW_CNT + 64 * layer;
            float* X1 = (float*)(ws + WS_X1); bf16* Hb = (bf16*)(ws + WS_H); const bf16* Yb = (const bf16*)(ws + WS_Y);
            int* r_eid = (int*)(ws + WS_ROUTE); int* r_pos = r_eid + 2 * M; float* r_gate = (float*)(r_pos + 2 * M);
            LAS int* hist = (LAS int*)lds; LAS int* basee = hist + 32; LAS int* rt_e = hist + 64; LAS int* rt_lp = rt_e + 128; LAS float* rt_g = (LAS float*)(rt_lp + 128);
            const float* lg = INP(4) + (size_t)(layer * 2) * D; const float* lb = INP(5) + (size_t)(layer * 2) * D;
            const float* wr = (const float*)(ws + WS_WRT) + (size_t)layer * NRT * D; const float* bgp = INP(14) + layer * NG; const float* bep = INP(16) + layer * NE;
            for (int ch = bid; ch < M / 64; ch += G) {
                if (tid < 32) hist[tid] = 0;
                __syncthreads();
                for (int ti = 0; ti < 8; ++ti) {
                    const int tl = wave * 8 + ti, m = ch * 64 + tl; const float* mb = modl + (size_t)(m >> 11) * (6 * D);
                    f32x4 v[4]; float s = 0.f;
#pragma unroll
                    for (int j = 0; j < 4; ++j) { const int d = 4 * lane + 256 * j;
                        const f32x4 xv = *(const f32x4*)(xcur + (size_t)m * D + d), g1 = *(const f32x4*)(mb + 2 * D + d);
                        const v2u yw = *(const v2u*)(Yb + (size_t)m * D + d); const f32x4 yv = {bflo(yw.x), bfhi(yw.x), bflo(yw.y), bfhi(yw.y)};
                        v[j] = ALPHA * xv + (1.f + g1) * yv; s += (v[j][0] + v[j][1]) + (v[j][2] + v[j][3]); }
                    const float mean = wave_sum(s) * (1.f / D); float q = 0.f;
#pragma unroll
                    for (int j = 0; j < 4; ++j) { v[j] = v[j] - mean; q += (v[j][0] * v[j][0] + v[j][1] * v[j][1]) + (v[j][2] * v[j][2] + v[j][3] * v[j][3]); }
                    const float rstd = rsqrtf(wave_sum(q) * (1.f / D) + LN_EPS);
#pragma unroll
                    for (int j = 0; j < 4; ++j) { const int d = 4 * lane + 256 * j;
                        const f32x4 x1 = v[j] * rstd * *(const f32x4*)(lg + d) + *(const f32x4*)(lb + d);
                        *(f32x4*)(X1 + (size_t)m * D + d) = x1;
                        const f32x4 h2 = x1 * (1.f + *(const f32x4*)(mb + 4 * D + d)) + *(const f32x4*)(mb + 3 * D + d);
                        v2u o; o.x = pk2(h2[0], h2[1]); o.y = pk2(h2[2], h2[3]); *(v2u*)(Hb + (size_t)m * D + d) = o;
                        v[j] = h2; }
                    float lgp[NG];
#pragma unroll
                    for (int o = 0; o < NG; ++o) { float a = 0.f;
#pragma unroll
                        for (int j = 0; j < 4; ++j) { const f32x4 w4 = *(const f32x4*)(wr + (size_t)o * D + 4 * lane + 256 * j); a += (v[j][0] * w4[0] + v[j][1] * w4[1]) + (v[j][2] * w4[2] + v[j][3] * w4[3]); }
                        lgp[o] = wave_sum(a) + bgp[o]; }
                    int gi = 0; float gm = lgp[0];
#pragma unroll
                    for (int o = 1; o < NG; ++o) if (lgp[o] > gm) { gm = lgp[o]; gi = o; }
                    float gs = 0.f;
#pragma unroll
                    for (int o = 0; o < NG; ++o) gs += __expf(lgp[o] - gm);
                    const float gprob = 1.f / gs;
                    gi = __builtin_amdgcn_readfirstlane(gi);
                    float le[EPG];
#pragma unroll
                    for (int e = 0; e < EPG; ++e) { float a = 0.f; const float* wp = wr + (size_t)(NG + gi * EPG + e) * D;
#pragma unroll
                        for (int j = 0; j < 4; ++j) { const f32x4 w4 = *(const f32x4*)(wp + 4 * lane + 256 * j); a += (v[j][0] * w4[0] + v[j][1] * w4[1]) + (v[j][2] * w4[2] + v[j][3] * w4[3]); }
                        le[e] = wave_sum(a) + bep[gi * EPG + e]; }
                    int i0 = 0; float m0 = le[0];
#pragma unroll
                    for (int e = 1; e < EPG; ++e) if (le[e] > m0) { m0 = le[e]; i0 = e; }
                    int i1 = 0; float m1 = -INFINITY;
#pragma unroll
                    for (int e = 0; e < EPG; ++e) if (e != i0 && le[e] > m1) { m1 = le[e]; i1 = e; }
                    const float p1 = __expf(m1 - m0), den = 1.f + p1;
                    if (lane == 0) { const int e0 = gi * EPG + i0, e1 = gi * EPG + i1;
                        rt_e[2 * tl] = e0; rt_e[2 * tl + 1] = e1; rt_g[2 * tl] = gprob / den; rt_g[2 * tl + 1] = gprob * p1 / den;
                        rt_lp[2 * tl] = atomicAdd((int*)&hist[e0], 1); rt_lp[2 * tl + 1] = atomicAdd((int*)&hist[e1], 1); }
                }
                __syncthreads();
                if (tid < 32) { const int c = hist[tid]; basee[tid] = c ? (int)__hip_atomic_fetch_add(cnt + tid, (unsigned)c, RLX_AGENT) : 0; }
                __syncthreads();
                if (tid < 128) { const int e = rt_e[tid], A = ch * 128 + tid; r_eid[A] = e; r_pos[A] = basee[e] + rt_lp[tid]; r_gate[A] = rt_g[tid]; }
                __syncthreads();
            }
        }
        GRID_SYNC();
        {
            PH_BEGIN
            const unsigned* cnt = (const unsigned*)(ws + WS_CTL) + CW_CNT + 64 * layer;
            const bf16* Hb = (const bf16*)(ws + WS_H); bf16* XS = (bf16*)(ws + WS_XS);
            const int* r_eid = (const int*)(ws + WS_ROUTE); const int* r_pos = r_eid + 2 * M;
            build_tiles(cnt, misc, tid);
            for (int m = gw; m < M; m += NGW) {
                const v4u a0 = *(const v4u*)(Hb + (size_t)m * D + 8 * lane), a1 = *(const v4u*)(Hb + (size_t)m * D + 512 + 8 * lane);
#pragma unroll
                for (int k = 0; k < 2; ++k) { const int e = r_eid[2 * m + k], slot = misc[e] * 256 + r_pos[2 * m + k];
                    *(v4u*)(XS + (size_t)slot * D + 8 * lane) = a0; *(v4u*)(XS + (size_t)slot * D + 512 + 8 * lane) = a1; }
            }
        }
        GRID_SYNC();
        {
            PH_BEGIN
            const int ntiles = __builtin_amdgcn_readfirstlane(misc[33]);
            pg8::Gemm g{(const bf16*)(ws + WS_XS), (const bf16*)(ws + WS_WGU), ntiles * 256, NE * D, D}; MoeOrder So{ntiles * 4, G, bid, misc + 64};
            pg8::EpiSwiglu E{(bf16*)(ws + WS_HMID)};
            pg8::gemm_phase<pg8::EpiSwiglu, MoeOrder, true, true>(lds, g, So, E);
        }
        GRID_SYNC();
        {
            PH_BEGIN
            const int ntiles = __builtin_amdgcn_readfirstlane(misc[33]);
            pg8::Gemm g{(const bf16*)(ws + WS_HMID), (const bf16*)(ws + WS_WDN), ntiles * 256, NE * D, DE}; MoeOrder So{ntiles * 4, G, bid, misc + 64};
            pg8::EpiStore8 E{(bf16*)(ws + WS_YS), D, 0, 0, 1.f, 3};
            pg8::gemm_phase<pg8::EpiStore8, MoeOrder, true, true>(lds, g, So, E);
        }
        GRID_SYNC();
        {
            PH_BEGIN
            const float* lg = INP(4) + (size_t)(layer * 2 + 1) * D; const float* lb = INP(5) + (size_t)(layer * 2 + 1) * D;
            const bool last = layer == DEPTH - 1; float* xo = last ? (float*)ldptr(ptab, 20) : (float*)(ws + WS_X2);
            const float* modl = (const float*)(ws + WS_MOD) + (size_t)layer * NB * 6 * D; const float* modn = modl + (size_t)NB * 6 * D;
            const float* X1 = (const float*)(ws + WS_X1); bf16* Hb = (bf16*)(ws + WS_H); const bf16* YS = (const bf16*)(ws + WS_YS);
            const int* r_eid = (const int*)(ws + WS_ROUTE); const int* r_pos = r_eid + 2 * M; const float* r_gate = (const float*)(r_pos + 2 * M);
            for (int m = gw; m < M; m += NGW) {
                const float* mb = modl + (size_t)(m >> 11) * (6 * D); const float* mn = modn + (size_t)(m >> 11) * (6 * D);
                const int s0 = misc[r_eid[2 * m]] * 256 + r_pos[2 * m], s1 = misc[r_eid[2 * m + 1]] * 256 + r_pos[2 * m + 1];
                const float g0 = r_gate[2 * m], g1v = r_gate[2 * m + 1];
                f32x4 v[4]; float s = 0.f;
#pragma unroll
                for (int j = 0; j < 4; ++j) { const int d = 4 * lane + 256 * j;
                    const f32x4 xv = *(const f32x4*)(X1 + (size_t)m * D + d), g2 = *(const f32x4*)(mb + 5 * D + d);
                    const v2u ya = *(const v2u*)(YS + (size_t)s0 * D + d), yb = *(const v2u*)(YS + (size_t)s1 * D + d);
                    const f32x4 y0 = {bflo(ya.x), bfhi(ya.x), bflo(ya.y), bfhi(ya.y)}, y1 = {bflo(yb.x), bfhi(yb.x), bflo(yb.y), bfhi(yb.y)};
                    v[j] = ALPHA * xv + (1.f + g2) * (g0 * y0 + g1v * y1); s += (v[j][0] + v[j][1]) + (v[j][2] + v[j][3]); }
                const float mean = wave_sum(s) * (1.f / D); float q = 0.f;
#pragma unroll
                for (int j = 0; j < 4; ++j) { v[j] = v[j] - mean; q += (v[j][0] * v[j][0] + v[j][1] * v[j][1]) + (v[j][2] * v[j][2] + v[j][3] * v[j][3]); }
                const float rstd = rsqrtf(wave_sum(q) * (1.f / D) + LN_EPS);
#pragma unroll
                for (int j = 0; j < 4; ++j) { const int d = 4 * lane + 256 * j;
                    const f32x4 x2 = v[j] * rstd * *(const f32x4*)(lg + d) + *(const f32x4*)(lb + d);
                    *(f32x4*)(xo + (size_t)m * D + d) = x2;
                    if (!last) { const f32x4 hn = x2 * (1.f + *(const f32x4*)(mn + D + d)) + *(const f32x4*)(mn + d);
                        v2u o; o.x = pk2(hn[0], hn[1]); o.y = pk2(hn[2], hn[3]); *(v2u*)(Hb + (size_t)m * D + d) = o; } }
            }
            if (!last) { LAS float* scr = (LAS float*)(lds + wave * 8704); moe_weight_items(INP(17), INP(18), INP(19), layer + 1, (bf16*)(ws + WS_WGU), (bf16*)(ws + WS_WDN), scr, gw, NGW, lane); }
        }
        if (layer != DEPTH - 1) GRID_SYNC();
    }
}

extern "C" void kernel_launch(void* const* d_in, const int* in_sizes, int n_in, void* d_out, int out_size, void* d_ws, size_t ws_size, hipStream_t stream) {
    static int grid = 0;
    if (grid == 0) {
        if (n_in != 20 || ws_size < WS_END) { fprintf(stderr, "kernel_launch: unexpected inputs (n_in %d, ws %zu)\n", n_in, ws_size); grid = -1; return; }
        int dev = 0, cus = 0, per_cu = 0;
        if (hipGetDevice(&dev) != hipSuccess || hipDeviceGetAttribute(&cus, hipDeviceAttributeMultiprocessorCount, dev) != hipSuccess) { grid = -1; return; }
        if (hipFuncSetAttribute((const void*)mk_fwd, hipFuncAttributeMaxDynamicSharedMemorySize, LDS_BYTES) != hipSuccess) { fprintf(stderr, "kernel_launch: hipFuncSetAttribute failed\n"); grid = -1; return; }
        if (hipOccupancyMaxActiveBlocksPerMultiprocessor(&per_cu, (const void*)mk_fwd, NTHREADS, LDS_BYTES) != hipSuccess || per_cu < 1) { fprintf(stderr, "kernel_launch: occupancy query failed (%d)\n", per_cu); per_cu = 1; }
        (void)hipGetLastError();
        grid = cus * (per_cu < 1 ? 1 : 1);
    }
    if (grid < 0) return;
    (void)in_sizes; (void)out_size;
    if (hipMemsetAsync((char*)d_ws + WS_CTL, 0, CTL_ZERO_BYTES, stream) != hipSuccess) { fprintf(stderr, "kernel_launch: memset failed\n"); return; }
    Args a{};
    for (int i = 0; i < 20; ++i) a.in[i] = (const float*)d_in[i];
    a.out = (float*)d_out; a.ws = (unsigned char*)d_ws;
    void* kargs[] = {&a};
    hipError_t e = hipLaunchCooperativeKernel((const void*)mk_fwd, dim3(grid), dim3(NTHREADS), kargs, LDS_BYTES, stream);
    if (e != hipSuccess) fprintf(stderr, "kernel_launch: cooperative launch failed: %s (grid %d)\n", hipGetErrorString(e), grid);
}
```

```cpp
#include <hip/hip_runtime.h>
#include <hip/hip_cooperative_groups.h>
#include <cstdio>
#include <cstdint>
namespace cg = cooperative_groups;
namespace pg8 {
#define PG8_LAS __attribute__((address_space(3)))
typedef unsigned short bf16_t;
typedef short bf16x8 __attribute__((ext_vector_type(8)));
typedef float f32x4 __attribute__((ext_vector_type(4)));
typedef unsigned u32x4 __attribute__((ext_vector_type(4)));
constexpr int BM = 256, BK = 64, HALF = 128, HTB = HALF * BK * 2  , STAGE_BYTES = 8 * HTB, NXCD = 8, WGM = 8;

__host__ __device__ __forceinline__ int lds_byte(int r, int c) { const int st = (r >> 4) * 2 + (c >> 5), rr = r & 15, cc = c & 31, ob = rr * 64 + cc * 2; return st * 1024 + (ob ^ (((ob >> 9) & 1) << 5)); }
__host__ __device__ __forceinline__ void stage_rc(int b, int& R, int& C) { const int st = b / 1024, sb = b % 1024, swz = sb ^ (((sb >> 9) & 1) << 5); R = (st >> 1) * 16 + swz / 64; C = (st & 1) * 32 + (swz % 64) / 2; }
__host__ __device__ __forceinline__ int perm32(int rho) { const int n = rho >> 4, i = rho & 15; return 8 * (i >> 2) + 4 * n + (i & 3); }

struct Unit { int pm, pn; };
struct Gemm { const bf16_t* A; const bf16_t* Bt; int M, N, K; };

struct StaticOrder {
    int nM, nN, nwg, G, c;
    __host__ __device__ void init(int M, int N, int G_, int c_) { nM = M / BM; nN = N / BM; nwg = nM * nN; G = G_; c = c_; }
    __host__ __device__ bool next(int i, Unit& u) const {
        const long L = (long)i * G + c; if (L >= nwg) return false;
        int wgid = (int)L; { const int q = nwg / NXCD, r = nwg % NXCD, xcd = wgid % NXCD, off = wgid / NXCD; wgid = (xcd < r ? xcd * (q + 1) : r * (q + 1) + (xcd - r) * q) + off; }
        const int nig = WGM * nN, gid = wgid / nig, fm = gid * WGM, gsz = (nM - fm) < WGM ? (nM - fm) : WGM;
        u.pm = fm + ((wgid % nig) % gsz); u.pn = (wgid % nig) / gsz; return true;
    }
    __device__ __forceinline__ void a_ready(const Unit&) const {}
    __device__ __forceinline__ void done(const Unit&) const {}
};

__device__ __forceinline__ unsigned cvt_pk_bf16(float lo, float hi) { unsigned r; asm volatile("v_cvt_pk_bf16_f32 %0, %1, %2" : "=v"(r) : "v"(lo), "v"(hi)); return r; }
__device__ __forceinline__ u32x4 pack8(const f32x4& a, const f32x4& b) { u32x4 w; w.x = cvt_pk_bf16(a[0], a[1]); w.y = cvt_pk_bf16(a[2], a[3]); w.z = cvt_pk_bf16(b[0], b[1]); w.w = cvt_pk_bf16(b[2], b[3]); return w; }

struct EpiStore8 {
    static constexpr bool PERM = false, AFTER_DRAIN = false;
    bf16_t* O; int ldc; int split_cols; size_t split_stride; float scale0; int pn_mask;
    __device__ __forceinline__ void operator()(const f32x4 (&acc)[2][2][4][2], const Unit& u, int wr, int wc, int fr, int fq) const {
        const int row0 = u.pm * BM + wr * 64 + fr; int colt = (u.pn & pn_mask) * BM; bf16_t* base = O;
        float sc = 1.f; if (split_cols) { const int t = colt / split_cols; base += (size_t)t * split_stride; colt -= t * split_cols; if (t == 0) sc = scale0; }
        const int col0 = colt + wc * 32 + 8 * fq;
#pragma unroll
        for (int ai = 0; ai < 2; ++ai)
#pragma unroll
            for (int m = 0; m < 4; ++m) { bf16_t* rowp = base + (size_t)(row0 + ai * HALF + m * 16) * ldc + col0;
#pragma unroll
                for (int bj = 0; bj < 2; ++bj) { const f32x4 v0 = acc[ai][bj][m][0] * sc, v1 = acc[ai][bj][m][1] * sc; *(u32x4*)(rowp + bj * HALF) = pack8(v0, v1); } }
    }
};
__device__ __forceinline__ float silu_f(float g) { return g * __builtin_amdgcn_rcpf(1.f + __expf(-g)); }
struct EpiSwiglu {
    static constexpr bool PERM = false, AFTER_DRAIN = false;
    bf16_t* O;
    __device__ __forceinline__ void operator()(const f32x4 (&acc)[2][2][4][2], const Unit& u, int wr, int wc, int fr, int fq) const {
        const int row0 = u.pm * BM + wr * 64 + fr; const int col0 = (u.pn & 3) * 128 + wc * 32 + 8 * fq;
#pragma unroll
        for (int ai = 0; ai < 2; ++ai)
#pragma unroll
            for (int m = 0; m < 4; ++m) { bf16_t* rowp = O + (size_t)(row0 + ai * HALF + m * 16) * 512 + col0; f32x4 h[2];
#pragma unroll
                for (int n = 0; n < 2; ++n) { const f32x4 g = acc[ai][0][m][n], up = acc[ai][1][m][n];
                    h[n] = (f32x4){silu_f(g[0]) * up[0], silu_f(g[1]) * up[1], silu_f(g[2]) * up[2], silu_f(g[3]) * up[3]}; }
                *(u32x4*)rowp = pack8(h[0], h[1]); }
    }
};
struct EpiGqaQkv {
    static constexpr bool PERM = false, AFTER_DRAIN = false;
    bf16_t *Q, *K, *V; const float* qn; const float* kn; const float* cs; const float* sn; float qscale;
    __device__ __forceinline__ void operator()(const f32x4 (&acc)[2][2][4][2], const Unit& u, int wr, int wc, int fr, int fq) const {
        const int row0 = u.pm * BM + wr * 64 + fr; const int pn = u.pn;
        const int type = pn < 4 ? 0 : (pn == 4 ? 1 : 2);
        bf16_t* base = type == 0 ? Q + (4 * pn + wc) * 64 : (type == 1 ? K : V) + wc * 64; const int ldc = type == 0 ? 1024 : 256;
        const int dlo = 32 * (fq >> 1) + 8 * (fq & 1);
        const int tlo = (fq >> 1) * 16 + 8 * (fq & 1);
        const float* gain = type == 0 ? qn : kn; const float sc = type == 0 ? qscale : 1.f;
        f32x4 gv[2][2];
#pragma unroll
        for (int bj = 0; bj < 2; ++bj)
#pragma unroll
            for (int n = 0; n < 2; ++n) gv[bj][n] = *(const f32x4*)(gain + dlo + 16 * bj + 4 * n) * sc;
#pragma unroll
        for (int ai = 0; ai < 2; ++ai)
#pragma unroll
            for (int m = 0; m < 4; ++m) { const int row = row0 + ai * HALF + m * 16; bf16_t* rowp = base + (size_t)row * ldc + dlo; f32x4 o[2][2];
                if (type < 2) {
                    float ss = 0.f;
#pragma unroll
                    for (int bj = 0; bj < 2; ++bj)
#pragma unroll
                        for (int n = 0; n < 2; ++n) { const f32x4 x = acc[ai][bj][m][n]; ss += (x[0] * x[0] + x[1] * x[1]) + (x[2] * x[2] + x[3] * x[3]); }
                    ss += __shfl_xor(ss, 16); ss += __shfl_xor(ss, 32);
                    const float rinv = rsqrtf(ss * (1.f / 64.f) + 1e-6f);
                    const int t = row & 2047;
#pragma unroll
                    for (int n = 0; n < 2; ++n) { const f32x4 c4 = *(const f32x4*)(cs + t * 32 + tlo + 4 * n), s4 = *(const f32x4*)(sn + t * 32 + tlo + 4 * n);
                        const f32x4 x1 = acc[ai][0][m][n] * rinv * gv[0][n], x2 = acc[ai][1][m][n] * rinv * gv[1][n];
                        o[0][n] = x1 * c4 - x2 * s4; o[1][n] = x2 * c4 + x1 * s4; }
                } else {
#pragma unroll
                    for (int bj = 0; bj < 2; ++bj)
#pragma unroll
                        for (int n = 0; n < 2; ++n) o[bj][n] = acc[ai][bj][m][n];
                }
#pragma unroll
                for (int bj = 0; bj < 2; ++bj) *(u32x4*)(rowp + 16 * bj) = pack8(o[bj][0], o[bj][1]); }
    }
};
template <class Epi, class Sched, bool ALIGN_EPI = false, bool SP2 = false>
__device__ __forceinline__ void gemm_phase(PG8_LAS unsigned char* lds, const Gemm g, const Sched& S, const Epi& E) {
    int tid_ = threadIdx.x; asm volatile("" : "+v"(tid_)); const int tid = tid_, wid = __builtin_amdgcn_readfirstlane(tid >> 6), lane = tid & 63, wr = wid >> 2, wc = wid & 3, fr = lane & 15, fq = lane >> 4;
    const int K = g.K, nt = K / BK;
    unsigned voffA[2], voffB[2];
#pragma unroll
    for (int i = 0; i < 2; ++i) { int R, C; stage_rc(tid * 16 + i * 8192, R, C); const int Rb = Epi::PERM ? ((R & ~31) + perm32(R & 31)) : R;
        voffA[i] = (unsigned)(R * K + C) * 2u; voffB[i] = (unsigned)(Rb * K + C) * 2u; }
    const size_t kstep = (size_t)(BK * 2);
    const size_t hstep = (size_t)HALF * K * 2;
    const size_t tstep = 2 * hstep;
    const unsigned ldsw = (unsigned)wid * 1024u;
    const int aoff = lds_byte(wr * 64 + fr, fq * 8), boff = lds_byte(wc * 32 + fr, fq * 8);
#define PG8_SA(b, h) (((b) * 2 + (h)) * HTB)
#define PG8_SB(b, h) ((4 + (b) * 2 + (h)) * HTB)
#define PG8_STAGE(bufoff, gbase, voff) do { _Pragma("unroll") for (int _i = 0; _i < 2; ++_i) \
        __builtin_amdgcn_global_load_lds((const unsigned*)((const char*)(gbase) + (voff)[_i]), (PG8_LAS unsigned*)(lds + (bufoff) + ldsw + _i * 8192), 16, 0, 0); } while (0)
#define PG8_LDA(dst, b, h) do { _Pragma("unroll") for (int m = 0; m < 4; ++m) _Pragma("unroll") for (int k = 0; k < 2; ++k) dst[m][k] = *(const PG8_LAS bf16x8*)(lds + PG8_SA(b, h) + aoff + m * 2048 + k * 1024); } while (0)
#define PG8_LDB(dst, b, h) do { _Pragma("unroll") for (int n = 0; n < 2; ++n) _Pragma("unroll") for (int k = 0; k < 2; ++k) dst[n][k] = *(const PG8_LAS bf16x8*)(lds + PG8_SB(b, h) + boff + n * 2048 + k * 1024); } while (0)
#define PG8_MMA(ai, bj, At, Bt) do { __builtin_amdgcn_s_setprio(1); _Pragma("unroll") for (int m = 0; m < 4; ++m) _Pragma("unroll") for (int n = 0; n < 2; ++n) _Pragma("unroll") for (int k = 0; k < 2; ++k) \
        acc[ai][bj][m][n] = __builtin_amdgcn_mfma_f32_16x16x32_bf16(Bt[n][k], At[m][k], acc[ai][bj][m][n], 0, 0, 0); __builtin_amdgcn_s_setprio(0); } while (0)
#define PG8_WAIT_V(n) asm volatile("s_waitcnt vmcnt(" #n ")" ::: "memory")
#define PG8_WAIT_L(n) asm volatile("s_waitcnt lgkmcnt(" #n ")" ::: "memory")
#define PG8_BAR __builtin_amdgcn_s_barrier()
#define PG8_SCHED __builtin_amdgcn_sched_barrier(0)
    Unit cur, nxt; int ui = 0;
    if (!S.next(0, cur)) return;
    f32x4 acc[2][2][4][2];
#pragma unroll
    for (int a = 0; a < 2; ++a)
#pragma unroll
        for (int b = 0; b < 2; ++b)
#pragma unroll
            for (int m = 0; m < 4; ++m)
#pragma unroll
                for (int n = 0; n < 2; ++n) acc[a][b][m][n] = (f32x4){0.f, 0.f, 0.f, 0.f};
    bf16x8 At[4][2], B0[2][2], B1[2][2];
    const char* cA = (const char*)g.A + (size_t)cur.pm * tstep; const char* cB = (const char*)g.Bt + (size_t)cur.pn * tstep;
    S.a_ready(cur);
    if constexpr (SP2) {
        PG8_STAGE(PG8_SB(0, 0), cB, voffB); PG8_STAGE(PG8_SB(0, 1), cB + hstep, voffB); PG8_STAGE(PG8_SA(0, 0), cA, voffA); PG8_STAGE(PG8_SA(0, 1), cA + hstep, voffA);
        if (wr == 1) PG8_BAR;
        PG8_WAIT_V(2); PG8_BAR;
        PG8_STAGE(PG8_SB(1, 0), cB + kstep, voffB); PG8_STAGE(PG8_SA(1, 0), cA + kstep, voffA); PG8_STAGE(PG8_SB(1, 1), cB + hstep + kstep, voffB);
        PG8_WAIT_V(6); PG8_BAR;
    } else {
        PG8_STAGE(PG8_SB(0, 0), cB, voffB); PG8_STAGE(PG8_SA(0, 0), cA, voffA); PG8_STAGE(PG8_SB(0, 1), cB + hstep, voffB); PG8_STAGE(PG8_SA(0, 1), cA + hstep, voffA);
        if (wr == 1) PG8_BAR;
        PG8_WAIT_V(4); PG8_BAR;
        PG8_STAGE(PG8_SB(1, 0), cB + kstep, voffB); PG8_STAGE(PG8_SA(1, 0), cA + kstep, voffA); PG8_STAGE(PG8_SB(1, 1), cB + hstep + kstep, voffB);
        PG8_WAIT_V(6); PG8_BAR;
    }
    for (;;) {
        const bool has_next = S.next(ui + 1, nxt);
        const char* nA = has_next ? (const char*)g.A + (size_t)nxt.pm * tstep : cA; const char* nB = has_next ? (const char*)g.Bt + (size_t)nxt.pn * tstep : cB;
        for (int t = 0; t < nt; t += 2) {
            const bool last = (t == nt - 2);
            const char* a1 = cA + (size_t)(t + 1) * kstep;
            const char* a2 = last ? nA : cA + (size_t)(t + 2) * kstep; const char* b2 = last ? nB : cB + (size_t)(t + 2) * kstep;
            const char* a3 = a2 + kstep; const char* b3 = b2 + kstep;
            if (last && has_next) S.a_ready(nxt);
            if constexpr (SP2) {
            PG8_LDB(B0, 0, 0); PG8_LDB(B1, 0, 1); PG8_SCHED; PG8_LDA(At, 0, 0); PG8_STAGE(PG8_SA(1, 1), a1 + hstep, voffA);
            PG8_WAIT_V(8); PG8_WAIT_L(0); PG8_BAR; PG8_MMA(0, 0, At, B0); PG8_MMA(0, 1, At, B1); PG8_BAR; PG8_SCHED;
            PG8_LDA(At, 0, 1); PG8_STAGE(PG8_SB(0, 0), b2, voffB); PG8_STAGE(PG8_SB(0, 1), b2 + hstep, voffB); PG8_STAGE(PG8_SA(0, 0), a2, voffA);
            PG8_WAIT_V(8); PG8_WAIT_L(0); PG8_BAR; PG8_MMA(1, 0, At, B0); PG8_MMA(1, 1, At, B1); PG8_BAR; PG8_SCHED;
            PG8_LDB(B0, 1, 0); PG8_LDB(B1, 1, 1); PG8_SCHED; PG8_LDA(At, 1, 0); PG8_STAGE(PG8_SA(0, 1), a2 + hstep, voffA);
            PG8_WAIT_V(8); PG8_WAIT_L(0); PG8_BAR; PG8_MMA(0, 0, At, B0); PG8_MMA(0, 1, At, B1); PG8_BAR; PG8_SCHED;
            PG8_LDA(At, 1, 1); PG8_STAGE(PG8_SB(1, 0), b3, voffB); PG8_STAGE(PG8_SB(1, 1), b3 + hstep, voffB); PG8_STAGE(PG8_SA(1, 0), a3, voffA);
            PG8_WAIT_V(8); PG8_WAIT_L(0); PG8_BAR; PG8_MMA(1, 0, At, B0); PG8_MMA(1, 1, At, B1); PG8_BAR; PG8_SCHED;
            } else {
            PG8_LDB(B0, 0, 0); PG8_SCHED; PG8_LDA(At, 0, 0); PG8_STAGE(PG8_SA(1, 1), a1 + hstep, voffA);
            PG8_WAIT_L(8); PG8_BAR; PG8_WAIT_L(0); PG8_MMA(0, 0, At, B0); PG8_BAR; PG8_SCHED;
            PG8_LDB(B1, 0, 1); PG8_STAGE(PG8_SB(0, 0), b2, voffB);
            PG8_BAR; PG8_WAIT_L(0); PG8_MMA(0, 1, At, B1); PG8_BAR;
            PG8_LDA(At, 0, 1); PG8_STAGE(PG8_SA(0, 0), a2, voffA);
            PG8_BAR; PG8_WAIT_L(0); PG8_MMA(1, 0, At, B0); PG8_BAR; PG8_SCHED;
            PG8_STAGE(PG8_SB(0, 1), b2 + hstep, voffB);
            PG8_WAIT_V(6); PG8_BAR; PG8_MMA(1, 1, At, B1); PG8_BAR;
            PG8_LDB(B0, 1, 0); PG8_SCHED; PG8_LDA(At, 1, 0); PG8_STAGE(PG8_SA(0, 1), a2 + hstep, voffA);
            PG8_WAIT_L(8); PG8_BAR; PG8_WAIT_L(0); PG8_MMA(0, 0, At, B0); PG8_BAR; PG8_SCHED;
            PG8_LDB(B1, 1, 1); PG8_STAGE(PG8_SB(1, 0), b3, voffB);
            PG8_BAR; PG8_WAIT_L(0); PG8_MMA(0, 1, At, B1); PG8_BAR;
            PG8_LDA(At, 1, 1); PG8_STAGE(PG8_SA(1, 0), a3, voffA);
            PG8_BAR; PG8_WAIT_L(0); PG8_MMA(1, 0, At, B0); PG8_BAR; PG8_SCHED;
            PG8_STAGE(PG8_SB(1, 1), b3 + hstep, voffB);
            PG8_WAIT_V(6); PG8_BAR; PG8_MMA(1, 1, At, B1); PG8_BAR;
            }
        }
        if constexpr (ALIGN_EPI) { if (wr == 0) PG8_BAR; }
        if constexpr (!Epi::AFTER_DRAIN) { E(acc, cur, wr, wc, fr, fq); S.done(cur); }
        if (!has_next) break;
#pragma unroll
        for (int a = 0; a < 2; ++a)
#pragma unroll
            for (int b = 0; b < 2; ++b)
#pragma unroll
                for (int m = 0; m < 4; ++m)
#pragma unroll
                    for (int n = 0; n < 2; ++n) acc[a][b][m][n] = (f32x4){0.f, 0.f, 0.f, 0.f};
        cur = nxt; cA = nA; cB = nB; ++ui;
        if constexpr (ALIGN_EPI) { if (wr == 1) PG8_BAR; }
    }
    PG8_WAIT_V(0);
    if constexpr (!ALIGN_EPI) { if (wr == 0) PG8_BAR; }
    PG8_BAR;
    if constexpr (Epi::AFTER_DRAIN) { E.fused(acc, cur, wr, wc, fr, fq, lds, wid, lane); S.done(cur); }
#undef PG8_SA
#undef PG8_SB
#undef PG8_STAGE
#undef PG8_LDA
#undef PG8_LDB
#undef PG8_MMA
#undef PG8_WAIT_V
#undef PG8_WAIT_L
#undef PG8_BAR
#undef PG8_SCHED
}
}
#include <hip/hip_bf16.h>
#include <cmath>
namespace attn_body {
using bf16=__hip_bfloat16;
using bf16x8=__attribute__((ext_vector_type(8)))short;
using s16x4=__attribute__((ext_vector_type(4)))short;
using f32x16=__attribute__((ext_vector_type(16)))float;
using u32x4=__attribute__((ext_vector_type(4)))unsigned;
constexpr int BATCH=8,NHEAD=16,SEQ=2048,D=64,DM=NHEAD*D,KVP=256;
constexpr int NW=8,QBLK=32,QB=QBLK*NW,KVBLK=64,NQB=SEQ/QB;
constexpr int ATTN_PITCH=DM, ATTN_UNIT_ROWS=QB;
__device__ __forceinline__ int crow(int r,int hi){return (r&3)+8*(r>>2)+4*hi;}
#define SBAR() __builtin_amdgcn_sched_barrier(0)
__device__ __forceinline__ void cmask(f32x16&p0,f32x16&p1,int jb,int qrel,int hi){
  const float NEG=-INFINITY; int kb=64*jb+4*hi;
  #pragma unroll
  for(int r=0;r<16;++r){int kv=kb+(r&3)+8*(r>>2); if(kv>qrel)p0[r]=NEG; if(kv+32>qrel)p1[r]=NEG;}
}

constexpr int NSLOT=3, SLOTB=8192;
constexpr int LDS_K=0, LDS_V=NSLOT*SLOTB, LDS_WS=2*NSLOT*SLOTB, LDS_OST=LDS_WS+NW*64*4, LDS_BYTES=LDS_OST+NW*4096;
constexpr float C2=0.125f*1.4426950408889634f;
__device__ __forceinline__ void glds16(const void*gsrc,unsigned lds_dst){unsigned keep;
  asm volatile("s_mov_b32 %0, m0\n\ts_mov_b32 m0, %2\n\ts_nop 0\n\tglobal_load_lds_dwordx4 %1, off\n\ts_mov_b32 m0, %0":"=&s"(keep):"v"(gsrc),"s"(lds_dst):"memory");}
__device__ __forceinline__ float max3f(float a,float b,float c){float r;asm("v_max3_f32 %0, %1, %2, %3":"=v"(r):"v"(a),"v"(b),"v"(c));return r;}
__device__ __forceinline__ float max2f(float a,float b){float r;asm("v_max_f32_e32 %0, %1, %2":"=v"(r):"v"(a),"v"(b));return r;}
__device__ __forceinline__ float fadd_s(float a,float b){float r;asm("v_add_f32_e32 %0, %1, %2":"=v"(r):"v"(a),"v"(b));return r;}
__device__ __forceinline__ float fsub_s(float a,float b){float r;asm("v_sub_f32_e32 %0, %1, %2":"=v"(r):"v"(a),"v"(b));return r;}
typedef float f32x2_t __attribute__((ext_vector_type(2))); typedef __bf16 bf16x2_t __attribute__((ext_vector_type(2)));
__device__ __forceinline__ unsigned cvtpk_s(float lo,float hi){f32x2_t v={lo,hi};bf16x2_t b=__builtin_convertvector(v,bf16x2_t);return __builtin_bit_cast(unsigned,b);}
#define WAIT_BAR(N) asm volatile("s_waitcnt vmcnt(" #N ") lgkmcnt(0)\n\ts_barrier":::"memory")

__device__ __forceinline__ void qkt(f32x16&p0,f32x16&p1,const char*Kslot,const bf16x8*qr,const f32x16&negm,int r32,int hi){
  const char*kb=Kslot+hi*1024+r32*16;
  #pragma unroll
  for(int d0=0;d0<4;++d0){
    const bf16x8 b0=*reinterpret_cast<const bf16x8*>(kb+d0*2048);
    const bf16x8 b1=*reinterpret_cast<const bf16x8*>(kb+d0*2048+512);
    if(d0==0){p0=__builtin_amdgcn_mfma_f32_32x32x16_bf16(b0,qr[0],negm,0,0,0);p1=__builtin_amdgcn_mfma_f32_32x32x16_bf16(b1,qr[0],negm,0,0,0);}
    else{p0=__builtin_amdgcn_mfma_f32_32x32x16_bf16(b0,qr[d0],p0,0,0,0);p1=__builtin_amdgcn_mfma_f32_32x32x16_bf16(b1,qr[d0],p1,0,0,0);}}
}
typedef __attribute__((address_space(3))) const char* lds_cptr;
typedef short v4i16_t __attribute__((ext_vector_type(4)));
__device__ __forceinline__ void kload8(bf16x8*kf,lds_cptr kp){
  kf[0]=*(const __attribute__((address_space(3))) bf16x8*)(kp);      kf[1]=*(const __attribute__((address_space(3))) bf16x8*)(kp+512);
  kf[2]=*(const __attribute__((address_space(3))) bf16x8*)(kp+2048); kf[3]=*(const __attribute__((address_space(3))) bf16x8*)(kp+2560);
  kf[4]=*(const __attribute__((address_space(3))) bf16x8*)(kp+4096); kf[5]=*(const __attribute__((address_space(3))) bf16x8*)(kp+4608);
  kf[6]=*(const __attribute__((address_space(3))) bf16x8*)(kp+6144); kf[7]=*(const __attribute__((address_space(3))) bf16x8*)(kp+6656);
}
__device__ __forceinline__ void kload2(bf16x8*kf,lds_cptr kp,int j){ kf[2*j]=*(const __attribute__((address_space(3))) bf16x8*)(kp+j*2048); kf[2*j+1]=*(const __attribute__((address_space(3))) bf16x8*)(kp+j*2048+512); }
__device__ __forceinline__ s16x4 vtr(lds_cptr p){ return __builtin_bit_cast(s16x4,__builtin_amdgcn_ds_read_tr16_b64_v4i16((__attribute__((address_space(3))) v4i16_t*)p)); }
__device__ __forceinline__ float rowmax(const f32x16&p0,const f32x16&p1){
  float a=max3f(p0[0],p0[1],p1[0]),b=max3f(p0[2],p0[3],p1[1]);a=max3f(a,p1[2],p1[3]);
  #pragma unroll
  for(int r=4;r<16;r+=4){a=max3f(a,p0[r],p0[r+1]);b=max3f(b,p0[r+2],p0[r+3]);a=max3f(a,p1[r],p1[r+1]);b=max3f(b,p1[r+2],p1[r+3]);}
  const float m=max2f(a,b);
  auto rr=__builtin_amdgcn_permlane32_swap(__float_as_uint(m),__float_as_uint(m),false,false);
  return max2f(__uint_as_float(rr[0]),__uint_as_float(rr[1]));
}
__device__ __forceinline__ void pv(f32x16*o,int vb,bf16x8 pa0,bf16x8 pa1,bf16x8 pa2,bf16x8 pa3){
  #pragma unroll
  for(int d0=0;d0<2;++d0){s16x4 lo[4],hi[4];
    #pragma unroll
    for(int ks=0;ks<4;++ks){
      asm volatile("ds_read_b64_tr_b16 %0,%1 offset:%c2":"=&v"(lo[ks]):"v"(vb),"i"(d0*4096+ks*1024):"memory");
      asm volatile("ds_read_b64_tr_b16 %0,%1 offset:%c2":"=&v"(hi[ks]):"v"(vb),"i"(d0*4096+ks*1024+512):"memory");}
    asm volatile("s_waitcnt lgkmcnt(0)":::"memory");SBAR();
    #define PK(k) (bf16x8){lo[k][0],lo[k][1],lo[k][2],lo[k][3],hi[k][0],hi[k][1],hi[k][2],hi[k][3]}
    o[d0]=__builtin_amdgcn_mfma_f32_32x32x16_bf16(pa0,PK(0),o[d0],0,0,0);
    o[d0]=__builtin_amdgcn_mfma_f32_32x32x16_bf16(pa1,PK(1),o[d0],0,0,0);
    o[d0]=__builtin_amdgcn_mfma_f32_32x32x16_bf16(pa2,PK(2),o[d0],0,0,0);
    o[d0]=__builtin_amdgcn_mfma_f32_32x32x16_bf16(pa3,PK(3),o[d0],0,0,0);
    #undef PK
  }
}

#ifndef ATTN_STORE16
#define ATTN_STORE16(p,v) (*(u32x4*)(p)=(v))
#endif
template<int THRL> __device__ __forceinline__ void attn_unit(int b,int h,int qb,const bf16*Q,const bf16*__restrict__ K,const bf16*__restrict__ V,bf16*O,char*shm){
  int tid_=threadIdx.x; asm volatile("":"+v"(tid_)); const int tid=tid_,lane=tid&63,r32=lane&31,hi=lane>>5; const int wid=__builtin_amdgcn_readfirstlane(tid>>6);
  const long rowbase=(long)b*SEQ; const int q0=qb*QB;
  const bf16*Qw=Q+(rowbase+q0+wid*QBLK)*DM+h*D;
  const bf16*Kh=K+rowbase*KVP+(h>>2)*D,*Vh=V+rowbase*KVP+(h>>2)*D;
  const unsigned lds0=(unsigned)(uintptr_t)shm;
  float*wsf=(float*)(shm+LDS_WS)+wid*64;
  const bf16*ksrc=Kh+(long)lane*KVP+wid*8;
  const bf16*vsrc=Vh+(long)(16*(wid&3)+(lane>>2))*KVP+(wid>>2)*32+(lane&3)*8;
  const unsigned kdst=lds0+LDS_K+wid*1024, vdst=lds0+LDS_V+wid*1024;
  #define DMA_K(t,slot) glds16(ksrc+(long)(t)*KVBLK*KVP,(unsigned)__builtin_amdgcn_readfirstlane(kdst+(slot)))
  #define DMA_V(t,slot) glds16(vsrc+(long)(t)*KVBLK*KVP,(unsigned)__builtin_amdgcn_readfirstlane(vdst+(slot)))
  const int vb0=(int)(lds0+LDS_V)+((lane>>4)&1)*32+(lane&3)*8+(4*hi+((lane&15)>>2))*64;
  const char*Kbase=shm+LDS_K; bf16x8 kf[8];
  const lds_cptr shm3=(lds_cptr)shm; const lds_cptr kp0=shm3+LDS_K+hi*1024+r32*16; const lds_cptr vp0=shm3+LDS_V+((lane>>4)&1)*32+(lane&3)*8+(4*hi+((lane&15)>>2))*64;
  const int NT=SEQ/KVBLK;
  DMA_K(0,0);DMA_V(0,0);DMA_K(1,SLOTB);
  bf16x8 qr[4];
  #pragma unroll
  for(int d0=0;d0<4;++d0)qr[d0]=*reinterpret_cast<const bf16x8*>(&Qw[(long)r32*DM+d0*16+hi*8]);
  float mhat=0.f,l_reg=0.f;f32x16 o[2];o[0]=f32x16{};o[1]=f32x16{};f32x16 negm=f32x16{};asm volatile("":"+v"(negm));
  const int qrel=wid*QBLK+r32;
  #define CMASK(P0,P1,t) do{}while(0)
  bool resc=false;
  #define START(P0,P1) do{ const float rm=rowmax(P0,P1); resc=false; \
    { const float dl=rm; mhat=fadd_s(mhat,dl); \
      _Pragma("unroll") for(int r=0;r<16;++r){P0[r]=fsub_s(P0[r],dl);P1[r]=fsub_s(P1[r],dl);} \
      _Pragma("unroll") for(int r=0;r<16;++r)negm[r]=-mhat; asm volatile("":"+v"(negm)); } \
    _Pragma("unroll") for(int r=0;r<16;++r)P0[r]=__builtin_amdgcn_exp2f(P0[r]); }while(0)
  #define RESC() do{ if(resc){ asm volatile("s_waitcnt lgkmcnt(0)":::"memory"); \
      _Pragma("unroll") for(int d_=0;d_<2;++d_) _Pragma("unroll") for(int r=0;r<16;++r)o[d_][r]*=wsf[crow(r,hi)]; } }while(0)
  f32x16 pA0,pA1,pB0,pB1;
  int sl_prev=0,sl_cur=0,sl_next=SLOTB;
  #define ROT() do{sl_prev=sl_cur;sl_cur=sl_next;sl_next=(sl_next==(NSLOT-1)*SLOTB)?0:sl_next+SLOTB;}while(0)
  DMA_K(2,2*SLOTB);
  WAIT_BAR(3);
  qkt(pA0,pA1,Kbase,qr,negm,r32,hi);asm volatile("s_nop 15\n\ts_nop 7":"+v"(pA0),"+v"(pA1));CMASK(pA0,pA1,0);
  START(pA0,pA1);
  _Pragma("unroll") for(int r=0;r<16;++r)pA1[r]=__builtin_amdgcn_exp2f(pA1[r]);
  WAIT_BAR(0);
  DMA_K(3,0);DMA_V(1,SLOTB);
  ROT();
  kload8(kf,kp0+sl_cur);
  WAIT_BAR(2);
  s16x4 vlo[8],vhi[8]; u32x4 pw0,pw1,pw2,pw3;
  #define PKW(P,B) cvtpk_s(P[B],P[B+1])
  #define PAF(k) __builtin_bit_cast(bf16x8,pw##k)
  #define VFR(i) (bf16x8){vlo[i][0],vlo[i][1],vlo[i][2],vlo[i][3],vhi[i][0],vhi[i][1],vhi[i][2],vhi[i][3]}
  #define PIN(x) asm volatile("":"+v"(x))
  #define MX3(a,b,c) __builtin_fmaxf(__builtin_fmaxf((a),(b)),(c))
  #define GAPA(MF,A0,A1,A2,A3,W0,W1,PW) do{ MF; sacc+=A0; sacc+=A1; sacc+=A2; sacc+=A3; PIN(sacc); W0; W1; PIN(PW); SBAR(); }while(0)
  #define EX(v) __builtin_amdgcn_exp2f(v)
  #define GAPB(MF,X,B) do{ MF; X[B]=EX(X[B]); X[B+1]=EX(X[B+1]); X[B+2]=EX(X[B+2]); X[B+3]=EX(X[B+3]); PIN(X); SBAR(); }while(0)
  #define VRD(i) do{ vlo[i]=vtr(vp_+(((i)>>2)*4096+((i)&3)*1024)); vhi[i]=vtr(vp_+(((i)>>2)*4096+((i)&3)*1024+512)); }while(0)
  #define KRD(G,j) do{ if(G){ kload2(kf,kp0+sl_next,j); SBAR(); } }while(0)
  #define STEP(C0,C1,P0,P1,t,GK,GV,GL) do{ SBAR(); \
    const lds_cptr vp_=vp0+sl_prev; \
    VRD(0); SBAR(); float sacc=(P0[0]+P0[1]); \
    GAPA(C0=__builtin_amdgcn_mfma_f32_32x32x16_bf16(kf[0],qr[0],negm,0,0,0), P0[2],P0[3],P0[4],P0[5],     pw0[0]=PKW(P0,0), pw0[1]=PKW(P0,2), pw0); \
    VRD(4); SBAR(); GAPA(C1=__builtin_amdgcn_mfma_f32_32x32x16_bf16(kf[1],qr[0],negm,0,0,0), P0[6],P0[7],P0[8],P0[9],     pw0[2]=PKW(P0,4), pw0[3]=PKW(P0,6), pw0); \
    VRD(1); SBAR(); GAPA(C0=__builtin_amdgcn_mfma_f32_32x32x16_bf16(kf[2],qr[1],C0,0,0,0),   P0[10],P0[11],P0[12],P0[13], pw1[0]=PKW(P0,8), pw1[1]=PKW(P0,10), pw1); \
    VRD(5); SBAR(); GAPA(C1=__builtin_amdgcn_mfma_f32_32x32x16_bf16(kf[3],qr[1],C1,0,0,0),   P0[14],P0[15],P1[0],P1[1],   pw1[2]=PKW(P0,12),pw1[3]=PKW(P0,14), pw1); \
    VRD(2); SBAR(); GAPA(C0=__builtin_amdgcn_mfma_f32_32x32x16_bf16(kf[4],qr[2],C0,0,0,0),   P1[2],P1[3],P1[4],P1[5],     pw2[0]=PKW(P1,0), pw2[1]=PKW(P1,2), pw2); \
    VRD(6); SBAR(); GAPA(C1=__builtin_amdgcn_mfma_f32_32x32x16_bf16(kf[5],qr[2],C1,0,0,0),   P1[6],P1[7],P1[8],P1[9],     pw2[2]=PKW(P1,4), pw2[3]=PKW(P1,6), pw2); \
    VRD(3); SBAR(); GAPA(C0=__builtin_amdgcn_mfma_f32_32x32x16_bf16(kf[6],qr[3],C0,0,0,0),   P1[10],P1[11],P1[12],P1[13], pw3[0]=PKW(P1,8), pw3[1]=PKW(P1,10), pw3); \
    VRD(7); SBAR(); GAPA(C1=__builtin_amdgcn_mfma_f32_32x32x16_bf16(kf[7],qr[3],C1,0,0,0),   P1[14],P1[15],0.f,0.f,       pw3[2]=PKW(P1,12),pw3[3]=PKW(P1,14), pw3); \
    l_reg+=sacc; \
    if(GK){DMA_K((t)+3,sl_cur);} if(GV){DMA_V((t)+1,sl_next);} \
    CMASK(C0,C1,t); \
    { float a=MX3(C0[0],C0[1],C1[0]),b=MX3(C0[2],C0[3],C1[1]); a=MX3(a,C1[2],C1[3]); \
      _Pragma("unroll") for(int r=4;r<16;r+=4){a=MX3(a,C0[r],C0[r+1]);b=MX3(b,C0[r+2],C0[r+3]);a=MX3(a,C1[r],C1[r+1]);b=MX3(b,C1[r+2],C1[r+3]);} \
      float rm=__builtin_fmaxf(a,b); { auto rr=__builtin_amdgcn_permlane32_swap(__float_as_uint(rm),__float_as_uint(rm),false,false); rm=__builtin_fmaxf(__uint_as_float(rr[0]),__uint_as_float(rr[1])); } \
      resc=false; \
      if(__builtin_expect(__any(rm>(float)THRL),0)){ const float dl=__builtin_fmaxf(rm,0.f); mhat+=dl; \
        _Pragma("unroll") for(int r=0;r<16;++r){C0[r]-=dl;C1[r]-=dl;} \
        _Pragma("unroll") for(int r=0;r<16;++r)negm[r]=-mhat; asm volatile("":"+v"(negm)); \
        const float f=__builtin_amdgcn_exp2f(-dl); l_reg*=f; if(hi==0)wsf[r32]=f; resc=true; } } \
    SBAR(); \
    GAPB(o[0]=__builtin_amdgcn_mfma_f32_32x32x16_bf16(PAF(0),VFR(0),o[0],0,0,0), C0,0); \
    GAPB(o[1]=__builtin_amdgcn_mfma_f32_32x32x16_bf16(PAF(0),VFR(4),o[1],0,0,0), C0,4); \
    KRD(GL,0); GAPB(o[0]=__builtin_amdgcn_mfma_f32_32x32x16_bf16(PAF(1),VFR(1),o[0],0,0,0), C0,8); \
    KRD(GL,1); GAPB(o[1]=__builtin_amdgcn_mfma_f32_32x32x16_bf16(PAF(1),VFR(5),o[1],0,0,0), C0,12); \
    KRD(GL,2); GAPB(o[0]=__builtin_amdgcn_mfma_f32_32x32x16_bf16(PAF(2),VFR(2),o[0],0,0,0), C1,0); \
    KRD(GL,3); GAPB(o[1]=__builtin_amdgcn_mfma_f32_32x32x16_bf16(PAF(2),VFR(6),o[1],0,0,0), C1,4); \
    GAPB(o[0]=__builtin_amdgcn_mfma_f32_32x32x16_bf16(PAF(3),VFR(3),o[0],0,0,0), C1,8); \
    GAPB(o[1]=__builtin_amdgcn_mfma_f32_32x32x16_bf16(PAF(3),VFR(7),o[1],0,0,0), C1,12); \
    }while(0)
  int t=1;
  #undef CMASK
  #define CMASK(P0,P1,t) do{}while(0)
  for(;t+5<NT;t+=2){
    STEP(pB0,pB1,pA0,pA1,t,true,true,true);     WAIT_BAR(2); RESC(); ROT();
    STEP(pA0,pA1,pB0,pB1,t+1,true,true,true);   WAIT_BAR(2); RESC(); ROT();
  }
  #undef CMASK
  #define CMASK(P0,P1,t) do{}while(0)
  #define ENDW(tt) do{ if((tt)+3<NT){WAIT_BAR(2);} else if((tt)+2<NT){WAIT_BAR(1);} else {WAIT_BAR(0);} }while(0)
  for(;t+1<NT;t+=2){
    STEP(pB0,pB1,pA0,pA1,t,(t+3<NT),(t+1<NT),(t+1<NT));       ENDW(t);   RESC(); ROT();
    STEP(pA0,pA1,pB0,pB1,t+1,(t+4<NT),(t+2<NT),(t+2<NT));     ENDW(t+1); RESC(); ROT();
  }
  STEP(pB0,pB1,pA0,pA1,NT-1,false,false,false); RESC();
  { float sacc=pB0[0]+pB0[1]; _Pragma("unroll") for(int r=2;r<16;++r)sacc+=pB0[r]; _Pragma("unroll") for(int r=0;r<16;++r)sacc+=pB1[r]; l_reg+=sacc;
    pw0=(u32x4){PKW(pB0,0),PKW(pB0,2),PKW(pB0,4),PKW(pB0,6)};pw1=(u32x4){PKW(pB0,8),PKW(pB0,10),PKW(pB0,12),PKW(pB0,14)};pw2=(u32x4){PKW(pB1,0),PKW(pB1,2),PKW(pB1,4),PKW(pB1,6)};pw3=(u32x4){PKW(pB1,8),PKW(pB1,10),PKW(pB1,12),PKW(pB1,14)};
    SBAR(); pv(o,vb0+sl_cur,PAF(0),PAF(1),PAF(2),PAF(3)); }
  #undef PKW
  #undef PAF
  #undef VFR
  #undef PIN
  #undef MX3
  #undef GAPA
  #undef GAPB
  #undef EX
  #undef VRD
  #undef KRD
  #undef STEP
  #undef ENDW
  {auto rr=__builtin_amdgcn_permlane32_swap(__float_as_uint(l_reg),__float_as_uint(l_reg),false,false);l_reg=__uint_as_float(rr[0])+__uint_as_float(rr[1]);}
  if(hi==0)wsf[32+r32]=l_reg;asm volatile("s_waitcnt lgkmcnt(0)":::"memory");
  float rli[16];
  #pragma unroll
  for(int r=0;r<16;++r)rli[r]=__builtin_amdgcn_rcpf(wsf[32+crow(r,hi)]);
  bf16*Ow=O+(rowbase+q0+wid*QBLK)*DM+h*D;
  { bf16*stg=(bf16*)(shm+LDS_OST)+wid*2048;
    #pragma unroll
    for(int r=0;r<16;++r){const int orow=crow(r,hi);
      #pragma unroll
      for(int d0=0;d0<2;++d0)stg[orow*64+d0*32+r32]=__float2bfloat16(o[d0][r]*rli[r]);}
    asm volatile("s_waitcnt lgkmcnt(0)":::"memory");
    #pragma unroll
    for(int i=0;i<4;++i){const int row=i*8+(lane>>3),ch=lane&7; const u32x4 v=*(const u32x4*)(stg+row*64+ch*8); ATTN_STORE16(Ow+(long)row*DM+ch*8,v);} }
  asm volatile("s_waitcnt lgkmcnt(0)\n\ts_barrier":::"memory");
  #undef DMA_K
  #undef DMA_V
  #undef CMASK
  #undef START
  #undef RESC
  #undef ROT
}
constexpr int ATTN_LDS_BYTES=LDS_BYTES;
struct AttnTensors { const bf16* Q; const bf16* K; const bf16* V; bf16* O; };
struct AttnUnit { int bh; int qb; };
struct StaticOrder {
  int vcu,G;
  __device__ __forceinline__ explicit StaticOrder(int grid,int block):vcu((grid%8==0)?(block%8)*(grid/8)+block/8:block),G(grid){}
  __device__ __forceinline__ bool next(int i,AttnUnit&u)const{ const int L=i*G+vcu; if(L>=1024)return false; const int xg=L>>5,w=L&31; const int grp=(xg&7)*4+(xg>>3); u.bh=(grp>>2)*NHEAD+(grp&3)*4+(w>>3); u.qb=w&7; return true; }
  __device__ __forceinline__ void a_ready(const AttnUnit&)const{}
  __device__ __forceinline__ void done(const AttnUnit&)const{}
};
template<class Sched,int THRL=8> __device__ __forceinline__ void attn_phase(char*lds,const AttnTensors&T,const Sched&S){
  AttnUnit u;
  for(int i=0;S.next(i,u);++i){ S.a_ready(u); attn_unit<THRL>(u.bh/NHEAD,u.bh%NHEAD,u.qb,T.Q,T.K,T.V,T.O,lds); S.done(u); }
}
#undef SBAR
#undef WAIT_BAR
}
namespace na_body {
typedef short bf16x8 __attribute__((ext_vector_type(8)));
typedef short s16x4 __attribute__((ext_vector_type(4)));
typedef float f32x4 __attribute__((ext_vector_type(4)));
typedef unsigned u32x4 __attribute__((ext_vector_type(4)));
typedef unsigned u32x2 __attribute__((ext_vector_type(2)));
#define NA_LAS __attribute__((address_space(3)))
constexpr int VROW = 160, LDS_V = 0, LDS_BIAS = 9 * 64 * VROW, NA_LDS_BYTES = LDS_BIAS + 15 * 64 * 4;
__device__ __forceinline__ unsigned cvtpk(float lo, float hi) { typedef float f2 __attribute__((ext_vector_type(2))); typedef __bf16 b2 __attribute__((ext_vector_type(2))); f2 v = {lo, hi}; b2 b = __builtin_convertvector(v, b2); return __builtin_bit_cast(unsigned, b); }
__device__ __forceinline__ s16x4 vtr(const NA_LAS char* p) { typedef short v4i16_t __attribute__((ext_vector_type(4))); return __builtin_bit_cast(s16x4, __builtin_amdgcn_ds_read_tr16_b64_v4i16((NA_LAS v4i16_t*)p)); }

__device__ __forceinline__ void na_phase(NA_LAS char* lds, const unsigned short* Qg, const unsigned short* Kg, const unsigned short* Vg, unsigned short* Og, const float* __restrict__ rpb, int G, int bid) {
    int tid_ = threadIdx.x; asm volatile("" : "+v"(tid_));
    const int tid = tid_, lane = tid & 63, wave = __builtin_amdgcn_readfirstlane(tid >> 6), fr = lane & 15, fq = lane >> 4;
    const int vcu = (G % 8 == 0) ? (bid % 8) * (G / 8) + bid / 8 : bid;
    constexpr int NUNITS = 8 * 16 * 16;
    const int per = (NUNITS + G - 1) / G, u_lo = vcu * per, u_hi = (u_lo + per < NUNITS) ? u_lo + per : NUNITS;
    if (u_lo >= u_hi) return;
    u32x4 vr[9];
#define NA_PREFETCH(U) do { const int b_ = (U) >> 8, h_ = ((U) >> 4) & 15, r0_ = 2 * ((U) & 15); const int R0_ = min(max(r0_ - 4, 0), 24); const int ntok_ = min(9, 32 - R0_) * 64; \
        const unsigned short* src_ = Vg + ((size_t)(b_ * 2048 + R0_ * 64)) * 1024 + h_ * 64; \
        _Pragma("unroll") for (int i_ = 0; i_ < 9; ++i_) { const int idx_ = tid + 512 * i_; if ((idx_ >> 3) < ntok_) vr[i_] = *(const u32x4*)(src_ + (size_t)(idx_ >> 3) * 1024 + (idx_ & 7) * 8); } } while (0)
    NA_PREFETCH(u_lo);
    for (int U = u_lo; U < u_hi; ++U) {
        const int b = U >> 8, h = (U >> 4) & 15, r0 = 2 * (U & 15); const int R0 = min(max(r0 - 4, 0), 24);
        if (U != u_lo) __syncthreads();
#pragma unroll
        for (int i = 0; i < 9; ++i) { const int idx = tid + 512 * i; *(NA_LAS u32x4*)(lds + LDS_V + (idx >> 3) * VROW + (idx & 7) * 16) = vr[i]; }
        for (int i = tid; i < 15 * 64; i += 512) { const int dr = i >> 6, dc = (i & 63) - 16; ((NA_LAS float*)(lds + LDS_BIAS))[i] = (dc >= 0 && dc < 31) ? rpb[(h * 15 + dr) * 31 + dc] * 1.4426950408889634f : 0.f; }
        __syncthreads();
        if (U + 1 < u_hi) NA_PREFETCH(U + 1);
        const int r = r0 + (wave >> 2), q0 = 16 * (wave & 3), qcol = q0 + fr;
        const int rs = min(max(r - 4, 0), 24), b0 = min(max(q0 - 8, 0), 32), winlo = min(max(qcol - 8, 0), 48);
        const size_t tokq = (size_t)b * 2048 + r * 64 + qcol;
        bf16x8 qf[2];
#pragma unroll
        for (int ks = 0; ks < 2; ++ks) qf[ks] = *(const bf16x8*)(Qg + tokq * 1024 + h * 64 + 32 * ks + 8 * fq);
        f32x4 am[2];
#pragma unroll
        for (int t = 0; t < 2; ++t)
#pragma unroll
            for (int i = 0; i < 4; ++i) am[t][i] = ((unsigned)(b0 + 16 * t + 4 * fq + i - winlo) < 16u) ? 0.f : -INFINITY;
        const unsigned short* kbase = Kg + ((size_t)b * 2048 + b0 + fr) * 1024 + h * 64 + 8 * fq;
        const NA_LAS char* bias_l = lds + LDS_BIAS + (b0 - qcol + 15 + 16 + 4 * fq) * 4;
        const NA_LAS char* v_l = lds + LDS_V + (b0 + 4 * fq + (fr >> 2)) * VROW + (fr & 3) * 8;
        float m = -INFINITY, lsum = 0.f; f32x4 oacc[4];
#pragma unroll
        for (int dt = 0; dt < 4; ++dt) oacc[dt] = (f32x4){0.f, 0.f, 0.f, 0.f};
        bf16x8 kf[2][2], kn[2][2];
#pragma unroll
        for (int t = 0; t < 2; ++t)
#pragma unroll
            for (int ks = 0; ks < 2; ++ks) kf[t][ks] = *(const bf16x8*)(kbase + (size_t)rs * 65536 + t * 16384 + ks * 32);
#pragma unroll
        for (int kr = 0; kr < 8; ++kr) {
            const int krow = rs + kr;
            if (kr < 7) {
#pragma unroll
                for (int t = 0; t < 2; ++t)
#pragma unroll
                    for (int ks = 0; ks < 2; ++ks) kn[t][ks] = *(const bf16x8*)(kbase + (size_t)(krow + 1) * 65536 + t * 16384 + ks * 32);
            }
            f32x4 s[2];
#pragma unroll
            for (int t = 0; t < 2; ++t) { s[t] = __builtin_amdgcn_mfma_f32_16x16x32_bf16(kf[t][0], qf[0], am[t], 0, 0, 0); s[t] = __builtin_amdgcn_mfma_f32_16x16x32_bf16(kf[t][1], qf[1], s[t], 0, 0, 0); }
            const NA_LAS float* bl = (const NA_LAS float*)(bias_l + (krow - r + 7) * 256);
#pragma unroll
            for (int t = 0; t < 2; ++t)
#pragma unroll
                for (int i = 0; i < 4; ++i) s[t][i] += bl[16 * t + i];
            float mx = fmaxf(fmaxf(fmaxf(s[0][0], s[0][1]), fmaxf(s[0][2], s[0][3])), fmaxf(fmaxf(s[1][0], s[1][1]), fmaxf(s[1][2], s[1][3])));
            mx = fmaxf(mx, __shfl_xor(mx, 16)); mx = fmaxf(mx, __shfl_xor(mx, 32));
            const float mn = fmaxf(m, mx), al = __builtin_amdgcn_exp2f(m - mn); m = mn;
            float ps = 0.f;
#pragma unroll
            for (int t = 0; t < 2; ++t)
#pragma unroll
                for (int i = 0; i < 4; ++i) { s[t][i] = __builtin_amdgcn_exp2f(s[t][i] - mn); ps += s[t][i]; }
            lsum = lsum * al + ps;
            u32x4 pw; pw.x = cvtpk(s[0][0], s[0][1]); pw.y = cvtpk(s[0][2], s[0][3]); pw.z = cvtpk(s[1][0], s[1][1]); pw.w = cvtpk(s[1][2], s[1][3]);
            const bf16x8 pb = __builtin_bit_cast(bf16x8, pw);
            const NA_LAS char* vp = v_l + (krow - R0) * 64 * VROW;
#pragma unroll
            for (int dt = 0; dt < 4; ++dt) {
                const s16x4 lo = vtr(vp + dt * 32), hi = vtr(vp + 16 * VROW + dt * 32);
                const bf16x8 vf = {lo[0], lo[1], lo[2], lo[3], hi[0], hi[1], hi[2], hi[3]};
                oacc[dt] = oacc[dt] * al;
                oacc[dt] = __builtin_amdgcn_mfma_f32_16x16x32_bf16(vf, pb, oacc[dt], 0, 0, 0);
            }
#pragma unroll
            for (int t = 0; t < 2; ++t)
#pragma unroll
                for (int ks = 0; ks < 2; ++ks) kf[t][ks] = kn[t][ks];
        }
        lsum += __shfl_xor(lsum, 16); lsum += __shfl_xor(lsum, 32);
        const float rl = 1.f / lsum;
        unsigned short* op = Og + tokq * 1024 + h * 64 + 4 * fq;
#pragma unroll
        for (int dt = 0; dt < 4; ++dt) { u32x2 w; w.x = cvtpk(oacc[dt][0] * rl, oacc[dt][1] * rl); w.y = cvtpk(oacc[dt][2] * rl, oacc[dt][3] * rl); *(u32x2*)(op + 16 * dt) = w; }
    }
#undef NA_PREFETCH
}
}
constexpr int NWAVES = 8, NTHREADS = 512;
constexpr int D = 1024, NB = 8, S = 2048, M = NB * S, DEPTH = 4, NH = 16, HD = 64, GW = 64, ROWS = 32;
constexpr int KVD = 256, NE = 32, NG = 4, EPG = 8, DE = 512, NQKV_NA = 3072, NQKV_GQ = 1536, NRT = 36;
constexpr float ALPHA = 1.6817928305074290f, LN_EPS = 1e-5f;
constexpr float LOG2E = 1.4426950408889634f, C2 = 0.125f * 1.4426950408889634f;
constexpr int MAXTILES = 160;

constexpr size_t MiB = 1u << 20;
constexpr size_t WS_CTL = 0, CTL_ZERO_BYTES = 1 * MiB;
constexpr size_t WS_MOD = 1 * MiB, WS_ROPE = 2 * MiB, WS_WRT = 3 * MiB;
constexpr size_t WS_WQKV_NA = 4 * MiB, WS_WO_NA = 16 * MiB, WS_WQKV_GQ = 20 * MiB, WS_WO_GQ = 26 * MiB;
constexpr size_t WS_WGU = 32 * MiB, WS_WDN = 96 * MiB;
constexpr size_t WS_X1 = 128 * MiB, WS_X2 = 192 * MiB, WS_H = 256 * MiB, WS_Q = 288 * MiB, WS_K = 320 * MiB, WS_V = 352 * MiB, WS_Y = 384 * MiB;
constexpr size_t WS_XS = 416 * MiB, WS_HMID = 496 * MiB, WS_YS = 536 * MiB, WS_ROUTE = 616 * MiB, WS_END = 620 * MiB;
constexpr int CW_BAR = 16384;
constexpr int CW_CNT = 8192;

constexpr int RING_BYTES = 131072, MISC_OFF = RING_BYTES, LDS_BYTES = 147456;

#define LAS __attribute__((address_space(3)))
typedef unsigned short bf16;
typedef unsigned v4u __attribute__((ext_vector_type(4)));
typedef unsigned v2u __attribute__((ext_vector_type(2)));
typedef float f32x4 __attribute__((ext_vector_type(4)));
#define RLX_AGENT __ATOMIC_RELAXED, __HIP_MEMORY_SCOPE_AGENT
__device__ __forceinline__ unsigned f2bf(float f) { unsigned u = __builtin_bit_cast(unsigned, f); return (u + 0x7fffu + ((u >> 16) & 1u)) >> 16; }
__device__ __forceinline__ unsigned pk2(float lo, float hi) { return f2bf(lo) | (f2bf(hi) << 16); }
__device__ __forceinline__ float bflo(unsigned w) { return __uint_as_float(w << 16); }
__device__ __forceinline__ float bfhi(unsigned w) { return __uint_as_float(w & 0xffff0000u); }
__device__ __forceinline__ float bf2f(bf16 v) { return __uint_as_float((unsigned)v << 16); }
__device__ __forceinline__ float wave_sum(float v) {
#pragma unroll
    for (int o = 1; o < 64; o <<= 1) v += __shfl_xor(v, o);
    return v;
}

struct Args { const float* in[20]; float* out; unsigned char* ws; };

__device__ __forceinline__ int rho_p8(int cc) { return (cc & 128) + (cc & 96) + 16 * ((cc >> 2) & 1) + 4 * ((cc >> 3) & 3) + (cc & 3); }
__device__ __forceinline__ int rho_head(int cc) { const int wc = cc >> 6, fq = 2 * ((cc >> 5) & 1) + ((cc >> 3) & 1), bj = (cc >> 4) & 1; return 128 * bj + 32 * wc + 16 * ((cc >> 2) & 1) + 4 * fq + (cc & 3); }
__device__ __forceinline__ int dest_row(int mode, int c) {
    if (mode == 0) return (c & ~255) + rho_p8(c & 255);
    if (mode == 1) return (c & ~255) + rho_head(c & 255);
    const int jj = c & 127; return (c >> 7) * 256 + (mode == 3 ? 128 : 0) + (jj & 96) + 16 * ((jj >> 2) & 1) + 4 * ((jj >> 3) & 3) + (jj & 3);
}
__device__ __forceinline__ void transpose_item(const float* __restrict__ W, int K, int N, bf16* __restrict__ WT, int mode, LAS float* scr, int item, int lane) {
    const int nblk = N / 32, kb = item / nblk, nb = item % nblk, k0 = 64 * kb, n0 = 32 * nb;
#pragma unroll 8
    for (int i = 0; i < 32; ++i) { const int kk = 2 * i + (lane >> 5); scr[kk * 33 + (lane & 31)] = W[(size_t)(k0 + kk) * N + n0 + (lane & 31)]; }
    asm volatile("s_waitcnt lgkmcnt(0)" ::: "memory");
    const int c = lane & 7;
#pragma unroll
    for (int j = 0; j < 4; ++j) { const int n = (lane >> 3) + 8 * j; const LAS float* s = scr + (8 * c) * 33 + n;
        v4u o; o.x = pk2(s[0 * 33], s[1 * 33]); o.y = pk2(s[2 * 33], s[3 * 33]); o.z = pk2(s[4 * 33], s[5 * 33]); o.w = pk2(s[6 * 33], s[7 * 33]);
        *(v4u*)(WT + (size_t)dest_row(mode, n0 + n) * K + k0 + 8 * c) = o; }
    asm volatile("s_waitcnt lgkmcnt(0)" ::: "memory");
}
__device__ __forceinline__ void moe_weight_items(const float* __restrict__ wgate, const float* __restrict__ wup, const float* __restrict__ wdown, int layer,
                                                 bf16* __restrict__ Wgu, bf16* __restrict__ Wdn, LAS float* scr, int gw, int NGW, int lane) {
    for (int it = gw; it < NE * 768; it += NGW) {
        const int e = it / 768, r = it % 768, which = r >> 8, sub = r & 255; const size_t le = (size_t)layer * NE + e;
        if (which == 0) transpose_item(wgate + le * D * DE, D, DE, Wgu + (size_t)e * D * D, 2, scr, sub, lane);
        else if (which == 1) transpose_item(wup + le * D * DE, D, DE, Wgu + (size_t)e * D * D, 3, scr, sub, lane);
        else transpose_item(wdown + le * DE * D, DE, D, Wdn + (size_t)e * D * DE, 0, scr, sub, lane);
    }
}

struct MoeOrder {
    int nunits, G, c; const LAS int* tile_e;
    __device__ __forceinline__ bool next(int i, pg8::Unit& u) const {
        const long L = (long)i * G + c; if (L >= nunits) return false;
        const int pm = (int)(L >> 2); u.pm = pm; u.pn = __builtin_amdgcn_readfirstlane(tile_e[pm]) * 4 + (int)(L & 3); return true;
    }
    __device__ __forceinline__ void a_ready(const pg8::Unit&) const {}
    __device__ __forceinline__ void done(const pg8::Unit&) const {}
};
__device__ __forceinline__ void build_tiles(const unsigned* cnt, LAS int* misc, int tid) {
    if (tid == 0) { int s = 0;
        for (int e = 0; e < NE; ++e) { misc[e] = s; const int c = (int)__hip_atomic_load(cnt + e, RLX_AGENT); const int nt = (c + 255) >> 8;
            for (int t = 0; t < nt; ++t) if (s + t < MAXTILES) misc[64 + s + t] = e; s += nt; }
        misc[32] = s; misc[33] = s < MAXTILES ? s : MAXTILES; }
    __syncthreads();
}

__device__ __forceinline__ void na_attn_simple(const bf16* Qb, const bf16* Kb, const bf16* Vb, bf16* Ob, const float* __restrict__ rpb, int gw, int NGW, int lane) {
    for (int w = gw; w < M * NH; w += NGW) {
        const int m = w >> 4, h = w & 15, b = m >> 11, t = m & 2047, r = t >> 6, c = t & 63;
        const int rs = min(max(r - 4, 0), ROWS - 8), wsx = min(max(c - 8, 0), GW - 16);
        const float q = bf2f(Qb[(size_t)m * D + h * HD + lane]);
        float mx = -INFINITY, l = 0.f, acc = 0.f;
        for (int kr = 0; kr < 8; ++kr)
            for (int kc = 0; kc < 16; ++kc) {
                const int krow = rs + kr, kcol = wsx + kc; const size_t tok = (size_t)b * S + krow * GW + kcol;
                const float kv = bf2f(Kb[tok * D + h * HD + lane]), vv = bf2f(Vb[tok * D + h * HD + lane]);
                const int dr = krow - r + 7, dc = min(max(kcol - c + 15, 0), 30);
                const float s = wave_sum(q * kv) + rpb[(h * 15 + dr) * 31 + dc] * LOG2E;
                const float mn = fmaxf(mx, s), al = __builtin_amdgcn_exp2f(mx - mn), p = __builtin_amdgcn_exp2f(s - mn);
                l = l * al + p; acc = acc * al + p * vv; mx = mn;
            }
        Ob[(size_t)m * D + h * HD + lane] = (bf16)f2bf(acc / l);
    }
}
__device__ __forceinline__ void gqa_attn_simple(const bf16* Qb, const bf16* Kb, const bf16* Vb, bf16* Ob, int gw, int NGW, int lane) {
    for (int w = gw; w < M * NH; w += NGW) {
        const int m = w >> 4, h = w & 15, b = m >> 11, kvh = h >> 2;
        const float q = bf2f(Qb[(size_t)m * D + h * HD + lane]);
        float mx = -INFINITY, l = 0.f, acc = 0.f;
        const bf16* kp = Kb + (size_t)b * S * KVD + kvh * HD + lane; const bf16* vp = Vb + (size_t)b * S * KVD + kvh * HD + lane;
        for (int j = 0; j < S; ++j) {
            const float kv = bf2f(kp[(size_t)j * KVD]), vv = bf2f(vp[(size_t)j * KVD]);
            const float s = wave_sum(q * kv);
            const float mn = fmaxf(mx, s), al = __builtin_amdgcn_exp2f(mx - mn), p = __builtin_amdgcn_exp2f(s - mn);
            l = l * al + p; acc = acc * al + p * vv; mx = mn;
        }
        Ob[(size_t)m * D + h * HD + lane] = (bf16)f2bf(acc / l);
    }
}
#define XB_TMO      128
#define XB_XCNT(j)  (256  + 64 * (j))
#define XB_XSUB(j)  (1280 + 64 * (j))
#define XB_XGEN(j)  (2304 + 64 * (j))
#define XB_TOP      3328
#define XB_TOPGEN   3392
#define XCD_BAR_WORDS 3456
#define XB_SPIN_CAP (1u << 18)

__device__ __forceinline__ unsigned xb_ld(unsigned* p)              { return __hip_atomic_load(p, __ATOMIC_RELAXED, __HIP_MEMORY_SCOPE_AGENT); }
__device__ __forceinline__ unsigned xb_add(unsigned* p, unsigned v) { return __hip_atomic_fetch_add(p, v, __ATOMIC_RELAXED, __HIP_MEMORY_SCOPE_AGENT); }
__device__ __forceinline__ unsigned xb_xcc_id() { return (unsigned)__builtin_amdgcn_s_getreg((3 << 11) | 20) & 0xFu; }
#define XB_SPIN(cond, bar) do { unsigned _sp = 0; while (cond) { __builtin_amdgcn_s_sleep(1); \
    if ((++_sp & 255u) == 0u) { if (xb_ld(&(bar)[XB_TMO])) break; if (_sp > XB_SPIN_CAP) { atomicAdd(&(bar)[XB_TMO], 1u); break; } } } } while (0)

struct XcdBarrier {
    unsigned* bar; unsigned x;
    volatile LAS unsigned* st;
};

__device__ __forceinline__ XcdBarrier xcd_barrier_post(unsigned* bar, volatile LAS unsigned* st) {
    XcdBarrier b; b.bar = bar; b.x = xb_xcc_id(); b.st = st;
    if (threadIdx.x == 0) (void)xb_add(&bar[XB_XCNT(b.x)], 1u);
    return b;
}
__device__ __forceinline__ void xcd_barrier_complete(unsigned* bar, unsigned x, unsigned& nloc, unsigned& nx) {
    const unsigned G = gridDim.x * gridDim.y * gridDim.z;
    unsigned sum, cnt, mine, sp = 0u;
    for (;;) {
        sum = 0u; cnt = 0u; mine = 0u;
#pragma unroll
        for (unsigned j = 0; j < 16; ++j) { const unsigned c = xb_ld(&bar[XB_XCNT(j)]); sum += c; cnt += (c > 0u) ? 1u : 0u; mine = (j == x) ? c : mine; }
        if (sum == G) break;
        __builtin_amdgcn_s_sleep(1);
        if ((++sp & 255u) == 0u) { if (xb_ld(&bar[XB_TMO])) break; if (sp > XB_SPIN_CAP) { atomicAdd(&bar[XB_TMO], 1u); break; } }
    }
    nloc = mine > 0u ? mine : 1u; nx = cnt > 0u ? cnt : 1u;
}

__device__ __forceinline__ void xcd_barrier(const XcdBarrier& b) {
    asm volatile("s_waitcnt vmcnt(0)" ::: "memory");
    __syncthreads();
    if (threadIdx.x == 0) {
        unsigned* bar = b.bar;
        __builtin_amdgcn_s_waitcnt(0);
        unsigned nloc = b.st[0], nx = b.st[1];
        if (nloc == 0u) { xcd_barrier_complete(bar, b.x, nloc, nx); b.st[0] = nloc; b.st[1] = nx; }
        const unsigned old = xb_add(&bar[XB_XSUB(b.x)], 1u);
        const unsigned gen = old / nloc;
        if (old + 1u == (gen + 1u) * nloc) {
            __builtin_amdgcn_fence(__ATOMIC_RELEASE, "agent");
            asm volatile("s_waitcnt vmcnt(0)" ::: "memory");
            const unsigned og = xb_add(&bar[XB_TOP], 1u);
            const unsigned tg = og / nx;
            if (og + 1u == (tg + 1u) * nx) xb_add(&bar[XB_TOPGEN], 1u);
            else XB_SPIN(xb_ld(&bar[XB_TOPGEN]) == tg, bar);
            __builtin_amdgcn_fence(__ATOMIC_ACQUIRE, "agent");
            xb_add(&bar[XB_XGEN(b.x)], 1u);
            asm volatile("s_waitcnt vmcnt(0)" ::: "memory");
        } else {
            XB_SPIN(xb_ld(&bar[XB_XGEN(b.x)]) == gen, bar);
            __builtin_amdgcn_fence(__ATOMIC_ACQUIRE, "agent");
            asm volatile("s_waitcnt vmcnt(0)" ::: "memory");
        }
    }
    __syncthreads();
}
__device__ __forceinline__ unsigned char* ldptr(const LAS unsigned* ptab, int i) {
    const unsigned lo = (unsigned)__builtin_amdgcn_readfirstlane((int)ptab[2 * i]), hi = (unsigned)__builtin_amdgcn_readfirstlane((int)ptab[2 * i + 1]);
    return (unsigned char*)(__attribute__((address_space(1))) unsigned char*)(((unsigned long long)hi << 32) | lo);
}
#define GRID_SYNC_CG() do { cg::this_grid().sync(); asm volatile("" ::: "memory"); } while (0)
#define GRID_SYNC() do { unsigned lb_ = (unsigned)(uintptr_t)lds_raw; asm volatile("" : "+s"(lb_)); LAS unsigned char* l_ = (LAS unsigned char*)lb_; \
    XcdBarrier xb_; xb_.bar = (unsigned*)(ldptr((LAS unsigned*)(l_ + MISC_OFF + 1024), 21) + WS_CTL) + CW_BAR; xb_.x = xb_xcc_id(); xb_.st = (volatile LAS unsigned*)(l_ + MISC_OFF + 2048); \
    xcd_barrier(xb_); asm volatile("" ::: "memory"); } while (0)
#define PH_BEGIN \
    unsigned ldsb_ = (unsigned)(uintptr_t)lds_raw; asm volatile("" : "+s"(ldsb_)); \
    LAS unsigned char* lds = (LAS unsigned char*)ldsb_; LAS int* misc = (LAS int*)(lds + MISC_OFF); LAS unsigned* ptab = (LAS unsigned*)(lds + MISC_OFF + 1024); (void)misc; \
    int tid = threadIdx.x; asm volatile("" : "+v"(tid)); \
    const int lane = tid & 63, wave = __builtin_amdgcn_readfirstlane(tid >> 6); \
    int G = gridDim.x, bid = blockIdx.x; asm volatile("" : "+s"(G), "+s"(bid)); const int gw = bid * NWAVES + wave, NGW = G * NWAVES; \
    unsigned char* ws = ldptr(ptab, 21); (void)lane; (void)gw; (void)NGW; (void)ws;
#define INP(i) ((const float*)ldptr(ptab, (i)))

__global__ void __launch_bounds__(NTHREADS, 2) mk_fwd(Args args) {
    extern __shared__ __attribute__((aligned(16))) unsigned char lds_raw[];
    { LAS unsigned* ptab = (LAS unsigned*)((LAS unsigned char*)lds_raw + MISC_OFF + 1024);
    if (threadIdx.x < 22) { const unsigned long long p = threadIdx.x < 20 ? (unsigned long long)args.in[threadIdx.x] : (threadIdx.x == 20 ? (unsigned long long)args.out : (unsigned long long)args.ws);
        ptab[2 * threadIdx.x] = (unsigned)p; ptab[2 * threadIdx.x + 1] = (unsigned)(p >> 32); }
      volatile LAS unsigned* st = (volatile LAS unsigned*)((LAS unsigned char*)lds_raw + MISC_OFF + 2048);
      if (threadIdx.x == 64) { st[0] = 0u; st[1] = 0u; }
      __syncthreads();
      (void)xcd_barrier_post((unsigned*)(args.ws + WS_CTL) + CW_BAR, st); }
    __syncthreads();

    {
        PH_BEGIN
        const float* c_in = INP(1); const float* ada_w = INP(2); const float* ada_b = INP(3);
        float* mod = (float*)(ws + WS_MOD); float* ropec = (float*)(ws + WS_ROPE); float* ropes = ropec + S * 32; float* wrt = (float*)(ws + WS_WRT);
        LAS float* ca = (LAS float*)lds;
        LAS float* red = (LAS float*)(lds + 32768);
        for (int i = tid; i < NB * D; i += NTHREADS) { const float v = c_in[i]; ca[i] = v / (1.f + __expf(-v)); }
        __syncthreads();
        for (int it = bid; it < DEPTH * 192; it += G) {
            const int l = it / 192, col0 = (it % 192) * 32, cl = tid & 31, ks = tid >> 5;
            const float* wp = ada_w + ((size_t)l * D + 64 * ks) * (6 * D) + col0 + cl;
            float acc[NB];
#pragma unroll
            for (int b = 0; b < NB; ++b) acc[b] = 0.f;
#pragma unroll 16
            for (int kk = 0; kk < 64; ++kk) { const float wv = wp[(size_t)kk * (6 * D)];
#pragma unroll
                for (int b = 0; b < NB; ++b) acc[b] += ca[b * D + 64 * ks + kk] * wv; }
#pragma unroll
            for (int b = 0; b < NB; ++b) red[(ks * NB + b) * 32 + cl] = acc[b];
            __syncthreads();
            if (tid < 256) { const int b = tid >> 5; float s = 0.f;
#pragma unroll
                for (int k2 = 0; k2 < 16; ++k2) s += red[(k2 * NB + b) * 32 + cl];
                mod[((size_t)l * NB + b) * (6 * D) + col0 + cl] = s + ada_b[l * 6 * D + col0 + cl]; }
            __syncthreads();
        }
        for (int i = bid * NTHREADS + tid; i < S * 32; i += G * NTHREADS) {
            const int t = i >> 5, a = (i >> 4) & 1, p = i & 15;
            const float pos = (float)(a == 0 ? t / GW : t % GW);
            const float ang = pos * exp2f(-(float)p * (13.287712379549449f / 16.f));
            const float kf = rintf(ang * 0.15915494309189535f);
            float r = fmaf(-kf, 6.2831854820251465f, ang); r = fmaf(-kf, -1.7484555314695172e-07f, r);
            ropec[i] = __cosf(r); ropes[i] = __sinf(r);
        }
        { const float* m_wg = INP(13); const float* m_we = INP(15);
          for (int i = bid * NTHREADS + tid; i < DEPTH * NRT * D; i += G * NTHREADS) {
            const int l = i / (NRT * D), o = (i / D) % NRT, k = i % D;
            wrt[i] = o < NG ? m_wg[((size_t)l * D + k) * NG + o] : m_we[((size_t)l * D + k) * NE + (o - NG)];
          } }
        LAS float* scr = (LAS float*)(lds + 49152 + wave * 8704);
        { const float* na_wqkv = INP(6); const float* na_wo = INP(8); const float* gq_wqkv = INP(9); const float* gq_wo = INP(12);
          bf16* Wqkv_na = (bf16*)(ws + WS_WQKV_NA); bf16* Wo_na = (bf16*)(ws + WS_WO_NA); bf16* Wqkv_gq = (bf16*)(ws + WS_WQKV_GQ); bf16* Wo_gq = (bf16*)(ws + WS_WO_GQ);
          constexpr int I_NQ = 16 * 96, I_O = 16 * 32, I_GQ = 16 * 48, I_DENSE = 2 * (I_NQ + I_O + I_GQ + I_O);
          for (int it = gw; it < I_DENSE; it += NGW) {
            int r = it; const int j = r / (I_DENSE / 2); r %= (I_DENSE / 2);
            if (r < I_NQ) { transpose_item(na_wqkv + (size_t)j * D * NQKV_NA, D, NQKV_NA, Wqkv_na + (size_t)j * NQKV_NA * D, 0, scr, r, lane); continue; } r -= I_NQ;
            if (r < I_O) { transpose_item(na_wo + (size_t)j * D * D, D, D, Wo_na + (size_t)j * D * D, 0, scr, r, lane); continue; } r -= I_O;
            if (r < I_GQ) { transpose_item(gq_wqkv + (size_t)j * D * NQKV_GQ, D, NQKV_GQ, Wqkv_gq + (size_t)j * NQKV_GQ * D, 1, scr, r, lane); continue; } r -= I_GQ;
            transpose_item(gq_wo + (size_t)j * D * D, D, D, Wo_gq + (size_t)j * D * D, 0, scr, r, lane);
          } }
        moe_weight_items(INP(17), INP(18), INP(19), 0, (bf16*)(ws + WS_WGU), (bf16*)(ws + WS_WDN), scr, gw, NGW, lane);
    }
    GRID_SYNC_CG();
    {
        PH_BEGIN
        const float* x_in = INP(0); const float* mod = (const float*)(ws + WS_MOD); bf16* Hb = (bf16*)(ws + WS_H);
        for (int m = gw; m < M; m += NGW) {
            const float* mb = mod + (size_t)(m >> 11) * (6 * D);
#pragma unroll
            for (int j = 0; j < 4; ++j) { const int d = 4 * lane + 256 * j;
                const f32x4 xv = *(const f32x4*)(x_in + (size_t)m * D + d), sh = *(const f32x4*)(mb + d), sc = *(const f32x4*)(mb + D + d);
                const f32x4 hv = xv * (1.f + sc) + sh; v2u o; o.x = pk2(hv[0], hv[1]); o.y = pk2(hv[2], hv[3]);
                *(v2u*)(Hb + (size_t)m * D + d) = o; }
        }
    }
    GRID_SYNC();

    for (int layer = 0; layer < DEPTH; ++layer) {
        {
            PH_BEGIN
            const int j2 = layer >> 1;
            bf16* Hb = (bf16*)(ws + WS_H); bf16* Qb = (bf16*)(ws + WS_Q);
            if ((layer & 1) == 0) {
                pg8::Gemm g{Hb, (bf16*)(ws + WS_WQKV_NA) + (size_t)j2 * NQKV_NA * D, M, NQKV_NA, D}; pg8::StaticOrder So; So.init(M, NQKV_NA, G, bid);
                pg8::EpiStore8 E{Qb, D, D, (size_t)(WS_K - WS_Q) / 2, C2, 0x7fffffff};
                pg8::gemm_phase<pg8::EpiStore8, pg8::StaticOrder, true, true>(lds, g, So, E);
            } else {
                pg8::Gemm g{Hb, (bf16*)(ws + WS_WQKV_GQ) + (size_t)j2 * NQKV_GQ * D, M, NQKV_GQ, D}; pg8::StaticOrder So; So.init(M, NQKV_GQ, G, bid);
                const float* ropec = (const float*)(ws + WS_ROPE);
                pg8::EpiGqaQkv E{Qb, (bf16*)(ws + WS_K), (bf16*)(ws + WS_V), INP(10) + j2 * HD, INP(11) + j2 * HD, ropec, ropec + S * 32, C2};
                pg8::gemm_phase<pg8::EpiGqaQkv, pg8::StaticOrder, true, true>(lds, g, So, E);
            }
        }
        GRID_SYNC();
        {
            PH_BEGIN
            bf16* Qb = (bf16*)(ws + WS_Q); const bf16* Kb = (const bf16*)(ws + WS_K); const bf16* Vb = (const bf16*)(ws + WS_V);
            if ((layer & 1) == 0) na_body::na_phase((LAS char*)lds, Qb, Kb, Vb, Qb, INP(7) + (size_t)(layer >> 1) * NH * 15 * 31, G, bid);
            else {
                const attn_body::AttnTensors AT{(const attn_body::bf16*)Qb, (const attn_body::bf16*)Kb, (const attn_body::bf16*)Vb, (attn_body::bf16*)Qb};
                const attn_body::StaticOrder So(G, bid);
                attn_body::attn_phase<attn_body::StaticOrder>((char*)lds, AT, So);
            }
        }
        GRID_SYNC();
        {
            PH_BEGIN
            const bf16* Wo = (const bf16*)(ws + ((layer & 1) == 0 ? WS_WO_NA : WS_WO_GQ)) + (size_t)(layer >> 1) * D * D;
            pg8::Gemm g{(const bf16*)(ws + WS_Q), Wo, M, D, D}; pg8::StaticOrder So; So.init(M, D, G, bid);
            pg8::EpiStore8 E{(bf16*)(ws + WS_Y), D, 0, 0, 1.f, 0x7fffffff};
            pg8::gemm_phase<pg8::EpiStore8, pg8::StaticOrder, true, true>(lds, g, So, E);
        }
        GRID_SYNC();
        {
            PH_BEGIN
            const float* xcur = layer == 0 ? INP(0) : (const float*)(ws + WS_X2);
            const float* modl = (const float*)(ws + WS_MOD) + (size_t)layer * NB * 6 * D;
            unsigned* cnt = (unsigned*)(ws + WS_CTL) + CW_CNT + 64 * layer;
            float* X1 = (float*)(ws + WS_X1); bf16* Hb = (bf16*)(ws + WS_H); const bf16* Yb = (const bf16*)(ws + WS_Y);
            int* r_eid = (int*)(ws + WS_ROUTE); int* r_pos = r_eid + 2 * M; float* r_gate = (float*)(r_pos + 2 * M);
            LAS int* hist = (LAS int*)lds; LAS int* basee = hist + 32; LAS int* rt_e = hist + 64; LAS int* rt_lp = rt_e + 128; LAS float* rt_g = (LAS float*)(rt_lp + 128);
            const float* lg = INP(4) + (size_t)(layer * 2) * D; const float* lb = INP(5) + (size_t)(layer * 2) * D;
            const float* wr = (const float*)(ws + WS_WRT) + (size_t)layer * NRT * D; const float* bgp = INP(14) + layer * NG; const float* bep = INP(16) + layer * NE;
            for (int ch = bid; ch < M / 64; ch += G) {
                if (tid < 32) hist[tid] = 0;
                __syncthreads();
                for (int ti = 0; ti < 8; ++ti) {
                    const int tl = wave * 8 + ti, m = ch * 64 + tl; const float* mb = modl + (size_t)(m >> 11) * (6 * D);
                    f32x4 v[4]; float s = 0.f;
#pragma unroll
                    for (int j = 0; j < 4; ++j) { const int d = 4 * lane + 256 * j;
                        const f32x4 xv = *(const f32x4*)(xcur + (size_t)m * D + d), g1 = *(const f32x4*)(mb + 2 * D + d);
                        const v2u yw = *(const v2u*)(Yb + (size_t)m * D + d); const f32x4 yv = {bflo(yw.x), bfhi(yw.x), bflo(yw.y), bfhi(yw.y)};
                        v[j] = ALPHA * xv + (1.f + g1) * yv; s += (v[j][0] + v[j][1]) + (v[j][2] + v[j][3]); }
                    const float mean = wave_sum(s) * (1.f / D); float q = 0.f;
#pragma unroll
                    for (int j = 0; j < 4; ++j) { v[j] = v[j] - mean; q += (v[j][0] * v[j][0] + v[j][1] * v[j][1]) + (v[j][2] * v[j][2] + v[j][3] * v[j][3]); }
                    const float rstd = rsqrtf(wave_sum(q) * (1.f / D) + LN_EPS);
#pragma unroll
                    for (int j = 0; j < 4; ++j) { const int d = 4 * lane + 256 * j;
                        const f32x4 x1 = v[j] * rstd * *(const f32x4*)(lg + d) + *(const f32x4*)(lb + d);
                        *(f32x4*)(X1 + (size_t)m * D + d) = x1;
                        const f32x4 h2 = x1 * (1.f + *(const f32x4*)(mb + 4 * D + d)) + *(const f32x4*)(mb + 3 * D + d);
                        v2u o; o.x = pk2(h2[0], h2[1]); o.y = pk2(h2[2], h2[3]); *(v2u*)(Hb + (size_t)m * D + d) = o;
                        v[j] = h2; }
                    float lgp[NG];
#pragma unroll
                    for (int o = 0; o < NG; ++o) { float a = 0.f;
#pragma unroll
                        for (int j = 0; j < 4; ++j) { const f32x4 w4 = *(const f32x4*)(wr + (size_t)o * D + 4 * lane + 256 * j); a += (v[j][0] * w4[0] + v[j][1] * w4[1]) + (v[j][2] * w4[2] + v[j][3] * w4[3]); }
                        lgp[o] = wave_sum(a) + bgp[o]; }
                    int gi = 0; float gm = lgp[0];
#pragma unroll
                    for (int o = 1; o < NG; ++o) if (lgp[o] > gm) { gm = lgp[o]; gi = o; }
                    float gs = 0.f;
#pragma unroll
                    for (int o = 0; o < NG; ++o) gs += __expf(lgp[o] - gm);
                    const float gprob = 1.f / gs;
                    gi = __builtin_amdgcn_readfirstlane(gi);
                    float le[EPG];
#pragma unroll
                    for (int e = 0; e < EPG; ++e) { float a = 0.f; const float* wp = wr + (size_t)(NG + gi * EPG + e) * D;
#pragma unroll
                        for (int j = 0; j < 4; ++j) { const f32x4 w4 = *(const f32x4*)(wp + 4 * lane + 256 * j); a += (v[j][0] * w4[0] + v[j][1] * w4[1]) + (v[j][2] * w4[2] + v[j][3] * w4[3]); }
                        le[e] = wave_sum(a) + bep[gi * EPG + e]; }
                    int i0 = 0; float m0 = le[0];
#pragma unroll
                    for (int e = 1; e < EPG; ++e) if (le[e] > m0) { m0 = le[e]; i0 = e; }
                    int i1 = 0; float m1 = -INFINITY;
#pragma unroll
                    for (int e = 0; e < EPG; ++e) if (e != i0 && le[e] > m1) { m1 = le[e]; i1 = e; }
                    const float p1 = __expf(m1 - m0), den = 1.f + p1;
                    if (lane == 0) { const int e0 = gi * EPG + i0, e1 = gi * EPG + i1;
                        rt_e[2 * tl] = e0; rt_e[2 * tl + 1] = e1; rt_g[2 * tl] = gprob / den; rt_g[2 * tl + 1] = gprob * p1 / den;
                        rt_lp[2 * tl] = atomicAdd((int*)&hist[e0], 1); rt_lp[2 * tl + 1] = atomicAdd((int*)&hist[e1], 1); }
                }
                __syncthreads();
                if (tid < 32) { const int c = hist[tid]; basee[tid] = c ? (int)__hip_atomic_fetch_add(cnt + tid, (unsigned)c, RLX_AGENT) : 0; }
                __syncthreads();
                if (tid < 128) { const int e = rt_e[tid], A = ch * 128 + tid; r_eid[A] = e; r_pos[A] = basee[e] + rt_lp[tid]; r_gate[A] = rt_g[tid]; }
                __syncthreads();
            }
        }
        GRID_SYNC();
        {
            PH_BEGIN
            const unsigned* cnt = (const unsigned*)(ws + WS_CTL) + CW_CNT + 64 * layer;
            const bf16* Hb = (const bf16*)(ws + WS_H); bf16* XS = (bf16*)(ws + WS_XS);
            const int* r_eid = (const int*)(ws + WS_ROUTE); const int* r_pos = r_eid + 2 * M;
            build_tiles(cnt, misc, tid);
            for (int m = gw; m < M; m += NGW) {
                const v4u a0 = *(const v4u*)(Hb + (size_t)m * D + 8 * lane), a1 = *(const v4u*)(Hb + (size_t)m * D + 512 + 8 * lane);
#pragma unroll
                for (int k = 0; k < 2; ++k) { const int e = r_eid[2 * m + k], slot = misc[e] * 256 + r_pos[2 * m + k];
                    *(v4u*)(XS + (size_t)slot * D + 8 * lane) = a0; *(v4u*)(XS + (size_t)slot * D + 512 + 8 * lane) = a1; }
            }
        }
        GRID_SYNC();
        {
            PH_BEGIN
            const int ntiles = __builtin_amdgcn_readfirstlane(misc[33]);
            pg8::Gemm g{(const bf16*)(ws + WS_XS), (const bf16*)(ws + WS_WGU), ntiles * 256, NE * D, D}; MoeOrder So{ntiles * 4, G, bid, misc + 64};
            pg8::EpiSwiglu E{(bf16*)(ws + WS_HMID)};
            pg8::gemm_phase<pg8::EpiSwiglu, MoeOrder, true, true>(lds, g, So, E);
        }
        GRID_SYNC();
        {
            PH_BEGIN
            const int ntiles = __builtin_amdgcn_readfirstlane(misc[33]);
            pg8::Gemm g{(const bf16*)(ws + WS_HMID), (const bf16*)(ws + WS_WDN), ntiles * 256, NE * D, DE}; MoeOrder So{ntiles * 4, G, bid, misc + 64};
            pg8::EpiStore8 E{(bf16*)(ws + WS_YS), D, 0, 0, 1.f, 3};
            pg8::gemm_phase<pg8::EpiStore8, MoeOrder, true, true>(lds, g, So, E);
        }
        GRID_SYNC();
        {
            PH_BEGIN
            const float* lg = INP(4) + (size_t)(layer * 2 + 1) * D; const float* lb = INP(5) + (size_t)(layer * 2 + 1) * D;
            const bool last = layer == DEPTH - 1; float* xo = last ? (float*)ldptr(ptab, 20) : (float*)(ws + WS_X2);
            const float* modl = (const float*)(ws + WS_MOD) + (size_t)layer * NB * 6 * D; const float* modn = modl + (size_t)NB * 6 * D;
            const float* X1 = (const float*)(ws + WS_X1); bf16* Hb = (bf16*)(ws + WS_H); const bf16* YS = (const bf16*)(ws + WS_YS);
            const int* r_eid = (const int*)(ws + WS_ROUTE); const int* r_pos = r_eid + 2 * M; const float* r_gate = (const float*)(r_pos + 2 * M);
            for (int m = gw; m < M; m += NGW) {
                const float* mb = modl + (size_t)(m >> 11) * (6 * D); const float* mn = modn + (size_t)(m >> 11) * (6 * D);
                const int s0 = misc[r_eid[2 * m]] * 256 + r_pos[2 * m], s1 = misc[r_eid[2 * m + 1]] * 256 + r_pos[2 * m + 1];
                const float g0 = r_gate[2 * m], g1v = r_gate[2 * m + 1];
                f32x4 v[4]; float s = 0.f;
#pragma unroll
                for (int j = 0; j < 4; ++j) { const int d = 4 * lane + 256 * j;
                    const f32x4 xv = *(const f32x4*)(X1 + (size_t)m * D + d), g2 = *(const f32x4*)(mb + 5 * D + d);
                    const v2u ya = *(const v2u*)(YS + (size_t)s0 * D + d), yb = *(const v2u*)(YS + (size_t)s1 * D + d);
                    const f32x4 y0 = {bflo(ya.x), bfhi(ya.x), bflo(ya.y), bfhi(ya.y)}, y1 = {bflo(yb.x), bfhi(yb.x), bflo(yb.y), bfhi(yb.y)};
                    v[j] = ALPHA * xv + (1.f + g2) * (g0 * y0 + g1v * y1); s += (v[j][0] + v[j][1]) + (v[j][2] + v[j][3]); }
                const float mean = wave_sum(s) * (1.f / D); float q = 0.f;
#pragma unroll
                for (int j = 0; j < 4; ++j) { v[j] = v[j] - mean; q += (v[j][0] * v[j][0] + v[j][1] * v[j][1]) + (v[j][2] * v[j][2] + v[j][3] * v[j][3]); }
                const float rstd = rsqrtf(wave_sum(q) * (1.f / D) + LN_EPS);
#pragma unroll
                for (int j = 0; j < 4; ++j) { const int d = 4 * lane + 256 * j;
                    const f32x4 x2 = v[j] * rstd * *(const f32x4*)(lg + d) + *(const f32x4*)(lb + d);
                    *(f32x4*)(xo + (size_t)m * D + d) = x2;
                    if (!last) { const f32x4 hn = x2 * (1.f + *(const f32x4*)(mn + D + d)) + *(const f32x4*)(mn + d);
                        v2u o; o.x = pk2(hn[0], hn[1]); o.y = pk2(hn[2], hn[3]); *(v2u*)(Hb + (size_t)m * D + d) = o; } }
            }
            if (!last) { LAS float* scr = (LAS float*)(lds + wave * 8704); moe_weight_items(INP(17), INP(18), INP(19), layer + 1, (bf16*)(ws + WS_WGU), (bf16*)(ws + WS_WDN), scr, gw, NGW, lane); }
        }
        if (layer != DEPTH - 1) GRID_SYNC();
    }
}

extern "C" void kernel_launch(void* const* d_in, const int* in_sizes, int n_in, void* d_out, int out_size, void* d_ws, size_t ws_size, hipStream_t stream) {
    static int grid = 0;
    if (grid == 0) {
        if (n_in != 20 || ws_size < WS_END) { fprintf(stderr, "kernel_launch: unexpected inputs (n_in %d, ws %zu)\n", n_in, ws_size); grid = -1; return; }
        int dev = 0, cus = 0, per_cu = 0;
        if (hipGetDevice(&dev) != hipSuccess || hipDeviceGetAttribute(&cus, hipDeviceAttributeMultiprocessorCount, dev) != hipSuccess) { grid = -1; return; }
        if (hipFuncSetAttribute((const void*)mk_fwd, hipFuncAttributeMaxDynamicSharedMemorySize, LDS_BYTES) != hipSuccess) { fprintf(stderr, "kernel_launch: hipFuncSetAttribute failed\n"); grid = -1; return; }
        if (hipOccupancyMaxActiveBlocksPerMultiprocessor(&per_cu, (const void*)mk_fwd, NTHREADS, LDS_BYTES) != hipSuccess || per_cu < 1) { fprintf(stderr, "kernel_launch: occupancy query failed (%d)\n", per_cu); per_cu = 1; }
        (void)hipGetLastError();
        grid = cus * (per_cu < 1 ? 1 : 1);
    }
    if (grid < 0) return;
    (void)in_sizes; (void)out_size;
    if (hipMemsetAsync((char*)d_ws + WS_CTL, 0, CTL_ZERO_BYTES, stream) != hipSuccess) { fprintf(stderr, "kernel_launch: memset failed\n"); return; }
    Args a{};
    for (int i = 0; i < 20; ++i) a.in[i] = (const float*)d_in[i];
    a.out = (float*)d_out; a.ws = (unsigned char*)d_ws;
    void* kargs[] = {&a};
    hipError_t e = hipLaunchCooperativeKernel((const void*)mk_fwd, dim3(grid), dim3(NTHREADS), kargs, LDS_BYTES, stream);
    if (e != hipSuccess) fprintf(stderr, "kernel_launch: cooperative launch failed: %s (grid %d)\n", hipGetErrorString(e), grid);
}
```

```cpp
#include <hip/hip_runtime.h>
#include <hip/hip_cooperative_groups.h>
#include <cstdio>
#include <cstdint>
namespace cg = cooperative_groups;
namespace pg8 {
#define PG8_LAS __attribute__((address_space(3)))
typedef unsigned short bf16_t;
typedef short bf16x8 __attribute__((ext_vector_type(8)));
typedef float f32x4 __attribute__((ext_vector_type(4)));
typedef unsigned u32x4 __attribute__((ext_vector_type(4)));
constexpr int BM = 256, BK = 64, HALF = 128, HTB = HALF * BK * 2  , STAGE_BYTES = 8 * HTB, NXCD = 8, WGM = 8;

__host__ __device__ __forceinline__ int lds_byte(int r, int c) { const int st = (r >> 4) * 2 + (c >> 5), rr = r & 15, cc = c & 31, ob = rr * 64 + cc * 2; return st * 1024 + (ob ^ (((ob >> 9) & 1) << 5)); }
__host__ __device__ __forceinline__ void stage_rc(int b, int& R, int& C) { const int st = b / 1024, sb = b % 1024, swz = sb ^ (((sb >> 9) & 1) << 5); R = (st >> 1) * 16 + swz / 64; C = (st & 1) * 32 + (swz % 64) / 2; }
__host__ __device__ __forceinline__ int perm32(int rho) { const int n = rho >> 4, i = rho & 15; return 8 * (i >> 2) + 4 * n + (i & 3); }

struct Unit { int pm, pn; };
struct Gemm { const bf16_t* A; const bf16_t* Bt; int M, N, K; };

struct StaticOrder {
    int nM, nN, nwg, G, c;
    __host__ __device__ void init(int M, int N, int G_, int c_) { nM = M / BM; nN = N / BM; nwg = nM * nN; G = G_; c = c_; }
    __host__ __device__ bool next(int i, Unit& u) const {
        const long L = (long)i * G + c; if (L >= nwg) return false;
        int wgid = (int)L; { const int q = nwg / NXCD, r = nwg % NXCD, xcd = wgid % NXCD, off = wgid / NXCD; wgid = (xcd < r ? xcd * (q + 1) : r * (q + 1) + (xcd - r) * q) + off; }
        const int nig = WGM * nN, gid = wgid / nig, fm = gid * WGM, gsz = (nM - fm) < WGM ? (nM - fm) : WGM;
        u.pm = fm + ((wgid % nig) % gsz); u.pn = (wgid % nig) / gsz; return true;
    }
    __device__ __forceinline__ void a_ready(const Unit&) const {}
    __device__ __forceinline__ void done(const Unit&) const {}
};

__device__ __forceinline__ unsigned cvt_pk_bf16(float lo, float hi) { unsigned r; asm volatile("v_cvt_pk_bf16_f32 %0, %1, %2" : "=v"(r) : "v"(lo), "v"(hi)); return r; }
__device__ __forceinline__ u32x4 pack8(const f32x4& a, const f32x4& b) { u32x4 w; w.x = cvt_pk_bf16(a[0], a[1]); w.y = cvt_pk_bf16(a[2], a[3]); w.z = cvt_pk_bf16(b[0], b[1]); w.w = cvt_pk_bf16(b[2], b[3]); return w; }

struct EpiStore8 {
    static constexpr bool PERM = false, AFTER_DRAIN = false;
    bf16_t* O; int ldc; int split_cols; size_t split_stride; float scale0; int pn_mask;
    __device__ __forceinline__ void operator()(const f32x4 (&acc)[2][2][4][2], const Unit& u, int wr, int wc, int fr, int fq) const {
        const int row0 = u.pm * BM + wr * 64 + fr; int colt = (u.pn & pn_mask) * BM; bf16_t* base = O;
        float sc = 1.f; if (split_cols) { const int t = colt / split_cols; base += (size_t)t * split_stride; colt -= t * split_cols; if (t == 0) sc = scale0; }
        const int col0 = colt + wc * 32 + 8 * fq;
#pragma unroll
        for (int ai = 0; ai < 2; ++ai)
#pragma unroll
            for (int m = 0; m < 4; ++m) { bf16_t* rowp = base + (size_t)(row0 + ai * HALF + m * 16) * ldc + col0;
#pragma unroll
                for (int bj = 0; bj < 2; ++bj) { const f32x4 v0 = acc[ai][bj][m][0] * sc, v1 = acc[ai][bj][m][1] * sc; *(u32x4*)(rowp + bj * HALF) = pack8(v0, v1); } }
    }
};
__device__ __forceinline__ float silu_f(float g) { return g * __builtin_amdgcn_rcpf(1.f + __expf(-g)); }
struct EpiSwiglu {
    static constexpr bool PERM = false, AFTER_DRAIN = false;
    bf16_t* O;
    __device__ __forceinline__ void operator()(const f32x4 (&acc)[2][2][4][2], const Unit& u, int wr, int wc, int fr, int fq) const {
        const int row0 = u.pm * BM + wr * 64 + fr; const int col0 = (u.pn & 3) * 128 + wc * 32 + 8 * fq;
#pragma unroll
        for (int ai = 0; ai < 2; ++ai)
#pragma unroll
            for (int m = 0; m < 4; ++m) { bf16_t* rowp = O + (size_t)(row0 + ai * HALF + m * 16) * 512 + col0; f32x4 h[2];
#pragma unroll
                for (int n = 0; n < 2; ++n) { const f32x4 g = acc[ai][0][m][n], up = acc[ai][1][m][n];
                    h[n] = (f32x4){silu_f(g[0]) * up[0], silu_f(g[1]) * up[1], silu_f(g[2]) * up[2], silu_f(g[3]) * up[3]}; }
                *(u32x4*)rowp = pack8(h[0], h[1]); }
    }
};
struct EpiGqaQkv {
    static constexpr bool PERM = false, AFTER_DRAIN = false;
    bf16_t *Q, *K, *V; const float* qn; const float* kn; const float* cs; const float* sn; float qscale;
    __device__ __forceinline__ void operator()(const f32x4 (&acc)[2][2][4][2], const Unit& u, int wr, int wc, int fr, int fq) const {
        const int row0 = u.pm * BM + wr * 64 + fr; const int pn = u.pn;
        const int type = pn < 4 ? 0 : (pn == 4 ? 1 : 2);
        bf16_t* base = type == 0 ? Q + (4 * pn + wc) * 64 : (type == 1 ? K : V) + wc * 64; const int ldc = type == 0 ? 1024 : 256;
        const int dlo = 32 * (fq >> 1) + 8 * (fq & 1);
        const int tlo = (fq >> 1) * 16 + 8 * (fq & 1);
        const float* gain = type == 0 ? qn : kn; const float sc = type == 0 ? qscale : 1.f;
        f32x4 gv[2][2];
#pragma unroll
        for (int bj = 0; bj < 2; ++bj)
#pragma unroll
            for (int n = 0; n < 2; ++n) gv[bj][n] = *(const f32x4*)(gain + dlo + 16 * bj + 4 * n) * sc;
#pragma unroll
        for (int ai = 0; ai < 2; ++ai)
#pragma unroll
            for (int m = 0; m < 4; ++m) { const int row = row0 + ai * HALF + m * 16; bf16_t* rowp = base + (size_t)row * ldc + dlo; f32x4 o[2][2];
                if (type < 2) {
                    float ss = 0.f;
#pragma unroll
                    for (int bj = 0; bj < 2; ++bj)
#pragma unroll
                        for (int n = 0; n < 2; ++n) { const f32x4 x = acc[ai][bj][m][n]; ss += (x[0] * x[0] + x[1] * x[1]) + (x[2] * x[2] + x[3] * x[3]); }
                    ss += __shfl_xor(ss, 16); ss += __shfl_xor(ss, 32);
                    const float rinv = rsqrtf(ss * (1.f / 64.f) + 1e-6f);
                    const int t = row & 2047;
#pragma unroll
                    for (int n = 0; n < 2; ++n) { const f32x4 c4 = *(const f32x4*)(cs + t * 32 + tlo + 4 * n), s4 = *(const f32x4*)(sn + t * 32 + tlo + 4 * n);
                        const f32x4 x1 = acc[ai][0][m][n] * rinv * gv[0][n], x2 = acc[ai][1][m][n] * rinv * gv[1][n];
                        o[0][n] = x1 * c4 - x2 * s4; o[1][n] = x2 * c4 + x1 * s4; }
                } else {
#pragma unroll
                    for (int bj = 0; bj < 2; ++bj)
#pragma unroll
                        for (int n = 0; n < 2; ++n) o[bj][n] = acc[ai][bj][m][n];
                }
#pragma unroll
                for (int bj = 0; bj < 2; ++bj) *(u32x4*)(rowp + 16 * bj) = pack8(o[bj][0], o[bj][1]); }
    }
};
template <class Epi, class Sched, bool ALIGN_EPI = false, bool SP2 = false, bool GATHER = false>
__device__ __forceinline__ void gemm_phase(PG8_LAS unsigned char* lds, const Gemm g, const Sched& S, const Epi& E) {
    int tid_ = threadIdx.x; asm volatile("" : "+v"(tid_)); const int tid = tid_, wid = __builtin_amdgcn_readfirstlane(tid >> 6), lane = tid & 63, wr = wid >> 2, wc = wid & 3, fr = lane & 15, fq = lane >> 4;
    const int K = g.K, nt = K / BK;
    unsigned voffA[2], voffB[2];
#pragma unroll
    for (int i = 0; i < 2; ++i) { int R, C; stage_rc(tid * 16 + i * 8192, R, C); const int Rb = Epi::PERM ? ((R & ~31) + perm32(R & 31)) : R;
        voffA[i] = (unsigned)(R * K + C) * 2u; voffB[i] = (unsigned)(Rb * K + C) * 2u; }
    static_assert(!GATHER || SP2, "row gather is wired into the SP2 loop only");
    unsigned vAc[2][2], vAn[2][2], vA2[2][2];
    int gR[2], gC[2];
#pragma unroll
    for (int i = 0; i < 2; ++i) { int R, C; stage_rc(tid * 16 + i * 8192, R, C); gR[i] = R; gC[i] = C; }
#define PG8_ROWOFF(dst, u) do { if constexpr (GATHER) { _Pragma("unroll") for (int h_ = 0; h_ < 2; ++h_) _Pragma("unroll") for (int i_ = 0; i_ < 2; ++i_) \
        dst[h_][i_] = ((unsigned)S.arow(u, h_ * HALF + gR[i_]) * (unsigned)K + (unsigned)gC[i_]) * 2u; } } while (0)
    const size_t kstep = (size_t)(BK * 2);
    const size_t hstep = (size_t)HALF * K * 2;
    const size_t tstep = 2 * hstep;
    const unsigned ldsw = (unsigned)wid * 1024u;
    const int aoff = lds_byte(wr * 64 + fr, fq * 8), boff = lds_byte(wc * 32 + fr, fq * 8);
#define PG8_SA(b, h) (((b) * 2 + (h)) * HTB)
#define PG8_SB(b, h) ((4 + (b) * 2 + (h)) * HTB)
#define PG8_STAGE(bufoff, gbase, voff) do { _Pragma("unroll") for (int _i = 0; _i < 2; ++_i) \
        __builtin_amdgcn_global_load_lds((const unsigned*)((const char*)(gbase) + (voff)[_i]), (PG8_LAS unsigned*)(lds + (bufoff) + ldsw + _i * 8192), 16, 0, 0); } while (0)
#define PG8_STAGE_A(bufoff, base, h, W) do { if constexpr (GATHER) { PG8_STAGE(bufoff, base, W[h]); } else { PG8_STAGE(bufoff, (base) + (h) * hstep, voffA); } } while (0)
#define PG8_LDA(dst, b, h) do { _Pragma("unroll") for (int m = 0; m < 4; ++m) _Pragma("unroll") for (int k = 0; k < 2; ++k) dst[m][k] = *(const PG8_LAS bf16x8*)(lds + PG8_SA(b, h) + aoff + m * 2048 + k * 1024); } while (0)
#define PG8_LDB(dst, b, h) do { _Pragma("unroll") for (int n = 0; n < 2; ++n) _Pragma("unroll") for (int k = 0; k < 2; ++k) dst[n][k] = *(const PG8_LAS bf16x8*)(lds + PG8_SB(b, h) + boff + n * 2048 + k * 1024); } while (0)
#define PG8_MMA(ai, bj, At, Bt) do { __builtin_amdgcn_s_setprio(1); _Pragma("unroll") for (int m = 0; m < 4; ++m) _Pragma("unroll") for (int n = 0; n < 2; ++n) _Pragma("unroll") for (int k = 0; k < 2; ++k) \
        acc[ai][bj][m][n] = __builtin_amdgcn_mfma_f32_16x16x32_bf16(Bt[n][k], At[m][k], acc[ai][bj][m][n], 0, 0, 0); __builtin_amdgcn_s_setprio(0); } while (0)
#define PG8_WAIT_V(n) asm volatile("s_waitcnt vmcnt(" #n ")" ::: "memory")
#define PG8_WAIT_L(n) asm volatile("s_waitcnt lgkmcnt(" #n ")" ::: "memory")
#define PG8_BAR __builtin_amdgcn_s_barrier()
#define PG8_SCHED __builtin_amdgcn_sched_barrier(0)
    Unit cur, nxt; int ui = 0;
    if (!S.next(0, cur)) return;
    f32x4 acc[2][2][4][2];
#pragma unroll
    for (int a = 0; a < 2; ++a)
#pragma unroll
        for (int b = 0; b < 2; ++b)
#pragma unroll
            for (int m = 0; m < 4; ++m)
#pragma unroll
                for (int n = 0; n < 2; ++n) acc[a][b][m][n] = (f32x4){0.f, 0.f, 0.f, 0.f};
    bf16x8 At[4][2], B0[2][2], B1[2][2];
    const char* cA = (const char*)g.A + (GATHER ? (size_t)0 : (size_t)cur.pm * tstep); PG8_ROWOFF(vAc, cur); const char* cB = (const char*)g.Bt + (size_t)cur.pn * tstep;
    S.a_ready(cur);
    if constexpr (SP2) {
        PG8_STAGE(PG8_SB(0, 0), cB, voffB); PG8_STAGE(PG8_SB(0, 1), cB + hstep, voffB); PG8_STAGE_A(PG8_SA(0, 0), cA, 0, vAc); PG8_STAGE_A(PG8_SA(0, 1), cA, 1, vAc);
        if (wr == 1) PG8_BAR;
        PG8_WAIT_V(2); PG8_BAR;
        PG8_STAGE(PG8_SB(1, 0), cB + kstep, voffB); PG8_STAGE_A(PG8_SA(1, 0), cA + kstep, 0, vAc); PG8_STAGE(PG8_SB(1, 1), cB + hstep + kstep, voffB);
        PG8_WAIT_V(6); PG8_BAR;
    } else {
        PG8_STAGE(PG8_SB(0, 0), cB, voffB); PG8_STAGE(PG8_SA(0, 0), cA, voffA); PG8_STAGE(PG8_SB(0, 1), cB + hstep, voffB); PG8_STAGE(PG8_SA(0, 1), cA + hstep, voffA);
        if (wr == 1) PG8_BAR;
        PG8_WAIT_V(4); PG8_BAR;
        PG8_STAGE(PG8_SB(1, 0), cB + kstep, voffB); PG8_STAGE(PG8_SA(1, 0), cA + kstep, voffA); PG8_STAGE(PG8_SB(1, 1), cB + hstep + kstep, voffB);
        PG8_WAIT_V(6); PG8_BAR;
    }
    for (;;) {
        const bool has_next = S.next(ui + 1, nxt);
        const char* nA = has_next ? (const char*)g.A + (GATHER ? (size_t)0 : (size_t)nxt.pm * tstep) : cA;
        if constexpr (GATHER) { if (has_next) { PG8_ROWOFF(vAn, nxt); } else { _Pragma("unroll") for (int h_ = 0; h_ < 2; ++h_) _Pragma("unroll") for (int i_ = 0; i_ < 2; ++i_) vAn[h_][i_] = vAc[h_][i_]; } } const char* nB = has_next ? (const char*)g.Bt + (size_t)nxt.pn * tstep : cB;
        for (int t = 0; t < nt; t += 2) {
            const bool last = (t == nt - 2);
            const char* a1 = cA + (size_t)(t + 1) * kstep;
            const char* a2 = last ? nA : cA + (size_t)(t + 2) * kstep; const char* b2 = last ? nB : cB + (size_t)(t + 2) * kstep;
            const char* a3 = a2 + kstep; const char* b3 = b2 + kstep;
            if constexpr (GATHER) { _Pragma("unroll") for (int h_ = 0; h_ < 2; ++h_) _Pragma("unroll") for (int i_ = 0; i_ < 2; ++i_) vA2[h_][i_] = last ? vAn[h_][i_] : vAc[h_][i_]; }
            if (last && has_next) S.a_ready(nxt);
            if constexpr (SP2) {
            PG8_LDB(B0, 0, 0); PG8_LDB(B1, 0, 1); PG8_SCHED; PG8_LDA(At, 0, 0); PG8_STAGE_A(PG8_SA(1, 1), a1, 1, vAc);
            PG8_WAIT_V(8); PG8_WAIT_L(0); PG8_BAR; PG8_MMA(0, 0, At, B0); PG8_MMA(0, 1, At, B1); PG8_BAR; PG8_SCHED;
            PG8_LDA(At, 0, 1); PG8_STAGE(PG8_SB(0, 0), b2, voffB); PG8_STAGE(PG8_SB(0, 1), b2 + hstep, voffB); PG8_STAGE_A(PG8_SA(0, 0), a2, 0, vA2);
            PG8_WAIT_V(8); PG8_WAIT_L(0); PG8_BAR; PG8_MMA(1, 0, At, B0); PG8_MMA(1, 1, At, B1); PG8_BAR; PG8_SCHED;
            PG8_LDB(B0, 1, 0); PG8_LDB(B1, 1, 1); PG8_SCHED; PG8_LDA(At, 1, 0); PG8_STAGE_A(PG8_SA(0, 1), a2, 1, vA2);
            PG8_WAIT_V(8); PG8_WAIT_L(0); PG8_BAR; PG8_MMA(0, 0, At, B0); PG8_MMA(0, 1, At, B1); PG8_BAR; PG8_SCHED;
            PG8_LDA(At, 1, 1); PG8_STAGE(PG8_SB(1, 0), b3, voffB); PG8_STAGE(PG8_SB(1, 1), b3 + hstep, voffB); PG8_STAGE_A(PG8_SA(1, 0), a3, 0, vA2);
            PG8_WAIT_V(8); PG8_WAIT_L(0); PG8_BAR; PG8_MMA(1, 0, At, B0); PG8_MMA(1, 1, At, B1); PG8_BAR; PG8_SCHED;
            } else {
            PG8_LDB(B0, 0, 0); PG8_SCHED; PG8_LDA(At, 0, 0); PG8_STAGE(PG8_SA(1, 1), a1 + hstep, voffA);
            PG8_WAIT_L(8); PG8_BAR; PG8_WAIT_L(0); PG8_MMA(0, 0, At, B0); PG8_BAR; PG8_SCHED;
            PG8_LDB(B1, 0, 1); PG8_STAGE(PG8_SB(0, 0), b2, voffB);
            PG8_BAR; PG8_WAIT_L(0); PG8_MMA(0, 1, At, B1); PG8_BAR;
            PG8_LDA(At, 0, 1); PG8_STAGE(PG8_SA(0, 0), a2, voffA);
            PG8_BAR; PG8_WAIT_L(0); PG8_MMA(1, 0, At, B0); PG8_BAR; PG8_SCHED;
            PG8_STAGE(PG8_SB(0, 1), b2 + hstep, voffB);
            PG8_WAIT_V(6); PG8_BAR; PG8_MMA(1, 1, At, B1); PG8_BAR;
            PG8_LDB(B0, 1, 0); PG8_SCHED; PG8_LDA(At, 1, 0); PG8_STAGE(PG8_SA(0, 1), a2 + hstep, voffA);
            PG8_WAIT_L(8); PG8_BAR; PG8_WAIT_L(0); PG8_MMA(0, 0, At, B0); PG8_BAR; PG8_SCHED;
            PG8_LDB(B1, 1, 1); PG8_STAGE(PG8_SB(1, 0), b3, voffB);
            PG8_BAR; PG8_WAIT_L(0); PG8_MMA(0, 1, At, B1); PG8_BAR;
            PG8_LDA(At, 1, 1); PG8_STAGE(PG8_SA(1, 0), a3, voffA);
            PG8_BAR; PG8_WAIT_L(0); PG8_MMA(1, 0, At, B0); PG8_BAR; PG8_SCHED;
            PG8_STAGE(PG8_SB(1, 1), b3 + hstep, voffB);
            PG8_WAIT_V(6); PG8_BAR; PG8_MMA(1, 1, At, B1); PG8_BAR;
            }
        }
        if constexpr (ALIGN_EPI) { if (wr == 0) PG8_BAR; }
        if constexpr (!Epi::AFTER_DRAIN) { E(acc, cur, wr, wc, fr, fq); S.done(cur); }
        if (!has_next) break;
#pragma unroll
        for (int a = 0; a < 2; ++a)
#pragma unroll
            for (int b = 0; b < 2; ++b)
#pragma unroll
                for (int m = 0; m < 4; ++m)
#pragma unroll
                    for (int n = 0; n < 2; ++n) acc[a][b][m][n] = (f32x4){0.f, 0.f, 0.f, 0.f};
        cur = nxt; cA = nA; cB = nB; ++ui;
        if constexpr (GATHER) { _Pragma("unroll") for (int h_ = 0; h_ < 2; ++h_) _Pragma("unroll") for (int i_ = 0; i_ < 2; ++i_) vAc[h_][i_] = vAn[h_][i_]; }
        if constexpr (ALIGN_EPI) { if (wr == 1) PG8_BAR; }
    }
    PG8_WAIT_V(0);
    if constexpr (!ALIGN_EPI) { if (wr == 0) PG8_BAR; }
    PG8_BAR;
    if constexpr (Epi::AFTER_DRAIN) { E.fused(acc, cur, wr, wc, fr, fq, lds, wid, lane); S.done(cur); }
#undef PG8_SA
#undef PG8_SB
#undef PG8_STAGE
#undef PG8_STAGE_A
#undef PG8_ROWOFF
#undef PG8_LDA
#undef PG8_LDB
#undef PG8_MMA
#undef PG8_WAIT_V
#undef PG8_WAIT_L
#undef PG8_BAR
#undef PG8_SCHED
}
}
#include <hip/hip_bf16.h>
#include <cmath>
namespace attn_body {
using bf16=__hip_bfloat16;
using bf16x8=__attribute__((ext_vector_type(8)))short;
using s16x4=__attribute__((ext_vector_type(4)))short;
using f32x16=__attribute__((ext_vector_type(16)))float;
using u32x4=__attribute__((ext_vector_type(4)))unsigned;
constexpr int BATCH=8,NHEAD=16,SEQ=2048,D=64,DM=NHEAD*D,KVP=256;
constexpr int NW=8,QBLK=32,QB=QBLK*NW,KVBLK=64,NQB=SEQ/QB;
constexpr int ATTN_PITCH=DM, ATTN_UNIT_ROWS=QB;
__device__ __forceinline__ int crow(int r,int hi){return (r&3)+8*(r>>2)+4*hi;}
#define SBAR() __builtin_amdgcn_sched_barrier(0)
__device__ __forceinline__ void cmask(f32x16&p0,f32x16&p1,int jb,int qrel,int hi){
  const float NEG=-INFINITY; int kb=64*jb+4*hi;
  #pragma unroll
  for(int r=0;r<16;++r){int kv=kb+(r&3)+8*(r>>2); if(kv>qrel)p0[r]=NEG; if(kv+32>qrel)p1[r]=NEG;}
}

constexpr int NSLOT=3, SLOTB=8192;
constexpr int LDS_K=0, LDS_V=NSLOT*SLOTB, LDS_WS=2*NSLOT*SLOTB, LDS_OST=LDS_WS+NW*64*4, LDS_BYTES=LDS_OST+NW*4096;
constexpr float C2=0.125f*1.4426950408889634f;
__device__ __forceinline__ void glds16(const void*gsrc,unsigned lds_dst){unsigned keep;
  asm volatile("s_mov_b32 %0, m0\n\ts_mov_b32 m0, %2\n\ts_nop 0\n\tglobal_load_lds_dwordx4 %1, off\n\ts_mov_b32 m0, %0":"=&s"(keep):"v"(gsrc),"s"(lds_dst):"memory");}
__device__ __forceinline__ float max3f(float a,float b,float c){float r;asm("v_max3_f32 %0, %1, %2, %3":"=v"(r):"v"(a),"v"(b),"v"(c));return r;}
__device__ __forceinline__ float max2f(float a,float b){float r;asm("v_max_f32_e32 %0, %1, %2":"=v"(r):"v"(a),"v"(b));return r;}
__device__ __forceinline__ float fadd_s(float a,float b){float r;asm("v_add_f32_e32 %0, %1, %2":"=v"(r):"v"(a),"v"(b));return r;}
__device__ __forceinline__ float fsub_s(float a,float b){float r;asm("v_sub_f32_e32 %0, %1, %2":"=v"(r):"v"(a),"v"(b));return r;}
typedef float f32x2_t __attribute__((ext_vector_type(2))); typedef __bf16 bf16x2_t __attribute__((ext_vector_type(2)));
__device__ __forceinline__ unsigned cvtpk_s(float lo,float hi){f32x2_t v={lo,hi};bf16x2_t b=__builtin_convertvector(v,bf16x2_t);return __builtin_bit_cast(unsigned,b);}
#define WAIT_BAR(N) asm volatile("s_waitcnt vmcnt(" #N ") lgkmcnt(0)\n\ts_barrier":::"memory")

__device__ __forceinline__ void qkt(f32x16&p0,f32x16&p1,const char*Kslot,const bf16x8*qr,const f32x16&negm,int r32,int hi){
  const char*kb=Kslot+hi*1024+r32*16;
  #pragma unroll
  for(int d0=0;d0<4;++d0){
    const bf16x8 b0=*reinterpret_cast<const bf16x8*>(kb+d0*2048);
    const bf16x8 b1=*reinterpret_cast<const bf16x8*>(kb+d0*2048+512);
    if(d0==0){p0=__builtin_amdgcn_mfma_f32_32x32x16_bf16(b0,qr[0],negm,0,0,0);p1=__builtin_amdgcn_mfma_f32_32x32x16_bf16(b1,qr[0],negm,0,0,0);}
    else{p0=__builtin_amdgcn_mfma_f32_32x32x16_bf16(b0,qr[d0],p0,0,0,0);p1=__builtin_amdgcn_mfma_f32_32x32x16_bf16(b1,qr[d0],p1,0,0,0);}}
}
typedef __attribute__((address_space(3))) const char* lds_cptr;
typedef short v4i16_t __attribute__((ext_vector_type(4)));
__device__ __forceinline__ void kload8(bf16x8*kf,lds_cptr kp){
  kf[0]=*(const __attribute__((address_space(3))) bf16x8*)(kp);      kf[1]=*(const __attribute__((address_space(3))) bf16x8*)(kp+512);
  kf[2]=*(const __attribute__((address_space(3))) bf16x8*)(kp+2048); kf[3]=*(const __attribute__((address_space(3))) bf16x8*)(kp+2560);
  kf[4]=*(const __attribute__((address_space(3))) bf16x8*)(kp+4096); kf[5]=*(const __attribute__((address_space(3))) bf16x8*)(kp+4608);
  kf[6]=*(const __attribute__((address_space(3))) bf16x8*)(kp+6144); kf[7]=*(const __attribute__((address_space(3))) bf16x8*)(kp+6656);
}
__device__ __forceinline__ void kload2(bf16x8*kf,lds_cptr kp,int j){ kf[2*j]=*(const __attribute__((address_space(3))) bf16x8*)(kp+j*2048); kf[2*j+1]=*(const __attribute__((address_space(3))) bf16x8*)(kp+j*2048+512); }
__device__ __forceinline__ s16x4 vtr(lds_cptr p){ return __builtin_bit_cast(s16x4,__builtin_amdgcn_ds_read_tr16_b64_v4i16((__attribute__((address_space(3))) v4i16_t*)p)); }
__device__ __forceinline__ float rowmax(const f32x16&p0,const f32x16&p1){
  float a=max3f(p0[0],p0[1],p1[0]),b=max3f(p0[2],p0[3],p1[1]);a=max3f(a,p1[2],p1[3]);
  #pragma unroll
  for(int r=4;r<16;r+=4){a=max3f(a,p0[r],p0[r+1]);b=max3f(b,p0[r+2],p0[r+3]);a=max3f(a,p1[r],p1[r+1]);b=max3f(b,p1[r+2],p1[r+3]);}
  const float m=max2f(a,b);
  auto rr=__builtin_amdgcn_permlane32_swap(__float_as_uint(m),__float_as_uint(m),false,false);
  return max2f(__uint_as_float(rr[0]),__uint_as_float(rr[1]));
}
__device__ __forceinline__ void pv(f32x16*o,int vb,bf16x8 pa0,bf16x8 pa1,bf16x8 pa2,bf16x8 pa3){
  #pragma unroll
  for(int d0=0;d0<2;++d0){s16x4 lo[4],hi[4];
    #pragma unroll
    for(int ks=0;ks<4;++ks){
      asm volatile("ds_read_b64_tr_b16 %0,%1 offset:%c2":"=&v"(lo[ks]):"v"(vb),"i"(d0*4096+ks*1024):"memory");
      asm volatile("ds_read_b64_tr_b16 %0,%1 offset:%c2":"=&v"(hi[ks]):"v"(vb),"i"(d0*4096+ks*1024+512):"memory");}
    asm volatile("s_waitcnt lgkmcnt(0)":::"memory");SBAR();
    #define PK(k) (bf16x8){lo[k][0],lo[k][1],lo[k][2],lo[k][3],hi[k][0],hi[k][1],hi[k][2],hi[k][3]}
    o[d0]=__builtin_amdgcn_mfma_f32_32x32x16_bf16(pa0,PK(0),o[d0],0,0,0);
    o[d0]=__builtin_amdgcn_mfma_f32_32x32x16_bf16(pa1,PK(1),o[d0],0,0,0);
    o[d0]=__builtin_amdgcn_mfma_f32_32x32x16_bf16(pa2,PK(2),o[d0],0,0,0);
    o[d0]=__builtin_amdgcn_mfma_f32_32x32x16_bf16(pa3,PK(3),o[d0],0,0,0);
    #undef PK
  }
}

#ifndef ATTN_STORE16
#define ATTN_STORE16(p,v) (*(u32x4*)(p)=(v))
#endif
template<int THRL> __device__ __forceinline__ void attn_unit(int b,int h,int qb,const bf16*Q,const bf16*__restrict__ K,const bf16*__restrict__ V,bf16*O,char*shm){
  int tid_=threadIdx.x; asm volatile("":"+v"(tid_)); const int tid=tid_,lane=tid&63,r32=lane&31,hi=lane>>5; const int wid=__builtin_amdgcn_readfirstlane(tid>>6);
  const long rowbase=(long)b*SEQ; const int q0=qb*QB;
  const bf16*Qw=Q+(rowbase+q0+wid*QBLK)*DM+h*D;
  const bf16*Kh=K+rowbase*KVP+(h>>2)*D,*Vh=V+rowbase*KVP+(h>>2)*D;
  const unsigned lds0=(unsigned)(uintptr_t)shm;
  float*wsf=(float*)(shm+LDS_WS)+wid*64;
  const bf16*ksrc=Kh+(long)lane*KVP+wid*8;
  const bf16*vsrc=Vh+(long)(16*(wid&3)+(lane>>2))*KVP+(wid>>2)*32+(lane&3)*8;
  const unsigned kdst=lds0+LDS_K+wid*1024, vdst=lds0+LDS_V+wid*1024;
  #define DMA_K(t,slot) glds16(ksrc+(long)(t)*KVBLK*KVP,(unsigned)__builtin_amdgcn_readfirstlane(kdst+(slot)))
  #define DMA_V(t,slot) glds16(vsrc+(long)(t)*KVBLK*KVP,(unsigned)__builtin_amdgcn_readfirstlane(vdst+(slot)))
  const int vb0=(int)(lds0+LDS_V)+((lane>>4)&1)*32+(lane&3)*8+(4*hi+((lane&15)>>2))*64;
  const char*Kbase=shm+LDS_K; bf16x8 kf[8];
  const lds_cptr shm3=(lds_cptr)shm; const lds_cptr kp0=shm3+LDS_K+hi*1024+r32*16; const lds_cptr vp0=shm3+LDS_V+((lane>>4)&1)*32+(lane&3)*8+(4*hi+((lane&15)>>2))*64;
  const int NT=SEQ/KVBLK;
  DMA_K(0,0);DMA_V(0,0);DMA_K(1,SLOTB);
  bf16x8 qr[4];
  #pragma unroll
  for(int d0=0;d0<4;++d0)qr[d0]=*reinterpret_cast<const bf16x8*>(&Qw[(long)r32*DM+d0*16+hi*8]);
  float mhat=0.f,l_reg=0.f;f32x16 o[2];o[0]=f32x16{};o[1]=f32x16{};f32x16 negm=f32x16{};asm volatile("":"+v"(negm));
  const int qrel=wid*QBLK+r32;
  #define CMASK(P0,P1,t) do{}while(0)
  bool resc=false;
  #define START(P0,P1) do{ const float rm=rowmax(P0,P1); resc=false; \
    { const float dl=rm; mhat=fadd_s(mhat,dl); \
      _Pragma("unroll") for(int r=0;r<16;++r){P0[r]=fsub_s(P0[r],dl);P1[r]=fsub_s(P1[r],dl);} \
      _Pragma("unroll") for(int r=0;r<16;++r)negm[r]=-mhat; asm volatile("":"+v"(negm)); } \
    _Pragma("unroll") for(int r=0;r<16;++r)P0[r]=__builtin_amdgcn_exp2f(P0[r]); }while(0)
  #define RESC() do{ if(resc){ asm volatile("s_waitcnt lgkmcnt(0)":::"memory"); \
      _Pragma("unroll") for(int d_=0;d_<2;++d_) _Pragma("unroll") for(int r=0;r<16;++r)o[d_][r]*=wsf[crow(r,hi)]; } }while(0)
  f32x16 pA0,pA1,pB0,pB1;
  int sl_prev=0,sl_cur=0,sl_next=SLOTB;
  #define ROT() do{sl_prev=sl_cur;sl_cur=sl_next;sl_next=(sl_next==(NSLOT-1)*SLOTB)?0:sl_next+SLOTB;}while(0)
  DMA_K(2,2*SLOTB);
  WAIT_BAR(3);
  qkt(pA0,pA1,Kbase,qr,negm,r32,hi);asm volatile("s_nop 15\n\ts_nop 7":"+v"(pA0),"+v"(pA1));CMASK(pA0,pA1,0);
  START(pA0,pA1);
  _Pragma("unroll") for(int r=0;r<16;++r)pA1[r]=__builtin_amdgcn_exp2f(pA1[r]);
  WAIT_BAR(0);
  DMA_K(3,0);DMA_V(1,SLOTB);
  ROT();
  kload8(kf,kp0+sl_cur);
  WAIT_BAR(2);
  s16x4 vlo[8],vhi[8]; u32x4 pw0,pw1,pw2,pw3;
  #define PKW(P,B) cvtpk_s(P[B],P[B+1])
  #define PAF(k) __builtin_bit_cast(bf16x8,pw##k)
  #define VFR(i) (bf16x8){vlo[i][0],vlo[i][1],vlo[i][2],vlo[i][3],vhi[i][0],vhi[i][1],vhi[i][2],vhi[i][3]}
  #define PIN(x) asm volatile("":"+v"(x))
  #define MX3(a,b,c) __builtin_fmaxf(__builtin_fmaxf((a),(b)),(c))
  #define GAPA(MF,A0,A1,A2,A3,W0,W1,PW) do{ MF; sacc+=A0; sacc+=A1; sacc+=A2; sacc+=A3; PIN(sacc); W0; W1; PIN(PW); SBAR(); }while(0)
  #define EX(v) __builtin_amdgcn_exp2f(v)
  #define GAPB(MF,X,B) do{ MF; X[B]=EX(X[B]); X[B+1]=EX(X[B+1]); X[B+2]=EX(X[B+2]); X[B+3]=EX(X[B+3]); PIN(X); SBAR(); }while(0)
  #define VRD(i) do{ vlo[i]=vtr(vp_+(((i)>>2)*4096+((i)&3)*1024)); vhi[i]=vtr(vp_+(((i)>>2)*4096+((i)&3)*1024+512)); }while(0)
  #define KRD(G,j) do{ if(G){ kload2(kf,kp0+sl_next,j); SBAR(); } }while(0)
  #define STEP(C0,C1,P0,P1,t,GK,GV,GL) do{ SBAR(); \
    const lds_cptr vp_=vp0+sl_prev; \
    VRD(0); SBAR(); float sacc=(P0[0]+P0[1]); \
    GAPA(C0=__builtin_amdgcn_mfma_f32_32x32x16_bf16(kf[0],qr[0],negm,0,0,0), P0[2],P0[3],P0[4],P0[5],     pw0[0]=PKW(P0,0), pw0[1]=PKW(P0,2), pw0); \
    VRD(4); SBAR(); GAPA(C1=__builtin_amdgcn_mfma_f32_32x32x16_bf16(kf[1],qr[0],negm,0,0,0), P0[6],P0[7],P0[8],P0[9],     pw0[2]=PKW(P0,4), pw0[3]=PKW(P0,6), pw0); \
    VRD(1); SBAR(); GAPA(C0=__builtin_amdgcn_mfma_f32_32x32x16_bf16(kf[2],qr[1],C0,0,0,0),   P0[10],P0[11],P0[12],P0[13], pw1[0]=PKW(P0,8), pw1[1]=PKW(P0,10), pw1); \
    VRD(5); SBAR(); GAPA(C1=__builtin_amdgcn_mfma_f32_32x32x16_bf16(kf[3],qr[1],C1,0,0,0),   P0[14],P0[15],P1[0],P1[1],   pw1[2]=PKW(P0,12),pw1[3]=PKW(P0,14), pw1); \
    VRD(2); SBAR(); GAPA(C0=__builtin_amdgcn_mfma_f32_32x32x16_bf16(kf[4],qr[2],C0,0,0,0),   P1[2],P1[3],P1[4],P1[5],     pw2[0]=PKW(P1,0), pw2[1]=PKW(P1,2), pw2); \
    VRD(6); SBAR(); GAPA(C1=__builtin_amdgcn_mfma_f32_32x32x16_bf16(kf[5],qr[2],C1,0,0,0),   P1[6],P1[7],P1[8],P1[9],     pw2[2]=PKW(P1,4), pw2[3]=PKW(P1,6), pw2); \
    VRD(3); SBAR(); GAPA(C0=__builtin_amdgcn_mfma_f32_32x32x16_bf16(kf[6],qr[3],C0,0,0,0),   P1[10],P1[11],P1[12],P1[13], pw3[0]=PKW(P1,8), pw3[1]=PKW(P1,10), pw3); \
    VRD(7); SBAR(); GAPA(C1=__builtin_amdgcn_mfma_f32_32x32x16_bf16(kf[7],qr[3],C1,0,0,0),   P1[14],P1[15],0.f,0.f,       pw3[2]=PKW(P1,12),pw3[3]=PKW(P1,14), pw3); \
    l_reg+=sacc; \
    if(GK){DMA_K((t)+3,sl_cur);} if(GV){DMA_V((t)+1,sl_next);} \
    CMASK(C0,C1,t); \
    { float a=MX3(C0[0],C0[1],C1[0]),b=MX3(C0[2],C0[3],C1[1]); a=MX3(a,C1[2],C1[3]); \
      _Pragma("unroll") for(int r=4;r<16;r+=4){a=MX3(a,C0[r],C0[r+1]);b=MX3(b,C0[r+2],C0[r+3]);a=MX3(a,C1[r],C1[r+1]);b=MX3(b,C1[r+2],C1[r+3]);} \
      float rm=__builtin_fmaxf(a,b); { auto rr=__builtin_amdgcn_permlane32_swap(__float_as_uint(rm),__float_as_uint(rm),false,false); rm=__builtin_fmaxf(__uint_as_float(rr[0]),__uint_as_float(rr[1])); } \
      resc=false; \
      if(__builtin_expect(__any(rm>(float)THRL),0)){ const float dl=__builtin_fmaxf(rm,0.f); mhat+=dl; \
        _Pragma("unroll") for(int r=0;r<16;++r){C0[r]-=dl;C1[r]-=dl;} \
        _Pragma("unroll") for(int r=0;r<16;++r)negm[r]=-mhat; asm volatile("":"+v"(negm)); \
        const float f=__builtin_amdgcn_exp2f(-dl); l_reg*=f; if(hi==0)wsf[r32]=f; resc=true; } } \
    SBAR(); \
    GAPB(o[0]=__builtin_amdgcn_mfma_f32_32x32x16_bf16(PAF(0),VFR(0),o[0],0,0,0), C0,0); \
    GAPB(o[1]=__builtin_amdgcn_mfma_f32_32x32x16_bf16(PAF(0),VFR(4),o[1],0,0,0), C0,4); \
    KRD(GL,0); GAPB(o[0]=__builtin_amdgcn_mfma_f32_32x32x16_bf16(PAF(1),VFR(1),o[0],0,0,0), C0,8); \
    KRD(GL,1); GAPB(o[1]=__builtin_amdgcn_mfma_f32_32x32x16_bf16(PAF(1),VFR(5),o[1],0,0,0), C0,12); \
    KRD(GL,2); GAPB(o[0]=__builtin_amdgcn_mfma_f32_32x32x16_bf16(PAF(2),VFR(2),o[0],0,0,0), C1,0); \
    KRD(GL,3); GAPB(o[1]=__builtin_amdgcn_mfma_f32_32x32x16_bf16(PAF(2),VFR(6),o[1],0,0,0), C1,4); \
    GAPB(o[0]=__builtin_amdgcn_mfma_f32_32x32x16_bf16(PAF(3),VFR(3),o[0],0,0,0), C1,8); \
    GAPB(o[1]=__builtin_amdgcn_mfma_f32_32x32x16_bf16(PAF(3),VFR(7),o[1],0,0,0), C1,12); \
    }while(0)
  int t=1;
  #undef CMASK
  #define CMASK(P0,P1,t) do{}while(0)
  for(;t+5<NT;t+=2){
    STEP(pB0,pB1,pA0,pA1,t,true,true,true);     WAIT_BAR(2); RESC(); ROT();
    STEP(pA0,pA1,pB0,pB1,t+1,true,true,true);   WAIT_BAR(2); RESC(); ROT();
  }
  #undef CMASK
  #define CMASK(P0,P1,t) do{}while(0)
  #define ENDW(tt) do{ if((tt)+3<NT){WAIT_BAR(2);} else if((tt)+2<NT){WAIT_BAR(1);} else {WAIT_BAR(0);} }while(0)
  for(;t+1<NT;t+=2){
    STEP(pB0,pB1,pA0,pA1,t,(t+3<NT),(t+1<NT),(t+1<NT));       ENDW(t);   RESC(); ROT();
    STEP(pA0,pA1,pB0,pB1,t+1,(t+4<NT),(t+2<NT),(t+2<NT));     ENDW(t+1); RESC(); ROT();
  }
  STEP(pB0,pB1,pA0,pA1,NT-1,false,false,false); RESC();
  { float sacc=pB0[0]+pB0[1]; _Pragma("unroll") for(int r=2;r<16;++r)sacc+=pB0[r]; _Pragma("unroll") for(int r=0;r<16;++r)sacc+=pB1[r]; l_reg+=sacc;
    pw0=(u32x4){PKW(pB0,0),PKW(pB0,2),PKW(pB0,4),PKW(pB0,6)};pw1=(u32x4){PKW(pB0,8),PKW(pB0,10),PKW(pB0,12),PKW(pB0,14)};pw2=(u32x4){PKW(pB1,0),PKW(pB1,2),PKW(pB1,4),PKW(pB1,6)};pw3=(u32x4){PKW(pB1,8),PKW(pB1,10),PKW(pB1,12),PKW(pB1,14)};
    SBAR(); pv(o,vb0+sl_cur,PAF(0),PAF(1),PAF(2),PAF(3)); }
  #undef PKW
  #undef PAF
  #undef VFR
  #undef PIN
  #undef MX3
  #undef GAPA
  #undef GAPB
  #undef EX
  #undef VRD
  #undef KRD
  #undef STEP
  #undef ENDW
  {auto rr=__builtin_amdgcn_permlane32_swap(__float_as_uint(l_reg),__float_as_uint(l_reg),false,false);l_reg=__uint_as_float(rr[0])+__uint_as_float(rr[1]);}
  if(hi==0)wsf[32+r32]=l_reg;asm volatile("s_waitcnt lgkmcnt(0)":::"memory");
  float rli[16];
  #pragma unroll
  for(int r=0;r<16;++r)rli[r]=__builtin_amdgcn_rcpf(wsf[32+crow(r,hi)]);
  bf16*Ow=O+(rowbase+q0+wid*QBLK)*DM+h*D;
  { bf16*stg=(bf16*)(shm+LDS_OST)+wid*2048;
    #pragma unroll
    for(int r=0;r<16;++r){const int orow=crow(r,hi);
      #pragma unroll
      for(int d0=0;d0<2;++d0)stg[orow*64+d0*32+r32]=__float2bfloat16(o[d0][r]*rli[r]);}
    asm volatile("s_waitcnt lgkmcnt(0)":::"memory");
    #pragma unroll
    for(int i=0;i<4;++i){const int row=i*8+(lane>>3),ch=lane&7; const u32x4 v=*(const u32x4*)(stg+row*64+ch*8); ATTN_STORE16(Ow+(long)row*DM+ch*8,v);} }
  asm volatile("s_waitcnt lgkmcnt(0)\n\ts_barrier":::"memory");
  #undef DMA_K
  #undef DMA_V
  #undef CMASK
  #undef START
  #undef RESC
  #undef ROT
}
constexpr int ATTN_LDS_BYTES=LDS_BYTES;
struct AttnTensors { const bf16* Q; const bf16* K; const bf16* V; bf16* O; };
struct AttnUnit { int bh; int qb; };
struct StaticOrder {
  int vcu,G;
  __device__ __forceinline__ explicit StaticOrder(int grid,int block):vcu((grid%8==0)?(block%8)*(grid/8)+block/8:block),G(grid){}
  __device__ __forceinline__ bool next(int i,AttnUnit&u)const{ const int L=i*G+vcu; if(L>=1024)return false; const int xg=L>>5,w=L&31; const int grp=(xg&7)*4+(xg>>3); u.bh=(grp>>2)*NHEAD+(grp&3)*4+(w>>3); u.qb=w&7; return true; }
  __device__ __forceinline__ void a_ready(const AttnUnit&)const{}
  __device__ __forceinline__ void done(const AttnUnit&)const{}
};
template<class Sched,int THRL=8> __device__ __forceinline__ void attn_phase(char*lds,const AttnTensors&T,const Sched&S){
  AttnUnit u;
  for(int i=0;S.next(i,u);++i){ S.a_ready(u); attn_unit<THRL>(u.bh/NHEAD,u.bh%NHEAD,u.qb,T.Q,T.K,T.V,T.O,lds); S.done(u); }
}
#undef SBAR
#undef WAIT_BAR
}
namespace na_body {
typedef short bf16x8 __attribute__((ext_vector_type(8)));
typedef short s16x4 __attribute__((ext_vector_type(4)));
typedef float f32x4 __attribute__((ext_vector_type(4)));
typedef unsigned u32x4 __attribute__((ext_vector_type(4)));
typedef unsigned u32x2 __attribute__((ext_vector_type(2)));
#define NA_LAS __attribute__((address_space(3)))
constexpr int VROW = 160, LDS_V = 0, LDS_BIAS = 9 * 64 * VROW, NA_LDS_BYTES = LDS_BIAS + 15 * 64 * 4;
__device__ __forceinline__ unsigned cvtpk(float lo, float hi) { typedef float f2 __attribute__((ext_vector_type(2))); typedef __bf16 b2 __attribute__((ext_vector_type(2))); f2 v = {lo, hi}; b2 b = __builtin_convertvector(v, b2); return __builtin_bit_cast(unsigned, b); }
__device__ __forceinline__ s16x4 vtr(const NA_LAS char* p) { typedef short v4i16_t __attribute__((ext_vector_type(4))); return __builtin_bit_cast(s16x4, __builtin_amdgcn_ds_read_tr16_b64_v4i16((NA_LAS v4i16_t*)p)); }

__device__ __forceinline__ void na_phase(NA_LAS char* lds, const unsigned short* Qg, const unsigned short* Kg, const unsigned short* Vg, unsigned short* Og, const float* __restrict__ rpb, int G, int bid) {
    int tid_ = threadIdx.x; asm volatile("" : "+v"(tid_));
    const int tid = tid_, lane = tid & 63, wave = __builtin_amdgcn_readfirstlane(tid >> 6), fr = lane & 15, fq = lane >> 4;
    const int vcu = (G % 8 == 0) ? (bid % 8) * (G / 8) + bid / 8 : bid;
    constexpr int NUNITS = 8 * 16 * 16;
    const int per = (NUNITS + G - 1) / G, u_lo = vcu * per, u_hi = (u_lo + per < NUNITS) ? u_lo + per : NUNITS;
    if (u_lo >= u_hi) return;
    u32x4 vr[9];
#define NA_PREFETCH(U) do { const int b_ = (U) >> 8, h_ = ((U) >> 4) & 15, r0_ = 2 * ((U) & 15); const int R0_ = min(max(r0_ - 4, 0), 24); const int ntok_ = min(9, 32 - R0_) * 64; \
        const unsigned short* src_ = Vg + ((size_t)(b_ * 2048 + R0_ * 64)) * 1024 + h_ * 64; \
        _Pragma("unroll") for (int i_ = 0; i_ < 9; ++i_) { const int idx_ = tid + 512 * i_; if ((idx_ >> 3) < ntok_) vr[i_] = *(const u32x4*)(src_ + (size_t)(idx_ >> 3) * 1024 + (idx_ & 7) * 8); } } while (0)
    NA_PREFETCH(u_lo);
    for (int U = u_lo; U < u_hi; ++U) {
        const int b = U >> 8, h = (U >> 4) & 15, r0 = 2 * (U & 15); const int R0 = min(max(r0 - 4, 0), 24);
        if (U != u_lo) __syncthreads();
#pragma unroll
        for (int i = 0; i < 9; ++i) { const int idx = tid + 512 * i; *(NA_LAS u32x4*)(lds + LDS_V + (idx >> 3) * VROW + (idx & 7) * 16) = vr[i]; }
        for (int i = tid; i < 15 * 64; i += 512) { const int dr = i >> 6, dc = (i & 63) - 16; ((NA_LAS float*)(lds + LDS_BIAS))[i] = (dc >= 0 && dc < 31) ? rpb[(h * 15 + dr) * 31 + dc] * 1.4426950408889634f : 0.f; }
        __syncthreads();
        if (U + 1 < u_hi) NA_PREFETCH(U + 1);
        const int r = r0 + (wave >> 2), q0 = 16 * (wave & 3), qcol = q0 + fr;
        const int rs = min(max(r - 4, 0), 24), b0 = min(max(q0 - 8, 0), 32), winlo = min(max(qcol - 8, 0), 48);
        const size_t tokq = (size_t)b * 2048 + r * 64 + qcol;
        bf16x8 qf[2];
#pragma unroll
        for (int ks = 0; ks < 2; ++ks) qf[ks] = *(const bf16x8*)(Qg + tokq * 1024 + h * 64 + 32 * ks + 8 * fq);
        f32x4 am[2];
#pragma unroll
        for (int t = 0; t < 2; ++t)
#pragma unroll
            for (int i = 0; i < 4; ++i) am[t][i] = ((unsigned)(b0 + 16 * t + 4 * fq + i - winlo) < 16u) ? 0.f : -INFINITY;
        const unsigned short* kbase = Kg + ((size_t)b * 2048 + b0 + fr) * 1024 + h * 64 + 8 * fq;
        const NA_LAS char* bias_l = lds + LDS_BIAS + (b0 - qcol + 15 + 16 + 4 * fq) * 4;
        const NA_LAS char* v_l = lds + LDS_V + (b0 + 4 * fq + (fr >> 2)) * VROW + (fr & 3) * 8;
        float m = -INFINITY, lsum = 0.f; f32x4 oacc[4];
#pragma unroll
        for (int dt = 0; dt < 4; ++dt) oacc[dt] = (f32x4){0.f, 0.f, 0.f, 0.f};
        bf16x8 kf[2][2], kn[2][2];
#pragma unroll
        for (int t = 0; t < 2; ++t)
#pragma unroll
            for (int ks = 0; ks < 2; ++ks) kf[t][ks] = *(const bf16x8*)(kbase + (size_t)rs * 65536 + t * 16384 + ks * 32);
#pragma unroll
        for (int kr = 0; kr < 8; ++kr) {
            const int krow = rs + kr;
            if (kr < 7) {
#pragma unroll
                for (int t = 0; t < 2; ++t)
#pragma unroll
                    for (int ks = 0; ks < 2; ++ks) kn[t][ks] = *(const bf16x8*)(kbase + (size_t)(krow + 1) * 65536 + t * 16384 + ks * 32);
            }
            f32x4 s[2];
#pragma unroll
            for (int t = 0; t < 2; ++t) { s[t] = __builtin_amdgcn_mfma_f32_16x16x32_bf16(kf[t][0], qf[0], am[t], 0, 0, 0); s[t] = __builtin_amdgcn_mfma_f32_16x16x32_bf16(kf[t][1], qf[1], s[t], 0, 0, 0); }
            const NA_LAS float* bl = (const NA_LAS float*)(bias_l + (krow - r + 7) * 256);
#pragma unroll
            for (int t = 0; t < 2; ++t)
#pragma unroll
                for (int i = 0; i < 4; ++i) s[t][i] += bl[16 * t + i];
            float mx = fmaxf(fmaxf(fmaxf(s[0][0], s[0][1]), fmaxf(s[0][2], s[0][3])), fmaxf(fmaxf(s[1][0], s[1][1]), fmaxf(s[1][2], s[1][3])));
            mx = fmaxf(mx, __shfl_xor(mx, 16)); mx = fmaxf(mx, __shfl_xor(mx, 32));
            const float mn = fmaxf(m, mx), al = __builtin_amdgcn_exp2f(m - mn); m = mn;
            float ps = 0.f;
#pragma unroll
            for (int t = 0; t < 2; ++t)
#pragma unroll
                for (int i = 0; i < 4; ++i) { s[t][i] = __builtin_amdgcn_exp2f(s[t][i] - mn); ps += s[t][i]; }
            lsum = lsum * al + ps;
            u32x4 pw; pw.x = cvtpk(s[0][0], s[0][1]); pw.y = cvtpk(s[0][2], s[0][3]); pw.z = cvtpk(s[1][0], s[1][1]); pw.w = cvtpk(s[1][2], s[1][3]);
            const bf16x8 pb = __builtin_bit_cast(bf16x8, pw);
            const NA_LAS char* vp = v_l + (krow - R0) * 64 * VROW;
#pragma unroll
            for (int dt = 0; dt < 4; ++dt) {
                const s16x4 lo = vtr(vp + dt * 32), hi = vtr(vp + 16 * VROW + dt * 32);
                const bf16x8 vf = {lo[0], lo[1], lo[2], lo[3], hi[0], hi[1], hi[2], hi[3]};
                oacc[dt] = oacc[dt] * al;
                oacc[dt] = __builtin_amdgcn_mfma_f32_16x16x32_bf16(vf, pb, oacc[dt], 0, 0, 0);
            }
#pragma unroll
            for (int t = 0; t < 2; ++t)
#pragma unroll
                for (int ks = 0; ks < 2; ++ks) kf[t][ks] = kn[t][ks];
        }
        lsum += __shfl_xor(lsum, 16); lsum += __shfl_xor(lsum, 32);
        const float rl = 1.f / lsum;
        unsigned short* op = Og + tokq * 1024 + h * 64 + 4 * fq;
#pragma unroll
        for (int dt = 0; dt < 4; ++dt) { u32x2 w; w.x = cvtpk(oacc[dt][0] * rl, oacc[dt][1] * rl); w.y = cvtpk(oacc[dt][2] * rl, oacc[dt][3] * rl); *(u32x2*)(op + 16 * dt) = w; }
    }
#undef NA_PREFETCH
}
}
constexpr int NWAVES = 8, NTHREADS = 512;
constexpr int D = 1024, NB = 8, S = 2048, M = NB * S, DEPTH = 4, NH = 16, HD = 64, GW = 64, ROWS = 32;
constexpr int KVD = 256, NE = 32, NG = 4, EPG = 8, DE = 512, NQKV_NA = 3072, NQKV_GQ = 1536, NRT = 36;
constexpr float ALPHA = 1.6817928305074290f, LN_EPS = 1e-5f;
constexpr float LOG2E = 1.4426950408889634f, C2 = 0.125f * 1.4426950408889634f;
constexpr int MAXTILES = 160;

constexpr size_t MiB = 1u << 20;
constexpr size_t WS_CTL = 0, CTL_ZERO_BYTES = 1 * MiB;
constexpr size_t WS_MOD = 1 * MiB, WS_ROPE = 2 * MiB, WS_WRT = 3 * MiB;
constexpr size_t WS_WQKV_NA = 4 * MiB, WS_WO_NA = 16 * MiB, WS_WQKV_GQ = 20 * MiB, WS_WO_GQ = 26 * MiB;
constexpr size_t WS_WGU = 32 * MiB, WS_WDN = 96 * MiB;
constexpr size_t WS_X1 = 128 * MiB, WS_X2 = 192 * MiB, WS_H = 256 * MiB, WS_Q = 288 * MiB, WS_K = 320 * MiB, WS_V = 352 * MiB, WS_Y = 384 * MiB;
constexpr size_t WS_XS = 416 * MiB, WS_HMID = 496 * MiB, WS_YS = 536 * MiB, WS_ROUTE = 616 * MiB, WS_TOKMAP = 618 * MiB, WS_END = 622 * MiB;
constexpr int CW_TS = 60000;
constexpr int CW_BAR = 16384;
constexpr int CW_CNT = 32768, CNT_LAYER_STRIDE = 2048;

constexpr int RING_BYTES = 131072, MISC_OFF = RING_BYTES, LDS_BYTES = 147456;

#define LAS __attribute__((address_space(3)))
typedef unsigned short bf16;
typedef unsigned v4u __attribute__((ext_vector_type(4)));
typedef unsigned v2u __attribute__((ext_vector_type(2)));
typedef float f32x4 __attribute__((ext_vector_type(4)));
#define RLX_AGENT __ATOMIC_RELAXED, __HIP_MEMORY_SCOPE_AGENT
__device__ __forceinline__ unsigned f2bf(float f) { unsigned u = __builtin_bit_cast(unsigned, f); return (u + 0x7fffu + ((u >> 16) & 1u)) >> 16; }
__device__ __forceinline__ unsigned pk2(float lo, float hi) { return f2bf(lo) | (f2bf(hi) << 16); }
__device__ __forceinline__ float bflo(unsigned w) { return __uint_as_float(w << 16); }
__device__ __forceinline__ float bfhi(unsigned w) { return __uint_as_float(w & 0xffff0000u); }
__device__ __forceinline__ float bf2f(bf16 v) { return __uint_as_float((unsigned)v << 16); }
__device__ __forceinline__ float wave_sum(float v) {
    int x = __builtin_bit_cast(int, v);
    v += __builtin_bit_cast(float, __builtin_amdgcn_update_dpp(0, x, 0xB1, 0xF, 0xF, false)); x = __builtin_bit_cast(int, v);
    v += __builtin_bit_cast(float, __builtin_amdgcn_update_dpp(0, x, 0x4E, 0xF, 0xF, false)); x = __builtin_bit_cast(int, v);
    v += __builtin_bit_cast(float, __builtin_amdgcn_update_dpp(0, x, 0x141, 0xF, 0xF, false)); x = __builtin_bit_cast(int, v);
    v += __builtin_bit_cast(float, __builtin_amdgcn_update_dpp(0, x, 0x140, 0xF, 0xF, false)); x = __builtin_bit_cast(int, v);
    const float r0 = __builtin_bit_cast(float, __builtin_amdgcn_readlane(x, 0)), r1 = __builtin_bit_cast(float, __builtin_amdgcn_readlane(x, 16));
    const float r2 = __builtin_bit_cast(float, __builtin_amdgcn_readlane(x, 32)), r3 = __builtin_bit_cast(float, __builtin_amdgcn_readlane(x, 48));
    return (r0 + r1) + (r2 + r3);
}

struct Args { const float* in[20]; float* out; unsigned char* ws; };

__device__ __forceinline__ int rho_p8(int cc) { return (cc & 128) + (cc & 96) + 16 * ((cc >> 2) & 1) + 4 * ((cc >> 3) & 3) + (cc & 3); }
__device__ __forceinline__ int rho_head(int cc) { const int wc = cc >> 6, fq = 2 * ((cc >> 5) & 1) + ((cc >> 3) & 1), bj = (cc >> 4) & 1; return 128 * bj + 32 * wc + 16 * ((cc >> 2) & 1) + 4 * fq + (cc & 3); }
__device__ __forceinline__ int dest_row(int mode, int c) {
    if (mode == 0) return (c & ~255) + rho_p8(c & 255);
    if (mode == 1) return (c & ~255) + rho_head(c & 255);
    const int jj = c & 127; return (c >> 7) * 256 + (mode == 3 ? 128 : 0) + (jj & 96) + 16 * ((jj >> 2) & 1) + 4 * ((jj >> 3) & 3) + (jj & 3);
}
struct TrItem { const float* W; bf16* WT; int K, N, mode, item; };
__device__ __forceinline__ void tr_load(const TrItem& t, f32x4 (&r)[8], int lane) {
    const int nblk = t.N / 32, kb = t.item / nblk, nb = t.item % nblk;
    const float* src = t.W + (size_t)(64 * kb + (lane >> 3)) * t.N + 32 * nb + 4 * (lane & 7);
#pragma unroll
    for (int i = 0; i < 8; ++i) r[i] = *(const f32x4*)(src + (size_t)(8 * i) * t.N);
}
__device__ __forceinline__ void tr_store(const TrItem& t, const f32x4 (&r)[8], LAS float* scr, int lane) {
    const int nblk = t.N / 32, kb = t.item / nblk, nb = t.item % nblk, k0 = 64 * kb, n0 = 32 * nb;
#pragma unroll
    for (int i = 0; i < 8; ++i) { LAS float* d = scr + ((lane >> 3) + 8 * i) * 33 + 4 * (lane & 7); d[0] = r[i][0]; d[1] = r[i][1]; d[2] = r[i][2]; d[3] = r[i][3]; }
    asm volatile("s_waitcnt lgkmcnt(0)" ::: "memory");
    const int c = lane & 7;
#pragma unroll
    for (int j = 0; j < 4; ++j) { const int n = (lane >> 3) + 8 * j; const LAS float* sp = scr + (8 * c) * 33 + n;
        v4u o; o.x = pk2(sp[0 * 33], sp[1 * 33]); o.y = pk2(sp[2 * 33], sp[3 * 33]); o.z = pk2(sp[4 * 33], sp[5 * 33]); o.w = pk2(sp[6 * 33], sp[7 * 33]);
        *(v4u*)(t.WT + (size_t)dest_row(t.mode, n0 + n) * t.K + k0 + 8 * c) = o; }
    asm volatile("s_waitcnt lgkmcnt(0)" ::: "memory");
}
__device__ __forceinline__ TrItem moe_item(const float* wgate, const float* wup, const float* wdown, int layer, bf16* Wgu, bf16* Wdn, int it) {
    const int e = it / 768, r = it % 768, which = r >> 8, sub = r & 255; const size_t le = (size_t)layer * NE + e; TrItem t;
    if (which == 0) t = TrItem{wgate + le * D * DE, Wgu + (size_t)e * D * D, D, DE, 2, sub};
    else if (which == 1) t = TrItem{wup + le * D * DE, Wgu + (size_t)e * D * D, D, DE, 3, sub};
    else t = TrItem{wdown + le * DE * D, Wdn + (size_t)e * D * DE, DE, D, 0, sub};
    return t;
}
__device__ __forceinline__ void moe_weight_items(const float* __restrict__ wgate, const float* __restrict__ wup, const float* __restrict__ wdown, int layer,
                                                 bf16* __restrict__ Wgu, bf16* __restrict__ Wdn, LAS float* scr, int gw, int NGW, int lane) {
    if (gw >= NE * 768) return;
    f32x4 rn[8]; TrItem tn = moe_item(wgate, wup, wdown, layer, Wgu, Wdn, gw); tr_load(tn, rn, lane);
    for (int it = gw; it < NE * 768; it += NGW) {
        f32x4 rc[8]; const TrItem tc = tn;
#pragma unroll
        for (int i = 0; i < 8; ++i) rc[i] = rn[i];
        if (it + NGW < NE * 768) { tn = moe_item(wgate, wup, wdown, layer, Wgu, Wdn, it + NGW); tr_load(tn, rn, lane); }
        tr_store(tc, rc, scr, lane);
    }
}
__device__ __forceinline__ void transpose_item(const float* __restrict__ W, int K, int N, bf16* __restrict__ WT, int mode, LAS float* scr, int item, int lane) {
    const TrItem t{W, WT, K, N, mode, item}; f32x4 r[8]; tr_load(t, r, lane); tr_store(t, r, scr, lane);
}

struct MoeOrder {
    int nunits, G, c; const LAS int* tile_e; const LAS int* tbase; const LAS int* trows; const int* tokmap;
    __device__ __forceinline__ bool next(int i, pg8::Unit& u) const {
        const long L = (long)i * G + c; if (L >= nunits) return false;
        const int pm = (int)(L >> 2); u.pm = pm; u.pn = __builtin_amdgcn_readfirstlane(tile_e[pm]) * 4 + (int)(L & 3); return true;
    }
    __device__ __forceinline__ int arow(const pg8::Unit& u, int rr) const {
        const int base = __builtin_amdgcn_readfirstlane(tbase[u.pm]), rows = __builtin_amdgcn_readfirstlane(trows[u.pm]);
        return rr < rows ? tokmap[base + rr] : 0;
    }
    __device__ __forceinline__ void a_ready(const pg8::Unit&) const {}
    __device__ __forceinline__ void done(const pg8::Unit&) const {}
};
constexpr int TOKCAP = 16384;
__device__ __forceinline__ void build_tiles(const unsigned* cnt, LAS int* misc, int tid) {
    if (tid == 0) { int s = 0;
        for (int e = 0; e < NE; ++e) { misc[e] = s; const int c = (int)__hip_atomic_load(cnt + 64 * e, RLX_AGENT); const int nt = (c + 255) >> 8;
            for (int t = 0; t < nt; ++t) if (s + t < MAXTILES) { misc[64 + s + t] = e; misc[256 + s + t] = e * TOKCAP + t * 256; misc[448 + s + t] = (c - t * 256) < 256 ? (c - t * 256) : 256; } s += nt; }
        misc[32] = s; misc[33] = s < MAXTILES ? s : MAXTILES; }
    __syncthreads();
}

__device__ __forceinline__ void na_attn_simple(const bf16* Qb, const bf16* Kb, const bf16* Vb, bf16* Ob, const float* __restrict__ rpb, int gw, int NGW, int lane) {
    for (int w = gw; w < M * NH; w += NGW) {
        const int m = w >> 4, h = w & 15, b = m >> 11, t = m & 2047, r = t >> 6, c = t & 63;
        const int rs = min(max(r - 4, 0), ROWS - 8), wsx = min(max(c - 8, 0), GW - 16);
        const float q = bf2f(Qb[(size_t)m * D + h * HD + lane]);
        float mx = -INFINITY, l = 0.f, acc = 0.f;
        for (int kr = 0; kr < 8; ++kr)
            for (int kc = 0; kc < 16; ++kc) {
                const int krow = rs + kr, kcol = wsx + kc; const size_t tok = (size_t)b * S + krow * GW + kcol;
                const float kv = bf2f(Kb[tok * D + h * HD + lane]), vv = bf2f(Vb[tok * D + h * HD + lane]);
                const int dr = krow - r + 7, dc = min(max(kcol - c + 15, 0), 30);
                const float s = wave_sum(q * kv) + rpb[(h * 15 + dr) * 31 + dc] * LOG2E;
                const float mn = fmaxf(mx, s), al = __builtin_amdgcn_exp2f(mx - mn), p = __builtin_amdgcn_exp2f(s - mn);
                l = l * al + p; acc = acc * al + p * vv; mx = mn;
            }
        Ob[(size_t)m * D + h * HD + lane] = (bf16)f2bf(acc / l);
    }
}
__device__ __forceinline__ void gqa_attn_simple(const bf16* Qb, const bf16* Kb, const bf16* Vb, bf16* Ob, int gw, int NGW, int lane) {
    for (int w = gw; w < M * NH; w += NGW) {
        const int m = w >> 4, h = w & 15, b = m >> 11, kvh = h >> 2;
        const float q = bf2f(Qb[(size_t)m * D + h * HD + lane]);
        float mx = -INFINITY, l = 0.f, acc = 0.f;
        const bf16* kp = Kb + (size_t)b * S * KVD + kvh * HD + lane; const bf16* vp = Vb + (size_t)b * S * KVD + kvh * HD + lane;
        for (int j = 0; j < S; ++j) {
            const float kv = bf2f(kp[(size_t)j * KVD]), vv = bf2f(vp[(size_t)j * KVD]);
            const float s = wave_sum(q * kv);
            const float mn = fmaxf(mx, s), al = __builtin_amdgcn_exp2f(mx - mn), p = __builtin_amdgcn_exp2f(s - mn);
            l = l * al + p; acc = acc * al + p * vv; mx = mn;
        }
        Ob[(size_t)m * D + h * HD + lane] = (bf16)f2bf(acc / l);
    }
}
#define XB_TMO      128
#define XB_XCNT(j)  (256  + 64 * (j))
#define XB_XSUB(j)  (1280 + 64 * (j))
#define XB_XGEN(j)  (2304 + 64 * (j))
#define XB_TOP      3328
#define XB_TOPGEN   3392
#define XCD_BAR_WORDS 3456
#define XB_SPIN_CAP (1u << 18)

__device__ __forceinline__ unsigned xb_ld(unsigned* p)              { return __hip_atomic_load(p, __ATOMIC_RELAXED, __HIP_MEMORY_SCOPE_AGENT); }
__device__ __forceinline__ unsigned xb_add(unsigned* p, unsigned v) { return __hip_atomic_fetch_add(p, v, __ATOMIC_RELAXED, __HIP_MEMORY_SCOPE_AGENT); }
__device__ __forceinline__ unsigned xb_xcc_id() { return (unsigned)__builtin_amdgcn_s_getreg((3 << 11) | 20) & 0xFu; }
#define XB_SPIN(cond, bar) do { unsigned _sp = 0; while (cond) { __builtin_amdgcn_s_sleep(1); \
    if ((++_sp & 255u) == 0u) { if (xb_ld(&(bar)[XB_TMO])) break; if (_sp > XB_SPIN_CAP) { atomicAdd(&(bar)[XB_TMO], 1u); break; } } } } while (0)

struct XcdBarrier {
    unsigned* bar; unsigned x;
    volatile LAS unsigned* st;
};

__device__ __forceinline__ XcdBarrier xcd_barrier_post(unsigned* bar, volatile LAS unsigned* st) {
    XcdBarrier b; b.bar = bar; b.x = xb_xcc_id(); b.st = st;
    if (threadIdx.x == 0) (void)xb_add(&bar[XB_XCNT(b.x)], 1u);
    return b;
}
__device__ __forceinline__ void xcd_barrier_complete(unsigned* bar, unsigned x, unsigned& nloc, unsigned& nx) {
    const unsigned G = gridDim.x * gridDim.y * gridDim.z;
    unsigned sum, cnt, mine, sp = 0u;
    for (;;) {
        sum = 0u; cnt = 0u; mine = 0u;
#pragma unroll
        for (unsigned j = 0; j < 16; ++j) { const unsigned c = xb_ld(&bar[XB_XCNT(j)]); sum += c; cnt += (c > 0u) ? 1u : 0u; mine = (j == x) ? c : mine; }
        if (sum == G) break;
        __builtin_amdgcn_s_sleep(1);
        if ((++sp & 255u) == 0u) { if (xb_ld(&bar[XB_TMO])) break; if (sp > XB_SPIN_CAP) { atomicAdd(&bar[XB_TMO], 1u); break; } }
    }
    nloc = mine > 0u ? mine : 1u; nx = cnt > 0u ? cnt : 1u;
}

__device__ __forceinline__ void xcd_barrier(const XcdBarrier& b) {
    asm volatile("s_waitcnt vmcnt(0)" ::: "memory");
    __syncthreads();
    if (threadIdx.x == 0) {
        unsigned* bar = b.bar;
        __builtin_amdgcn_s_waitcnt(0);
        unsigned nloc = b.st[0], nx = b.st[1];
        if (nloc == 0u) { xcd_barrier_complete(bar, b.x, nloc, nx); b.st[0] = nloc; b.st[1] = nx; }
        const unsigned old = xb_add(&bar[XB_XSUB(b.x)], 1u);
        const unsigned gen = old / nloc;
        if (old + 1u == (gen + 1u) * nloc) {
            __builtin_amdgcn_fence(__ATOMIC_RELEASE, "agent");
            asm volatile("s_waitcnt vmcnt(0)" ::: "memory");
            const unsigned og = xb_add(&bar[XB_TOP], 1u);
            const unsigned tg = og / nx;
            if (og + 1u == (tg + 1u) * nx) xb_add(&bar[XB_TOPGEN], 1u);
            else XB_SPIN(xb_ld(&bar[XB_TOPGEN]) == tg, bar);
            __builtin_amdgcn_fence(__ATOMIC_ACQUIRE, "agent");
            xb_add(&bar[XB_XGEN(b.x)], 1u);
            asm volatile("s_waitcnt vmcnt(0)" ::: "memory");
        } else {
            XB_SPIN(xb_ld(&bar[XB_XGEN(b.x)]) == gen, bar);
            __builtin_amdgcn_fence(__ATOMIC_ACQUIRE, "agent");
            asm volatile("s_waitcnt vmcnt(0)" ::: "memory");
        }
    }
    __syncthreads();
}
__device__ __forceinline__ unsigned char* ldptr(const LAS unsigned* ptab, int i) {
    const unsigned lo = (unsigned)__builtin_amdgcn_readfirstlane((int)ptab[2 * i]), hi = (unsigned)__builtin_amdgcn_readfirstlane((int)ptab[2 * i + 1]);
    return (unsigned char*)(__attribute__((address_space(1))) unsigned char*)(((unsigned long long)hi << 32) | lo);
}
#ifndef PROBE_REPEAT
#define PROBE_REPEAT -1
#endif
#define NREP(k) ((PROBE_REPEAT == (k)) ? 2 : 1)
#ifndef PROBE_TS
#define PROBE_TS -1
#endif
#define TS_T0(k) unsigned long long ts0_##k = 0; if (PROBE_TS == (k) && blockIdx.x == 0 && threadIdx.x == 0) ts0_##k = __builtin_amdgcn_s_memrealtime();
#define TS_T1(k) if (PROBE_TS == (k) && blockIdx.x == 0 && threadIdx.x == 0) atomicAdd((unsigned*)(ws + WS_CTL) + CW_TS, (unsigned)(__builtin_amdgcn_s_memrealtime() - ts0_##k));
#define GRID_SYNC_T(k) do { if (PROBE_TS == (k)) { PH_BEGIN TS_T0(k) GRID_SYNC(); TS_T1(k) } else { GRID_SYNC(); } } while (0)
#define LDS_BARRIER() do { asm volatile("s_waitcnt lgkmcnt(0)" ::: "memory"); __builtin_amdgcn_s_barrier(); asm volatile("" ::: "memory"); } while (0)
#define GRID_SYNC_CG() do { cg::this_grid().sync(); asm volatile("" ::: "memory"); } while (0)
#define GRID_SYNC() do { unsigned lb_ = (unsigned)(uintptr_t)lds_raw; asm volatile("" : "+s"(lb_)); LAS unsigned char* l_ = (LAS unsigned char*)lb_; \
    XcdBarrier xb_; xb_.bar = (unsigned*)(ldptr((LAS unsigned*)(l_ + MISC_OFF + 8192), 21) + WS_CTL) + CW_BAR; xb_.x = xb_xcc_id(); xb_.st = (volatile LAS unsigned*)(l_ + MISC_OFF + 8448); \
    xcd_barrier(xb_); asm volatile("" ::: "memory"); } while (0)
#define PH_BEGIN \
    unsigned ldsb_ = (unsigned)(uintptr_t)lds_raw; asm volatile("" : "+s"(ldsb_)); \
    LAS unsigned char* lds = (LAS unsigned char*)ldsb_; LAS int* misc = (LAS int*)(lds + MISC_OFF); LAS unsigned* ptab = (LAS unsigned*)(lds + MISC_OFF + 8192); (void)misc; \
    int tid = threadIdx.x; asm volatile("" : "+v"(tid)); \
    const int lane = tid & 63, wave = __builtin_amdgcn_readfirstlane(tid >> 6); \
    int G = gridDim.x, bid = blockIdx.x; asm volatile("" : "+s"(G), "+s"(bid)); const int gw = bid * NWAVES + wave, NGW = G * NWAVES; \
    unsigned char* ws = ldptr(ptab, 21); (void)lane; (void)gw; (void)NGW; (void)ws;
#define INP(i) ((const float*)ldptr(ptab, (i)))

__global__ void __launch_bounds__(NTHREADS, 2) mk_fwd(Args args) {
    extern __shared__ __attribute__((aligned(16))) unsigned char lds_raw[];
    { LAS unsigned* ptab = (LAS unsigned*)((LAS unsigned char*)lds_raw + MISC_OFF + 8192);
    if (threadIdx.x < 22) { const unsigned long long p = threadIdx.x < 20 ? (unsigned long long)args.in[threadIdx.x] : (threadIdx.x == 20 ? (unsigned long long)args.out : (unsigned long long)args.ws);
        ptab[2 * threadIdx.x] = (unsigned)p; ptab[2 * threadIdx.x + 1] = (unsigned)(p >> 32); }
      volatile LAS unsigned* st = (volatile LAS unsigned*)((LAS unsigned char*)lds_raw + MISC_OFF + 8448);
      if (threadIdx.x == 64) { st[0] = 0u; st[1] = 0u; }
      __syncthreads();
      (void)xcd_barrier_post((unsigned*)(args.ws + WS_CTL) + CW_BAR, st); }
    __syncthreads();

    {
        PH_BEGIN
        const float* c_in = INP(1); const float* ada_w = INP(2); const float* ada_b = INP(3);
        float* mod = (float*)(ws + WS_MOD); float* ropec = (float*)(ws + WS_ROPE); float* ropes = ropec + S * 32;
        LAS float* ca = (LAS float*)lds;
        LAS float* red = (LAS float*)(lds + 32768);
        for (int i = tid; i < NB * D; i += NTHREADS) { const float v = c_in[i]; ca[i] = v / (1.f + __expf(-v)); }
        __syncthreads();
        for (int it = bid; it < DEPTH * 192; it += G) {
            const int l = it / 192, col0 = (it % 192) * 32, cl = tid & 31, ks = tid >> 5;
            const float* wp = ada_w + ((size_t)l * D + 64 * ks) * (6 * D) + col0 + cl;
            float acc[NB];
#pragma unroll
            for (int b = 0; b < NB; ++b) acc[b] = 0.f;
#pragma unroll 16
            for (int kk = 0; kk < 64; ++kk) { const float wv = wp[(size_t)kk * (6 * D)];
#pragma unroll
                for (int b = 0; b < NB; ++b) acc[b] += ca[b * D + 64 * ks + kk] * wv; }
#pragma unroll
            for (int b = 0; b < NB; ++b) red[(ks * NB + b) * 32 + cl] = acc[b];
            __syncthreads();
            if (tid < 256) { const int b = tid >> 5; float s = 0.f;
#pragma unroll
                for (int k2 = 0; k2 < 16; ++k2) s += red[(k2 * NB + b) * 32 + cl];
                mod[((size_t)l * NB + b) * (6 * D) + col0 + cl] = s + ada_b[l * 6 * D + col0 + cl]; }
            __syncthreads();
        }
        for (int i = bid * NTHREADS + tid; i < S * 32; i += G * NTHREADS) {
            const int t = i >> 5, a = (i >> 4) & 1, p = i & 15;
            const float pos = (float)(a == 0 ? t / GW : t % GW);
            const float ang = pos * exp2f(-(float)p * (13.287712379549449f / 16.f));
            const float kf = rintf(ang * 0.15915494309189535f);
            float r = fmaf(-kf, 6.2831854820251465f, ang); r = fmaf(-kf, -1.7484555314695172e-07f, r);
            ropec[i] = __cosf(r); ropes[i] = __sinf(r);
        }
        { const float* m_wg = INP(13); const float* m_we = INP(15); bf16* wrh = (bf16*)(ws + WS_WRT); bf16* wrl = wrh + DEPTH * 48 * D;
          for (int i = bid * NTHREADS + tid; i < DEPTH * 48 * D; i += G * NTHREADS) {
            const int l = i / (48 * D), o = (i / D) % 48, k = i % D;
            const float v = o < NG ? m_wg[((size_t)l * D + k) * NG + o] : (o < NRT ? m_we[((size_t)l * D + k) * NE + (o - NG)] : 0.f);
            const unsigned hi = f2bf(v); wrh[i] = (bf16)hi; wrl[i] = (bf16)f2bf(v - __uint_as_float(hi << 16));
          } }
        LAS float* scr = (LAS float*)(lds + 49152 + wave * 8704);
        { const float* na_wqkv = INP(6); const float* na_wo = INP(8); const float* gq_wqkv = INP(9); const float* gq_wo = INP(12);
          bf16* Wqkv_na = (bf16*)(ws + WS_WQKV_NA); bf16* Wo_na = (bf16*)(ws + WS_WO_NA); bf16* Wqkv_gq = (bf16*)(ws + WS_WQKV_GQ); bf16* Wo_gq = (bf16*)(ws + WS_WO_GQ);
          constexpr int I_NQ = 16 * 96, I_O = 16 * 32, I_GQ = 16 * 48, I_DENSE = 2 * (I_NQ + I_O + I_GQ + I_O);
          for (int it = gw; it < I_DENSE; it += NGW) {
            int r = it; const int j = r / (I_DENSE / 2); r %= (I_DENSE / 2);
            if (r < I_NQ) { transpose_item(na_wqkv + (size_t)j * D * NQKV_NA, D, NQKV_NA, Wqkv_na + (size_t)j * NQKV_NA * D, 0, scr, r, lane); continue; } r -= I_NQ;
            if (r < I_O) { transpose_item(na_wo + (size_t)j * D * D, D, D, Wo_na + (size_t)j * D * D, 0, scr, r, lane); continue; } r -= I_O;
            if (r < I_GQ) { transpose_item(gq_wqkv + (size_t)j * D * NQKV_GQ, D, NQKV_GQ, Wqkv_gq + (size_t)j * NQKV_GQ * D, 1, scr, r, lane); continue; } r -= I_GQ;
            transpose_item(gq_wo + (size_t)j * D * D, D, D, Wo_gq + (size_t)j * D * D, 0, scr, r, lane);
          } }
        moe_weight_items(INP(17), INP(18), INP(19), 0, (bf16*)(ws + WS_WGU), (bf16*)(ws + WS_WDN), scr, gw, NGW, lane);
    }
    GRID_SYNC_CG();
    {
        PH_BEGIN
        const float* x_in = INP(0); const float* mod = (const float*)(ws + WS_MOD); bf16* Hb = (bf16*)(ws + WS_H);
        for (int m = gw; m < M; m += NGW) {
            const float* mb = mod + (size_t)(m >> 11) * (6 * D);
#pragma unroll
            for (int j = 0; j < 4; ++j) { const int d = 4 * lane + 256 * j;
                const f32x4 xv = *(const f32x4*)(x_in + (size_t)m * D + d), sh = *(const f32x4*)(mb + d), sc = *(const f32x4*)(mb + D + d);
                const f32x4 hv = xv * (1.f + sc) + sh; v2u o; o.x = pk2(hv[0], hv[1]); o.y = pk2(hv[2], hv[3]);
                *(v2u*)(Hb + (size_t)m * D + d) = o; }
        }
    }
    GRID_SYNC();

    for (int layer = 0; layer < DEPTH; ++layer) {
        for (int rep_ = 0; rep_ < NREP(0); ++rep_) {
            { PH_BEGIN TS_T0(110)
            const int j2 = layer >> 1;
            bf16* Hb = (bf16*)(ws + WS_H); bf16* Qb = (bf16*)(ws + WS_Q);
            if ((layer & 1) == 0) {
                pg8::Gemm g{Hb, (bf16*)(ws + WS_WQKV_NA) + (size_t)j2 * NQKV_NA * D, M, NQKV_NA, D}; pg8::StaticOrder So; So.init(M, NQKV_NA, G, bid);
                pg8::EpiStore8 E{Qb, D, D, (size_t)(WS_K - WS_Q) / 2, C2, 0x7fffffff};
                pg8::gemm_phase<pg8::EpiStore8, pg8::StaticOrder, true, true>(lds, g, So, E);
            } else {
                pg8::Gemm g{Hb, (bf16*)(ws + WS_WQKV_GQ) + (size_t)j2 * NQKV_GQ * D, M, NQKV_GQ, D}; pg8::StaticOrder So; So.init(M, NQKV_GQ, G, bid);
                const float* ropec = (const float*)(ws + WS_ROPE);
                pg8::EpiGqaQkv E{Qb, (bf16*)(ws + WS_K), (bf16*)(ws + WS_V), INP(10) + j2 * HD, INP(11) + j2 * HD, ropec, ropec + S * 32, C2};
                pg8::gemm_phase<pg8::EpiGqaQkv, pg8::StaticOrder, true, true>(lds, g, So, E);
            }
        TS_T1(110) } GRID_SYNC_T(120); }
        for (int rep_ = 0; rep_ < NREP(1); ++rep_) {
            { PH_BEGIN TS_T0(111)
            bf16* Qb = (bf16*)(ws + WS_Q); const bf16* Kb = (const bf16*)(ws + WS_K); const bf16* Vb = (const bf16*)(ws + WS_V);
            bf16* Ob = (PROBE_REPEAT == 1 && rep_ == 0) ? (bf16*)(ws + WS_XS) : Qb;
            if ((layer & 1) == 0) na_body::na_phase((LAS char*)lds, Qb, Kb, Vb, Ob, INP(7) + (size_t)(layer >> 1) * NH * 15 * 31, G, bid);
            else {
                const attn_body::AttnTensors AT{(const attn_body::bf16*)Qb, (const attn_body::bf16*)Kb, (const attn_body::bf16*)Vb, (attn_body::bf16*)Ob};
                const attn_body::StaticOrder So(G, bid);
                attn_body::attn_phase<attn_body::StaticOrder>((char*)lds, AT, So);
            }
        TS_T1(111) } GRID_SYNC_T(121); }
        for (int rep_ = 0; rep_ < NREP(2); ++rep_) {
            { PH_BEGIN TS_T0(112)
            const bf16* Wo = (const bf16*)(ws + ((layer & 1) == 0 ? WS_WO_NA : WS_WO_GQ)) + (size_t)(layer >> 1) * D * D;
            pg8::Gemm g{(const bf16*)(ws + WS_Q), Wo, M, D, D}; pg8::StaticOrder So; So.init(M, D, G, bid);
            pg8::EpiStore8 E{(bf16*)(ws + WS_Y), D, 0, 0, 1.f, 0x7fffffff};
            pg8::gemm_phase<pg8::EpiStore8, pg8::StaticOrder, true, true>(lds, g, So, E);
        TS_T1(112) } GRID_SYNC_T(122); }
        for (int rep_ = 0; rep_ < NREP(3); ++rep_) {
            { PH_BEGIN TS_T0(113)
            const float* xcur = layer == 0 ? INP(0) : (const float*)(ws + WS_X2);
            const float* modl = (const float*)(ws + WS_MOD) + (size_t)layer * NB * 6 * D;
            const bool dmy_ = (PROBE_REPEAT == 3 && rep_ == 0);
            unsigned* cnt = (unsigned*)(ws + WS_CTL) + CW_CNT + CNT_LAYER_STRIDE * (layer + (dmy_ ? 8 : 0));
            float* X1 = (float*)(ws + WS_X1); bf16* Hb = (bf16*)(ws + WS_H); const bf16* Yb = (const bf16*)(ws + WS_Y);
            int* r_eid = (int*)(ws + (dmy_ ? WS_XS : WS_ROUTE)); int* r_pos = r_eid + 2 * M; float* r_gate = (float*)(r_pos + 2 * M);
            int* tokmap = (int*)(ws + WS_TOKMAP);
            LAS unsigned char* Hhi = lds; LAS unsigned char* Hlo = lds + 33024; LAS float* part = (LAS float*)(lds + 66048); LAS float* lgt = (LAS float*)(lds + 90624);
            LAS float* prm = (LAS float*)(lds + 98304);
            LAS int* hist = (LAS int*)(lds + 93696); LAS int* basee = hist + 32; LAS int* rt_e = hist + 64; LAS int* rt_lp = rt_e + 128; LAS float* rt_g = (LAS float*)(rt_lp + 128);
            const float* lg = INP(4) + (size_t)(layer * 2) * D; const float* lb = INP(5) + (size_t)(layer * 2) * D;
            const bf16* wrh = (const bf16*)(ws + WS_WRT) + (size_t)layer * 48 * D; const bf16* wrl = wrh + (size_t)DEPTH * 48 * D;
            const float* bgp = INP(14) + layer * NG; const float* bep = INP(16) + layer * NE;
            const int fr = lane & 15, fq = lane >> 4;
            for (int ch = bid; ch < M / 64; ch += G) {
                if (tid < 32) hist[tid] = 0;
                { const float* mbc = modl + (size_t)((ch * 64) >> 11) * (6 * D);
                  for (int i = tid; i < D; i += NTHREADS) { prm[i] = 1.f + mbc[2 * D + i]; prm[D + i] = lg[i]; prm[2 * D + i] = lb[i]; prm[3 * D + i] = 1.f + mbc[4 * D + i]; prm[4 * D + i] = mbc[3 * D + i]; } }
                __syncthreads();
                f32x4 xn[2][4]; v2u yn[2][4];
#define LN1_LOAD(PS) do { _Pragma("unroll") for (int tt_ = 0; tt_ < 2; ++tt_) { const size_t mo_ = (size_t)(ch * 64 + (PS) * 16 + 2 * wave + tt_) * D + 4 * lane; \
        _Pragma("unroll") for (int j_ = 0; j_ < 4; ++j_) { xn[tt_][j_] = *(const f32x4*)(xcur + mo_ + 256 * j_); yn[tt_][j_] = *(const v2u*)(Yb + mo_ + 256 * j_); } } } while (0)
                LN1_LOAD(0);
                for (int ps = 0; ps < 4; ++ps) {
                    TS_T0(130)
                    f32x4 xc[2][4]; v2u yc[2][4];
#pragma unroll
                    for (int tt = 0; tt < 2; ++tt)
#pragma unroll
                        for (int j = 0; j < 4; ++j) { xc[tt][j] = xn[tt][j]; yc[tt][j] = yn[tt][j]; }
                    LN1_LOAD(ps < 3 ? ps + 1 : 3);
#pragma unroll
                    for (int tt = 0; tt < 2; ++tt) {
                        const int tl = 2 * wave + tt, m = ch * 64 + ps * 16 + tl;
                        f32x4 v[4]; float sm = 0.f;
#pragma unroll
                        for (int j = 0; j < 4; ++j) { const int d = 4 * lane + 256 * j;
                            const f32x4 xv = xc[tt][j], g1 = *(const LAS f32x4*)(prm + d);
                            const v2u yw = yc[tt][j]; const f32x4 yv = {bflo(yw.x), bfhi(yw.x), bflo(yw.y), bfhi(yw.y)};
                            v[j] = ALPHA * xv + g1 * yv; sm += (v[j][0] + v[j][1]) + (v[j][2] + v[j][3]); }
                        const float mean = wave_sum(sm) * (1.f / D); float q = 0.f;
#pragma unroll
                        for (int j = 0; j < 4; ++j) { v[j] = v[j] - mean; q += (v[j][0] * v[j][0] + v[j][1] * v[j][1]) + (v[j][2] * v[j][2] + v[j][3] * v[j][3]); }
                        const float rstd = rsqrtf(wave_sum(q) * (1.f / D) + LN_EPS);
#pragma unroll
                        for (int j = 0; j < 4; ++j) { const int d = 4 * lane + 256 * j;
                            const f32x4 x1 = v[j] * rstd * *(const LAS f32x4*)(prm + D + d) + *(const LAS f32x4*)(prm + 2 * D + d);
                            *(f32x4*)(X1 + (size_t)m * D + d) = x1;
                            const f32x4 h2 = x1 * *(const LAS f32x4*)(prm + 3 * D + d) + *(const LAS f32x4*)(prm + 4 * D + d);
                            unsigned hb[4], lbv[4];
#pragma unroll
                            for (int e = 0; e < 4; ++e) { hb[e] = f2bf(h2[e]); lbv[e] = f2bf(h2[e] - __uint_as_float(hb[e] << 16)); }
                            v2u oh; oh.x = hb[0] | (hb[1] << 16); oh.y = hb[2] | (hb[3] << 16); v2u ol; ol.x = lbv[0] | (lbv[1] << 16); ol.y = lbv[2] | (lbv[3] << 16);
                            *(v2u*)(Hb + (size_t)m * D + d) = oh;
                            *(LAS v2u*)(Hhi + tl * 2064 + d * 2) = oh; *(LAS v2u*)(Hlo + tl * 2064 + d * 2) = ol; }
                    }
                    LDS_BARRIER();
                    TS_T1(130) TS_T0(131)
                    { f32x4 acc[3];
#pragma unroll
                      for (int nt = 0; nt < 3; ++nt) acc[nt] = (f32x4){0.f, 0.f, 0.f, 0.f};
#pragma unroll
                      for (int ks = 0; ks < 4; ++ks) { const int kk = 128 * wave + 32 * ks + 8 * fq;
                          const pg8::bf16x8 hh = *(const LAS pg8::bf16x8*)(Hhi + fr * 2064 + kk * 2), hl = *(const LAS pg8::bf16x8*)(Hlo + fr * 2064 + kk * 2);
#pragma unroll
                          for (int nt = 0; nt < 3; ++nt) { const pg8::bf16x8 wh = *(const pg8::bf16x8*)(wrh + (size_t)(16 * nt + fr) * D + kk), wl = *(const pg8::bf16x8*)(wrl + (size_t)(16 * nt + fr) * D + kk);
                              acc[nt] = __builtin_amdgcn_mfma_f32_16x16x32_bf16(wh, hh, acc[nt], 0, 0, 0);
                              acc[nt] = __builtin_amdgcn_mfma_f32_16x16x32_bf16(wh, hl, acc[nt], 0, 0, 0);
                              acc[nt] = __builtin_amdgcn_mfma_f32_16x16x32_bf16(wl, hh, acc[nt], 0, 0, 0); } }
#pragma unroll
                      for (int nt = 0; nt < 3; ++nt) *(LAS f32x4*)(part + (wave * 16 + fr) * 48 + 16 * nt + 4 * fq) = acc[nt]; }
                    LDS_BARRIER();
                    TS_T1(131) TS_T0(132)
                    for (int idx = tid; idx < 16 * 48; idx += NTHREADS) { const int o = idx % 48; float sacc = o < NG ? bgp[o] : (o < NRT ? bep[o - NG] : 0.f);
#pragma unroll
                        for (int w8 = 0; w8 < 8; ++w8) sacc += part[w8 * 16 * 48 + idx];
                        lgt[idx] = sacc; }
                    LDS_BARRIER();
                    if (tid < 16) { const LAS float* L = lgt + tid * 48; const int tl = ps * 16 + tid;
                        int gi = 0; float gm = L[0];
#pragma unroll
                        for (int o = 1; o < NG; ++o) if (L[o] > gm) { gm = L[o]; gi = o; }
                        float gs = 0.f;
#pragma unroll
                        for (int o = 0; o < NG; ++o) gs += __expf(L[o] - gm);
                        const float gprob = 1.f / gs; const LAS float* E8 = L + NG + gi * EPG;
                        int i0 = 0; float m0 = E8[0];
#pragma unroll
                        for (int e = 1; e < EPG; ++e) if (E8[e] > m0) { m0 = E8[e]; i0 = e; }
                        int i1 = 0; float m1 = -INFINITY;
#pragma unroll
                        for (int e = 0; e < EPG; ++e) if (e != i0 && E8[e] > m1) { m1 = E8[e]; i1 = e; }
                        const float p1 = __expf(m1 - m0), den = 1.f + p1; const int e0 = gi * EPG + i0, e1 = gi * EPG + i1;
                        rt_e[2 * tl] = e0; rt_e[2 * tl + 1] = e1; rt_g[2 * tl] = gprob / den; rt_g[2 * tl + 1] = gprob * p1 / den;
                        rt_lp[2 * tl] = atomicAdd((int*)&hist[e0], 1); rt_lp[2 * tl + 1] = atomicAdd((int*)&hist[e1], 1); }
                    TS_T1(132)
                }
                TS_T0(133)
                __syncthreads();
                if (tid < 32) { const int c = hist[tid]; basee[tid] = c ? (int)__hip_atomic_fetch_add(cnt + 64 * tid, (unsigned)c, RLX_AGENT) : 0; }
                __syncthreads();
                if (tid < 128) { const int e = rt_e[tid], A = ch * 128 + tid, ps_ = basee[e] + rt_lp[tid]; r_eid[A] = e; r_pos[A] = ps_; r_gate[A] = rt_g[tid]; if (!dmy_) tokmap[e * TOKCAP + ps_] = A >> 1; }
                __syncthreads();
                TS_T1(133)
            }
#undef LN1_LOAD
        TS_T1(113) } GRID_SYNC_T(123); }
        for (int rep_ = 0; rep_ < NREP(5); ++rep_) {
            { PH_BEGIN TS_T0(115)
            build_tiles((const unsigned*)(ws + WS_CTL) + CW_CNT + CNT_LAYER_STRIDE * layer, misc, tid);
            const int ntiles = __builtin_amdgcn_readfirstlane(misc[33]);
            pg8::Gemm g{(const bf16*)(ws + WS_H), (const bf16*)(ws + WS_WGU), ntiles * 256, NE * D, D}; MoeOrder So{ntiles * 4, G, bid, misc + 64, misc + 256, misc + 448, (const int*)(ws + WS_TOKMAP)};
            pg8::EpiSwiglu E{(bf16*)(ws + WS_HMID)};
            pg8::gemm_phase<pg8::EpiSwiglu, MoeOrder, true, true, true>(lds, g, So, E);
        TS_T1(115) } GRID_SYNC_T(125); }
        for (int rep_ = 0; rep_ < NREP(6); ++rep_) {
            { PH_BEGIN TS_T0(116)
            const int ntiles = __builtin_amdgcn_readfirstlane(misc[33]);
            pg8::Gemm g{(const bf16*)(ws + WS_HMID), (const bf16*)(ws + WS_WDN), ntiles * 256, NE * D, DE}; MoeOrder So{ntiles * 4, G, bid, misc + 64, misc + 256, misc + 448, nullptr};
            pg8::EpiStore8 E{(bf16*)(ws + WS_YS), D, 0, 0, 1.f, 3};
            pg8::gemm_phase<pg8::EpiStore8, MoeOrder, true, true>(lds, g, So, E);
        TS_T1(116) } GRID_SYNC_T(126); }
        for (int rep_ = 0; rep_ < NREP(7); ++rep_) {
            { PH_BEGIN TS_T0(117)
            const float* lg = INP(4) + (size_t)(layer * 2 + 1) * D; const float* lb = INP(5) + (size_t)(layer * 2 + 1) * D;
            const bool last = layer == DEPTH - 1; float* xo = last ? (float*)ldptr(ptab, 20) : (float*)(ws + WS_X2);
            const float tsc = (PROBE_TS >= 0 && last) ? 1.f + (float)__hip_atomic_load((unsigned*)(ws + WS_CTL) + CW_TS, RLX_AGENT) * 1e-6f : 1.f;
            const float* modl = (const float*)(ws + WS_MOD) + (size_t)layer * NB * 6 * D; const float* modn = modl + (size_t)NB * 6 * D;
            const float* X1 = (const float*)(ws + WS_X1); bf16* Hb = (bf16*)(ws + WS_H); const bf16* YS = (const bf16*)(ws + WS_YS);
            const int* r_eid = (const int*)(ws + WS_ROUTE); const int* r_pos = r_eid + 2 * M; const float* r_gate = (const float*)(r_pos + 2 * M);
            TS_T0(140)
            LAS float* prm = (LAS float*)(lds + 98304);
            for (int ch = bid; ch < M / 64; ch += G) {
                __syncthreads();
                { const float* mbc = modl + (size_t)((ch * 64) >> 11) * (6 * D); const float* mnc = modn + (size_t)((ch * 64) >> 11) * (6 * D);
                  for (int i = tid; i < D; i += NTHREADS) { prm[i] = 1.f + mbc[5 * D + i]; prm[D + i] = lg[i]; prm[2 * D + i] = lb[i];
                      prm[3 * D + i] = last ? 0.f : 1.f + mnc[D + i]; prm[4 * D + i] = last ? 0.f : mnc[i]; } }
                __syncthreads();
                const int mbase = ch * 64 + wave * 8;
                int sl0, sl1; float gt0, gt1;
                { const int mi = mbase + (lane & 7); sl0 = misc[r_eid[2 * mi]] * 256 + r_pos[2 * mi]; sl1 = misc[r_eid[2 * mi + 1]] * 256 + r_pos[2 * mi + 1]; gt0 = r_gate[2 * mi]; gt1 = r_gate[2 * mi + 1]; }
                f32x4 xn[4]; v2u yan[4], ybn[4];
#define CMB_LOAD(I) do { const int mi_ = mbase + (I); const int s0_ = __builtin_amdgcn_readlane(sl0, (I)), s1_ = __builtin_amdgcn_readlane(sl1, (I)); \
        _Pragma("unroll") for (int j_ = 0; j_ < 4; ++j_) { const int d_ = 4 * lane + 256 * j_; xn[j_] = *(const f32x4*)(X1 + (size_t)mi_ * D + d_); \
            yan[j_] = *(const v2u*)(YS + (size_t)s0_ * D + d_); ybn[j_] = *(const v2u*)(YS + (size_t)s1_ * D + d_); } } while (0)
                CMB_LOAD(0);
#pragma unroll
                for (int i = 0; i < 8; ++i) {
                    const int m = mbase + i;
                    const float g0 = __builtin_bit_cast(float, __builtin_amdgcn_readlane(__builtin_bit_cast(int, gt0), i)), g1v = __builtin_bit_cast(float, __builtin_amdgcn_readlane(__builtin_bit_cast(int, gt1), i));
                    f32x4 xc[4]; v2u yac[4], ybc[4];
#pragma unroll
                    for (int j = 0; j < 4; ++j) { xc[j] = xn[j]; yac[j] = yan[j]; ybc[j] = ybn[j]; }
                    if (i < 7) CMB_LOAD(i + 1);
                    f32x4 v[4]; float sm = 0.f;
#pragma unroll
                    for (int j = 0; j < 4; ++j) { const int d = 4 * lane + 256 * j;
                        const f32x4 g2 = *(const LAS f32x4*)(prm + d); const v2u ya = yac[j], yb = ybc[j];
                        const f32x4 y0 = {bflo(ya.x), bfhi(ya.x), bflo(ya.y), bfhi(ya.y)}, y1 = {bflo(yb.x), bfhi(yb.x), bflo(yb.y), bfhi(yb.y)};
                        v[j] = ALPHA * xc[j] + g2 * (g0 * y0 + g1v * y1); sm += (v[j][0] + v[j][1]) + (v[j][2] + v[j][3]); }
                    const float mean = wave_sum(sm) * (1.f / D); float q = 0.f;
#pragma unroll
                    for (int j = 0; j < 4; ++j) { v[j] = v[j] - mean; q += (v[j][0] * v[j][0] + v[j][1] * v[j][1]) + (v[j][2] * v[j][2] + v[j][3] * v[j][3]); }
                    const float rstd = rsqrtf(wave_sum(q) * (1.f / D) + LN_EPS);
#pragma unroll
                    for (int j = 0; j < 4; ++j) { const int d = 4 * lane + 256 * j;
                        const f32x4 x2 = v[j] * rstd * *(const LAS f32x4*)(prm + D + d) + *(const LAS f32x4*)(prm + 2 * D + d);
                        *(f32x4*)(xo + (size_t)m * D + d) = x2 * tsc;
                        if (!last) { const f32x4 hn = x2 * *(const LAS f32x4*)(prm + 3 * D + d) + *(const LAS f32x4*)(prm + 4 * D + d);
                            v2u o; o.x = pk2(hn[0], hn[1]); o.y = pk2(hn[2], hn[3]); *(v2u*)(Hb + (size_t)m * D + d) = o; } }
                }
#undef CMB_LOAD
            }
            __syncthreads();
            TS_T1(140) TS_T0(141)
            if (!last) { LAS float* scr = (LAS float*)(lds + wave * 8704); moe_weight_items(INP(17), INP(18), INP(19), layer + 1, (bf16*)(ws + WS_WGU), (bf16*)(ws + WS_WDN), scr, gw, NGW, lane); }
            TS_T1(141)
        TS_T1(117) } if (layer != DEPTH - 1 || PROBE_REPEAT == 7) GRID_SYNC_T(127); }
    }
}

extern "C" void kernel_launch(void* const* d_in, const int* in_sizes, int n_in, void* d_out, int out_size, void* d_ws, size_t ws_size, hipStream_t stream) {
    static int grid = 0;
    if (grid == 0) {
        if (n_in != 20 || ws_size < WS_END) { fprintf(stderr, "kernel_launch: unexpected inputs (n_in %d, ws %zu)\n", n_in, ws_size); grid = -1; return; }
        int dev = 0, cus = 0, per_cu = 0;
        if (hipGetDevice(&dev) != hipSuccess || hipDeviceGetAttribute(&cus, hipDeviceAttributeMultiprocessorCount, dev) != hipSuccess) { grid = -1; return; }
        if (hipFuncSetAttribute((const void*)mk_fwd, hipFuncAttributeMaxDynamicSharedMemorySize, LDS_BYTES) != hipSuccess) { fprintf(stderr, "kernel_launch: hipFuncSetAttribute failed\n"); grid = -1; return; }
        if (hipOccupancyMaxActiveBlocksPerMultiprocessor(&per_cu, (const void*)mk_fwd, NTHREADS, LDS_BYTES) != hipSuccess || per_cu < 1) { fprintf(stderr, "kernel_launch: occupancy query failed (%d)\n", per_cu); per_cu = 1; }
        (void)hipGetLastError();
        grid = cus * (per_cu < 1 ? 1 : 1);
    }
    if (grid < 0) return;
    (void)in_sizes; (void)out_size;
    if (hipMemsetAsync((char*)d_ws + WS_CTL, 0, CTL_ZERO_BYTES, stream) != hipSuccess) { fprintf(stderr, "kernel_launch: memset failed\n"); return; }
    Args a{};
    for (int i = 0; i < 20; ++i) a.in[i] = (const float*)d_in[i];
    a.out = (float*)d_out; a.ws = (unsigned char*)d_ws;
    void* kargs[] = {&a};
    hipError_t e = hipLaunchCooperativeKernel((const void*)mk_fwd, dim3(grid), dim3(NTHREADS), kargs, LDS_BYTES, stream);
    if (e != hipSuccess) fprintf(stderr, "kernel_launch: cooperative launch failed: %s (grid %d)\n", hipGetErrorString(e), grid);
}
```

```cpp
#include <hip/hip_runtime.h>
#include <hip/hip_cooperative_groups.h>
#include <cstdio>
#include <cstdint>
namespace cg = cooperative_groups;
namespace pg8 {
#define PG8_LAS __attribute__((address_space(3)))
typedef unsigned short bf16_t;
typedef short bf16x8 __attribute__((ext_vector_type(8)));
typedef float f32x4 __attribute__((ext_vector_type(4)));
typedef unsigned u32x4 __attribute__((ext_vector_type(4)));
constexpr int BM = 256, BK = 64, HALF = 128, HTB = HALF * BK * 2  , STAGE_BYTES = 8 * HTB, NXCD = 8, WGM = 8;

__host__ __device__ __forceinline__ int lds_byte(int r, int c) { const int st = (r >> 4) * 2 + (c >> 5), rr = r & 15, cc = c & 31, ob = rr * 64 + cc * 2; return st * 1024 + (ob ^ (((ob >> 9) & 1) << 5)); }
__host__ __device__ __forceinline__ void stage_rc(int b, int& R, int& C) { const int st = b / 1024, sb = b % 1024, swz = sb ^ (((sb >> 9) & 1) << 5); R = (st >> 1) * 16 + swz / 64; C = (st & 1) * 32 + (swz % 64) / 2; }
__host__ __device__ __forceinline__ int perm32(int rho) { const int n = rho >> 4, i = rho & 15; return 8 * (i >> 2) + 4 * n + (i & 3); }

struct Unit { int pm, pn; };
struct Gemm { const bf16_t* A; const bf16_t* Bt; int M, N, K; };

struct StaticOrder {
    int nM, nN, nwg, G, c;
    __host__ __device__ void init(int M, int N, int G_, int c_) { nM = M / BM; nN = N / BM; nwg = nM * nN; G = G_; c = c_; }
    __host__ __device__ bool next(int i, Unit& u) const {
        const long L = (long)i * G + c; if (L >= nwg) return false;
        int wgid = (int)L; { const int q = nwg / NXCD, r = nwg % NXCD, xcd = wgid % NXCD, off = wgid / NXCD; wgid = (xcd < r ? xcd * (q + 1) : r * (q + 1) + (xcd - r) * q) + off; }
        const int nig = WGM * nN, gid = wgid / nig, fm = gid * WGM, gsz = (nM - fm) < WGM ? (nM - fm) : WGM;
        u.pm = fm + ((wgid % nig) % gsz); u.pn = (wgid % nig) / gsz; return true;
    }
    __device__ __forceinline__ void a_ready(const Unit&) const {}
    __device__ __forceinline__ void done(const Unit&) const {}
};

__device__ __forceinline__ unsigned cvt_pk_bf16(float lo, float hi) { unsigned r; asm volatile("v_cvt_pk_bf16_f32 %0, %1, %2" : "=v"(r) : "v"(lo), "v"(hi)); return r; }
__device__ __forceinline__ u32x4 pack8(const f32x4& a, const f32x4& b) { u32x4 w; w.x = cvt_pk_bf16(a[0], a[1]); w.y = cvt_pk_bf16(a[2], a[3]); w.z = cvt_pk_bf16(b[0], b[1]); w.w = cvt_pk_bf16(b[2], b[3]); return w; }

struct EpiStore8 {
    static constexpr bool PERM = false, AFTER_DRAIN = false;
    bf16_t* O; int ldc; int split_cols; size_t split_stride; float scale0; int pn_mask;
    __device__ __forceinline__ void operator()(const f32x4 (&acc)[2][2][4][2], const Unit& u, int wr, int wc, int fr, int fq) const {
        const int row0 = u.pm * BM + wr * 64 + fr; int colt = (u.pn & pn_mask) * BM; bf16_t* base = O;
        float sc = 1.f; if (split_cols) { const int t = colt / split_cols; base += (size_t)t * split_stride; colt -= t * split_cols; if (t == 0) sc = scale0; }
        const int col0 = colt + wc * 32 + 8 * fq;
#pragma unroll
        for (int ai = 0; ai < 2; ++ai)
#pragma unroll
            for (int m = 0; m < 4; ++m) { bf16_t* rowp = base + (size_t)(row0 + ai * HALF + m * 16) * ldc + col0;
#pragma unroll
                for (int bj = 0; bj < 2; ++bj) { const f32x4 v0 = acc[ai][bj][m][0] * sc, v1 = acc[ai][bj][m][1] * sc; *(u32x4*)(rowp + bj * HALF) = pack8(v0, v1); } }
    }
};
__device__ __forceinline__ float silu_f(float g) { return g * __builtin_amdgcn_rcpf(1.f + __expf(-g)); }
struct EpiSwiglu {
    static constexpr bool PERM = false, AFTER_DRAIN = false;
    bf16_t* O;
    __device__ __forceinline__ void operator()(const f32x4 (&acc)[2][2][4][2], const Unit& u, int wr, int wc, int fr, int fq) const {
        const int row0 = u.pm * BM + wr * 64 + fr; const int col0 = (u.pn & 3) * 128 + wc * 32 + 8 * fq;
#pragma unroll
        for (int ai = 0; ai < 2; ++ai)
#pragma unroll
            for (int m = 0; m < 4; ++m) { bf16_t* rowp = O + (size_t)(row0 + ai * HALF + m * 16) * 512 + col0; f32x4 h[2];
#pragma unroll
                for (int n = 0; n < 2; ++n) { const f32x4 g = acc[ai][0][m][n], up = acc[ai][1][m][n];
                    h[n] = (f32x4){silu_f(g[0]) * up[0], silu_f(g[1]) * up[1], silu_f(g[2]) * up[2], silu_f(g[3]) * up[3]}; }
                *(u32x4*)rowp = pack8(h[0], h[1]); }
    }
};
struct EpiGqaQkv {
    static constexpr bool PERM = false, AFTER_DRAIN = false;
    bf16_t *Q, *K, *V; const float* qn; const float* kn; const float* cs; const float* sn; float qscale;
    __device__ __forceinline__ void operator()(const f32x4 (&acc)[2][2][4][2], const Unit& u, int wr, int wc, int fr, int fq) const {
        const int row0 = u.pm * BM + wr * 64 + fr; const int pn = u.pn;
        const int type = pn < 4 ? 0 : (pn == 4 ? 1 : 2);
        bf16_t* base = type == 0 ? Q + (4 * pn + wc) * 64 : (type == 1 ? K : V) + wc * 64; const int ldc = type == 0 ? 1024 : 256;
        const int dlo = 32 * (fq >> 1) + 8 * (fq & 1);
        const int tlo = (fq >> 1) * 16 + 8 * (fq & 1);
        const float* gain = type == 0 ? qn : kn; const float sc = type == 0 ? qscale : 1.f;
        f32x4 gv[2][2];
#pragma unroll
        for (int bj = 0; bj < 2; ++bj)
#pragma unroll
            for (int n = 0; n < 2; ++n) gv[bj][n] = *(const f32x4*)(gain + dlo + 16 * bj + 4 * n) * sc;
#pragma unroll
        for (int ai = 0; ai < 2; ++ai)
#pragma unroll
            for (int m = 0; m < 4; ++m) { const int row = row0 + ai * HALF + m * 16; bf16_t* rowp = base + (size_t)row * ldc + dlo; f32x4 o[2][2];
                if (type < 2) {
                    float ss = 0.f;
#pragma unroll
                    for (int bj = 0; bj < 2; ++bj)
#pragma unroll
                        for (int n = 0; n < 2; ++n) { const f32x4 x = acc[ai][bj][m][n]; ss += (x[0] * x[0] + x[1] * x[1]) + (x[2] * x[2] + x[3] * x[3]); }
                    ss += __shfl_xor(ss, 16); ss += __shfl_xor(ss, 32);
                    const float rinv = rsqrtf(ss * (1.f / 64.f) + 1e-6f);
                    const int t = row & 2047;
#pragma unroll
                    for (int n = 0; n < 2; ++n) { const f32x4 c4 = *(const f32x4*)(cs + t * 32 + tlo + 4 * n), s4 = *(const f32x4*)(sn + t * 32 + tlo + 4 * n);
                        const f32x4 x1 = acc[ai][0][m][n] * rinv * gv[0][n], x2 = acc[ai][1][m][n] * rinv * gv[1][n];
                        o[0][n] = x1 * c4 - x2 * s4; o[1][n] = x2 * c4 + x1 * s4; }
                } else {
#pragma unroll
                    for (int bj = 0; bj < 2; ++bj)
#pragma unroll
                        for (int n = 0; n < 2; ++n) o[bj][n] = acc[ai][bj][m][n];
                }
#pragma unroll
                for (int bj = 0; bj < 2; ++bj) *(u32x4*)(rowp + 16 * bj) = pack8(o[bj][0], o[bj][1]); }
    }
};
template <class Epi, class Sched, bool ALIGN_EPI = false, bool SP2 = false, bool GATHER = false>
__device__ __forceinline__ void gemm_phase(PG8_LAS unsigned char* lds, const Gemm g, const Sched& S, const Epi& E) {
    int tid_ = threadIdx.x; asm volatile("" : "+v"(tid_)); const int tid = tid_, wid = __builtin_amdgcn_readfirstlane(tid >> 6), lane = tid & 63, wr = wid >> 2, wc = wid & 3, fr = lane & 15, fq = lane >> 4;
    const int K = g.K, nt = K / BK;
    unsigned voffA[2], voffB[2];
#pragma unroll
    for (int i = 0; i < 2; ++i) { int R, C; stage_rc(tid * 16 + i * 8192, R, C); const int Rb = Epi::PERM ? ((R & ~31) + perm32(R & 31)) : R;
        voffA[i] = (unsigned)(R * K + C) * 2u; voffB[i] = (unsigned)(Rb * K + C) * 2u; }
    static_assert(!GATHER || SP2, "row gather is wired into the SP2 loop only");
    unsigned vAc[2][2], vAn[2][2], vA2[2][2];
    int gR[2], gC[2];
#pragma unroll
    for (int i = 0; i < 2; ++i) { int R, C; stage_rc(tid * 16 + i * 8192, R, C); gR[i] = R; gC[i] = C; }
#define PG8_ROWOFF(dst, u) do { if constexpr (GATHER) { _Pragma("unroll") for (int h_ = 0; h_ < 2; ++h_) _Pragma("unroll") for (int i_ = 0; i_ < 2; ++i_) \
        dst[h_][i_] = ((unsigned)S.arow(u, h_ * HALF + gR[i_]) * (unsigned)K + (unsigned)gC[i_]) * 2u; } } while (0)
    const size_t kstep = (size_t)(BK * 2);
    const size_t hstep = (size_t)HALF * K * 2;
    const size_t tstep = 2 * hstep;
    const unsigned ldsw = (unsigned)wid * 1024u;
    const int aoff = lds_byte(wr * 64 + fr, fq * 8), boff = lds_byte(wc * 32 + fr, fq * 8);
#define PG8_SA(b, h) (((b) * 2 + (h)) * HTB)
#define PG8_SB(b, h) ((4 + (b) * 2 + (h)) * HTB)
#define PG8_STAGE(bufoff, gbase, voff) do { _Pragma("unroll") for (int _i = 0; _i < 2; ++_i) \
        __builtin_amdgcn_global_load_lds((const unsigned*)((const char*)(gbase) + (voff)[_i]), (PG8_LAS unsigned*)(lds + (bufoff) + ldsw + _i * 8192), 16, 0, 0); } while (0)
#define PG8_STAGE_A(bufoff, base, h, W) do { if constexpr (GATHER) { PG8_STAGE(bufoff, base, W[h]); } else { PG8_STAGE(bufoff, (base) + (h) * hstep, voffA); } } while (0)
#define PG8_LDA(dst, b, h) do { _Pragma("unroll") for (int m = 0; m < 4; ++m) _Pragma("unroll") for (int k = 0; k < 2; ++k) dst[m][k] = *(const PG8_LAS bf16x8*)(lds + PG8_SA(b, h) + aoff + m * 2048 + k * 1024); } while (0)
#define PG8_LDB(dst, b, h) do { _Pragma("unroll") for (int n = 0; n < 2; ++n) _Pragma("unroll") for (int k = 0; k < 2; ++k) dst[n][k] = *(const PG8_LAS bf16x8*)(lds + PG8_SB(b, h) + boff + n * 2048 + k * 1024); } while (0)
#define PG8_MMA(ai, bj, At, Bt) do { __builtin_amdgcn_s_setprio(1); _Pragma("unroll") for (int m = 0; m < 4; ++m) _Pragma("unroll") for (int n = 0; n < 2; ++n) _Pragma("unroll") for (int k = 0; k < 2; ++k) \
        acc[ai][bj][m][n] = __builtin_amdgcn_mfma_f32_16x16x32_bf16(Bt[n][k], At[m][k], acc[ai][bj][m][n], 0, 0, 0); __builtin_amdgcn_s_setprio(0); } while (0)
#define PG8_WAIT_V(n) asm volatile("s_waitcnt vmcnt(" #n ")" ::: "memory")
#define PG8_WAIT_L(n) asm volatile("s_waitcnt lgkmcnt(" #n ")" ::: "memory")
#define PG8_BAR __builtin_amdgcn_s_barrier()
#define PG8_SCHED __builtin_amdgcn_sched_barrier(0)
    Unit cur, nxt; int ui = 0;
    if (!S.next(0, cur)) return;
    f32x4 acc[2][2][4][2];
#pragma unroll
    for (int a = 0; a < 2; ++a)
#pragma unroll
        for (int b = 0; b < 2; ++b)
#pragma unroll
            for (int m = 0; m < 4; ++m)
#pragma unroll
                for (int n = 0; n < 2; ++n) acc[a][b][m][n] = (f32x4){0.f, 0.f, 0.f, 0.f};
    bf16x8 At[4][2], B0[2][2], B1[2][2];
    const char* cA = (const char*)g.A + (GATHER ? (size_t)0 : (size_t)cur.pm * tstep); PG8_ROWOFF(vAc, cur); const char* cB = (const char*)g.Bt + (size_t)cur.pn * tstep;
    S.a_ready(cur);
    if constexpr (SP2) {
        PG8_STAGE(PG8_SB(0, 0), cB, voffB); PG8_STAGE(PG8_SB(0, 1), cB + hstep, voffB); PG8_STAGE_A(PG8_SA(0, 0), cA, 0, vAc); PG8_STAGE_A(PG8_SA(0, 1), cA, 1, vAc);
        if (wr == 1) PG8_BAR;
        PG8_WAIT_V(2); PG8_BAR;
        PG8_STAGE(PG8_SB(1, 0), cB + kstep, voffB); PG8_STAGE_A(PG8_SA(1, 0), cA + kstep, 0, vAc); PG8_STAGE(PG8_SB(1, 1), cB + hstep + kstep, voffB);
        PG8_WAIT_V(6); PG8_BAR;
    } else {
        PG8_STAGE(PG8_SB(0, 0), cB, voffB); PG8_STAGE(PG8_SA(0, 0), cA, voffA); PG8_STAGE(PG8_SB(0, 1), cB + hstep, voffB); PG8_STAGE(PG8_SA(0, 1), cA + hstep, voffA);
        if (wr == 1) PG8_BAR;
        PG8_WAIT_V(4); PG8_BAR;
        PG8_STAGE(PG8_SB(1, 0), cB + kstep, voffB); PG8_STAGE(PG8_SA(1, 0), cA + kstep, voffA); PG8_STAGE(PG8_SB(1, 1), cB + hstep + kstep, voffB);
        PG8_WAIT_V(6); PG8_BAR;
    }
    for (;;) {
        const bool has_next = S.next(ui + 1, nxt);
        const char* nA = has_next ? (const char*)g.A + (GATHER ? (size_t)0 : (size_t)nxt.pm * tstep) : cA;
        if constexpr (GATHER) { if (has_next) { PG8_ROWOFF(vAn, nxt); } else { _Pragma("unroll") for (int h_ = 0; h_ < 2; ++h_) _Pragma("unroll") for (int i_ = 0; i_ < 2; ++i_) vAn[h_][i_] = vAc[h_][i_]; } } const char* nB = has_next ? (const char*)g.Bt + (size_t)nxt.pn * tstep : cB;
        for (int t = 0; t < nt; t += 2) {
            const bool last = (t == nt - 2);
            const char* a1 = cA + (size_t)(t + 1) * kstep;
            const char* a2 = last ? nA : cA + (size_t)(t + 2) * kstep; const char* b2 = last ? nB : cB + (size_t)(t + 2) * kstep;
            const char* a3 = a2 + kstep; const char* b3 = b2 + kstep;
            if constexpr (GATHER) { _Pragma("unroll") for (int h_ = 0; h_ < 2; ++h_) _Pragma("unroll") for (int i_ = 0; i_ < 2; ++i_) vA2[h_][i_] = last ? vAn[h_][i_] : vAc[h_][i_]; }
            if (last && has_next) S.a_ready(nxt);
            if constexpr (SP2) {
            PG8_LDB(B0, 0, 0); PG8_LDB(B1, 0, 1); PG8_SCHED; PG8_LDA(At, 0, 0); PG8_STAGE_A(PG8_SA(1, 1), a1, 1, vAc);
            PG8_WAIT_V(8); PG8_WAIT_L(0); PG8_BAR; PG8_MMA(0, 0, At, B0); PG8_MMA(0, 1, At, B1); PG8_BAR; PG8_SCHED;
            PG8_LDA(At, 0, 1); PG8_STAGE(PG8_SB(0, 0), b2, voffB); PG8_STAGE(PG8_SB(0, 1), b2 + hstep, voffB); PG8_STAGE_A(PG8_SA(0, 0), a2, 0, vA2);
            PG8_WAIT_V(8); PG8_WAIT_L(0); PG8_BAR; PG8_MMA(1, 0, At, B0); PG8_MMA(1, 1, At, B1); PG8_BAR; PG8_SCHED;
            PG8_LDB(B0, 1, 0); PG8_LDB(B1, 1, 1); PG8_SCHED; PG8_LDA(At, 1, 0); PG8_STAGE_A(PG8_SA(0, 1), a2, 1, vA2);
            PG8_WAIT_V(8); PG8_WAIT_L(0); PG8_BAR; PG8_MMA(0, 0, At, B0); PG8_MMA(0, 1, At, B1); PG8_BAR; PG8_SCHED;
            PG8_LDA(At, 1, 1); PG8_STAGE(PG8_SB(1, 0), b3, voffB); PG8_STAGE(PG8_SB(1, 1), b3 + hstep, voffB); PG8_STAGE_A(PG8_SA(1, 0), a3, 0, vA2);
            PG8_WAIT_V(8); PG8_WAIT_L(0); PG8_BAR; PG8_MMA(1, 0, At, B0); PG8_MMA(1, 1, At, B1); PG8_BAR; PG8_SCHED;
            } else {
            PG8_LDB(B0, 0, 0); PG8_SCHED; PG8_LDA(At, 0, 0); PG8_STAGE(PG8_SA(1, 1), a1 + hstep, voffA);
            PG8_WAIT_L(8); PG8_BAR; PG8_WAIT_L(0); PG8_MMA(0, 0, At, B0); PG8_BAR; PG8_SCHED;
            PG8_LDB(B1, 0, 1); PG8_STAGE(PG8_SB(0, 0), b2, voffB);
            PG8_BAR; PG8_WAIT_L(0); PG8_MMA(0, 1, At, B1); PG8_BAR;
            PG8_LDA(At, 0, 1); PG8_STAGE(PG8_SA(0, 0), a2, voffA);
            PG8_BAR; PG8_WAIT_L(0); PG8_MMA(1, 0, At, B0); PG8_BAR; PG8_SCHED;
            PG8_STAGE(PG8_SB(0, 1), b2 + hstep, voffB);
            PG8_WAIT_V(6); PG8_BAR; PG8_MMA(1, 1, At, B1); PG8_BAR;
            PG8_LDB(B0, 1, 0); PG8_SCHED; PG8_LDA(At, 1, 0); PG8_STAGE(PG8_SA(0, 1), a2 + hstep, voffA);
            PG8_WAIT_L(8); PG8_BAR; PG8_WAIT_L(0); PG8_MMA(0, 0, At, B0); PG8_BAR; PG8_SCHED;
            PG8_LDB(B1, 1, 1); PG8_STAGE(PG8_SB(1, 0), b3, voffB);
            PG8_BAR; PG8_WAIT_L(0); PG8_MMA(0, 1, At, B1); PG8_BAR;
            PG8_LDA(At, 1, 1); PG8_STAGE(PG8_SA(1, 0), a3, voffA);
            PG8_BAR; PG8_WAIT_L(0); PG8_MMA(1, 0, At, B0); PG8_BAR; PG8_SCHED;
            PG8_STAGE(PG8_SB(1, 1), b3 + hstep, voffB);
            PG8_WAIT_V(6); PG8_BAR; PG8_MMA(1, 1, At, B1); PG8_BAR;
            }
        }
        if constexpr (ALIGN_EPI) { if (wr == 0) PG8_BAR; }
        if constexpr (!Epi::AFTER_DRAIN) { E(acc, cur, wr, wc, fr, fq); S.done(cur); }
        if (!has_next) break;
#pragma unroll
        for (int a = 0; a < 2; ++a)
#pragma unroll
            for (int b = 0; b < 2; ++b)
#pragma unroll
                for (int m = 0; m < 4; ++m)
#pragma unroll
                    for (int n = 0; n < 2; ++n) acc[a][b][m][n] = (f32x4){0.f, 0.f, 0.f, 0.f};
        cur = nxt; cA = nA; cB = nB; ++ui;
        if constexpr (GATHER) { _Pragma("unroll") for (int h_ = 0; h_ < 2; ++h_) _Pragma("unroll") for (int i_ = 0; i_ < 2; ++i_) vAc[h_][i_] = vAn[h_][i_]; }
        if constexpr (ALIGN_EPI) { if (wr == 1) PG8_BAR; }
    }
    PG8_WAIT_V(0);
    if constexpr (!ALIGN_EPI) { if (wr == 0) PG8_BAR; }
    PG8_BAR;
    if constexpr (Epi::AFTER_DRAIN) { E.fused(acc, cur, wr, wc, fr, fq, lds, wid, lane); S.done(cur); }
#undef PG8_SA
#undef PG8_SB
#undef PG8_STAGE
#undef PG8_STAGE_A
#undef PG8_ROWOFF
#undef PG8_LDA
#undef PG8_LDB
#undef PG8_MMA
#undef PG8_WAIT_V
#undef PG8_WAIT_L
#undef PG8_BAR
#undef PG8_SCHED
}
}
#include <hip/hip_bf16.h>
#include <cmath>
namespace attn_body {
using bf16=__hip_bfloat16;
using bf16x8=__attribute__((ext_vector_type(8)))short;
using s16x4=__attribute__((ext_vector_type(4)))short;
using f32x16=__attribute__((ext_vector_type(16)))float;
using u32x4=__attribute__((ext_vector_type(4)))unsigned;
constexpr int BATCH=8,NHEAD=16,SEQ=2048,D=64,DM=NHEAD*D,KVP=256;
constexpr int NW=8,QBLK=32,QB=QBLK*NW,KVBLK=64,NQB=SEQ/QB;
constexpr int ATTN_PITCH=DM, ATTN_UNIT_ROWS=QB;
__device__ __forceinline__ int crow(int r,int hi){return (r&3)+8*(r>>2)+4*hi;}
#define SBAR() __builtin_amdgcn_sched_barrier(0)
__device__ __forceinline__ void cmask(f32x16&p0,f32x16&p1,int jb,int qrel,int hi){
  const float NEG=-INFINITY; int kb=64*jb+4*hi;
  #pragma unroll
  for(int r=0;r<16;++r){int kv=kb+(r&3)+8*(r>>2); if(kv>qrel)p0[r]=NEG; if(kv+32>qrel)p1[r]=NEG;}
}

constexpr int NSLOT=3, SLOTB=8192;
constexpr int LDS_K=0, LDS_V=NSLOT*SLOTB, LDS_WS=2*NSLOT*SLOTB, LDS_OST=LDS_WS+NW*64*4, LDS_BYTES=LDS_OST+NW*4096;
constexpr float C2=0.125f*1.4426950408889634f;
__device__ __forceinline__ void glds16(const void*gsrc,unsigned lds_dst){unsigned keep;
  asm volatile("s_mov_b32 %0, m0\n\ts_mov_b32 m0, %2\n\ts_nop 0\n\tglobal_load_lds_dwordx4 %1, off\n\ts_mov_b32 m0, %0":"=&s"(keep):"v"(gsrc),"s"(lds_dst):"memory");}
__device__ __forceinline__ float max3f(float a,float b,float c){float r;asm("v_max3_f32 %0, %1, %2, %3":"=v"(r):"v"(a),"v"(b),"v"(c));return r;}
__device__ __forceinline__ float max2f(float a,float b){float r;asm("v_max_f32_e32 %0, %1, %2":"=v"(r):"v"(a),"v"(b));return r;}
__device__ __forceinline__ float fadd_s(float a,float b){float r;asm("v_add_f32_e32 %0, %1, %2":"=v"(r):"v"(a),"v"(b));return r;}
__device__ __forceinline__ float fsub_s(float a,float b){float r;asm("v_sub_f32_e32 %0, %1, %2":"=v"(r):"v"(a),"v"(b));return r;}
typedef float f32x2_t __attribute__((ext_vector_type(2))); typedef __bf16 bf16x2_t __attribute__((ext_vector_type(2)));
__device__ __forceinline__ unsigned cvtpk_s(float lo,float hi){f32x2_t v={lo,hi};bf16x2_t b=__builtin_convertvector(v,bf16x2_t);return __builtin_bit_cast(unsigned,b);}
#define WAIT_BAR(N) asm volatile("s_waitcnt vmcnt(" #N ") lgkmcnt(0)\n\ts_barrier":::"memory")

__device__ __forceinline__ void qkt(f32x16&p0,f32x16&p1,const char*Kslot,const bf16x8*qr,const f32x16&negm,int r32,int hi){
  const char*kb=Kslot+hi*1024+r32*16;
  #pragma unroll
  for(int d0=0;d0<4;++d0){
    const bf16x8 b0=*reinterpret_cast<const bf16x8*>(kb+d0*2048);
    const bf16x8 b1=*reinterpret_cast<const bf16x8*>(kb+d0*2048+512);
    if(d0==0){p0=__builtin_amdgcn_mfma_f32_32x32x16_bf16(b0,qr[0],negm,0,0,0);p1=__builtin_amdgcn_mfma_f32_32x32x16_bf16(b1,qr[0],negm,0,0,0);}
    else{p0=__builtin_amdgcn_mfma_f32_32x32x16_bf16(b0,qr[d0],p0,0,0,0);p1=__builtin_amdgcn_mfma_f32_32x32x16_bf16(b1,qr[d0],p1,0,0,0);}}
}
typedef __attribute__((address_space(3))) const char* lds_cptr;
typedef short v4i16_t __attribute__((ext_vector_type(4)));
__device__ __forceinline__ void kload8(bf16x8*kf,lds_cptr kp){
  kf[0]=*(const __attribute__((address_space(3))) bf16x8*)(kp);      kf[1]=*(const __attribute__((address_space(3))) bf16x8*)(kp+512);
  kf[2]=*(const __attribute__((address_space(3))) bf16x8*)(kp+2048); kf[3]=*(const __attribute__((address_space(3))) bf16x8*)(kp+2560);
  kf[4]=*(const __attribute__((address_space(3))) bf16x8*)(kp+4096); kf[5]=*(const __attribute__((address_space(3))) bf16x8*)(kp+4608);
  kf[6]=*(const __attribute__((address_space(3))) bf16x8*)(kp+6144); kf[7]=*(const __attribute__((address_space(3))) bf16x8*)(kp+6656);
}
__device__ __forceinline__ void kload2(bf16x8*kf,lds_cptr kp,int j){ kf[2*j]=*(const __attribute__((address_space(3))) bf16x8*)(kp+j*2048); kf[2*j+1]=*(const __attribute__((address_space(3))) bf16x8*)(kp+j*2048+512); }
__device__ __forceinline__ s16x4 vtr(lds_cptr p){ return __builtin_bit_cast(s16x4,__builtin_amdgcn_ds_read_tr16_b64_v4i16((__attribute__((address_space(3))) v4i16_t*)p)); }
__device__ __forceinline__ float rowmax(const f32x16&p0,const f32x16&p1){
  float a=max3f(p0[0],p0[1],p1[0]),b=max3f(p0[2],p0[3],p1[1]);a=max3f(a,p1[2],p1[3]);
  #pragma unroll
  for(int r=4;r<16;r+=4){a=max3f(a,p0[r],p0[r+1]);b=max3f(b,p0[r+2],p0[r+3]);a=max3f(a,p1[r],p1[r+1]);b=max3f(b,p1[r+2],p1[r+3]);}
  const float m=max2f(a,b);
  auto rr=__builtin_amdgcn_permlane32_swap(__float_as_uint(m),__float_as_uint(m),false,false);
  return max2f(__uint_as_float(rr[0]),__uint_as_float(rr[1]));
}
__device__ __forceinline__ void pv(f32x16*o,int vb,bf16x8 pa0,bf16x8 pa1,bf16x8 pa2,bf16x8 pa3){
  #pragma unroll
  for(int d0=0;d0<2;++d0){s16x4 lo[4],hi[4];
    #pragma unroll
    for(int ks=0;ks<4;++ks){
      asm volatile("ds_read_b64_tr_b16 %0,%1 offset:%c2":"=&v"(lo[ks]):"v"(vb),"i"(d0*4096+ks*1024):"memory");
      asm volatile("ds_read_b64_tr_b16 %0,%1 offset:%c2":"=&v"(hi[ks]):"v"(vb),"i"(d0*4096+ks*1024+512):"memory");}
    asm volatile("s_waitcnt lgkmcnt(0)":::"memory");SBAR();
    #define PK(k) (bf16x8){lo[k][0],lo[k][1],lo[k][2],lo[k][3],hi[k][0],hi[k][1],hi[k][2],hi[k][3]}
    o[d0]=__builtin_amdgcn_mfma_f32_32x32x16_bf16(pa0,PK(0),o[d0],0,0,0);
    o[d0]=__builtin_amdgcn_mfma_f32_32x32x16_bf16(pa1,PK(1),o[d0],0,0,0);
    o[d0]=__builtin_amdgcn_mfma_f32_32x32x16_bf16(pa2,PK(2),o[d0],0,0,0);
    o[d0]=__builtin_amdgcn_mfma_f32_32x32x16_bf16(pa3,PK(3),o[d0],0,0,0);
    #undef PK
  }
}

#ifndef ATTN_STORE16
#define ATTN_STORE16(p,v) (*(u32x4*)(p)=(v))
#endif
template<int THRL> __device__ __forceinline__ void attn_unit(int b,int h,int qb,const bf16*Q,const bf16*__restrict__ K,const bf16*__restrict__ V,bf16*O,char*shm){
  int tid_=threadIdx.x; asm volatile("":"+v"(tid_)); const int tid=tid_,lane=tid&63,r32=lane&31,hi=lane>>5; const int wid=__builtin_amdgcn_readfirstlane(tid>>6);
  const long rowbase=(long)b*SEQ; const int q0=qb*QB;
  const bf16*Qw=Q+(rowbase+q0+wid*QBLK)*DM+h*D;
  const bf16*Kh=K+rowbase*KVP+(h>>2)*D,*Vh=V+rowbase*KVP+(h>>2)*D;
  const unsigned lds0=(unsigned)(uintptr_t)shm;
  float*wsf=(float*)(shm+LDS_WS)+wid*64;
  const bf16*ksrc=Kh+(long)lane*KVP+wid*8;
  const bf16*vsrc=Vh+(long)(16*(wid&3)+(lane>>2))*KVP+(wid>>2)*32+(lane&3)*8;
  const unsigned kdst=lds0+LDS_K+wid*1024, vdst=lds0+LDS_V+wid*1024;
  #define DMA_K(t,slot) glds16(ksrc+(long)(t)*KVBLK*KVP,(unsigned)__builtin_amdgcn_readfirstlane(kdst+(slot)))
  #define DMA_V(t,slot) glds16(vsrc+(long)(t)*KVBLK*KVP,(unsigned)__builtin_amdgcn_readfirstlane(vdst+(slot)))
  const int vb0=(int)(lds0+LDS_V)+((lane>>4)&1)*32+(lane&3)*8+(4*hi+((lane&15)>>2))*64;
  const char*Kbase=shm+LDS_K; bf16x8 kf[8];
  const lds_cptr shm3=(lds_cptr)shm; const lds_cptr kp0=shm3+LDS_K+hi*1024+r32*16; const lds_cptr vp0=shm3+LDS_V+((lane>>4)&1)*32+(lane&3)*8+(4*hi+((lane&15)>>2))*64;
  const int NT=SEQ/KVBLK;
  DMA_K(0,0);DMA_V(0,0);DMA_K(1,SLOTB);
  bf16x8 qr[4];
  #pragma unroll
  for(int d0=0;d0<4;++d0)qr[d0]=*reinterpret_cast<const bf16x8*>(&Qw[(long)r32*DM+d0*16+hi*8]);
  float mhat=0.f,l_reg=0.f;f32x16 o[2];o[0]=f32x16{};o[1]=f32x16{};f32x16 negm=f32x16{};asm volatile("":"+v"(negm));
  const int qrel=wid*QBLK+r32;
  #define CMASK(P0,P1,t) do{}while(0)
  bool resc=false;
  #define START(P0,P1) do{ const float rm=rowmax(P0,P1); resc=false; \
    { const float dl=rm; mhat=fadd_s(mhat,dl); \
      _Pragma("unroll") for(int r=0;r<16;++r){P0[r]=fsub_s(P0[r],dl);P1[r]=fsub_s(P1[r],dl);} \
      _Pragma("unroll") for(int r=0;r<16;++r)negm[r]=-mhat; asm volatile("":"+v"(negm)); } \
    _Pragma("unroll") for(int r=0;r<16;++r)P0[r]=__builtin_amdgcn_exp2f(P0[r]); }while(0)
  #define RESC() do{ if(resc){ asm volatile("s_waitcnt lgkmcnt(0)":::"memory"); \
      _Pragma("unroll") for(int d_=0;d_<2;++d_) _Pragma("unroll") for(int r=0;r<16;++r)o[d_][r]*=wsf[crow(r,hi)]; } }while(0)
  f32x16 pA0,pA1,pB0,pB1;
  int sl_prev=0,sl_cur=0,sl_next=SLOTB;
  #define ROT() do{sl_prev=sl_cur;sl_cur=sl_next;sl_next=(sl_next==(NSLOT-1)*SLOTB)?0:sl_next+SLOTB;}while(0)
  DMA_K(2,2*SLOTB);
  WAIT_BAR(3);
  qkt(pA0,pA1,Kbase,qr,negm,r32,hi);asm volatile("s_nop 15\n\ts_nop 7":"+v"(pA0),"+v"(pA1));CMASK(pA0,pA1,0);
  START(pA0,pA1);
  _Pragma("unroll") for(int r=0;r<16;++r)pA1[r]=__builtin_amdgcn_exp2f(pA1[r]);
  WAIT_BAR(0);
  DMA_K(3,0);DMA_V(1,SLOTB);
  ROT();
  kload8(kf,kp0+sl_cur);
  WAIT_BAR(2);
  s16x4 vlo[8],vhi[8]; u32x4 pw0,pw1,pw2,pw3;
  #define PKW(P,B) cvtpk_s(P[B],P[B+1])
  #define PAF(k) __builtin_bit_cast(bf16x8,pw##k)
  #define VFR(i) (bf16x8){vlo[i][0],vlo[i][1],vlo[i][2],vlo[i][3],vhi[i][0],vhi[i][1],vhi[i][2],vhi[i][3]}
  #define PIN(x) asm volatile("":"+v"(x))
  #define MX3(a,b,c) __builtin_fmaxf(__builtin_fmaxf((a),(b)),(c))
  #define GAPA(MF,A0,A1,A2,A3,W0,W1,PW) do{ MF; sacc+=A0; sacc+=A1; sacc+=A2; sacc+=A3; PIN(sacc); W0; W1; PIN(PW); SBAR(); }while(0)
  #define EX(v) __builtin_amdgcn_exp2f(v)
  #define GAPB(MF,X,B) do{ MF; X[B]=EX(X[B]); X[B+1]=EX(X[B+1]); X[B+2]=EX(X[B+2]); X[B+3]=EX(X[B+3]); PIN(X); SBAR(); }while(0)
  #define VRD(i) do{ vlo[i]=vtr(vp_+(((i)>>2)*4096+((i)&3)*1024)); vhi[i]=vtr(vp_+(((i)>>2)*4096+((i)&3)*1024+512)); }while(0)
  #define KRD(G,j) do{ if(G){ kload2(kf,kp0+sl_next,j); SBAR(); } }while(0)
  #define STEP(C0,C1,P0,P1,t,GK,GV,GL) do{ SBAR(); \
    const lds_cptr vp_=vp0+sl_prev; \
    VRD(0); SBAR(); float sacc=(P0[0]+P0[1]); \
    GAPA(C0=__builtin_amdgcn_mfma_f32_32x32x16_bf16(kf[0],qr[0],negm,0,0,0), P0[2],P0[3],P0[4],P0[5],     pw0[0]=PKW(P0,0), pw0[1]=PKW(P0,2), pw0); \
    VRD(4); SBAR(); GAPA(C1=__builtin_amdgcn_mfma_f32_32x32x16_bf16(kf[1],qr[0],negm,0,0,0), P0[6],P0[7],P0[8],P0[9],     pw0[2]=PKW(P0,4), pw0[3]=PKW(P0,6), pw0); \
    VRD(1); SBAR(); GAPA(C0=__builtin_amdgcn_mfma_f32_32x32x16_bf16(kf[2],qr[1],C0,0,0,0),   P0[10],P0[11],P0[12],P0[13], pw1[0]=PKW(P0,8), pw1[1]=PKW(P0,10), pw1); \
    VRD(5); SBAR(); GAPA(C1=__builtin_amdgcn_mfma_f32_32x32x16_bf16(kf[3],qr[1],C1,0,0,0),   P0[14],P0[15],P1[0],P1[1],   pw1[2]=PKW(P0,12),pw1[3]=PKW(P0,14), pw1); \
    VRD(2); SBAR(); GAPA(C0=__builtin_amdgcn_mfma_f32_32x32x16_bf16(kf[4],qr[2],C0,0,0,0),   P1[2],P1[3],P1[4],P1[5],     pw2[0]=PKW(P1,0), pw2[1]=PKW(P1,2), pw2); \
    VRD(6); SBAR(); GAPA(C1=__builtin_amdgcn_mfma_f32_32x32x16_bf16(kf[5],qr[2],C1,0,0,0),   P1[6],P1[7],P1[8],P1[9],     pw2[2]=PKW(P1,4), pw2[3]=PKW(P1,6), pw2); \
    VRD(3); SBAR(); GAPA(C0=__builtin_amdgcn_mfma_f32_32x32x16_bf16(kf[6],qr[3],C0,0,0,0),   P1[10],P1[11],P1[12],P1[13], pw3[0]=PKW(P1,8), pw3[1]=PKW(P1,10), pw3); \
    VRD(7); SBAR(); GAPA(C1=__builtin_amdgcn_mfma_f32_32x32x16_bf16(kf[7],qr[3],C1,0,0,0),   P1[14],P1[15],0.f,0.f,       pw3[2]=PKW(P1,12),pw3[3]=PKW(P1,14), pw3); \
    l_reg+=sacc; \
    if(GK){DMA_K((t)+3,sl_cur);} if(GV){DMA_V((t)+1,sl_next);} \
    CMASK(C0,C1,t); \
    { float a=MX3(C0[0],C0[1],C1[0]),b=MX3(C0[2],C0[3],C1[1]); a=MX3(a,C1[2],C1[3]); \
      _Pragma("unroll") for(int r=4;r<16;r+=4){a=MX3(a,C0[r],C0[r+1]);b=MX3(b,C0[r+2],C0[r+3]);a=MX3(a,C1[r],C1[r+1]);b=MX3(b,C1[r+2],C1[r+3]);} \
      float rm=__builtin_fmaxf(a,b); { auto rr=__builtin_amdgcn_permlane32_swap(__float_as_uint(rm),__float_as_uint(rm),false,false); rm=__builtin_fmaxf(__uint_as_float(rr[0]),__uint_as_float(rr[1])); } \
      resc=false; \
      if(__builtin_expect(__any(rm>(float)THRL),0)){ const float dl=__builtin_fmaxf(rm,0.f); mhat+=dl; \
        _Pragma("unroll") for(int r=0;r<16;++r){C0[r]-=dl;C1[r]-=dl;} \
        _Pragma("unroll") for(int r=0;r<16;++r)negm[r]=-mhat; asm volatile("":"+v"(negm)); \
        const float f=__builtin_amdgcn_exp2f(-dl); l_reg*=f; if(hi==0)wsf[r32]=f; resc=true; } } \
    SBAR(); \
    GAPB(o[0]=__builtin_amdgcn_mfma_f32_32x32x16_bf16(PAF(0),VFR(0),o[0],0,0,0), C0,0); \
    GAPB(o[1]=__builtin_amdgcn_mfma_f32_32x32x16_bf16(PAF(0),VFR(4),o[1],0,0,0), C0,4); \
    KRD(GL,0); GAPB(o[0]=__builtin_amdgcn_mfma_f32_32x32x16_bf16(PAF(1),VFR(1),o[0],0,0,0), C0,8); \
    KRD(GL,1); GAPB(o[1]=__builtin_amdgcn_mfma_f32_32x32x16_bf16(PAF(1),VFR(5),o[1],0,0,0), C0,12); \
    KRD(GL,2); GAPB(o[0]=__builtin_amdgcn_mfma_f32_32x32x16_bf16(PAF(2),VFR(2),o[0],0,0,0), C1,0); \
    KRD(GL,3); GAPB(o[1]=__builtin_amdgcn_mfma_f32_32x32x16_bf16(PAF(2),VFR(6),o[1],0,0,0), C1,4); \
    GAPB(o[0]=__builtin_amdgcn_mfma_f32_32x32x16_bf16(PAF(3),VFR(3),o[0],0,0,0), C1,8); \
    GAPB(o[1]=__builtin_amdgcn_mfma_f32_32x32x16_bf16(PAF(3),VFR(7),o[1],0,0,0), C1,12); \
    }while(0)
  int t=1;
  #undef CMASK
  #define CMASK(P0,P1,t) do{}while(0)
  for(;t+5<NT;t+=2){
    STEP(pB0,pB1,pA0,pA1,t,true,true,true);     WAIT_BAR(2); RESC(); ROT();
    STEP(pA0,pA1,pB0,pB1,t+1,true,true,true);   WAIT_BAR(2); RESC(); ROT();
  }
  #undef CMASK
  #define CMASK(P0,P1,t) do{}while(0)
  #define ENDW(tt) do{ if((tt)+3<NT){WAIT_BAR(2);} else if((tt)+2<NT){WAIT_BAR(1);} else {WAIT_BAR(0);} }while(0)
  for(;t+1<NT;t+=2){
    STEP(pB0,pB1,pA0,pA1,t,(t+3<NT),(t+1<NT),(t+1<NT));       ENDW(t);   RESC(); ROT();
    STEP(pA0,pA1,pB0,pB1,t+1,(t+4<NT),(t+2<NT),(t+2<NT));     ENDW(t+1); RESC(); ROT();
  }
  STEP(pB0,pB1,pA0,pA1,NT-1,false,false,false); RESC();
  { float sacc=pB0[0]+pB0[1]; _Pragma("unroll") for(int r=2;r<16;++r)sacc+=pB0[r]; _Pragma("unroll") for(int r=0;r<16;++r)sacc+=pB1[r]; l_reg+=sacc;
    pw0=(u32x4){PKW(pB0,0),PKW(pB0,2),PKW(pB0,4),PKW(pB0,6)};pw1=(u32x4){PKW(pB0,8),PKW(pB0,10),PKW(pB0,12),PKW(pB0,14)};pw2=(u32x4){PKW(pB1,0),PKW(pB1,2),PKW(pB1,4),PKW(pB1,6)};pw3=(u32x4){PKW(pB1,8),PKW(pB1,10),PKW(pB1,12),PKW(pB1,14)};
    SBAR(); pv(o,vb0+sl_cur,PAF(0),PAF(1),PAF(2),PAF(3)); }
  #undef PKW
  #undef PAF
  #undef VFR
  #undef PIN
  #undef MX3
  #undef GAPA
  #undef GAPB
  #undef EX
  #undef VRD
  #undef KRD
  #undef STEP
  #undef ENDW
  {auto rr=__builtin_amdgcn_permlane32_swap(__float_as_uint(l_reg),__float_as_uint(l_reg),false,false);l_reg=__uint_as_float(rr[0])+__uint_as_float(rr[1]);}
  if(hi==0)wsf[32+r32]=l_reg;asm volatile("s_waitcnt lgkmcnt(0)":::"memory");
  float rli[16];
  #pragma unroll
  for(int r=0;r<16;++r)rli[r]=__builtin_amdgcn_rcpf(wsf[32+crow(r,hi)]);
  bf16*Ow=O+(rowbase+q0+wid*QBLK)*DM+h*D;
  { bf16*stg=(bf16*)(shm+LDS_OST)+wid*2048;
    #pragma unroll
    for(int r=0;r<16;++r){const int orow=crow(r,hi);
      #pragma unroll
      for(int d0=0;d0<2;++d0)stg[orow*64+d0*32+r32]=__float2bfloat16(o[d0][r]*rli[r]);}
    asm volatile("s_waitcnt lgkmcnt(0)":::"memory");
    #pragma unroll
    for(int i=0;i<4;++i){const int row=i*8+(lane>>3),ch=lane&7; const u32x4 v=*(const u32x4*)(stg+row*64+ch*8); ATTN_STORE16(Ow+(long)row*DM+ch*8,v);} }
  asm volatile("s_waitcnt lgkmcnt(0)\n\ts_barrier":::"memory");
  #undef DMA_K
  #undef DMA_V
  #undef CMASK
  #undef START
  #undef RESC
  #undef ROT
}
constexpr int ATTN_LDS_BYTES=LDS_BYTES;
struct AttnTensors { const bf16* Q; const bf16* K; const bf16* V; bf16* O; };
struct AttnUnit { int bh; int qb; };
struct StaticOrder {
  int vcu,G;
  __device__ __forceinline__ explicit StaticOrder(int grid,int block):vcu((grid%8==0)?(block%8)*(grid/8)+block/8:block),G(grid){}
  __device__ __forceinline__ bool next(int i,AttnUnit&u)const{ const int L=i*G+vcu; if(L>=1024)return false; const int xg=L>>5,w=L&31; const int grp=(xg&7)*4+(xg>>3); u.bh=(grp>>2)*NHEAD+(grp&3)*4+(w>>3); u.qb=w&7; return true; }
  __device__ __forceinline__ void a_ready(const AttnUnit&)const{}
  __device__ __forceinline__ void done(const AttnUnit&)const{}
};
template<class Sched,int THRL=8> __device__ __forceinline__ void attn_phase(char*lds,const AttnTensors&T,const Sched&S){
  AttnUnit u;
  for(int i=0;S.next(i,u);++i){ S.a_ready(u); attn_unit<THRL>(u.bh/NHEAD,u.bh%NHEAD,u.qb,T.Q,T.K,T.V,T.O,lds); S.done(u); }
}
#undef SBAR
#undef WAIT_BAR
}
namespace na_body {
typedef short bf16x8 __attribute__((ext_vector_type(8)));
typedef short s16x4 __attribute__((ext_vector_type(4)));
typedef float f32x4 __attribute__((ext_vector_type(4)));
typedef unsigned u32x4 __attribute__((ext_vector_type(4)));
typedef unsigned u32x2 __attribute__((ext_vector_type(2)));
#define NA_LAS __attribute__((address_space(3)))
constexpr int VROW = 160, LDS_V = 0, LDS_BIAS = 9 * 64 * VROW, NA_LDS_BYTES = LDS_BIAS + 15 * 64 * 4;
__device__ __forceinline__ unsigned cvtpk(float lo, float hi) { typedef float f2 __attribute__((ext_vector_type(2))); typedef __bf16 b2 __attribute__((ext_vector_type(2))); f2 v = {lo, hi}; b2 b = __builtin_convertvector(v, b2); return __builtin_bit_cast(unsigned, b); }
__device__ __forceinline__ s16x4 vtr(const NA_LAS char* p) { typedef short v4i16_t __attribute__((ext_vector_type(4))); return __builtin_bit_cast(s16x4, __builtin_amdgcn_ds_read_tr16_b64_v4i16((NA_LAS v4i16_t*)p)); }

__device__ __forceinline__ void na_phase(NA_LAS char* lds, const unsigned short* Qg, const unsigned short* Kg, const unsigned short* Vg, unsigned short* Og, const float* __restrict__ rpb, int G, int bid, unsigned* tsw) {
    int tid_ = threadIdx.x; asm volatile("" : "+v"(tid_));
    const int tid = tid_, lane = tid & 63, wave = __builtin_amdgcn_readfirstlane(tid >> 6), fr = lane & 15, fq = lane >> 4;
    const int vcu = (G % 8 == 0) ? (bid % 8) * (G / 8) + bid / 8 : bid;
    constexpr int NUNITS = 8 * 16 * 16;
    const int per = (NUNITS + G - 1) / G, u_lo = vcu * per, u_hi = (u_lo + per < NUNITS) ? u_lo + per : NUNITS;
    if (u_lo >= u_hi) return;
    u32x4 vr[9];
#define NA_PREFETCH(U) do { const int b_ = (U) >> 8, h_ = ((U) >> 4) & 15, r0_ = 2 * ((U) & 15); const int R0_ = min(max(r0_ - 4, 0), 24); const int ntok_ = min(9, 32 - R0_) * 64; \
        const unsigned short* src_ = Vg + ((size_t)(b_ * 2048 + R0_ * 64)) * 1024 + h_ * 64; \
        _Pragma("unroll") for (int i_ = 0; i_ < 9; ++i_) { const int idx_ = tid + 512 * i_; if ((idx_ >> 3) < ntok_) vr[i_] = *(const u32x4*)(src_ + (size_t)(idx_ >> 3) * 1024 + (idx_ & 7) * 8); } } while (0)
#ifndef PROBE_TS
#define PROBE_TS -1
#endif
#define NTS0(k) unsigned long long nts0_##k = 0; if (PROBE_TS == (k) && blockIdx.x == 0 && threadIdx.x == 0) nts0_##k = __builtin_amdgcn_s_memrealtime();
#define NTS1(k) if (PROBE_TS == (k) && blockIdx.x == 0 && threadIdx.x == 0) atomicAdd(tsw, (unsigned)(__builtin_amdgcn_s_memrealtime() - nts0_##k));
    NA_PREFETCH(u_lo);
    for (int U = u_lo; U < u_hi; ++U) {
        const int b = U >> 8, h = (U >> 4) & 15, r0 = 2 * (U & 15); const int R0 = min(max(r0 - 4, 0), 24);
        NTS0(163)
        if (U != u_lo) __syncthreads();
        NTS1(163) NTS0(160)
#pragma unroll
        for (int i = 0; i < 9; ++i) { const int idx = tid + 512 * i; *(NA_LAS u32x4*)(lds + LDS_V + (idx >> 3) * VROW + (idx & 7) * 16) = vr[i]; }
        for (int i = tid; i < 15 * 64; i += 512) { const int dr = i >> 6, dc = (i & 63) - 16; ((NA_LAS float*)(lds + LDS_BIAS))[i] = (dc >= 0 && dc < 31) ? rpb[(h * 15 + dr) * 31 + dc] * 1.4426950408889634f : 0.f; }
        __syncthreads();
        NTS1(160) NTS0(161)
        if (U + 1 < u_hi) NA_PREFETCH(U + 1);
        const int r = r0 + (wave >> 2), q0 = 16 * (wave & 3), qcol = q0 + fr;
        const int rs = min(max(r - 4, 0), 24), b0 = min(max(q0 - 8, 0), 32), winlo = min(max(qcol - 8, 0), 48);
        const size_t tokq = (size_t)b * 2048 + r * 64 + qcol;
        bf16x8 qf[2];
#pragma unroll
        for (int ks = 0; ks < 2; ++ks) qf[ks] = *(const bf16x8*)(Qg + tokq * 1024 + h * 64 + 32 * ks + 8 * fq);
        f32x4 am[2];
#pragma unroll
        for (int t = 0; t < 2; ++t)
#pragma unroll
            for (int i = 0; i < 4; ++i) am[t][i] = ((unsigned)(b0 + 16 * t + 4 * fq + i - winlo) < 16u) ? 0.f : -INFINITY;
        const unsigned short* kbase = Kg + ((size_t)b * 2048 + b0 + fr) * 1024 + h * 64 + 8 * fq;
        const NA_LAS char* bias_l = lds + LDS_BIAS + (b0 - qcol + 15 + 16 + 4 * fq) * 4;
        const NA_LAS char* v_l = lds + LDS_V + (b0 + 4 * fq + (fr >> 2)) * VROW + (fr & 3) * 8;
        f32x4 sc[8][2];
        { bf16x8 ka[4][2][2], kb[4][2][2];
#pragma unroll
          for (int kr = 0; kr < 4; ++kr)
#pragma unroll
              for (int t = 0; t < 2; ++t)
#pragma unroll
                  for (int ks = 0; ks < 2; ++ks) ka[kr][t][ks] = *(const bf16x8*)(kbase + (size_t)(rs + kr) * 65536 + t * 16384 + ks * 32);
#pragma unroll
          for (int kr = 0; kr < 4; ++kr)
#pragma unroll
              for (int t = 0; t < 2; ++t)
#pragma unroll
                  for (int ks = 0; ks < 2; ++ks) kb[kr][t][ks] = *(const bf16x8*)(kbase + (size_t)(rs + 4 + kr) * 65536 + t * 16384 + ks * 32);
#pragma unroll
          for (int kr = 0; kr < 4; ++kr)
#pragma unroll
              for (int t = 0; t < 2; ++t) { sc[kr][t] = __builtin_amdgcn_mfma_f32_16x16x32_bf16(ka[kr][t][0], qf[0], am[t], 0, 0, 0); sc[kr][t] = __builtin_amdgcn_mfma_f32_16x16x32_bf16(ka[kr][t][1], qf[1], sc[kr][t], 0, 0, 0); }
#pragma unroll
          for (int kr = 0; kr < 4; ++kr)
#pragma unroll
              for (int t = 0; t < 2; ++t) { sc[4 + kr][t] = __builtin_amdgcn_mfma_f32_16x16x32_bf16(kb[kr][t][0], qf[0], am[t], 0, 0, 0); sc[4 + kr][t] = __builtin_amdgcn_mfma_f32_16x16x32_bf16(kb[kr][t][1], qf[1], sc[4 + kr][t], 0, 0, 0); } }
        NTS1(161) NTS0(162)
        float mx = -INFINITY;
#pragma unroll
        for (int kr = 0; kr < 8; ++kr) { const NA_LAS float* bl = (const NA_LAS float*)(bias_l + (rs + kr - r + 7) * 256);
#pragma unroll
            for (int t = 0; t < 2; ++t)
#pragma unroll
                for (int i = 0; i < 4; ++i) { sc[kr][t][i] += bl[16 * t + i]; mx = fmaxf(mx, sc[kr][t][i]); } }
        { auto r16 = __builtin_amdgcn_permlane16_swap(__float_as_uint(mx), __float_as_uint(mx), false, false); mx = fmaxf(__uint_as_float(r16[0]), __uint_as_float(r16[1]));
          auto r32 = __builtin_amdgcn_permlane32_swap(__float_as_uint(mx), __float_as_uint(mx), false, false); mx = fmaxf(__uint_as_float(r32[0]), __uint_as_float(r32[1])); }
        float lsum = 0.f; bf16x8 pb[8];
#pragma unroll
        for (int kr = 0; kr < 8; ++kr) {
#pragma unroll
            for (int t = 0; t < 2; ++t)
#pragma unroll
                for (int i = 0; i < 4; ++i) { sc[kr][t][i] = __builtin_amdgcn_exp2f(sc[kr][t][i] - mx); lsum += sc[kr][t][i]; }
            u32x4 pw; pw.x = cvtpk(sc[kr][0][0], sc[kr][0][1]); pw.y = cvtpk(sc[kr][0][2], sc[kr][0][3]); pw.z = cvtpk(sc[kr][1][0], sc[kr][1][1]); pw.w = cvtpk(sc[kr][1][2], sc[kr][1][3]);
            pb[kr] = __builtin_bit_cast(bf16x8, pw); }
        f32x4 oacc[4];
#pragma unroll
        for (int dt = 0; dt < 4; ++dt) oacc[dt] = (f32x4){0.f, 0.f, 0.f, 0.f};
#pragma unroll
        for (int kr = 0; kr < 8; ++kr) { const NA_LAS char* vp = v_l + (rs + kr - R0) * 64 * VROW;
#pragma unroll
            for (int dt = 0; dt < 4; ++dt) {
                const s16x4 lo = vtr(vp + dt * 32), hi = vtr(vp + 16 * VROW + dt * 32);
                const bf16x8 vf = {lo[0], lo[1], lo[2], lo[3], hi[0], hi[1], hi[2], hi[3]};
                oacc[dt] = __builtin_amdgcn_mfma_f32_16x16x32_bf16(vf, pb[kr], oacc[dt], 0, 0, 0); } }
        { auto r16 = __builtin_amdgcn_permlane16_swap(__float_as_uint(lsum), __float_as_uint(lsum), false, false); lsum = __uint_as_float(r16[0]) + __uint_as_float(r16[1]);
          auto r32 = __builtin_amdgcn_permlane32_swap(__float_as_uint(lsum), __float_as_uint(lsum), false, false); lsum = __uint_as_float(r32[0]) + __uint_as_float(r32[1]); }
        const float rl = 1.f / lsum;
        NTS1(162)
        unsigned short* op = Og + tokq * 1024 + h * 64 + 4 * fq;
#pragma unroll
        for (int dt = 0; dt < 4; ++dt) { u32x2 w; w.x = cvtpk(oacc[dt][0] * rl, oacc[dt][1] * rl); w.y = cvtpk(oacc[dt][2] * rl, oacc[dt][3] * rl); *(u32x2*)(op + 16 * dt) = w; }
    }
#undef NA_PREFETCH
}
}
constexpr int NWAVES = 8, NTHREADS = 512;
constexpr int D = 1024, NB = 8, S = 2048, M = NB * S, DEPTH = 4, NH = 16, HD = 64, GW = 64, ROWS = 32;
constexpr int KVD = 256, NE = 32, NG = 4, EPG = 8, DE = 512, NQKV_NA = 3072, NQKV_GQ = 1536, NRT = 36;
constexpr float ALPHA = 1.6817928305074290f, LN_EPS = 1e-5f;
constexpr float LOG2E = 1.4426950408889634f, C2 = 0.125f * 1.4426950408889634f;
constexpr int MAXTILES = 160;

constexpr size_t MiB = 1u << 20;
constexpr size_t WS_CTL = 0, CTL_ZERO_BYTES = 1 * MiB;
constexpr size_t WS_MOD = 1 * MiB, WS_ROPE = 2 * MiB, WS_WRT = 3 * MiB;
constexpr size_t WS_WQKV_NA = 4 * MiB, WS_WO_NA = 16 * MiB, WS_WQKV_GQ = 20 * MiB, WS_WO_GQ = 26 * MiB;
constexpr size_t WS_WGU = 32 * MiB, WS_WDN = 96 * MiB;
constexpr size_t WS_X1 = 128 * MiB, WS_X2 = 192 * MiB, WS_H = 256 * MiB, WS_Q = 288 * MiB, WS_K = 320 * MiB, WS_V = 352 * MiB, WS_Y = 384 * MiB;
constexpr size_t WS_XS = 416 * MiB, WS_HMID = 496 * MiB, WS_YS = 536 * MiB, WS_ROUTE = 616 * MiB, WS_TOKMAP = 618 * MiB, WS_WGU2 = 622 * MiB, WS_WDN2 = 686 * MiB, WS_END = 718 * MiB;
#define WGU_SET(l) (((l) & 1) ? WS_WGU2 : WS_WGU)
#define WDN_SET(l) (((l) & 1) ? WS_WDN2 : WS_WDN)
constexpr int CW_TS = 60000;
constexpr int CW_BAR = 16384;
constexpr int CW_CNT = 32768, CNT_LAYER_STRIDE = 2048;

constexpr int RING_BYTES = 131072, MISC_OFF = RING_BYTES, LDS_BYTES = 147456;

#define LAS __attribute__((address_space(3)))
typedef unsigned short bf16;
typedef unsigned v4u __attribute__((ext_vector_type(4)));
typedef unsigned v2u __attribute__((ext_vector_type(2)));
typedef float f32x4 __attribute__((ext_vector_type(4)));
#define RLX_AGENT __ATOMIC_RELAXED, __HIP_MEMORY_SCOPE_AGENT
__device__ __forceinline__ unsigned f2bf(float f) { unsigned u = __builtin_bit_cast(unsigned, f); return (u + 0x7fffu + ((u >> 16) & 1u)) >> 16; }
__device__ __forceinline__ unsigned pk2(float lo, float hi) { return f2bf(lo) | (f2bf(hi) << 16); }
__device__ __forceinline__ float bflo(unsigned w) { return __uint_as_float(w << 16); }
__device__ __forceinline__ float bfhi(unsigned w) { return __uint_as_float(w & 0xffff0000u); }
__device__ __forceinline__ float bf2f(bf16 v) { return __uint_as_float((unsigned)v << 16); }
__device__ __forceinline__ float wave_sum(float v) {
    int x = __builtin_bit_cast(int, v);
    v += __builtin_bit_cast(float, __builtin_amdgcn_update_dpp(0, x, 0xB1, 0xF, 0xF, false)); x = __builtin_bit_cast(int, v);
    v += __builtin_bit_cast(float, __builtin_amdgcn_update_dpp(0, x, 0x4E, 0xF, 0xF, false)); x = __builtin_bit_cast(int, v);
    v += __builtin_bit_cast(float, __builtin_amdgcn_update_dpp(0, x, 0x141, 0xF, 0xF, false)); x = __builtin_bit_cast(int, v);
    v += __builtin_bit_cast(float, __builtin_amdgcn_update_dpp(0, x, 0x140, 0xF, 0xF, false)); x = __builtin_bit_cast(int, v);
    const float r0 = __builtin_bit_cast(float, __builtin_amdgcn_readlane(x, 0)), r1 = __builtin_bit_cast(float, __builtin_amdgcn_readlane(x, 16));
    const float r2 = __builtin_bit_cast(float, __builtin_amdgcn_readlane(x, 32)), r3 = __builtin_bit_cast(float, __builtin_amdgcn_readlane(x, 48));
    return (r0 + r1) + (r2 + r3);
}

struct Args { const float* in[20]; float* out; unsigned char* ws; };

__device__ __forceinline__ int rho_p8(int cc) { return (cc & 128) + (cc & 96) + 16 * ((cc >> 2) & 1) + 4 * ((cc >> 3) & 3) + (cc & 3); }
__device__ __forceinline__ int rho_head(int cc) { const int wc = cc >> 6, fq = 2 * ((cc >> 5) & 1) + ((cc >> 3) & 1), bj = (cc >> 4) & 1; return 128 * bj + 32 * wc + 16 * ((cc >> 2) & 1) + 4 * fq + (cc & 3); }
__device__ __forceinline__ int dest_row(int mode, int c) {
    if (mode == 0) return (c & ~255) + rho_p8(c & 255);
    if (mode == 1) return (c & ~255) + rho_head(c & 255);
    const int jj = c & 127; return (c >> 7) * 256 + (mode == 3 ? 128 : 0) + (jj & 96) + 16 * ((jj >> 2) & 1) + 4 * ((jj >> 3) & 3) + (jj & 3);
}
struct TrItem { const float* W; bf16* WT; int K, N, mode, item; };
__device__ __forceinline__ void tr_load(const TrItem& t, f32x4 (&r)[8], int lane) {
    const int nblk = t.N / 32, kb = t.item / nblk, nb = t.item % nblk;
    const float* src = t.W + (size_t)(64 * kb + (lane >> 3)) * t.N + 32 * nb + 4 * (lane & 7);
#pragma unroll
    for (int i = 0; i < 8; ++i) r[i] = __builtin_nontemporal_load((const f32x4*)(src + (size_t)(8 * i) * t.N));
}
__device__ __forceinline__ void tr_store(const TrItem& t, const f32x4 (&r)[8], LAS float* scr, int lane) {
    const int nblk = t.N / 32, kb = t.item / nblk, nb = t.item % nblk, k0 = 64 * kb, n0 = 32 * nb;
#pragma unroll
    for (int i = 0; i < 8; ++i) { LAS float* d = scr + ((lane >> 3) + 8 * i) * 33 + 4 * (lane & 7); d[0] = r[i][0]; d[1] = r[i][1]; d[2] = r[i][2]; d[3] = r[i][3]; }
    asm volatile("s_waitcnt lgkmcnt(0)" ::: "memory");
    const int c = lane & 7;
#pragma unroll
    for (int j = 0; j < 4; ++j) { const int n = (lane >> 3) + 8 * j; const LAS float* sp = scr + (8 * c) * 33 + n;
        v4u o; o.x = pk2(sp[0 * 33], sp[1 * 33]); o.y = pk2(sp[2 * 33], sp[3 * 33]); o.z = pk2(sp[4 * 33], sp[5 * 33]); o.w = pk2(sp[6 * 33], sp[7 * 33]);
        __builtin_nontemporal_store(o, (v4u*)(t.WT + (size_t)dest_row(t.mode, n0 + n) * t.K + k0 + 8 * c)); }
    asm volatile("s_waitcnt lgkmcnt(0)" ::: "memory");
}
__device__ __forceinline__ TrItem moe_item(const float* wgate, const float* wup, const float* wdown, int layer, bf16* Wgu, bf16* Wdn, int it) {
    const int e = it / 768, r = it % 768, which = r >> 8, sub = r & 255; const size_t le = (size_t)layer * NE + e; TrItem t;
    if (which == 0) t = TrItem{wgate + le * D * DE, Wgu + (size_t)e * D * D, D, DE, 2, sub};
    else if (which == 1) t = TrItem{wup + le * D * DE, Wgu + (size_t)e * D * D, D, DE, 3, sub};
    else t = TrItem{wdown + le * DE * D, Wdn + (size_t)e * D * DE, DE, D, 0, sub};
    return t;
}
__device__ __forceinline__ void moe_weight_items(const float* __restrict__ wgate, const float* __restrict__ wup, const float* __restrict__ wdown, int layer,
                                                 bf16* __restrict__ Wgu, bf16* __restrict__ Wdn, LAS float* scr, int first, int stride, int end, int lane) {
    if (first >= end) return;
    f32x4 rn[8]; TrItem tn = moe_item(wgate, wup, wdown, layer, Wgu, Wdn, first); tr_load(tn, rn, lane);
    for (int it = first; it < end; it += stride) {
        f32x4 rc[8]; const TrItem tc = tn;
#pragma unroll
        for (int i = 0; i < 8; ++i) rc[i] = rn[i];
        if (it + stride < end) { tn = moe_item(wgate, wup, wdown, layer, Wgu, Wdn, it + stride); tr_load(tn, rn, lane); }
        tr_store(tc, rc, scr, lane);
    }
}
constexpr int CONV_ITEMS = NE * 768;
constexpr int CQ_A = 10, CQ_B = 7, CQ_C = 4;
__device__ __forceinline__ int conv_total_a(int layer, int G) { return ((layer & 1) && G == 256) ? 128 * NWAVES * CQ_A : 0; }
__device__ __forceinline__ int idle_cus(int nunits, int G) { const int rounds = (nunits + G - 1) / G; return rounds * G - nunits; }
__device__ __forceinline__ void transpose_item(const float* __restrict__ W, int K, int N, bf16* __restrict__ WT, int mode, LAS float* scr, int item, int lane) {
    const TrItem t{W, WT, K, N, mode, item}; f32x4 r[8]; tr_load(t, r, lane); tr_store(t, r, scr, lane);
}

struct MoeOrder {
    int nunits, G, c; const LAS int* tile_e; const LAS int* tbase; const LAS int* trows; const int* tokmap;
    __device__ __forceinline__ bool next(int i, pg8::Unit& u) const {
        const long L = (long)i * G + c; if (L >= nunits) return false;
        const int pm = (int)(L >> 2); u.pm = pm; u.pn = __builtin_amdgcn_readfirstlane(tile_e[pm]) * 4 + (int)(L & 3); return true;
    }
    __device__ __forceinline__ int arow(const pg8::Unit& u, int rr) const {
        const int base = __builtin_amdgcn_readfirstlane(tbase[u.pm]), rows = __builtin_amdgcn_readfirstlane(trows[u.pm]);
        return rr < rows ? tokmap[base + rr] : 0;
    }
    __device__ __forceinline__ void a_ready(const pg8::Unit&) const {}
    __device__ __forceinline__ void done(const pg8::Unit&) const {}
};
constexpr int TOKCAP = 16384;
__device__ __forceinline__ void build_tiles(const unsigned* cnt, LAS int* misc, int tid) {
    if (tid == 0) { int s = 0;
        for (int e = 0; e < NE; ++e) { misc[e] = s; const int c = (int)__hip_atomic_load(cnt + 64 * e, RLX_AGENT); const int nt = (c + 255) >> 8;
            for (int t = 0; t < nt; ++t) if (s + t < MAXTILES) { misc[64 + s + t] = e; misc[256 + s + t] = e * TOKCAP + t * 256; misc[448 + s + t] = (c - t * 256) < 256 ? (c - t * 256) : 256; } s += nt; }
        misc[32] = s; misc[33] = s < MAXTILES ? s : MAXTILES; }
    __syncthreads();
}

__device__ __forceinline__ void na_attn_simple(const bf16* Qb, const bf16* Kb, const bf16* Vb, bf16* Ob, const float* __restrict__ rpb, int gw, int NGW, int lane) {
    for (int w = gw; w < M * NH; w += NGW) {
        const int m = w >> 4, h = w & 15, b = m >> 11, t = m & 2047, r = t >> 6, c = t & 63;
        const int rs = min(max(r - 4, 0), ROWS - 8), wsx = min(max(c - 8, 0), GW - 16);
        const float q = bf2f(Qb[(size_t)m * D + h * HD + lane]);
        float mx = -INFINITY, l = 0.f, acc = 0.f;
        for (int kr = 0; kr < 8; ++kr)
            for (int kc = 0; kc < 16; ++kc) {
                const int krow = rs + kr, kcol = wsx + kc; const size_t tok = (size_t)b * S + krow * GW + kcol;
                const float kv = bf2f(Kb[tok * D + h * HD + lane]), vv = bf2f(Vb[tok * D + h * HD + lane]);
                const int dr = krow - r + 7, dc = min(max(kcol - c + 15, 0), 30);
                const float s = wave_sum(q * kv) + rpb[(h * 15 + dr) * 31 + dc] * LOG2E;
                const float mn = fmaxf(mx, s), al = __builtin_amdgcn_exp2f(mx - mn), p = __builtin_amdgcn_exp2f(s - mn);
                l = l * al + p; acc = acc * al + p * vv; mx = mn;
            }
        Ob[(size_t)m * D + h * HD + lane] = (bf16)f2bf(acc / l);
    }
}
__device__ __forceinline__ void gqa_attn_simple(const bf16* Qb, const bf16* Kb, const bf16* Vb, bf16* Ob, int gw, int NGW, int lane) {
    for (int w = gw; w < M * NH; w += NGW) {
        const int m = w >> 4, h = w & 15, b = m >> 11, kvh = h >> 2;
        const float q = bf2f(Qb[(size_t)m * D + h * HD + lane]);
        float mx = -INFINITY, l = 0.f, acc = 0.f;
        const bf16* kp = Kb + (size_t)b * S * KVD + kvh * HD + lane; const bf16* vp = Vb + (size_t)b * S * KVD + kvh * HD + lane;
        for (int j = 0; j < S; ++j) {
            const float kv = bf2f(kp[(size_t)j * KVD]), vv = bf2f(vp[(size_t)j * KVD]);
            const float s = wave_sum(q * kv);
            const float mn = fmaxf(mx, s), al = __builtin_amdgcn_exp2f(mx - mn), p = __builtin_amdgcn_exp2f(s - mn);
            l = l * al + p; acc = acc * al + p * vv; mx = mn;
        }
        Ob[(size_t)m * D + h * HD + lane] = (bf16)f2bf(acc / l);
    }
}
#define XB_TMO      128
#define XB_XCNT(j)  (256  + 64 * (j))
#define XB_XSUB(j)  (1280 + 64 * (j))
#define XB_XGEN(j)  (2304 + 64 * (j))
#define XB_TOP      3328
#define XB_TOPGEN   3392
#define XCD_BAR_WORDS 3456
#define XB_SPIN_CAP (1u << 18)

__device__ __forceinline__ unsigned xb_ld(unsigned* p)              { return __hip_atomic_load(p, __ATOMIC_RELAXED, __HIP_MEMORY_SCOPE_AGENT); }
__device__ __forceinline__ unsigned xb_add(unsigned* p, unsigned v) { return __hip_atomic_fetch_add(p, v, __ATOMIC_RELAXED, __HIP_MEMORY_SCOPE_AGENT); }
__device__ __forceinline__ unsigned xb_xcc_id() { return (unsigned)__builtin_amdgcn_s_getreg((3 << 11) | 20) & 0xFu; }
#define XB_SPIN(cond, bar) do { unsigned _sp = 0; while (cond) { __builtin_amdgcn_s_sleep(1); \
    if ((++_sp & 255u) == 0u) { if (xb_ld(&(bar)[XB_TMO])) break; if (_sp > XB_SPIN_CAP) { atomicAdd(&(bar)[XB_TMO], 1u); break; } } } } while (0)

struct XcdBarrier {
    unsigned* bar; unsigned x;
    volatile LAS unsigned* st;
};

__device__ __forceinline__ XcdBarrier xcd_barrier_post(unsigned* bar, volatile LAS unsigned* st) {
    XcdBarrier b; b.bar = bar; b.x = xb_xcc_id(); b.st = st;
    if (threadIdx.x == 0) (void)xb_add(&bar[XB_XCNT(b.x)], 1u);
    return b;
}
__device__ __forceinline__ void xcd_barrier_complete(unsigned* bar, unsigned x, unsigned& nloc, unsigned& nx) {
    const unsigned G = gridDim.x * gridDim.y * gridDim.z;
    unsigned sum, cnt, mine, sp = 0u;
    for (;;) {
        sum = 0u; cnt = 0u; mine = 0u;
#pragma unroll
        for (unsigned j = 0; j < 16; ++j) { const unsigned c = xb_ld(&bar[XB_XCNT(j)]); sum += c; cnt += (c > 0u) ? 1u : 0u; mine = (j == x) ? c : mine; }
        if (sum == G) break;
        __builtin_amdgcn_s_sleep(1);
        if ((++sp & 255u) == 0u) { if (xb_ld(&bar[XB_TMO])) break; if (sp > XB_SPIN_CAP) { atomicAdd(&bar[XB_TMO], 1u); break; } }
    }
    nloc = mine > 0u ? mine : 1u; nx = cnt > 0u ? cnt : 1u;
}

__device__ __forceinline__ void xcd_barrier(const XcdBarrier& b) {
    asm volatile("s_waitcnt vmcnt(0)" ::: "memory");
    __syncthreads();
    if (threadIdx.x == 0) {
        unsigned* bar = b.bar;
        __builtin_amdgcn_s_waitcnt(0);
        unsigned nloc = b.st[0], nx = b.st[1];
        if (nloc == 0u) { xcd_barrier_complete(bar, b.x, nloc, nx); b.st[0] = nloc; b.st[1] = nx; }
        const unsigned old = xb_add(&bar[XB_XSUB(b.x)], 1u);
        const unsigned gen = old / nloc;
        if (old + 1u == (gen + 1u) * nloc) {
            __builtin_amdgcn_fence(__ATOMIC_RELEASE, "agent");
            asm volatile("s_waitcnt vmcnt(0)" ::: "memory");
            const unsigned og = xb_add(&bar[XB_TOP], 1u);
            const unsigned tg = og / nx;
            if (og + 1u == (tg + 1u) * nx) xb_add(&bar[XB_TOPGEN], 1u);
            else XB_SPIN(xb_ld(&bar[XB_TOPGEN]) == tg, bar);
            __builtin_amdgcn_fence(__ATOMIC_ACQUIRE, "agent");
            xb_add(&bar[XB_XGEN(b.x)], 1u);
            asm volatile("s_waitcnt vmcnt(0)" ::: "memory");
        } else {
            XB_SPIN(xb_ld(&bar[XB_XGEN(b.x)]) == gen, bar);
            __builtin_amdgcn_fence(__ATOMIC_ACQUIRE, "agent");
            asm volatile("s_waitcnt vmcnt(0)" ::: "memory");
        }
    }
    __syncthreads();
}
__device__ __forceinline__ unsigned char* ldptr(const LAS unsigned* ptab, int i) {
    const unsigned lo = (unsigned)__builtin_amdgcn_readfirstlane((int)ptab[2 * i]), hi = (unsigned)__builtin_amdgcn_readfirstlane((int)ptab[2 * i + 1]);
    return (unsigned char*)(__attribute__((address_space(1))) unsigned char*)(((unsigned long long)hi << 32) | lo);
}
#ifndef PROBE_REPEAT
#define PROBE_REPEAT -1
#endif
#define NREP(k) ((PROBE_REPEAT == (k)) ? 2 : 1)
#ifndef PROBE_TS
#define PROBE_TS -1
#endif
#define TS_T0(k) unsigned long long ts0_##k = 0; if (PROBE_TS == (k) && blockIdx.x == 0 && threadIdx.x == 0) ts0_##k = __builtin_amdgcn_s_memrealtime();
#define TS_T1(k) if (PROBE_TS == (k) && blockIdx.x == 0 && threadIdx.x == 0) atomicAdd((unsigned*)(ws + WS_CTL) + CW_TS, (unsigned)(__builtin_amdgcn_s_memrealtime() - ts0_##k));
#define GRID_SYNC_T(k) do { if (PROBE_TS == (k)) { PH_BEGIN TS_T0(k) GRID_SYNC(); TS_T1(k) } else { GRID_SYNC(); } } while (0)
#define LDS_BARRIER() do { asm volatile("s_waitcnt lgkmcnt(0)" ::: "memory"); __builtin_amdgcn_s_barrier(); asm volatile("" ::: "memory"); } while (0)
#define GRID_SYNC_CG() do { cg::this_grid().sync(); asm volatile("" ::: "memory"); } while (0)
#define GRID_SYNC() do { unsigned lb_ = (unsigned)(uintptr_t)lds_raw; asm volatile("" : "+s"(lb_)); LAS unsigned char* l_ = (LAS unsigned char*)lb_; \
    XcdBarrier xb_; xb_.bar = (unsigned*)(ldptr((LAS unsigned*)(l_ + MISC_OFF + 8192), 21) + WS_CTL) + CW_BAR; xb_.x = xb_xcc_id(); xb_.st = (volatile LAS unsigned*)(l_ + MISC_OFF + 8448); \
    xcd_barrier(xb_); asm volatile("" ::: "memory"); } while (0)
#define PH_BEGIN \
    unsigned ldsb_ = (unsigned)(uintptr_t)lds_raw; asm volatile("" : "+s"(ldsb_)); \
    LAS unsigned char* lds = (LAS unsigned char*)ldsb_; LAS int* misc = (LAS int*)(lds + MISC_OFF); LAS unsigned* ptab = (LAS unsigned*)(lds + MISC_OFF + 8192); (void)misc; \
    int tid = threadIdx.x; asm volatile("" : "+v"(tid)); \
    const int lane = tid & 63, wave = __builtin_amdgcn_readfirstlane(tid >> 6); \
    int G = gridDim.x, bid = blockIdx.x; asm volatile("" : "+s"(G), "+s"(bid)); const int gw = bid * NWAVES + wave, NGW = G * NWAVES; \
    unsigned char* ws = ldptr(ptab, 21); (void)lane; (void)gw; (void)NGW; (void)ws;
#define INP(i) ((const float*)ldptr(ptab, (i)))

__global__ void __launch_bounds__(NTHREADS, 2) mk_fwd(Args args) {
    extern __shared__ __attribute__((aligned(16))) unsigned char lds_raw[];
    { LAS unsigned* ptab = (LAS unsigned*)((LAS unsigned char*)lds_raw + MISC_OFF + 8192);
    if (threadIdx.x < 22) { const unsigned long long p = threadIdx.x < 20 ? (unsigned long long)args.in[threadIdx.x] : (threadIdx.x == 20 ? (unsigned long long)args.out : (unsigned long long)args.ws);
        ptab[2 * threadIdx.x] = (unsigned)p; ptab[2 * threadIdx.x + 1] = (unsigned)(p >> 32); }
      volatile LAS unsigned* st = (volatile LAS unsigned*)((LAS unsigned char*)lds_raw + MISC_OFF + 8448);
      if (threadIdx.x == 64) { st[0] = 0u; st[1] = 0u; }
      __syncthreads();
      (void)xcd_barrier_post((unsigned*)(args.ws + WS_CTL) + CW_BAR, st); }
    __syncthreads();

    {
        PH_BEGIN TS_T0(100)
        const float* c_in = INP(1); const float* ada_w = INP(2); const float* ada_b = INP(3);
        float* mod = (float*)(ws + WS_MOD); float* ropec = (float*)(ws + WS_ROPE); float* ropes = ropec + S * 32;
        LAS float* ca = (LAS float*)lds;
        LAS float* red = (LAS float*)(lds + 32768);
        for (int i = tid; i < NB * D; i += NTHREADS) { const float v = c_in[i]; ca[i] = v / (1.f + __expf(-v)); }
        __syncthreads();
        for (int it = bid; it < DEPTH * 192; it += G) {
            const int l = it / 192, col0 = (it % 192) * 32, cl = tid & 31, ks = tid >> 5;
            const float* wp = ada_w + ((size_t)l * D + 64 * ks) * (6 * D) + col0 + cl;
            float acc[NB];
#pragma unroll
            for (int b = 0; b < NB; ++b) acc[b] = 0.f;
#pragma unroll 16
            for (int kk = 0; kk < 64; ++kk) { const float wv = wp[(size_t)kk * (6 * D)];
#pragma unroll
                for (int b = 0; b < NB; ++b) acc[b] += ca[b * D + 64 * ks + kk] * wv; }
#pragma unroll
            for (int b = 0; b < NB; ++b) red[(ks * NB + b) * 32 + cl] = acc[b];
            __syncthreads();
            if (tid < 256) { const int b = tid >> 5; float s = 0.f;
#pragma unroll
                for (int k2 = 0; k2 < 16; ++k2) s += red[(k2 * NB + b) * 32 + cl];
                mod[((size_t)l * NB + b) * (6 * D) + col0 + cl] = s + ada_b[l * 6 * D + col0 + cl]; }
            __syncthreads();
        }
        for (int i = bid * NTHREADS + tid; i < S * 32; i += G * NTHREADS) {
            const int t = i >> 5, a = (i >> 4) & 1, p = i & 15;
            const float pos = (float)(a == 0 ? t / GW : t % GW);
            const float ang = pos * exp2f(-(float)p * (13.287712379549449f / 16.f));
            const float kf = rintf(ang * 0.15915494309189535f);
            float r = fmaf(-kf, 6.2831854820251465f, ang); r = fmaf(-kf, -1.7484555314695172e-07f, r);
            ropec[i] = __cosf(r); ropes[i] = __sinf(r);
        }
        { const float* m_wg = INP(13); const float* m_we = INP(15); bf16* wrh = (bf16*)(ws + WS_WRT); bf16* wrl = wrh + DEPTH * 48 * D;
          for (int i = bid * NTHREADS + tid; i < DEPTH * 48 * D; i += G * NTHREADS) {
            const int l = i / (48 * D), o = (i / D) % 48, k = i % D;
            const float v = o < NG ? m_wg[((size_t)l * D + k) * NG + o] : (o < NRT ? m_we[((size_t)l * D + k) * NE + (o - NG)] : 0.f);
            const unsigned hi = f2bf(v); wrh[i] = (bf16)hi; wrl[i] = (bf16)f2bf(v - __uint_as_float(hi << 16));
          } }
        LAS float* scr = (LAS float*)(lds + 49152 + wave * 8704);
        { const float* na_wqkv = INP(6); const float* na_wo = INP(8); const float* gq_wqkv = INP(9); const float* gq_wo = INP(12);
          bf16* Wqkv_na = (bf16*)(ws + WS_WQKV_NA); bf16* Wo_na = (bf16*)(ws + WS_WO_NA); bf16* Wqkv_gq = (bf16*)(ws + WS_WQKV_GQ); bf16* Wo_gq = (bf16*)(ws + WS_WO_GQ);
          constexpr int I_NQ = 16 * 96, I_O = 16 * 32, I_GQ = 16 * 48, I_DENSE = 2 * (I_NQ + I_O + I_GQ + I_O);
          for (int it = gw; it < I_DENSE; it += NGW) {
            int r = it; const int j = r / (I_DENSE / 2); r %= (I_DENSE / 2);
            if (r < I_NQ) { transpose_item(na_wqkv + (size_t)j * D * NQKV_NA, D, NQKV_NA, Wqkv_na + (size_t)j * NQKV_NA * D, 0, scr, r, lane); continue; } r -= I_NQ;
            if (r < I_O) { transpose_item(na_wo + (size_t)j * D * D, D, D, Wo_na + (size_t)j * D * D, 0, scr, r, lane); continue; } r -= I_O;
            if (r < I_GQ) { transpose_item(gq_wqkv + (size_t)j * D * NQKV_GQ, D, NQKV_GQ, Wqkv_gq + (size_t)j * NQKV_GQ * D, 1, scr, r, lane); continue; } r -= I_GQ;
            transpose_item(gq_wo + (size_t)j * D * D, D, D, Wo_gq + (size_t)j * D * D, 0, scr, r, lane);
          } }
        TS_T0(102)
        moe_weight_items(INP(17), INP(18), INP(19), 0, (bf16*)(ws + WS_WGU), (bf16*)(ws + WS_WDN), scr, gw, NGW, CONV_ITEMS, lane);
        TS_T1(102) TS_T1(100)
    }
    GRID_SYNC_CG();
    {
        PH_BEGIN
        const float* x_in = INP(0); const float* mod = (const float*)(ws + WS_MOD); bf16* Hb = (bf16*)(ws + WS_H);
        for (int m = gw; m < M; m += NGW) {
            const float* mb = mod + (size_t)(m >> 11) * (6 * D);
#pragma unroll
            for (int j = 0; j < 4; ++j) { const int d = 4 * lane + 256 * j;
                const f32x4 xv = *(const f32x4*)(x_in + (size_t)m * D + d), sh = *(const f32x4*)(mb + d), sc = *(const f32x4*)(mb + D + d);
                const f32x4 hv = xv * (1.f + sc) + sh; v2u o; o.x = pk2(hv[0], hv[1]); o.y = pk2(hv[2], hv[3]);
                *(v2u*)(Hb + (size_t)m * D + d) = o; }
        }
    }
    GRID_SYNC();

    for (int layer = 0; layer < DEPTH; ++layer) {
        for (int rep_ = 0; rep_ < NREP(0); ++rep_) {
            { PH_BEGIN TS_T0(110)
            const int j2 = layer >> 1;
            bf16* Hb = (bf16*)(ws + WS_H); bf16* Qb = (bf16*)(ws + WS_Q);
            if ((layer & 1) == 0) {
                pg8::Gemm g{Hb, (bf16*)(ws + WS_WQKV_NA) + (size_t)j2 * NQKV_NA * D, M, NQKV_NA, D}; pg8::StaticOrder So; So.init(M, NQKV_NA, G, bid);
                pg8::EpiStore8 E{Qb, D, D, (size_t)(WS_K - WS_Q) / 2, C2, 0x7fffffff};
                pg8::gemm_phase<pg8::EpiStore8, pg8::StaticOrder, true, true>(lds, g, So, E);
            } else {
                pg8::Gemm g{Hb, (bf16*)(ws + WS_WQKV_GQ) + (size_t)j2 * NQKV_GQ * D, M, NQKV_GQ, D}; pg8::StaticOrder So; So.init(M, NQKV_GQ, G, bid);
                const float* ropec = (const float*)(ws + WS_ROPE);
                pg8::EpiGqaQkv E{Qb, (bf16*)(ws + WS_K), (bf16*)(ws + WS_V), INP(10) + j2 * HD, INP(11) + j2 * HD, ropec, ropec + S * 32, C2};
                pg8::gemm_phase<pg8::EpiGqaQkv, pg8::StaticOrder, true, true>(lds, g, So, E);
                if (layer + 1 < DEPTH && G == 256 && bid >= 128) {
                    const int tot = conv_total_a(layer, G);
                    moe_weight_items(INP(17), INP(18), INP(19), layer + 1, (bf16*)(ws + WGU_SET(layer + 1)), (bf16*)(ws + WDN_SET(layer + 1)), (LAS float*)(lds + wave * 8704), (bid - 128) * NWAVES + wave, 128 * NWAVES, tot, lane);
                }
            }
        TS_T1(110) } GRID_SYNC_T(120); }
        for (int rep_ = 0; rep_ < NREP(1); ++rep_) {
            { PH_BEGIN TS_T0(111)
            bf16* Qb = (bf16*)(ws + WS_Q); const bf16* Kb = (const bf16*)(ws + WS_K); const bf16* Vb = (const bf16*)(ws + WS_V);
            bf16* Ob = (PROBE_REPEAT == 1 && rep_ == 0) ? (bf16*)(ws + WS_XS) : Qb;
            TS_T0(150) TS_T0(151)
            if ((layer & 1) == 0) na_body::na_phase((LAS char*)lds, Qb, Kb, Vb, Ob, INP(7) + (size_t)(layer >> 1) * NH * 15 * 31, G, bid, (unsigned*)(ws + WS_CTL) + CW_TS);
            else {
                const attn_body::AttnTensors AT{(const attn_body::bf16*)Qb, (const attn_body::bf16*)Kb, (const attn_body::bf16*)Vb, (attn_body::bf16*)Ob};
                const attn_body::StaticOrder So(G, bid);
                attn_body::attn_phase<attn_body::StaticOrder>((char*)lds, AT, So);
            }
            if ((layer & 1) == 0) { TS_T1(150) } else { TS_T1(151) }
        TS_T1(111) } GRID_SYNC_T(121); }
        for (int rep_ = 0; rep_ < NREP(2); ++rep_) {
            { PH_BEGIN TS_T0(112)
            const bf16* Wo = (const bf16*)(ws + ((layer & 1) == 0 ? WS_WO_NA : WS_WO_GQ)) + (size_t)(layer >> 1) * D * D;
            pg8::Gemm g{(const bf16*)(ws + WS_Q), Wo, M, D, D}; pg8::StaticOrder So; So.init(M, D, G, bid);
            pg8::EpiStore8 E{(bf16*)(ws + WS_Y), D, 0, 0, 1.f, 0x7fffffff};
            pg8::gemm_phase<pg8::EpiStore8, pg8::StaticOrder, true, true>(lds, g, So, E);
        TS_T1(112) } GRID_SYNC_T(122); }
        for (int rep_ = 0; rep_ < NREP(3); ++rep_) {
            { PH_BEGIN TS_T0(113)
            const float* xcur = layer == 0 ? INP(0) : (const float*)(ws + WS_X2);
            const float* modl = (const float*)(ws + WS_MOD) + (size_t)layer * NB * 6 * D;
            const bool dmy_ = (PROBE_REPEAT == 3 && rep_ == 0);
            unsigned* cnt = (unsigned*)(ws + WS_CTL) + CW_CNT + CNT_LAYER_STRIDE * (layer + (dmy_ ? 8 : 0));
            float* X1 = (float*)(ws + WS_X1); bf16* Hb = (bf16*)(ws + WS_H); const bf16* Yb = (const bf16*)(ws + WS_Y);
            int* r_eid = (int*)(ws + (dmy_ ? WS_XS : WS_ROUTE)); int* r_pos = r_eid + 2 * M; float* r_gate = (float*)(r_pos + 2 * M);
            int* tokmap = (int*)(ws + WS_TOKMAP);
            LAS unsigned char* Hhi = lds; LAS unsigned char* Hlo = lds + 33024; LAS float* part = (LAS float*)(lds + 66048); LAS float* lgt = (LAS float*)(lds + 90624);
            LAS float* prm = (LAS float*)(lds + 98304);
            LAS int* hist = (LAS int*)(lds + 93696); LAS int* basee = hist + 32; LAS int* rt_e = hist + 64; LAS int* rt_lp = rt_e + 128; LAS float* rt_g = (LAS float*)(rt_lp + 128);
            const float* lg = INP(4) + (size_t)(layer * 2) * D; const float* lb = INP(5) + (size_t)(layer * 2) * D;
            const bf16* wrh = (const bf16*)(ws + WS_WRT) + (size_t)layer * 48 * D; const bf16* wrl = wrh + (size_t)DEPTH * 48 * D;
            const float* bgp = INP(14) + layer * NG; const float* bep = INP(16) + layer * NE;
            const int fr = lane & 15, fq = lane >> 4;
            for (int ch = bid; ch < M / 64; ch += G) {
                if (tid < 32) hist[tid] = 0;
                { const float* mbc = modl + (size_t)((ch * 64) >> 11) * (6 * D);
                  for (int i = tid; i < D; i += NTHREADS) { prm[i] = 1.f + mbc[2 * D + i]; prm[D + i] = lg[i]; prm[2 * D + i] = lb[i]; prm[3 * D + i] = 1.f + mbc[4 * D + i]; prm[4 * D + i] = mbc[3 * D + i]; } }
                __syncthreads();
                pg8::bf16x8 wfh[4][3];
#pragma unroll
                for (int ks = 0; ks < 4; ++ks)
#pragma unroll
                    for (int nt = 0; nt < 3; ++nt) wfh[ks][nt] = *(const pg8::bf16x8*)(wrh + (size_t)(16 * nt + fr) * D + 128 * wave + 32 * ks + 8 * fq);
                f32x4 xn[2][4]; v2u yn[2][4];
#define LN1_LOAD(PS) do { _Pragma("unroll") for (int tt_ = 0; tt_ < 2; ++tt_) { const size_t mo_ = (size_t)(ch * 64 + (PS) * 16 + 2 * wave + tt_) * D + 4 * lane; \
        _Pragma("unroll") for (int j_ = 0; j_ < 4; ++j_) { xn[tt_][j_] = *(const f32x4*)(xcur + mo_ + 256 * j_); yn[tt_][j_] = *(const v2u*)(Yb + mo_ + 256 * j_); } } } while (0)
                LN1_LOAD(0);
                for (int ps = 0; ps < 4; ++ps) {
                    TS_T0(130)
                    f32x4 xc[2][4]; v2u yc[2][4];
#pragma unroll
                    for (int tt = 0; tt < 2; ++tt)
#pragma unroll
                        for (int j = 0; j < 4; ++j) { xc[tt][j] = xn[tt][j]; yc[tt][j] = yn[tt][j]; }
                    LN1_LOAD(ps < 3 ? ps + 1 : 3);
#pragma unroll
                    for (int tt = 0; tt < 2; ++tt) {
                        const int tl = 2 * wave + tt, m = ch * 64 + ps * 16 + tl;
                        f32x4 v[4]; float sm = 0.f;
#pragma unroll
                        for (int j = 0; j < 4; ++j) { const int d = 4 * lane + 256 * j;
                            const f32x4 xv = xc[tt][j], g1 = *(const LAS f32x4*)(prm + d);
                            const v2u yw = yc[tt][j]; const f32x4 yv = {bflo(yw.x), bfhi(yw.x), bflo(yw.y), bfhi(yw.y)};
                            v[j] = ALPHA * xv + g1 * yv; sm += (v[j][0] + v[j][1]) + (v[j][2] + v[j][3]); }
                        const float mean = wave_sum(sm) * (1.f / D); float q = 0.f;
#pragma unroll
                        for (int j = 0; j < 4; ++j) { v[j] = v[j] - mean; q += (v[j][0] * v[j][0] + v[j][1] * v[j][1]) + (v[j][2] * v[j][2] + v[j][3] * v[j][3]); }
                        const float rstd = rsqrtf(wave_sum(q) * (1.f / D) + LN_EPS);
#pragma unroll
                        for (int j = 0; j < 4; ++j) { const int d = 4 * lane + 256 * j;
                            const f32x4 x1 = v[j] * rstd * *(const LAS f32x4*)(prm + D + d) + *(const LAS f32x4*)(prm + 2 * D + d);
                            *(f32x4*)(X1 + (size_t)m * D + d) = x1;
                            const f32x4 h2 = x1 * *(const LAS f32x4*)(prm + 3 * D + d) + *(const LAS f32x4*)(prm + 4 * D + d);
                            unsigned hb[4], lbv[4];
#pragma unroll
                            for (int e = 0; e < 4; ++e) { hb[e] = f2bf(h2[e]); lbv[e] = f2bf(h2[e] - __uint_as_float(hb[e] << 16)); }
                            v2u oh; oh.x = hb[0] | (hb[1] << 16); oh.y = hb[2] | (hb[3] << 16); v2u ol; ol.x = lbv[0] | (lbv[1] << 16); ol.y = lbv[2] | (lbv[3] << 16);
                            *(v2u*)(Hb + (size_t)m * D + d) = oh;
                            *(LAS v2u*)(Hhi + tl * 2064 + d * 2) = oh; *(LAS v2u*)(Hlo + tl * 2064 + d * 2) = ol; }
                    }
                    pg8::bf16x8 wfl[4][3];
#pragma unroll
                    for (int ks = 0; ks < 4; ++ks)
#pragma unroll
                        for (int nt = 0; nt < 3; ++nt) wfl[ks][nt] = *(const pg8::bf16x8*)(wrl + (size_t)(16 * nt + fr) * D + 128 * wave + 32 * ks + 8 * fq);
                    LDS_BARRIER();
                    TS_T1(130) TS_T0(131)
                    { f32x4 acc[3];
#pragma unroll
                      for (int nt = 0; nt < 3; ++nt) acc[nt] = (f32x4){0.f, 0.f, 0.f, 0.f};
#pragma unroll
                      for (int ks = 0; ks < 4; ++ks) { const int kk = 128 * wave + 32 * ks + 8 * fq;
                          const pg8::bf16x8 hh = *(const LAS pg8::bf16x8*)(Hhi + fr * 2064 + kk * 2), hl = *(const LAS pg8::bf16x8*)(Hlo + fr * 2064 + kk * 2);
#pragma unroll
                          for (int nt = 0; nt < 3; ++nt) { const pg8::bf16x8 wh = wfh[ks][nt], wl = wfl[ks][nt];
                              acc[nt] = __builtin_amdgcn_mfma_f32_16x16x32_bf16(wh, hh, acc[nt], 0, 0, 0);
                              acc[nt] = __builtin_amdgcn_mfma_f32_16x16x32_bf16(wh, hl, acc[nt], 0, 0, 0);
                              acc[nt] = __builtin_amdgcn_mfma_f32_16x16x32_bf16(wl, hh, acc[nt], 0, 0, 0); } }
#pragma unroll
                      for (int nt = 0; nt < 3; ++nt) *(LAS f32x4*)(part + (wave * 16 + fr) * 48 + 16 * nt + 4 * fq) = acc[nt]; }
                    LDS_BARRIER();
                    TS_T1(131) TS_T0(132)
                    for (int idx = tid; idx < 16 * 48; idx += NTHREADS) { const int o = idx % 48; float sacc = o < NG ? bgp[o] : (o < NRT ? bep[o - NG] : 0.f);
#pragma unroll
                        for (int w8 = 0; w8 < 8; ++w8) sacc += part[w8 * 16 * 48 + idx];
                        lgt[idx] = sacc; }
                    LDS_BARRIER();
                    if (tid < 16) { const LAS float* L = lgt + tid * 48; const int tl = ps * 16 + tid;
                        int gi = 0; float gm = L[0];
#pragma unroll
                        for (int o = 1; o < NG; ++o) if (L[o] > gm) { gm = L[o]; gi = o; }
                        float gs = 0.f;
#pragma unroll
                        for (int o = 0; o < NG; ++o) gs += __expf(L[o] - gm);
                        const float gprob = 1.f / gs; const LAS float* E8 = L + NG + gi * EPG;
                        int i0 = 0; float m0 = E8[0];
#pragma unroll
                        for (int e = 1; e < EPG; ++e) if (E8[e] > m0) { m0 = E8[e]; i0 = e; }
                        int i1 = 0; float m1 = -INFINITY;
#pragma unroll
                        for (int e = 0; e < EPG; ++e) if (e != i0 && E8[e] > m1) { m1 = E8[e]; i1 = e; }
                        const float p1 = __expf(m1 - m0), den = 1.f + p1; const int e0 = gi * EPG + i0, e1 = gi * EPG + i1;
                        rt_e[2 * tl] = e0; rt_e[2 * tl + 1] = e1; rt_g[2 * tl] = gprob / den; rt_g[2 * tl + 1] = gprob * p1 / den;
                        rt_lp[2 * tl] = atomicAdd((int*)&hist[e0], 1); rt_lp[2 * tl + 1] = atomicAdd((int*)&hist[e1], 1); }
                    TS_T1(132)
                }
                TS_T0(133)
                __syncthreads();
                if (tid < 32) { const int c = hist[tid]; basee[tid] = c ? (int)__hip_atomic_fetch_add(cnt + 64 * tid, (unsigned)c, RLX_AGENT) : 0; }
                __syncthreads();
                if (tid < 128) { const int e = rt_e[tid], A = ch * 128 + tid, ps_ = basee[e] + rt_lp[tid]; r_eid[A] = e; r_pos[A] = ps_; r_gate[A] = rt_g[tid]; if (!dmy_) tokmap[e * TOKCAP + ps_] = A >> 1; }
                __syncthreads();
                TS_T1(133)
            }
#undef LN1_LOAD
        TS_T1(113) } GRID_SYNC_T(123); }
        for (int rep_ = 0; rep_ < NREP(5); ++rep_) {
            { PH_BEGIN TS_T0(115)
            build_tiles((const unsigned*)(ws + WS_CTL) + CW_CNT + CNT_LAYER_STRIDE * layer, misc, tid);
            const int ntiles = __builtin_amdgcn_readfirstlane(misc[33]);
            pg8::Gemm g{(const bf16*)(ws + WS_H), (const bf16*)(ws + WGU_SET(layer)), ntiles * 256, NE * D, D}; MoeOrder So{ntiles * 4, G, bid, misc + 64, misc + 256, misc + 448, (const int*)(ws + WS_TOKMAP)};
            pg8::EpiSwiglu E{(bf16*)(ws + WS_HMID)};
            pg8::gemm_phase<pg8::EpiSwiglu, MoeOrder, true, true, true>(lds, g, So, E);
            if (layer + 1 < DEPTH) { const int idle = idle_cus(ntiles * 4, G), first = conv_total_a(layer, G);
                if (bid >= G - idle) { int end = first + idle * NWAVES * CQ_B; end = end < CONV_ITEMS ? end : CONV_ITEMS;
                    moe_weight_items(INP(17), INP(18), INP(19), layer + 1, (bf16*)(ws + WGU_SET(layer + 1)), (bf16*)(ws + WDN_SET(layer + 1)), (LAS float*)(lds + wave * 8704), first + (bid - (G - idle)) * NWAVES + wave, idle * NWAVES, end, lane); } }
        TS_T1(115) } GRID_SYNC_T(125); }
        for (int rep_ = 0; rep_ < NREP(6); ++rep_) {
            { PH_BEGIN TS_T0(116)
            const int ntiles = __builtin_amdgcn_readfirstlane(misc[33]);
            pg8::Gemm g{(const bf16*)(ws + WS_HMID), (const bf16*)(ws + WDN_SET(layer)), ntiles * 256, NE * D, DE}; MoeOrder So{ntiles * 4, G, bid, misc + 64, misc + 256, misc + 448, nullptr};
            pg8::EpiStore8 E{(bf16*)(ws + WS_YS), D, 0, 0, 1.f, 3};
            pg8::gemm_phase<pg8::EpiStore8, MoeOrder, true, true>(lds, g, So, E);
            if (layer + 1 < DEPTH) { const int idle = idle_cus(ntiles * 4, G); int first = conv_total_a(layer, G) + idle * NWAVES * CQ_B; first = first < CONV_ITEMS ? first : CONV_ITEMS;
                if (bid >= G - idle) { int end = first + idle * NWAVES * CQ_C; end = end < CONV_ITEMS ? end : CONV_ITEMS;
                    moe_weight_items(INP(17), INP(18), INP(19), layer + 1, (bf16*)(ws + WGU_SET(layer + 1)), (bf16*)(ws + WDN_SET(layer + 1)), (LAS float*)(lds + wave * 8704), first + (bid - (G - idle)) * NWAVES + wave, idle * NWAVES, end, lane); } }
        TS_T1(116) } GRID_SYNC_T(126); }
        for (int rep_ = 0; rep_ < NREP(7); ++rep_) {
            { PH_BEGIN TS_T0(117)
            const float* lg = INP(4) + (size_t)(layer * 2 + 1) * D; const float* lb = INP(5) + (size_t)(layer * 2 + 1) * D;
            const bool last = layer == DEPTH - 1; float* xo = last ? (float*)ldptr(ptab, 20) : (float*)(ws + WS_X2);
            const float tsc = (PROBE_TS >= 0 && last) ? 1.f + (float)__hip_atomic_load((unsigned*)(ws + WS_CTL) + CW_TS, RLX_AGENT) * 1e-6f : 1.f;
            const float* modl = (const float*)(ws + WS_MOD) + (size_t)layer * NB * 6 * D; const float* modn = modl + (size_t)NB * 6 * D;
            const float* X1 = (const float*)(ws + WS_X1); bf16* Hb = (bf16*)(ws + WS_H); const bf16* YS = (const bf16*)(ws + WS_YS);
            const int* r_eid = (const int*)(ws + WS_ROUTE); const int* r_pos = r_eid + 2 * M; const float* r_gate = (const float*)(r_pos + 2 * M);
            TS_T0(140)
            LAS float* prm = (LAS float*)(lds + 98304);
            for (int ch = bid; ch < M / 64; ch += G) {
                __syncthreads();
                { const float* mbc = modl + (size_t)((ch * 64) >> 11) * (6 * D); const float* mnc = modn + (size_t)((ch * 64) >> 11) * (6 * D);
                  for (int i = tid; i < D; i += NTHREADS) { prm[i] = 1.f + mbc[5 * D + i]; prm[D + i] = lg[i]; prm[2 * D + i] = lb[i];
                      prm[3 * D + i] = last ? 0.f : 1.f + mnc[D + i]; prm[4 * D + i] = last ? 0.f : mnc[i]; } }
                __syncthreads();
                const int mbase = ch * 64 + wave * 8;
                int sl0, sl1; float gt0, gt1;
                { const int mi = mbase + (lane & 7); sl0 = misc[r_eid[2 * mi]] * 256 + r_pos[2 * mi]; sl1 = misc[r_eid[2 * mi + 1]] * 256 + r_pos[2 * mi + 1]; gt0 = r_gate[2 * mi]; gt1 = r_gate[2 * mi + 1]; }
                f32x4 xn[4]; v2u yan[4], ybn[4];
#define CMB_LOAD(I) do { const int mi_ = mbase + (I); const int s0_ = __builtin_amdgcn_readlane(sl0, (I)), s1_ = __builtin_amdgcn_readlane(sl1, (I)); \
        _Pragma("unroll") for (int j_ = 0; j_ < 4; ++j_) { const int d_ = 4 * lane + 256 * j_; xn[j_] = *(const f32x4*)(X1 + (size_t)mi_ * D + d_); \
            yan[j_] = *(const v2u*)(YS + (size_t)s0_ * D + d_); ybn[j_] = *(const v2u*)(YS + (size_t)s1_ * D + d_); } } while (0)
                CMB_LOAD(0);
#pragma unroll
                for (int i = 0; i < 8; ++i) {
                    const int m = mbase + i;
                    const float g0 = __builtin_bit_cast(float, __builtin_amdgcn_readlane(__builtin_bit_cast(int, gt0), i)), g1v = __builtin_bit_cast(float, __builtin_amdgcn_readlane(__builtin_bit_cast(int, gt1), i));
                    f32x4 xc[4]; v2u yac[4], ybc[4];
#pragma unroll
                    for (int j = 0; j < 4; ++j) { xc[j] = xn[j]; yac[j] = yan[j]; ybc[j] = ybn[j]; }
                    if (i < 7) CMB_LOAD(i + 1);
                    f32x4 v[4]; float sm = 0.f;
#pragma unroll
                    for (int j = 0; j < 4; ++j) { const int d = 4 * lane + 256 * j;
                        const f32x4 g2 = *(const LAS f32x4*)(prm + d); const v2u ya = yac[j], yb = ybc[j];
                        const f32x4 y0 = {bflo(ya.x), bfhi(ya.x), bflo(ya.y), bfhi(ya.y)}, y1 = {bflo(yb.x), bfhi(yb.x), bflo(yb.y), bfhi(yb.y)};
                        v[j] = ALPHA * xc[j] + g2 * (g0 * y0 + g1v * y1); sm += (v[j][0] + v[j][1]) + (v[j][2] + v[j][3]); }
                    const float mean = wave_sum(sm) * (1.f / D); float q = 0.f;
#pragma unroll
                    for (int j = 0; j < 4; ++j) { v[j] = v[j] - mean; q += (v[j][0] * v[j][0] + v[j][1] * v[j][1]) + (v[j][2] * v[j][2] + v[j][3] * v[j][3]); }
                    const float rstd = rsqrtf(wave_sum(q) * (1.f / D) + LN_EPS);
#pragma unroll
                    for (int j = 0; j < 4; ++j) { const int d = 4 * lane + 256 * j;
                        const f32x4 x2 = v[j] * rstd * *(const LAS f32x4*)(prm + D + d) + *(const LAS f32x4*)(prm + 2 * D + d);
                        *(f32x4*)(xo + (size_t)m * D + d) = x2 * tsc;
                        if (!last) { const f32x4 hn = x2 * *(const LAS f32x4*)(prm + 3 * D + d) + *(const LAS f32x4*)(prm + 4 * D + d);
                            v2u o; o.x = pk2(hn[0], hn[1]); o.y = pk2(hn[2], hn[3]); *(v2u*)(Hb + (size_t)m * D + d) = o; } }
                }
#undef CMB_LOAD
            }
            __syncthreads();
            TS_T1(140) TS_T0(141)
            if (!last) { LAS float* scr = (LAS float*)(lds + wave * 8704); const int idle = idle_cus(__builtin_amdgcn_readfirstlane(misc[33]) * 4, G);
                int first = conv_total_a(layer, G) + idle * NWAVES * (CQ_B + CQ_C); first = first < CONV_ITEMS ? first : CONV_ITEMS;
                moe_weight_items(INP(17), INP(18), INP(19), layer + 1, (bf16*)(ws + WGU_SET(layer + 1)), (bf16*)(ws + WDN_SET(layer + 1)), scr, first + gw, NGW, CONV_ITEMS, lane); }
            TS_T1(141)
        TS_T1(117) } if (layer != DEPTH - 1 || PROBE_REPEAT == 7) GRID_SYNC_T(127); }
    }
}

extern "C" void kernel_launch(void* const* d_in, const int* in_sizes, int n_in, void* d_out, int out_size, void* d_ws, size_t ws_size, hipStream_t stream) {
    static int grid = 0;
    if (grid == 0) {
        if (n_in != 20 || ws_size < WS_END) { fprintf(stderr, "kernel_launch: unexpected inputs (n_in %d, ws %zu)\n", n_in, ws_size); grid = -1; return; }
        int dev = 0, cus = 0, per_cu = 0;
        if (hipGetDevice(&dev) != hipSuccess || hipDeviceGetAttribute(&cus, hipDeviceAttributeMultiprocessorCount, dev) != hipSuccess) { grid = -1; return; }
        if (hipFuncSetAttribute((const void*)mk_fwd, hipFuncAttributeMaxDynamicSharedMemorySize, LDS_BYTES) != hipSuccess) { fprintf(stderr, "kernel_launch: hipFuncSetAttribute failed\n"); grid = -1; return; }
        if (hipOccupancyMaxActiveBlocksPerMultiprocessor(&per_cu, (const void*)mk_fwd, NTHREADS, LDS_BYTES) != hipSuccess || per_cu < 1) { fprintf(stderr, "kernel_launch: occupancy query failed (%d)\n", per_cu); per_cu = 1; }
        (void)hipGetLastError();
        grid = cus * (per_cu < 1 ? 1 : 1);
    }
    if (grid < 0) return;
    (void)in_sizes; (void)out_size;
    if (hipMemsetAsync((char*)d_ws + WS_CTL, 0, CTL_ZERO_BYTES, stream) != hipSuccess) { fprintf(stderr, "kernel_launch: memset failed\n"); return; }
    Args a{};
    for (int i = 0; i < 20; ++i) a.in[i] = (const float*)d_in[i];
    a.out = (float*)d_out; a.ws = (unsigned char*)d_ws;
    void* kargs[] = {&a};
    hipError_t e = hipLaunchCooperativeKernel((const void*)mk_fwd, dim3(grid), dim3(NTHREADS), kargs, LDS_BYTES, stream);
    if (e != hipSuccess) fprintf(stderr, "kernel_launch: cooperative launch failed: %s (grid %d)\n", hipGetErrorString(e), grid);
}
```

```cpp
#include <hip/hip_runtime.h>
#include <hip/hip_cooperative_groups.h>
#include <cstdio>
#include <cstdint>
namespace cg = cooperative_groups;
namespace pg8 {
#define PG8_LAS __attribute__((address_space(3)))
typedef unsigned short bf16_t;
typedef short bf16x8 __attribute__((ext_vector_type(8)));
typedef float f32x4 __attribute__((ext_vector_type(4)));
typedef unsigned u32x4 __attribute__((ext_vector_type(4)));
constexpr int BM = 256, BK = 64, HALF = 128, HTB = HALF * BK * 2  , STAGE_BYTES = 8 * HTB, NXCD = 8, WGM = 8;

__host__ __device__ __forceinline__ int lds_byte(int r, int c) { const int st = (r >> 4) * 2 + (c >> 5), rr = r & 15, cc = c & 31, ob = rr * 64 + cc * 2; return st * 1024 + (ob ^ (((ob >> 9) & 1) << 5)); }
__host__ __device__ __forceinline__ void stage_rc(int b, int& R, int& C) { const int st = b / 1024, sb = b % 1024, swz = sb ^ (((sb >> 9) & 1) << 5); R = (st >> 1) * 16 + swz / 64; C = (st & 1) * 32 + (swz % 64) / 2; }
__host__ __device__ __forceinline__ int perm32(int rho) { const int n = rho >> 4, i = rho & 15; return 8 * (i >> 2) + 4 * n + (i & 3); }

struct Unit { int pm, pn; };
struct Gemm { const bf16_t* A; const bf16_t* Bt; int M, N, K; };

struct StaticOrder {
    int nM, nN, nwg, G, c;
    __host__ __device__ void init(int M, int N, int G_, int c_) { nM = M / BM; nN = N / BM; nwg = nM * nN; G = G_; c = c_; }
    __host__ __device__ bool next(int i, Unit& u) const {
        const long L = (long)i * G + c; if (L >= nwg) return false;
        int wgid = (int)L; { const int q = nwg / NXCD, r = nwg % NXCD, xcd = wgid % NXCD, off = wgid / NXCD; wgid = (xcd < r ? xcd * (q + 1) : r * (q + 1) + (xcd - r) * q) + off; }
        const int nig = WGM * nN, gid = wgid / nig, fm = gid * WGM, gsz = (nM - fm) < WGM ? (nM - fm) : WGM;
        u.pm = fm + ((wgid % nig) % gsz); u.pn = (wgid % nig) / gsz; return true;
    }
    __device__ __forceinline__ void a_ready(const Unit&) const {}
    __device__ __forceinline__ void done(const Unit&) const {}
};

__device__ __forceinline__ unsigned cvt_pk_bf16(float lo, float hi) { unsigned r; asm volatile("v_cvt_pk_bf16_f32 %0, %1, %2" : "=v"(r) : "v"(lo), "v"(hi)); return r; }
__device__ __forceinline__ u32x4 pack8(const f32x4& a, const f32x4& b) { u32x4 w; w.x = cvt_pk_bf16(a[0], a[1]); w.y = cvt_pk_bf16(a[2], a[3]); w.z = cvt_pk_bf16(b[0], b[1]); w.w = cvt_pk_bf16(b[2], b[3]); return w; }

struct EpiStore8 {
    static constexpr bool PERM = false, AFTER_DRAIN = false;
    bf16_t* O; int ldc; int split_cols; size_t split_stride; float scale0; int pn_mask;
    __device__ __forceinline__ void operator()(const f32x4 (&acc)[2][2][4][2], const Unit& u, int wr, int wc, int fr, int fq) const {
        const int row0 = u.pm * BM + wr * 64 + fr; int colt = (u.pn & pn_mask) * BM; bf16_t* base = O;
        float sc = 1.f; if (split_cols) { const int t = colt / split_cols; base += (size_t)t * split_stride; colt -= t * split_cols; if (t == 0) sc = scale0; }
        const int col0 = colt + wc * 32 + 8 * fq;
#pragma unroll
        for (int ai = 0; ai < 2; ++ai)
#pragma unroll
            for (int m = 0; m < 4; ++m) { bf16_t* rowp = base + (size_t)(row0 + ai * HALF + m * 16) * ldc + col0;
#pragma unroll
                for (int bj = 0; bj < 2; ++bj) { const f32x4 v0 = acc[ai][bj][m][0] * sc, v1 = acc[ai][bj][m][1] * sc; *(u32x4*)(rowp + bj * HALF) = pack8(v0, v1); } }
    }
};
__device__ __forceinline__ float silu_f(float g) { return g * __builtin_amdgcn_rcpf(1.f + __expf(-g)); }
struct EpiSwiglu {
    static constexpr bool PERM = false, AFTER_DRAIN = false;
    bf16_t* O;
    __device__ __forceinline__ void operator()(const f32x4 (&acc)[2][2][4][2], const Unit& u, int wr, int wc, int fr, int fq) const {
        const int row0 = u.pm * BM + wr * 64 + fr; const int col0 = (u.pn & 3) * 128 + wc * 32 + 8 * fq;
#pragma unroll
        for (int ai = 0; ai < 2; ++ai)
#pragma unroll
            for (int m = 0; m < 4; ++m) { bf16_t* rowp = O + (size_t)(row0 + ai * HALF + m * 16) * 512 + col0; f32x4 h[2];
#pragma unroll
                for (int n = 0; n < 2; ++n) { const f32x4 g = acc[ai][0][m][n], up = acc[ai][1][m][n];
                    h[n] = (f32x4){silu_f(g[0]) * up[0], silu_f(g[1]) * up[1], silu_f(g[2]) * up[2], silu_f(g[3]) * up[3]}; }
                *(u32x4*)rowp = pack8(h[0], h[1]); }
    }
};
struct EpiGqaQkv {
    static constexpr bool PERM = false, AFTER_DRAIN = false;
    bf16_t *Q, *K, *V; const float* qn; const float* kn; const float* cs; const float* sn; float qscale;
    __device__ __forceinline__ void operator()(const f32x4 (&acc)[2][2][4][2], const Unit& u, int wr, int wc, int fr, int fq) const {
        const int row0 = u.pm * BM + wr * 64 + fr; const int pn = u.pn;
        const int type = pn < 4 ? 0 : (pn == 4 ? 1 : 2);
        bf16_t* base = type == 0 ? Q + (4 * pn + wc) * 64 : (type == 1 ? K : V) + wc * 64; const int ldc = type == 0 ? 1024 : 256;
        const int dlo = 32 * (fq >> 1) + 8 * (fq & 1);
        const int tlo = (fq >> 1) * 16 + 8 * (fq & 1);
        const float* gain = type == 0 ? qn : kn; const float sc = type == 0 ? qscale : 1.f;
        f32x4 gv[2][2];
#pragma unroll
        for (int bj = 0; bj < 2; ++bj)
#pragma unroll
            for (int n = 0; n < 2; ++n) gv[bj][n] = *(const f32x4*)(gain + dlo + 16 * bj + 4 * n) * sc;
#pragma unroll
        for (int ai = 0; ai < 2; ++ai)
#pragma unroll
            for (int m = 0; m < 4; ++m) { const int row = row0 + ai * HALF + m * 16; bf16_t* rowp = base + (size_t)row * ldc + dlo; f32x4 o[2][2];
                if (type < 2) {
                    float ss = 0.f;
#pragma unroll
                    for (int bj = 0; bj < 2; ++bj)
#pragma unroll
                        for (int n = 0; n < 2; ++n) { const f32x4 x = acc[ai][bj][m][n]; ss += (x[0] * x[0] + x[1] * x[1]) + (x[2] * x[2] + x[3] * x[3]); }
                    ss += __shfl_xor(ss, 16); ss += __shfl_xor(ss, 32);
                    const float rinv = rsqrtf(ss * (1.f / 64.f) + 1e-6f);
                    const int t = row & 2047;
#pragma unroll
                    for (int n = 0; n < 2; ++n) { const f32x4 c4 = *(const f32x4*)(cs + t * 32 + tlo + 4 * n), s4 = *(const f32x4*)(sn + t * 32 + tlo + 4 * n);
                        const f32x4 x1 = acc[ai][0][m][n] * rinv * gv[0][n], x2 = acc[ai][1][m][n] * rinv * gv[1][n];
                        o[0][n] = x1 * c4 - x2 * s4; o[1][n] = x2 * c4 + x1 * s4; }
                } else {
#pragma unroll
                    for (int bj = 0; bj < 2; ++bj)
#pragma unroll
                        for (int n = 0; n < 2; ++n) o[bj][n] = acc[ai][bj][m][n];
                }
#pragma unroll
                for (int bj = 0; bj < 2; ++bj) *(u32x4*)(rowp + 16 * bj) = pack8(o[bj][0], o[bj][1]); }
    }
};
template <class Epi, class Sched, bool ALIGN_EPI = false, bool SP2 = false, bool GATHER = false>
__device__ __forceinline__ void gemm_phase(PG8_LAS unsigned char* lds, const Gemm g, const Sched& S, const Epi& E) {
    int tid_ = threadIdx.x; asm volatile("" : "+v"(tid_)); const int tid = tid_, wid = __builtin_amdgcn_readfirstlane(tid >> 6), lane = tid & 63, wr = wid >> 2, wc = wid & 3, fr = lane & 15, fq = lane >> 4;
    const int K = g.K, nt = K / BK;
    unsigned voffA[2], voffB[2];
#pragma unroll
    for (int i = 0; i < 2; ++i) { int R, C; stage_rc(tid * 16 + i * 8192, R, C); const int Rb = Epi::PERM ? ((R & ~31) + perm32(R & 31)) : R;
        voffA[i] = (unsigned)(R * K + C) * 2u; voffB[i] = (unsigned)(Rb * K + C) * 2u; }
    static_assert(!GATHER || SP2, "row gather is wired into the SP2 loop only");
    unsigned vAc[2][2], vAn[2][2], vA2[2][2];
    int gR[2], gC[2];
#pragma unroll
    for (int i = 0; i < 2; ++i) { int R, C; stage_rc(tid * 16 + i * 8192, R, C); gR[i] = R; gC[i] = C; }
#define PG8_ROWOFF(dst, u) do { if constexpr (GATHER) { _Pragma("unroll") for (int h_ = 0; h_ < 2; ++h_) _Pragma("unroll") for (int i_ = 0; i_ < 2; ++i_) \
        dst[h_][i_] = ((unsigned)S.arow(u, h_ * HALF + gR[i_]) * (unsigned)K + (unsigned)gC[i_]) * 2u; } } while (0)
    const size_t kstep = (size_t)(BK * 2);
    const size_t hstep = (size_t)HALF * K * 2;
    const size_t tstep = 2 * hstep;
    const unsigned ldsw = (unsigned)wid * 1024u;
    const int aoff = lds_byte(wr * 64 + fr, fq * 8), boff = lds_byte(wc * 32 + fr, fq * 8);
#define PG8_SA(b, h) (((b) * 2 + (h)) * HTB)
#define PG8_SB(b, h) ((4 + (b) * 2 + (h)) * HTB)
#define PG8_STAGE(bufoff, gbase, voff) do { _Pragma("unroll") for (int _i = 0; _i < 2; ++_i) \
        __builtin_amdgcn_global_load_lds((const unsigned*)((const char*)(gbase) + (voff)[_i]), (PG8_LAS unsigned*)(lds + (bufoff) + ldsw + _i * 8192), 16, 0, 0); } while (0)
#define PG8_STAGE_A(bufoff, base, h, W) do { if constexpr (GATHER) { PG8_STAGE(bufoff, base, W[h]); } else { PG8_STAGE(bufoff, (base) + (h) * hstep, voffA); } } while (0)
#define PG8_LDA(dst, b, h) do { _Pragma("unroll") for (int m = 0; m < 4; ++m) _Pragma("unroll") for (int k = 0; k < 2; ++k) dst[m][k] = *(const PG8_LAS bf16x8*)(lds + PG8_SA(b, h) + aoff + m * 2048 + k * 1024); } while (0)
#define PG8_LDB(dst, b, h) do { _Pragma("unroll") for (int n = 0; n < 2; ++n) _Pragma("unroll") for (int k = 0; k < 2; ++k) dst[n][k] = *(const PG8_LAS bf16x8*)(lds + PG8_SB(b, h) + boff + n * 2048 + k * 1024); } while (0)
#define PG8_MMA(ai, bj, At, Bt) do { __builtin_amdgcn_s_setprio(1); _Pragma("unroll") for (int m = 0; m < 4; ++m) _Pragma("unroll") for (int n = 0; n < 2; ++n) _Pragma("unroll") for (int k = 0; k < 2; ++k) \
        acc[ai][bj][m][n] = __builtin_amdgcn_mfma_f32_16x16x32_bf16(Bt[n][k], At[m][k], acc[ai][bj][m][n], 0, 0, 0); __builtin_amdgcn_s_setprio(0); } while (0)
#define PG8_WAIT_V(n) asm volatile("s_waitcnt vmcnt(" #n ")" ::: "memory")
#define PG8_WAIT_L(n) asm volatile("s_waitcnt lgkmcnt(" #n ")" ::: "memory")
#define PG8_BAR __builtin_amdgcn_s_barrier()
#define PG8_SCHED __builtin_amdgcn_sched_barrier(0)
    Unit cur, nxt; int ui = 0;
    if (!S.next(0, cur)) return;
    f32x4 acc[2][2][4][2];
#pragma unroll
    for (int a = 0; a < 2; ++a)
#pragma unroll
        for (int b = 0; b < 2; ++b)
#pragma unroll
            for (int m = 0; m < 4; ++m)
#pragma unroll
                for (int n = 0; n < 2; ++n) acc[a][b][m][n] = (f32x4){0.f, 0.f, 0.f, 0.f};
    bf16x8 At[4][2], B0[2][2], B1[2][2];
    const char* cA = (const char*)g.A + (GATHER ? (size_t)0 : (size_t)cur.pm * tstep); PG8_ROWOFF(vAc, cur); const char* cB = (const char*)g.Bt + (size_t)cur.pn * tstep;
    S.a_ready(cur);
    if constexpr (SP2) {
        PG8_STAGE(PG8_SB(0, 0), cB, voffB); PG8_STAGE(PG8_SB(0, 1), cB + hstep, voffB); PG8_STAGE_A(PG8_SA(0, 0), cA, 0, vAc); PG8_STAGE_A(PG8_SA(0, 1), cA, 1, vAc);
        if (wr == 1) PG8_BAR;
        PG8_WAIT_V(2); PG8_BAR;
        PG8_STAGE(PG8_SB(1, 0), cB + kstep, voffB); PG8_STAGE_A(PG8_SA(1, 0), cA + kstep, 0, vAc); PG8_STAGE(PG8_SB(1, 1), cB + hstep + kstep, voffB);
        PG8_WAIT_V(6); PG8_BAR;
    } else {
        PG8_STAGE(PG8_SB(0, 0), cB, voffB); PG8_STAGE(PG8_SA(0, 0), cA, voffA); PG8_STAGE(PG8_SB(0, 1), cB + hstep, voffB); PG8_STAGE(PG8_SA(0, 1), cA + hstep, voffA);
        if (wr == 1) PG8_BAR;
        PG8_WAIT_V(4); PG8_BAR;
        PG8_STAGE(PG8_SB(1, 0), cB + kstep, voffB); PG8_STAGE(PG8_SA(1, 0), cA + kstep, voffA); PG8_STAGE(PG8_SB(1, 1), cB + hstep + kstep, voffB);
        PG8_WAIT_V(6); PG8_BAR;
    }
    for (;;) {
        const bool has_next = S.next(ui + 1, nxt);
        const char* nA = has_next ? (const char*)g.A + (GATHER ? (size_t)0 : (size_t)nxt.pm * tstep) : cA;
        if constexpr (GATHER) { if (has_next) { PG8_ROWOFF(vAn, nxt); } else { _Pragma("unroll") for (int h_ = 0; h_ < 2; ++h_) _Pragma("unroll") for (int i_ = 0; i_ < 2; ++i_) vAn[h_][i_] = vAc[h_][i_]; } } const char* nB = has_next ? (const char*)g.Bt + (size_t)nxt.pn * tstep : cB;
        for (int t = 0; t < nt; t += 2) {
            const bool last = (t == nt - 2);
            const char* a1 = cA + (size_t)(t + 1) * kstep;
            const char* a2 = last ? nA : cA + (size_t)(t + 2) * kstep; const char* b2 = last ? nB : cB + (size_t)(t + 2) * kstep;
            const char* a3 = a2 + kstep; const char* b3 = b2 + kstep;
            if constexpr (GATHER) { _Pragma("unroll") for (int h_ = 0; h_ < 2; ++h_) _Pragma("unroll") for (int i_ = 0; i_ < 2; ++i_) vA2[h_][i_] = last ? vAn[h_][i_] : vAc[h_][i_]; }
            if (last && has_next) S.a_ready(nxt);
            if constexpr (SP2) {
            PG8_LDB(B0, 0, 0); PG8_LDB(B1, 0, 1); PG8_SCHED; PG8_LDA(At, 0, 0); PG8_STAGE_A(PG8_SA(1, 1), a1, 1, vAc);
            PG8_WAIT_V(8); PG8_WAIT_L(0); PG8_BAR; PG8_MMA(0, 0, At, B0); PG8_MMA(0, 1, At, B1); PG8_BAR; PG8_SCHED;
            PG8_LDA(At, 0, 1); PG8_STAGE(PG8_SB(0, 0), b2, voffB); PG8_STAGE(PG8_SB(0, 1), b2 + hstep, voffB); PG8_STAGE_A(PG8_SA(0, 0), a2, 0, vA2);
            PG8_WAIT_V(8); PG8_WAIT_L(0); PG8_BAR; PG8_MMA(1, 0, At, B0); PG8_MMA(1, 1, At, B1); PG8_BAR; PG8_SCHED;
            PG8_LDB(B0, 1, 0); PG8_LDB(B1, 1, 1); PG8_SCHED; PG8_LDA(At, 1, 0); PG8_STAGE_A(PG8_SA(0, 1), a2, 1, vA2);
            PG8_WAIT_V(8); PG8_WAIT_L(0); PG8_BAR; PG8_MMA(0, 0, At, B0); PG8_MMA(0, 1, At, B1); PG8_BAR; PG8_SCHED;
            PG8_LDA(At, 1, 1); PG8_STAGE(PG8_SB(1, 0), b3, voffB); PG8_STAGE(PG8_SB(1, 1), b3 + hstep, voffB); PG8_STAGE_A(PG8_SA(1, 0), a3, 0, vA2);
            PG8_WAIT_V(8); PG8_WAIT_L(0); PG8_BAR; PG8_MMA(1, 0, At, B0); PG8_MMA(1, 1, At, B1); PG8_BAR; PG8_SCHED;
            } else {
            PG8_LDB(B0, 0, 0); PG8_SCHED; PG8_LDA(At, 0, 0); PG8_STAGE(PG8_SA(1, 1), a1 + hstep, voffA);
            PG8_WAIT_L(8); PG8_BAR; PG8_WAIT_L(0); PG8_MMA(0, 0, At, B0); PG8_BAR; PG8_SCHED;
            PG8_LDB(B1, 0, 1); PG8_STAGE(PG8_SB(0, 0), b2, voffB);
            PG8_BAR; PG8_WAIT_L(0); PG8_MMA(0, 1, At, B1); PG8_BAR;
            PG8_LDA(At, 0, 1); PG8_STAGE(PG8_SA(0, 0), a2, voffA);
            PG8_BAR; PG8_WAIT_L(0); PG8_MMA(1, 0, At, B0); PG8_BAR; PG8_SCHED;
            PG8_STAGE(PG8_SB(0, 1), b2 + hstep, voffB);
            PG8_WAIT_V(6); PG8_BAR; PG8_MMA(1, 1, At, B1); PG8_BAR;
            PG8_LDB(B0, 1, 0); PG8_SCHED; PG8_LDA(At, 1, 0); PG8_STAGE(PG8_SA(0, 1), a2 + hstep, voffA);
            PG8_WAIT_L(8); PG8_BAR; PG8_WAIT_L(0); PG8_MMA(0, 0, At, B0); PG8_BAR; PG8_SCHED;
            PG8_LDB(B1, 1, 1); PG8_STAGE(PG8_SB(1, 0), b3, voffB);
            PG8_BAR; PG8_WAIT_L(0); PG8_MMA(0, 1, At, B1); PG8_BAR;
            PG8_LDA(At, 1, 1); PG8_STAGE(PG8_SA(1, 0), a3, voffA);
            PG8_BAR; PG8_WAIT_L(0); PG8_MMA(1, 0, At, B0); PG8_BAR; PG8_SCHED;
            PG8_STAGE(PG8_SB(1, 1), b3 + hstep, voffB);
            PG8_WAIT_V(6); PG8_BAR; PG8_MMA(1, 1, At, B1); PG8_BAR;
            }
        }
        if constexpr (ALIGN_EPI) { if (wr == 0) PG8_BAR; }
        if constexpr (!Epi::AFTER_DRAIN) { E(acc, cur, wr, wc, fr, fq); S.done(cur); }
        if (!has_next) break;
#pragma unroll
        for (int a = 0; a < 2; ++a)
#pragma unroll
            for (int b = 0; b < 2; ++b)
#pragma unroll
                for (int m = 0; m < 4; ++m)
#pragma unroll
                    for (int n = 0; n < 2; ++n) acc[a][b][m][n] = (f32x4){0.f, 0.f, 0.f, 0.f};
        cur = nxt; cA = nA; cB = nB; ++ui;
        if constexpr (GATHER) { _Pragma("unroll") for (int h_ = 0; h_ < 2; ++h_) _Pragma("unroll") for (int i_ = 0; i_ < 2; ++i_) vAc[h_][i_] = vAn[h_][i_]; }
        if constexpr (ALIGN_EPI) { if (wr == 1) PG8_BAR; }
    }
    PG8_WAIT_V(0);
    if constexpr (!ALIGN_EPI) { if (wr == 0) PG8_BAR; }
    PG8_BAR;
    if constexpr (Epi::AFTER_DRAIN) { E.fused(acc, cur, wr, wc, fr, fq, lds, wid, lane); S.done(cur); }
#undef PG8_SA
#undef PG8_SB
#undef PG8_STAGE
#undef PG8_STAGE_A
#undef PG8_ROWOFF
#undef PG8_LDA
#undef PG8_LDB
#undef PG8_MMA
#undef PG8_WAIT_V
#undef PG8_WAIT_L
#undef PG8_BAR
#undef PG8_SCHED
}
}
#include <hip/hip_bf16.h>
#include <cmath>
namespace attn_body {
using bf16=__hip_bfloat16;
using bf16x8=__attribute__((ext_vector_type(8)))short;
using s16x4=__attribute__((ext_vector_type(4)))short;
using f32x16=__attribute__((ext_vector_type(16)))float;
using u32x4=__attribute__((ext_vector_type(4)))unsigned;
constexpr int BATCH=8,NHEAD=16,SEQ=2048,D=64,DM=NHEAD*D,KVP=256;
constexpr int NW=8,QBLK=32,QB=QBLK*NW,KVBLK=64,NQB=SEQ/QB;
constexpr int ATTN_PITCH=DM, ATTN_UNIT_ROWS=QB;
__device__ __forceinline__ int crow(int r,int hi){return (r&3)+8*(r>>2)+4*hi;}
#define SBAR() __builtin_amdgcn_sched_barrier(0)
__device__ __forceinline__ void cmask(f32x16&p0,f32x16&p1,int jb,int qrel,int hi){
  const float NEG=-INFINITY; int kb=64*jb+4*hi;
  #pragma unroll
  for(int r=0;r<16;++r){int kv=kb+(r&3)+8*(r>>2); if(kv>qrel)p0[r]=NEG; if(kv+32>qrel)p1[r]=NEG;}
}

constexpr int NSLOT=3, SLOTB=8192;
constexpr int LDS_K=0, LDS_V=NSLOT*SLOTB, LDS_WS=2*NSLOT*SLOTB, LDS_OST=LDS_WS+NW*64*4, LDS_BYTES=LDS_OST+NW*4096;
constexpr float C2=0.125f*1.4426950408889634f;
__device__ __forceinline__ void glds16(const void*gsrc,unsigned lds_dst){unsigned keep;
  asm volatile("s_mov_b32 %0, m0\n\ts_mov_b32 m0, %2\n\ts_nop 0\n\tglobal_load_lds_dwordx4 %1, off\n\ts_mov_b32 m0, %0":"=&s"(keep):"v"(gsrc),"s"(lds_dst):"memory");}
__device__ __forceinline__ float max3f(float a,float b,float c){float r;asm("v_max3_f32 %0, %1, %2, %3":"=v"(r):"v"(a),"v"(b),"v"(c));return r;}
__device__ __forceinline__ float max2f(float a,float b){float r;asm("v_max_f32_e32 %0, %1, %2":"=v"(r):"v"(a),"v"(b));return r;}
__device__ __forceinline__ float fadd_s(float a,float b){float r;asm("v_add_f32_e32 %0, %1, %2":"=v"(r):"v"(a),"v"(b));return r;}
__device__ __forceinline__ float fsub_s(float a,float b){float r;asm("v_sub_f32_e32 %0, %1, %2":"=v"(r):"v"(a),"v"(b));return r;}
typedef float f32x2_t __attribute__((ext_vector_type(2))); typedef __bf16 bf16x2_t __attribute__((ext_vector_type(2)));
__device__ __forceinline__ unsigned cvtpk_s(float lo,float hi){f32x2_t v={lo,hi};bf16x2_t b=__builtin_convertvector(v,bf16x2_t);return __builtin_bit_cast(unsigned,b);}
#define WAIT_BAR(N) asm volatile("s_waitcnt vmcnt(" #N ") lgkmcnt(0)\n\ts_barrier":::"memory")

__device__ __forceinline__ void qkt(f32x16&p0,f32x16&p1,const char*Kslot,const bf16x8*qr,const f32x16&negm,int r32,int hi){
  const char*kb=Kslot+hi*1024+r32*16;
  #pragma unroll
  for(int d0=0;d0<4;++d0){
    const bf16x8 b0=*reinterpret_cast<const bf16x8*>(kb+d0*2048);
    const bf16x8 b1=*reinterpret_cast<const bf16x8*>(kb+d0*2048+512);
    if(d0==0){p0=__builtin_amdgcn_mfma_f32_32x32x16_bf16(b0,qr[0],negm,0,0,0);p1=__builtin_amdgcn_mfma_f32_32x32x16_bf16(b1,qr[0],negm,0,0,0);}
    else{p0=__builtin_amdgcn_mfma_f32_32x32x16_bf16(b0,qr[d0],p0,0,0,0);p1=__builtin_amdgcn_mfma_f32_32x32x16_bf16(b1,qr[d0],p1,0,0,0);}}
}
typedef __attribute__((address_space(3))) const char* lds_cptr;
typedef short v4i16_t __attribute__((ext_vector_type(4)));
__device__ __forceinline__ void kload8(bf16x8*kf,lds_cptr kp){
  kf[0]=*(const __attribute__((address_space(3))) bf16x8*)(kp);      kf[1]=*(const __attribute__((address_space(3))) bf16x8*)(kp+512);
  kf[2]=*(const __attribute__((address_space(3))) bf16x8*)(kp+2048); kf[3]=*(const __attribute__((address_space(3))) bf16x8*)(kp+2560);
  kf[4]=*(const __attribute__((address_space(3))) bf16x8*)(kp+4096); kf[5]=*(const __attribute__((address_space(3))) bf16x8*)(kp+4608);
  kf[6]=*(const __attribute__((address_space(3))) bf16x8*)(kp+6144); kf[7]=*(const __attribute__((address_space(3))) bf16x8*)(kp+6656);
}
__device__ __forceinline__ void kload2(bf16x8*kf,lds_cptr kp,int j){ kf[2*j]=*(const __attribute__((address_space(3))) bf16x8*)(kp+j*2048); kf[2*j+1]=*(const __attribute__((address_space(3))) bf16x8*)(kp+j*2048+512); }
__device__ __forceinline__ s16x4 vtr(lds_cptr p){ return __builtin_bit_cast(s16x4,__builtin_amdgcn_ds_read_tr16_b64_v4i16((__attribute__((address_space(3))) v4i16_t*)p)); }
__device__ __forceinline__ float rowmax(const f32x16&p0,const f32x16&p1){
  float a=max3f(p0[0],p0[1],p1[0]),b=max3f(p0[2],p0[3],p1[1]);a=max3f(a,p1[2],p1[3]);
  #pragma unroll
  for(int r=4;r<16;r+=4){a=max3f(a,p0[r],p0[r+1]);b=max3f(b,p0[r+2],p0[r+3]);a=max3f(a,p1[r],p1[r+1]);b=max3f(b,p1[r+2],p1[r+3]);}
  const float m=max2f(a,b);
  auto rr=__builtin_amdgcn_permlane32_swap(__float_as_uint(m),__float_as_uint(m),false,false);
  return max2f(__uint_as_float(rr[0]),__uint_as_float(rr[1]));
}
__device__ __forceinline__ void pv(f32x16*o,int vb,bf16x8 pa0,bf16x8 pa1,bf16x8 pa2,bf16x8 pa3){
  #pragma unroll
  for(int d0=0;d0<2;++d0){s16x4 lo[4],hi[4];
    #pragma unroll
    for(int ks=0;ks<4;++ks){
      asm volatile("ds_read_b64_tr_b16 %0,%1 offset:%c2":"=&v"(lo[ks]):"v"(vb),"i"(d0*4096+ks*1024):"memory");
      asm volatile("ds_read_b64_tr_b16 %0,%1 offset:%c2":"=&v"(hi[ks]):"v"(vb),"i"(d0*4096+ks*1024+512):"memory");}
    asm volatile("s_waitcnt lgkmcnt(0)":::"memory");SBAR();
    #define PK(k) (bf16x8){lo[k][0],lo[k][1],lo[k][2],lo[k][3],hi[k][0],hi[k][1],hi[k][2],hi[k][3]}
    o[d0]=__builtin_amdgcn_mfma_f32_32x32x16_bf16(pa0,PK(0),o[d0],0,0,0);
    o[d0]=__builtin_amdgcn_mfma_f32_32x32x16_bf16(pa1,PK(1),o[d0],0,0,0);
    o[d0]=__builtin_amdgcn_mfma_f32_32x32x16_bf16(pa2,PK(2),o[d0],0,0,0);
    o[d0]=__builtin_amdgcn_mfma_f32_32x32x16_bf16(pa3,PK(3),o[d0],0,0,0);
    #undef PK
  }
}

#ifndef ATTN_STORE16
#define ATTN_STORE16(p,v) (*(u32x4*)(p)=(v))
#endif
template<int THRL> __device__ __forceinline__ void attn_unit(int b,int h,int qb,const bf16*Q,const bf16*__restrict__ K,const bf16*__restrict__ V,bf16*O,char*shm){
  int tid_=threadIdx.x; asm volatile("":"+v"(tid_)); const int tid=tid_,lane=tid&63,r32=lane&31,hi=lane>>5; const int wid=__builtin_amdgcn_readfirstlane(tid>>6);
  const long rowbase=(long)b*SEQ; const int q0=qb*QB;
  const bf16*Qw=Q+(rowbase+q0+wid*QBLK)*DM+h*D;
  const bf16*Kh=K+rowbase*KVP+(h>>2)*D,*Vh=V+rowbase*KVP+(h>>2)*D;
  const unsigned lds0=(unsigned)(uintptr_t)shm;
  float*wsf=(float*)(shm+LDS_WS)+wid*64;
  const bf16*ksrc=Kh+(long)lane*KVP+wid*8;
  const bf16*vsrc=Vh+(long)(16*(wid&3)+(lane>>2))*KVP+(wid>>2)*32+(lane&3)*8;
  const unsigned kdst=lds0+LDS_K+wid*1024, vdst=lds0+LDS_V+wid*1024;
  #define DMA_K(t,slot) glds16(ksrc+(long)(t)*KVBLK*KVP,(unsigned)__builtin_amdgcn_readfirstlane(kdst+(slot)))
  #define DMA_V(t,slot) glds16(vsrc+(long)(t)*KVBLK*KVP,(unsigned)__builtin_amdgcn_readfirstlane(vdst+(slot)))
  const int vb0=(int)(lds0+LDS_V)+((lane>>4)&1)*32+(lane&3)*8+(4*hi+((lane&15)>>2))*64;
  const char*Kbase=shm+LDS_K; bf16x8 kf[8];
  const lds_cptr shm3=(lds_cptr)shm; const lds_cptr kp0=shm3+LDS_K+hi*1024+r32*16; const lds_cptr vp0=shm3+LDS_V+((lane>>4)&1)*32+(lane&3)*8+(4*hi+((lane&15)>>2))*64;
  const int NT=SEQ/KVBLK;
  DMA_K(0,0);DMA_V(0,0);DMA_K(1,SLOTB);
  bf16x8 qr[4];
  #pragma unroll
  for(int d0=0;d0<4;++d0)qr[d0]=*reinterpret_cast<const bf16x8*>(&Qw[(long)r32*DM+d0*16+hi*8]);
  float mhat=0.f,l_reg=0.f;f32x16 o[2];o[0]=f32x16{};o[1]=f32x16{};f32x16 negm=f32x16{};asm volatile("":"+v"(negm));
  const int qrel=wid*QBLK+r32;
  #define CMASK(P0,P1,t) do{}while(0)
  bool resc=false;
  #define START(P0,P1) do{ const float rm=rowmax(P0,P1); resc=false; \
    { const float dl=rm; mhat=fadd_s(mhat,dl); \
      _Pragma("unroll") for(int r=0;r<16;++r){P0[r]=fsub_s(P0[r],dl);P1[r]=fsub_s(P1[r],dl);} \
      _Pragma("unroll") for(int r=0;r<16;++r)negm[r]=-mhat; asm volatile("":"+v"(negm)); } \
    _Pragma("unroll") for(int r=0;r<16;++r)P0[r]=__builtin_amdgcn_exp2f(P0[r]); }while(0)
  #define RESC() do{ if(resc){ asm volatile("s_waitcnt lgkmcnt(0)":::"memory"); \
      _Pragma("unroll") for(int d_=0;d_<2;++d_) _Pragma("unroll") for(int r=0;r<16;++r)o[d_][r]*=wsf[crow(r,hi)]; } }while(0)
  f32x16 pA0,pA1,pB0,pB1;
  int sl_prev=0,sl_cur=0,sl_next=SLOTB;
  #define ROT() do{sl_prev=sl_cur;sl_cur=sl_next;sl_next=(sl_next==(NSLOT-1)*SLOTB)?0:sl_next+SLOTB;}while(0)
  DMA_K(2,2*SLOTB);
  WAIT_BAR(3);
  qkt(pA0,pA1,Kbase,qr,negm,r32,hi);asm volatile("s_nop 15\n\ts_nop 7":"+v"(pA0),"+v"(pA1));CMASK(pA0,pA1,0);
  START(pA0,pA1);
  _Pragma("unroll") for(int r=0;r<16;++r)pA1[r]=__builtin_amdgcn_exp2f(pA1[r]);
  WAIT_BAR(0);
  DMA_K(3,0);DMA_V(1,SLOTB);
  ROT();
  kload8(kf,kp0+sl_cur);
  WAIT_BAR(2);
  s16x4 vlo[8],vhi[8]; u32x4 pw0,pw1,pw2,pw3;
  #define PKW(P,B) cvtpk_s(P[B],P[B+1])
  #define PAF(k) __builtin_bit_cast(bf16x8,pw##k)
  #define VFR(i) (bf16x8){vlo[i][0],vlo[i][1],vlo[i][2],vlo[i][3],vhi[i][0],vhi[i][1],vhi[i][2],vhi[i][3]}
  #define PIN(x) asm volatile("":"+v"(x))
  #define MX3(a,b,c) __builtin_fmaxf(__builtin_fmaxf((a),(b)),(c))
  #define GAPA(MF,A0,A1,A2,A3,W0,W1,PW) do{ MF; sacc+=A0; sacc+=A1; sacc+=A2; sacc+=A3; PIN(sacc); W0; W1; PIN(PW); SBAR(); }while(0)
  #define EX(v) __builtin_amdgcn_exp2f(v)
  #define GAPB(MF,X,B) do{ MF; X[B]=EX(X[B]); X[B+1]=EX(X[B+1]); X[B+2]=EX(X[B+2]); X[B+3]=EX(X[B+3]); PIN(X); SBAR(); }while(0)
  #define VRD(i) do{ vlo[i]=vtr(vp_+(((i)>>2)*4096+((i)&3)*1024)); vhi[i]=vtr(vp_+(((i)>>2)*4096+((i)&3)*1024+512)); }while(0)
  #define KRD(G,j) do{ if(G){ kload2(kf,kp0+sl_next,j); SBAR(); } }while(0)
  #define STEP(C0,C1,P0,P1,t,GK,GV,GL) do{ SBAR(); \
    const lds_cptr vp_=vp0+sl_prev; \
    VRD(0); SBAR(); float sacc=(P0[0]+P0[1]); \
    GAPA(C0=__builtin_amdgcn_mfma_f32_32x32x16_bf16(kf[0],qr[0],negm,0,0,0), P0[2],P0[3],P0[4],P0[5],     pw0[0]=PKW(P0,0), pw0[1]=PKW(P0,2), pw0); \
    VRD(4); SBAR(); GAPA(C1=__builtin_amdgcn_mfma_f32_32x32x16_bf16(kf[1],qr[0],negm,0,0,0), P0[6],P0[7],P0[8],P0[9],     pw0[2]=PKW(P0,4), pw0[3]=PKW(P0,6), pw0); \
    VRD(1); SBAR(); GAPA(C0=__builtin_amdgcn_mfma_f32_32x32x16_bf16(kf[2],qr[1],C0,0,0,0),   P0[10],P0[11],P0[12],P0[13], pw1[0]=PKW(P0,8), pw1[1]=PKW(P0,10), pw1); \
    VRD(5); SBAR(); GAPA(C1=__builtin_amdgcn_mfma_f32_32x32x16_bf16(kf[3],qr[1],C1,0,0,0),   P0[14],P0[15],P1[0],P1[1],   pw1[2]=PKW(P0,12),pw1[3]=PKW(P0,14), pw1); \
    VRD(2); SBAR(); GAPA(C0=__builtin_amdgcn_mfma_f32_32x32x16_bf16(kf[4],qr[2],C0,0,0,0),   P1[2],P1[3],P1[4],P1[5],     pw2[0]=PKW(P1,0), pw2[1]=PKW(P1,2), pw2); \
    VRD(6); SBAR(); GAPA(C1=__builtin_amdgcn_mfma_f32_32x32x16_bf16(kf[5],qr[2],C1,0,0,0),   P1[6],P1[7],P1[8],P1[9],     pw2[2]=PKW(P1,4), pw2[3]=PKW(P1,6), pw2); \
    VRD(3); SBAR(); GAPA(C0=__builtin_amdgcn_mfma_f32_32x32x16_bf16(kf[6],qr[3],C0,0,0,0),   P1[10],P1[11],P1[12],P1[13], pw3[0]=PKW(P1,8), pw3[1]=PKW(P1,10), pw3); \
    VRD(7); SBAR(); GAPA(C1=__builtin_amdgcn_mfma_f32_32x32x16_bf16(kf[7],qr[3],C1,0,0,0),   P1[14],P1[15],0.f,0.f,       pw3[2]=PKW(P1,12),pw3[3]=PKW(P1,14), pw3); \
    l_reg+=sacc; \
    if(GK){DMA_K((t)+3,sl_cur);} if(GV){DMA_V((t)+1,sl_next);} \
    CMASK(C0,C1,t); \
    { float a=MX3(C0[0],C0[1],C1[0]),b=MX3(C0[2],C0[3],C1[1]); a=MX3(a,C1[2],C1[3]); \
      _Pragma("unroll") for(int r=4;r<16;r+=4){a=MX3(a,C0[r],C0[r+1]);b=MX3(b,C0[r+2],C0[r+3]);a=MX3(a,C1[r],C1[r+1]);b=MX3(b,C1[r+2],C1[r+3]);} \
      float rm=__builtin_fmaxf(a,b); { auto rr=__builtin_amdgcn_permlane32_swap(__float_as_uint(rm),__float_as_uint(rm),false,false); rm=__builtin_fmaxf(__uint_as_float(rr[0]),__uint_as_float(rr[1])); } \
      resc=false; \
      if(__builtin_expect(__any(rm>(float)THRL),0)){ const float dl=__builtin_fmaxf(rm,0.f); mhat+=dl; \
        _Pragma("unroll") for(int r=0;r<16;++r){C0[r]-=dl;C1[r]-=dl;} \
        _Pragma("unroll") for(int r=0;r<16;++r)negm[r]=-mhat; asm volatile("":"+v"(negm)); \
        const float f=__builtin_amdgcn_exp2f(-dl); l_reg*=f; if(hi==0)wsf[r32]=f; resc=true; } } \
    SBAR(); \
    GAPB(o[0]=__builtin_amdgcn_mfma_f32_32x32x16_bf16(PAF(0),VFR(0),o[0],0,0,0), C0,0); \
    GAPB(o[1]=__builtin_amdgcn_mfma_f32_32x32x16_bf16(PAF(0),VFR(4),o[1],0,0,0), C0,4); \
    KRD(GL,0); GAPB(o[0]=__builtin_amdgcn_mfma_f32_32x32x16_bf16(PAF(1),VFR(1),o[0],0,0,0), C0,8); \
    KRD(GL,1); GAPB(o[1]=__builtin_amdgcn_mfma_f32_32x32x16_bf16(PAF(1),VFR(5),o[1],0,0,0), C0,12); \
    KRD(GL,2); GAPB(o[0]=__builtin_amdgcn_mfma_f32_32x32x16_bf16(PAF(2),VFR(2),o[0],0,0,0), C1,0); \
    KRD(GL,3); GAPB(o[1]=__builtin_amdgcn_mfma_f32_32x32x16_bf16(PAF(2),VFR(6),o[1],0,0,0), C1,4); \
    GAPB(o[0]=__builtin_amdgcn_mfma_f32_32x32x16_bf16(PAF(3),VFR(3),o[0],0,0,0), C1,8); \
    GAPB(o[1]=__builtin_amdgcn_mfma_f32_32x32x16_bf16(PAF(3),VFR(7),o[1],0,0,0), C1,12); \
    }while(0)
  int t=1;
  #undef CMASK
  #define CMASK(P0,P1,t) do{}while(0)
  for(;t+5<NT;t+=2){
    STEP(pB0,pB1,pA0,pA1,t,true,true,true);     WAIT_BAR(2); RESC(); ROT();
    STEP(pA0,pA1,pB0,pB1,t+1,true,true,true);   WAIT_BAR(2); RESC(); ROT();
  }
  #undef CMASK
  #define CMASK(P0,P1,t) do{}while(0)
  #define ENDW(tt) do{ if((tt)+3<NT){WAIT_BAR(2);} else if((tt)+2<NT){WAIT_BAR(1);} else {WAIT_BAR(0);} }while(0)
  for(;t+1<NT;t+=2){
    STEP(pB0,pB1,pA0,pA1,t,(t+3<NT),(t+1<NT),(t+1<NT));       ENDW(t);   RESC(); ROT();
    STEP(pA0,pA1,pB0,pB1,t+1,(t+4<NT),(t+2<NT),(t+2<NT));     ENDW(t+1); RESC(); ROT();
  }
  STEP(pB0,pB1,pA0,pA1,NT-1,false,false,false); RESC();
  { float sacc=pB0[0]+pB0[1]; _Pragma("unroll") for(int r=2;r<16;++r)sacc+=pB0[r]; _Pragma("unroll") for(int r=0;r<16;++r)sacc+=pB1[r]; l_reg+=sacc;
    pw0=(u32x4){PKW(pB0,0),PKW(pB0,2),PKW(pB0,4),PKW(pB0,6)};pw1=(u32x4){PKW(pB0,8),PKW(pB0,10),PKW(pB0,12),PKW(pB0,14)};pw2=(u32x4){PKW(pB1,0),PKW(pB1,2),PKW(pB1,4),PKW(pB1,6)};pw3=(u32x4){PKW(pB1,8),PKW(pB1,10),PKW(pB1,12),PKW(pB1,14)};
    SBAR(); pv(o,vb0+sl_cur,PAF(0),PAF(1),PAF(2),PAF(3)); }
  #undef PKW
  #undef PAF
  #undef VFR
  #undef PIN
  #undef MX3
  #undef GAPA
  #undef GAPB
  #undef EX
  #undef VRD
  #undef KRD
  #undef STEP
  #undef ENDW
  {auto rr=__builtin_amdgcn_permlane32_swap(__float_as_uint(l_reg),__float_as_uint(l_reg),false,false);l_reg=__uint_as_float(rr[0])+__uint_as_float(rr[1]);}
  if(hi==0)wsf[32+r32]=l_reg;asm volatile("s_waitcnt lgkmcnt(0)":::"memory");
  float rli[16];
  #pragma unroll
  for(int r=0;r<16;++r)rli[r]=__builtin_amdgcn_rcpf(wsf[32+crow(r,hi)]);
  bf16*Ow=O+(rowbase+q0+wid*QBLK)*DM+h*D;
  { bf16*stg=(bf16*)(shm+LDS_OST)+wid*2048;
    #pragma unroll
    for(int r=0;r<16;++r){const int orow=crow(r,hi);
      #pragma unroll
      for(int d0=0;d0<2;++d0)stg[orow*64+d0*32+r32]=__float2bfloat16(o[d0][r]*rli[r]);}
    asm volatile("s_waitcnt lgkmcnt(0)":::"memory");
    #pragma unroll
    for(int i=0;i<4;++i){const int row=i*8+(lane>>3),ch=lane&7; const u32x4 v=*(const u32x4*)(stg+row*64+ch*8); ATTN_STORE16(Ow+(long)row*DM+ch*8,v);} }
  asm volatile("s_waitcnt lgkmcnt(0)\n\ts_barrier":::"memory");
  #undef DMA_K
  #undef DMA_V
  #undef CMASK
  #undef START
  #undef RESC
  #undef ROT
}
constexpr int ATTN_LDS_BYTES=LDS_BYTES;
struct AttnTensors { const bf16* Q; const bf16* K; const bf16* V; bf16* O; };
struct AttnUnit { int bh; int qb; };
struct StaticOrder {
  int vcu,G;
  __device__ __forceinline__ explicit StaticOrder(int grid,int block):vcu((grid%8==0)?(block%8)*(grid/8)+block/8:block),G(grid){}
  __device__ __forceinline__ bool next(int i,AttnUnit&u)const{ const int L=i*G+vcu; if(L>=1024)return false; const int xg=L>>5,w=L&31; const int grp=(xg&7)*4+(xg>>3); u.bh=(grp>>2)*NHEAD+(grp&3)*4+(w>>3); u.qb=w&7; return true; }
  __device__ __forceinline__ void a_ready(const AttnUnit&)const{}
  __device__ __forceinline__ void done(const AttnUnit&)const{}
};
template<class Sched,int THRL=8> __device__ __forceinline__ void attn_phase(char*lds,const AttnTensors&T,const Sched&S){
  AttnUnit u;
  for(int i=0;S.next(i,u);++i){ S.a_ready(u); attn_unit<THRL>(u.bh/NHEAD,u.bh%NHEAD,u.qb,T.Q,T.K,T.V,T.O,lds); S.done(u); }
}
#undef SBAR
#undef WAIT_BAR
}
namespace na_body {
typedef short bf16x8 __attribute__((ext_vector_type(8)));
typedef short s16x4 __attribute__((ext_vector_type(4)));
typedef float f32x4 __attribute__((ext_vector_type(4)));
typedef unsigned u32x4 __attribute__((ext_vector_type(4)));
typedef unsigned u32x2 __attribute__((ext_vector_type(2)));
#define NA_LAS __attribute__((address_space(3)))
constexpr int VROW = 160, KROW = 144, LDS_V = 0, LDS_BIAS = 9 * 64 * VROW, LDS_K = LDS_BIAS + 15 * 64 * 4, NA_LDS_BYTES = LDS_K + 5 * 64 * KROW;
__device__ __forceinline__ unsigned cvtpk(float lo, float hi) { typedef float f2 __attribute__((ext_vector_type(2))); typedef __bf16 b2 __attribute__((ext_vector_type(2))); f2 v = {lo, hi}; b2 b = __builtin_convertvector(v, b2); return __builtin_bit_cast(unsigned, b); }
__device__ __forceinline__ s16x4 vtr(const NA_LAS char* p) { typedef short v4i16_t __attribute__((ext_vector_type(4))); return __builtin_bit_cast(s16x4, __builtin_amdgcn_ds_read_tr16_b64_v4i16((NA_LAS v4i16_t*)p)); }

__device__ __forceinline__ void na_phase(NA_LAS char* lds, const unsigned short* Qg, const unsigned short* Kg, const unsigned short* Vg, unsigned short* Og, const float* __restrict__ rpb, int G, int bid, unsigned* tsw) {
    int tid_ = threadIdx.x; asm volatile("" : "+v"(tid_));
    const int tid = tid_, lane = tid & 63, wave = __builtin_amdgcn_readfirstlane(tid >> 6), fr = lane & 15, fq = lane >> 4;
    const int vcu = (G % 8 == 0) ? (bid % 8) * (G / 8) + bid / 8 : bid;
    constexpr int NUNITS = 8 * 16 * 16;
    const int per = (NUNITS + G - 1) / G, u_lo = vcu * per, u_hi = (u_lo + per < NUNITS) ? u_lo + per : NUNITS;
    if (u_lo >= u_hi) return;
    (void)tsw;
    u32x4 vr[9], ka[5], kb[5];
    const unsigned loff = (unsigned)((tid >> 3) * 1024 + (tid & 7) * 8);
#define NA_PREF_VA(U) do { const int b_ = (U) >> 8, h_ = ((U) >> 4) & 15, r0_ = 2 * ((U) & 15); const int R0_ = min(max(r0_ - 4, 0), 24); const int nrow_ = 32 - R0_; \
        const unsigned short* vb_ = Vg + ((size_t)(b_ * 2048 + R0_ * 64)) * 1024 + h_ * 64; const unsigned short* kb_ = Kg + ((size_t)(b_ * 2048 + R0_ * 64)) * 1024 + h_ * 64; \
        _Pragma("unroll") for (int i_ = 0; i_ < 9; ++i_) { if (i_ < nrow_) vr[i_] = *(const u32x4*)(vb_ + (size_t)i_ * 65536 + loff); } \
        _Pragma("unroll") for (int i_ = 0; i_ < 5; ++i_) { ka[i_] = *(const u32x4*)(kb_ + (size_t)i_ * 65536 + loff); } } while (0)
#define NA_PREF_B(U) do { const int b_ = (U) >> 8, h_ = ((U) >> 4) & 15, r0_ = 2 * ((U) & 15); const int R0_ = min(max(r0_ - 4, 0), 24); const int nrow_ = 32 - R0_; \
        const unsigned short* kb_ = Kg + ((size_t)(b_ * 2048 + R0_ * 64)) * 1024 + h_ * 64; \
        _Pragma("unroll") for (int i_ = 0; i_ < 5; ++i_) { if (i_ + 4 < nrow_) kb[i_] = *(const u32x4*)(kb_ + (size_t)(i_ + 4) * 65536 + loff); } } while (0)
    NA_PREF_VA(u_lo); NA_PREF_B(u_lo);
    int cur_h = -1;
    for (int U = u_lo; U < u_hi; ++U) {
        const int b = U >> 8, h = (U >> 4) & 15, r0 = 2 * (U & 15); const int R0 = min(max(r0 - 4, 0), 24);
        if (U != u_lo) __syncthreads();
#pragma unroll
        for (int i = 0; i < 9; ++i) { const int idx = tid + 512 * i; *(NA_LAS u32x4*)(lds + LDS_V + (idx >> 3) * VROW + (idx & 7) * 16) = vr[i]; }
#pragma unroll
        for (int i = 0; i < 5; ++i) { const int idx = tid + 512 * i; *(NA_LAS u32x4*)(lds + LDS_K + (idx >> 3) * KROW + (idx & 7) * 16) = ka[i]; }
        if (h != cur_h) { cur_h = h;
            for (int i = tid; i < 15 * 64; i += 512) { const int dr = i >> 6, dc = (i & 63) - 16; ((NA_LAS float*)(lds + LDS_BIAS))[i] = (dc >= 0 && dc < 31) ? rpb[(h * 15 + dr) * 31 + dc] * 1.4426950408889634f : 0.f; } }
        __syncthreads();
        if (U + 1 < u_hi) NA_PREF_VA(U + 1);
        const int r = r0 + (wave >> 2), q0 = 16 * (wave & 3), qcol = q0 + fr;
        const int rs = min(max(r - 4, 0), 24), b0 = min(max(q0 - 8, 0), 32), winlo = min(max(qcol - 8, 0), 48);
        const size_t tokq = (size_t)b * 2048 + r * 64 + qcol;
        bf16x8 qf[2];
#pragma unroll
        for (int ks = 0; ks < 2; ++ks) qf[ks] = *(const bf16x8*)(Qg + tokq * 1024 + h * 64 + 32 * ks + 8 * fq);
        f32x4 am[2];
#pragma unroll
        for (int t = 0; t < 2; ++t)
#pragma unroll
            for (int i = 0; i < 4; ++i) am[t][i] = ((unsigned)(b0 + 16 * t + 4 * fq + i - winlo) < 16u) ? 0.f : -INFINITY;
        const NA_LAS char* bias_l = lds + LDS_BIAS + (b0 - qcol + 15 + 16 + 4 * fq) * 4;
        const NA_LAS char* v_l = lds + LDS_V + (b0 + 4 * fq + (fr >> 2)) * VROW + (fr & 3) * 8;
        const NA_LAS char* k_l = lds + LDS_K + ((rs - R0) * 64 + b0 + fr) * KROW + fq * 16;
        f32x4 sc[8][2];
#pragma unroll
        for (int kr = 0; kr < 4; ++kr)
#pragma unroll
            for (int t = 0; t < 2; ++t) { const bf16x8 k0 = *(const NA_LAS bf16x8*)(k_l + kr * 64 * KROW + t * 16 * KROW), k1 = *(const NA_LAS bf16x8*)(k_l + kr * 64 * KROW + t * 16 * KROW + 64);
                sc[kr][t] = __builtin_amdgcn_mfma_f32_16x16x32_bf16(k0, qf[0], am[t], 0, 0, 0); sc[kr][t] = __builtin_amdgcn_mfma_f32_16x16x32_bf16(k1, qf[1], sc[kr][t], 0, 0, 0); }
        __syncthreads();
#pragma unroll
        for (int i = 0; i < 5; ++i) { const int idx = tid + 512 * i; *(NA_LAS u32x4*)(lds + LDS_K + (idx >> 3) * KROW + (idx & 7) * 16) = kb[i]; }
        if (U + 1 < u_hi) NA_PREF_B(U + 1);
        __syncthreads();
#pragma unroll
        for (int kr = 0; kr < 4; ++kr)
#pragma unroll
            for (int t = 0; t < 2; ++t) { const bf16x8 k0 = *(const NA_LAS bf16x8*)(k_l + kr * 64 * KROW + t * 16 * KROW), k1 = *(const NA_LAS bf16x8*)(k_l + kr * 64 * KROW + t * 16 * KROW + 64);
                sc[4 + kr][t] = __builtin_amdgcn_mfma_f32_16x16x32_bf16(k0, qf[0], am[t], 0, 0, 0); sc[4 + kr][t] = __builtin_amdgcn_mfma_f32_16x16x32_bf16(k1, qf[1], sc[4 + kr][t], 0, 0, 0); }
        float mx = -INFINITY;
#pragma unroll
        for (int kr = 0; kr < 8; ++kr) { const NA_LAS float* bl = (const NA_LAS float*)(bias_l + (rs + kr - r + 7) * 256);
#pragma unroll
            for (int t = 0; t < 2; ++t)
#pragma unroll
                for (int i = 0; i < 4; ++i) { sc[kr][t][i] += bl[16 * t + i]; mx = fmaxf(mx, sc[kr][t][i]); } }
        { auto r16 = __builtin_amdgcn_permlane16_swap(__float_as_uint(mx), __float_as_uint(mx), false, false); mx = fmaxf(__uint_as_float(r16[0]), __uint_as_float(r16[1]));
          auto r32 = __builtin_amdgcn_permlane32_swap(__float_as_uint(mx), __float_as_uint(mx), false, false); mx = fmaxf(__uint_as_float(r32[0]), __uint_as_float(r32[1])); }
        float lsum = 0.f; bf16x8 pb[8];
#pragma unroll
        for (int kr = 0; kr < 8; ++kr) {
#pragma unroll
            for (int t = 0; t < 2; ++t)
#pragma unroll
                for (int i = 0; i < 4; ++i) { sc[kr][t][i] = __builtin_amdgcn_exp2f(sc[kr][t][i] - mx); lsum += sc[kr][t][i]; }
            u32x4 pw; pw.x = cvtpk(sc[kr][0][0], sc[kr][0][1]); pw.y = cvtpk(sc[kr][0][2], sc[kr][0][3]); pw.z = cvtpk(sc[kr][1][0], sc[kr][1][1]); pw.w = cvtpk(sc[kr][1][2], sc[kr][1][3]);
            pb[kr] = __builtin_bit_cast(bf16x8, pw); }
        f32x4 oacc[4];
#pragma unroll
        for (int dt = 0; dt < 4; ++dt) oacc[dt] = (f32x4){0.f, 0.f, 0.f, 0.f};
#pragma unroll
        for (int kr = 0; kr < 8; ++kr) { const NA_LAS char* vp = v_l + (rs + kr - R0) * 64 * VROW;
#pragma unroll
            for (int dt = 0; dt < 4; ++dt) {
                const s16x4 lo = vtr(vp + dt * 32), hi = vtr(vp + 16 * VROW + dt * 32);
                const bf16x8 vf = {lo[0], lo[1], lo[2], lo[3], hi[0], hi[1], hi[2], hi[3]};
                oacc[dt] = __builtin_amdgcn_mfma_f32_16x16x32_bf16(vf, pb[kr], oacc[dt], 0, 0, 0); } }
        { auto r16 = __builtin_amdgcn_permlane16_swap(__float_as_uint(lsum), __float_as_uint(lsum), false, false); lsum = __uint_as_float(r16[0]) + __uint_as_float(r16[1]);
          auto r32 = __builtin_amdgcn_permlane32_swap(__float_as_uint(lsum), __float_as_uint(lsum), false, false); lsum = __uint_as_float(r32[0]) + __uint_as_float(r32[1]); }
        const float rl = 1.f / lsum;
        unsigned short* op = Og + tokq * 1024 + h * 64 + 4 * fq;
#pragma unroll
        for (int dt = 0; dt < 4; ++dt) { u32x2 w; w.x = cvtpk(oacc[dt][0] * rl, oacc[dt][1] * rl); w.y = cvtpk(oacc[dt][2] * rl, oacc[dt][3] * rl); *(u32x2*)(op + 16 * dt) = w; }
    }
#undef NA_PREF_VA
#undef NA_PREF_B
}
}
constexpr int NWAVES = 8, NTHREADS = 512;
constexpr int D = 1024, NB = 8, S = 2048, M = NB * S, DEPTH = 4, NH = 16, HD = 64, GW = 64, ROWS = 32;
constexpr int KVD = 256, NE = 32, NG = 4, EPG = 8, DE = 512, NQKV_NA = 3072, NQKV_GQ = 1536, NRT = 36;
constexpr float ALPHA = 1.6817928305074290f, LN_EPS = 1e-5f;
constexpr float LOG2E = 1.4426950408889634f, C2 = 0.125f * 1.4426950408889634f;
constexpr int MAXTILES = 160;

constexpr size_t MiB = 1u << 20;
constexpr size_t WS_CTL = 0, CTL_ZERO_BYTES = 1 * MiB;
constexpr size_t WS_MOD = 1 * MiB, WS_ROPE = 2 * MiB, WS_WRT = 3 * MiB;
constexpr size_t WS_WQKV_NA = 4 * MiB, WS_WO_NA = 16 * MiB, WS_WQKV_GQ = 20 * MiB, WS_WO_GQ = 26 * MiB;
constexpr size_t WS_WGU = 32 * MiB, WS_WDN = 96 * MiB;
constexpr size_t WS_X1 = 128 * MiB, WS_X2 = 192 * MiB, WS_H = 256 * MiB, WS_Q = 288 * MiB, WS_K = 320 * MiB, WS_V = 352 * MiB, WS_Y = 384 * MiB;
constexpr size_t WS_XS = 416 * MiB, WS_HMID = 496 * MiB, WS_YS = 536 * MiB, WS_ROUTE = 616 * MiB, WS_TOKMAP = 618 * MiB, WS_WGU2 = 622 * MiB, WS_WDN2 = 686 * MiB, WS_END = 718 * MiB;
#define WGU_SET(l) (((l) & 1) ? WS_WGU2 : WS_WGU)
#define WDN_SET(l) (((l) & 1) ? WS_WDN2 : WS_WDN)
constexpr int CW_TS = 60000;
constexpr int CW_BAR = 16384;
constexpr int CW_CNT = 32768, CNT_LAYER_STRIDE = 2048;

constexpr int RING_BYTES = 147456, MISC_OFF = RING_BYTES, LDS_BYTES = 163840;

#define LAS __attribute__((address_space(3)))
typedef unsigned short bf16;
typedef unsigned v4u __attribute__((ext_vector_type(4)));
typedef unsigned v2u __attribute__((ext_vector_type(2)));
typedef float f32x4 __attribute__((ext_vector_type(4)));
#define RLX_AGENT __ATOMIC_RELAXED, __HIP_MEMORY_SCOPE_AGENT
__device__ __forceinline__ unsigned f2bf(float f) { unsigned u = __builtin_bit_cast(unsigned, f); return (u + 0x7fffu + ((u >> 16) & 1u)) >> 16; }
__device__ __forceinline__ unsigned pk2(float lo, float hi) { return f2bf(lo) | (f2bf(hi) << 16); }
__device__ __forceinline__ float bflo(unsigned w) { return __uint_as_float(w << 16); }
__device__ __forceinline__ float bfhi(unsigned w) { return __uint_as_float(w & 0xffff0000u); }
__device__ __forceinline__ float bf2f(bf16 v) { return __uint_as_float((unsigned)v << 16); }
__device__ __forceinline__ float wave_sum(float v) {
    int x = __builtin_bit_cast(int, v);
    v += __builtin_bit_cast(float, __builtin_amdgcn_update_dpp(0, x, 0xB1, 0xF, 0xF, false)); x = __builtin_bit_cast(int, v);
    v += __builtin_bit_cast(float, __builtin_amdgcn_update_dpp(0, x, 0x4E, 0xF, 0xF, false)); x = __builtin_bit_cast(int, v);
    v += __builtin_bit_cast(float, __builtin_amdgcn_update_dpp(0, x, 0x141, 0xF, 0xF, false)); x = __builtin_bit_cast(int, v);
    v += __builtin_bit_cast(float, __builtin_amdgcn_update_dpp(0, x, 0x140, 0xF, 0xF, false)); x = __builtin_bit_cast(int, v);
    const float r0 = __builtin_bit_cast(float, __builtin_amdgcn_readlane(x, 0)), r1 = __builtin_bit_cast(float, __builtin_amdgcn_readlane(x, 16));
    const float r2 = __builtin_bit_cast(float, __builtin_amdgcn_readlane(x, 32)), r3 = __builtin_bit_cast(float, __builtin_amdgcn_readlane(x, 48));
    return (r0 + r1) + (r2 + r3);
}

struct Args { const float* in[20]; float* out; unsigned char* ws; };

__device__ __forceinline__ int rho_p8(int cc) { return (cc & 128) + (cc & 96) + 16 * ((cc >> 2) & 1) + 4 * ((cc >> 3) & 3) + (cc & 3); }
__device__ __forceinline__ int rho_head(int cc) { const int wc = cc >> 6, fq = 2 * ((cc >> 5) & 1) + ((cc >> 3) & 1), bj = (cc >> 4) & 1; return 128 * bj + 32 * wc + 16 * ((cc >> 2) & 1) + 4 * fq + (cc & 3); }
__device__ __forceinline__ int dest_row(int mode, int c) {
    if (mode == 0) return (c & ~255) + rho_p8(c & 255);
    if (mode == 1) return (c & ~255) + rho_head(c & 255);
    const int jj = c & 127; return (c >> 7) * 256 + (mode == 3 ? 128 : 0) + (jj & 96) + 16 * ((jj >> 2) & 1) + 4 * ((jj >> 3) & 3) + (jj & 3);
}
struct TrItem { const float* W; bf16* WT; int K, N, mode, item; };
__device__ __forceinline__ void tr_load(const TrItem& t, f32x4 (&r)[8], int lane) {
    const int nblk = t.N / 32, kb = t.item / nblk, nb = t.item % nblk;
    const float* src = t.W + (size_t)(64 * kb + (lane >> 3)) * t.N + 32 * nb + 4 * (lane & 7);
#pragma unroll
    for (int i = 0; i < 8; ++i) r[i] = __builtin_nontemporal_load((const f32x4*)(src + (size_t)(8 * i) * t.N));
}
__device__ __forceinline__ void tr_store(const TrItem& t, const f32x4 (&r)[8], LAS float* scr, int lane) {
    const int nblk = t.N / 32, kb = t.item / nblk, nb = t.item % nblk, k0 = 64 * kb, n0 = 32 * nb;
#pragma unroll
    for (int i = 0; i < 8; ++i) { LAS float* d = scr + ((lane >> 3) + 8 * i) * 33 + 4 * (lane & 7); d[0] = r[i][0]; d[1] = r[i][1]; d[2] = r[i][2]; d[3] = r[i][3]; }
    asm volatile("s_waitcnt lgkmcnt(0)" ::: "memory");
    const int c = lane & 7;
#pragma unroll
    for (int j = 0; j < 4; ++j) { const int n = (lane >> 3) + 8 * j; const LAS float* sp = scr + (8 * c) * 33 + n;
        v4u o; o.x = pk2(sp[0 * 33], sp[1 * 33]); o.y = pk2(sp[2 * 33], sp[3 * 33]); o.z = pk2(sp[4 * 33], sp[5 * 33]); o.w = pk2(sp[6 * 33], sp[7 * 33]);
        __builtin_nontemporal_store(o, (v4u*)(t.WT + (size_t)dest_row(t.mode, n0 + n) * t.K + k0 + 8 * c)); }
    asm volatile("s_waitcnt lgkmcnt(0)" ::: "memory");
}
__device__ __forceinline__ TrItem moe_item(const float* wgate, const float* wup, const float* wdown, int layer, bf16* Wgu, bf16* Wdn, int it) {
    const int e = it / 768, r = it % 768, which = r >> 8, sub = r & 255; const size_t le = (size_t)layer * NE + e; TrItem t;
    if (which == 0) t = TrItem{wgate + le * D * DE, Wgu + (size_t)e * D * D, D, DE, 2, sub};
    else if (which == 1) t = TrItem{wup + le * D * DE, Wgu + (size_t)e * D * D, D, DE, 3, sub};
    else t = TrItem{wdown + le * DE * D, Wdn + (size_t)e * D * DE, DE, D, 0, sub};
    return t;
}
__device__ __forceinline__ void moe_weight_items(const float* __restrict__ wgate, const float* __restrict__ wup, const float* __restrict__ wdown, int layer,
                                                 bf16* __restrict__ Wgu, bf16* __restrict__ Wdn, LAS float* scr, int first, int stride, int end, int lane) {
    if (first >= end) return;
    f32x4 rn[8]; TrItem tn = moe_item(wgate, wup, wdown, layer, Wgu, Wdn, first); tr_load(tn, rn, lane);
    for (int it = first; it < end; it += stride) {
        f32x4 rc[8]; const TrItem tc = tn;
#pragma unroll
        for (int i = 0; i < 8; ++i) rc[i] = rn[i];
        if (it + stride < end) { tn = moe_item(wgate, wup, wdown, layer, Wgu, Wdn, it + stride); tr_load(tn, rn, lane); }
        tr_store(tc, rc, scr, lane);
    }
}
constexpr int CONV_ITEMS = NE * 768;
constexpr int CQ_A = 10, CQ_B = 7, CQ_C = 4;
__device__ __forceinline__ int conv_total_a(int layer, int G) { return ((layer & 1) && G == 256) ? 128 * NWAVES * CQ_A : 0; }
__device__ __forceinline__ int idle_cus(int nunits, int G) { const int rounds = (nunits + G - 1) / G; return rounds * G - nunits; }
__device__ __forceinline__ void transpose_item(const float* __restrict__ W, int K, int N, bf16* __restrict__ WT, int mode, LAS float* scr, int item, int lane) {
    const TrItem t{W, WT, K, N, mode, item}; f32x4 r[8]; tr_load(t, r, lane); tr_store(t, r, scr, lane);
}

struct MoeOrder {
    int nunits, G, c; const LAS int* tile_e; const LAS int* tbase; const LAS int* trows; const int* tokmap;
    __device__ __forceinline__ bool next(int i, pg8::Unit& u) const {
        const long L = (long)i * G + c; if (L >= nunits) return false;
        const int pm = (int)(L >> 2); u.pm = pm; u.pn = __builtin_amdgcn_readfirstlane(tile_e[pm]) * 4 + (int)(L & 3); return true;
    }
    __device__ __forceinline__ int arow(const pg8::Unit& u, int rr) const {
        const int base = __builtin_amdgcn_readfirstlane(tbase[u.pm]), rows = __builtin_amdgcn_readfirstlane(trows[u.pm]);
        return rr < rows ? tokmap[base + rr] : 0;
    }
    __device__ __forceinline__ void a_ready(const pg8::Unit&) const {}
    __device__ __forceinline__ void done(const pg8::Unit&) const {}
};
constexpr int TOKCAP = 16384;
__device__ __forceinline__ void build_tiles(const unsigned* cnt, LAS int* misc, int tid) {
    if (tid == 0) { int s = 0;
        for (int e = 0; e < NE; ++e) { misc[e] = s; const int c = (int)__hip_atomic_load(cnt + 64 * e, RLX_AGENT); const int nt = (c + 255) >> 8;
            for (int t = 0; t < nt; ++t) if (s + t < MAXTILES) { misc[64 + s + t] = e; misc[256 + s + t] = e * TOKCAP + t * 256; misc[448 + s + t] = (c - t * 256) < 256 ? (c - t * 256) : 256; } s += nt; }
        misc[32] = s; misc[33] = s < MAXTILES ? s : MAXTILES; }
    __syncthreads();
}

__device__ __forceinline__ void na_attn_simple(const bf16* Qb, const bf16* Kb, const bf16* Vb, bf16* Ob, const float* __restrict__ rpb, int gw, int NGW, int lane) {
    for (int w = gw; w < M * NH; w += NGW) {
        const int m = w >> 4, h = w & 15, b = m >> 11, t = m & 2047, r = t >> 6, c = t & 63;
        const int rs = min(max(r - 4, 0), ROWS - 8), wsx = min(max(c - 8, 0), GW - 16);
        const float q = bf2f(Qb[(size_t)m * D + h * HD + lane]);
        float mx = -INFINITY, l = 0.f, acc = 0.f;
        for (int kr = 0; kr < 8; ++kr)
            for (int kc = 0; kc < 16; ++kc) {
                const int krow = rs + kr, kcol = wsx + kc; const size_t tok = (size_t)b * S + krow * GW + kcol;
                const float kv = bf2f(Kb[tok * D + h * HD + lane]), vv = bf2f(Vb[tok * D + h * HD + lane]);
                const int dr = krow - r + 7, dc = min(max(kcol - c + 15, 0), 30);
                const float s = wave_sum(q * kv) + rpb[(h * 15 + dr) * 31 + dc] * LOG2E;
                const float mn = fmaxf(mx, s), al = __builtin_amdgcn_exp2f(mx - mn), p = __builtin_amdgcn_exp2f(s - mn);
                l = l * al + p; acc = acc * al + p * vv; mx = mn;
            }
        Ob[(size_t)m * D + h * HD + lane] = (bf16)f2bf(acc / l);
    }
}
__device__ __forceinline__ void gqa_attn_simple(const bf16* Qb, const bf16* Kb, const bf16* Vb, bf16* Ob, int gw, int NGW, int lane) {
    for (int w = gw; w < M * NH; w += NGW) {
        const int m = w >> 4, h = w & 15, b = m >> 11, kvh = h >> 2;
        const float q = bf2f(Qb[(size_t)m * D + h * HD + lane]);
        float mx = -INFINITY, l = 0.f, acc = 0.f;
        const bf16* kp = Kb + (size_t)b * S * KVD + kvh * HD + lane; const bf16* vp = Vb + (size_t)b * S * KVD + kvh * HD + lane;
        for (int j = 0; j < S; ++j) {
            const float kv = bf2f(kp[(size_t)j * KVD]), vv = bf2f(vp[(size_t)j * KVD]);
            const float s = wave_sum(q * kv);
            const float mn = fmaxf(mx, s), al = __builtin_amdgcn_exp2f(mx - mn), p = __builtin_amdgcn_exp2f(s - mn);
            l = l * al + p; acc = acc * al + p * vv; mx = mn;
        }
        Ob[(size_t)m * D + h * HD + lane] = (bf16)f2bf(acc / l);
    }
}
#define XB_TMO      128
#define XB_XCNT(j)  (256  + 64 * (j))
#define XB_XSUB(j)  (1280 + 64 * (j))
#define XB_XGEN(j)  (2304 + 64 * (j))
#define XB_TOP      3328
#define XB_TOPGEN   3392
#define XCD_BAR_WORDS 3456
#define XB_SPIN_CAP (1u << 18)

__device__ __forceinline__ unsigned xb_ld(unsigned* p)              { return __hip_atomic_load(p, __ATOMIC_RELAXED, __HIP_MEMORY_SCOPE_AGENT); }
__device__ __forceinline__ unsigned xb_add(unsigned* p, unsigned v) { return __hip_atomic_fetch_add(p, v, __ATOMIC_RELAXED, __HIP_MEMORY_SCOPE_AGENT); }
__device__ __forceinline__ unsigned xb_xcc_id() { return (unsigned)__builtin_amdgcn_s_getreg((3 << 11) | 20) & 0xFu; }
#define XB_SPIN(cond, bar) do { unsigned _sp = 0; while (cond) { __builtin_amdgcn_s_sleep(1); \
    if ((++_sp & 255u) == 0u) { if (xb_ld(&(bar)[XB_TMO])) break; if (_sp > XB_SPIN_CAP) { atomicAdd(&(bar)[XB_TMO], 1u); break; } } } } while (0)

struct XcdBarrier {
    unsigned* bar; unsigned x;
    volatile LAS unsigned* st;
};

__device__ __forceinline__ XcdBarrier xcd_barrier_post(unsigned* bar, volatile LAS unsigned* st) {
    XcdBarrier b; b.bar = bar; b.x = xb_xcc_id(); b.st = st;
    if (threadIdx.x == 0) (void)xb_add(&bar[XB_XCNT(b.x)], 1u);
    return b;
}
__device__ __forceinline__ void xcd_barrier_complete(unsigned* bar, unsigned x, unsigned& nloc, unsigned& nx) {
    const unsigned G = gridDim.x * gridDim.y * gridDim.z;
    unsigned sum, cnt, mine, sp = 0u;
    for (;;) {
        sum = 0u; cnt = 0u; mine = 0u;
#pragma unroll
        for (unsigned j = 0; j < 16; ++j) { const unsigned c = xb_ld(&bar[XB_XCNT(j)]); sum += c; cnt += (c > 0u) ? 1u : 0u; mine = (j == x) ? c : mine; }
        if (sum == G) break;
        __builtin_amdgcn_s_sleep(1);
        if ((++sp & 255u) == 0u) { if (xb_ld(&bar[XB_TMO])) break; if (sp > XB_SPIN_CAP) { atomicAdd(&bar[XB_TMO], 1u); break; } }
    }
    nloc = mine > 0u ? mine : 1u; nx = cnt > 0u ? cnt : 1u;
}

__device__ __forceinline__ void xcd_barrier(const XcdBarrier& b) {
    asm volatile("s_waitcnt vmcnt(0)" ::: "memory");
    __syncthreads();
    if (threadIdx.x == 0) {
        unsigned* bar = b.bar;
        __builtin_amdgcn_s_waitcnt(0);
        unsigned nloc = b.st[0], nx = b.st[1];
        if (nloc == 0u) { xcd_barrier_complete(bar, b.x, nloc, nx); b.st[0] = nloc; b.st[1] = nx; }
        const unsigned old = xb_add(&bar[XB_XSUB(b.x)], 1u);
        const unsigned gen = old / nloc;
        if (old + 1u == (gen + 1u) * nloc) {
            __builtin_amdgcn_fence(__ATOMIC_RELEASE, "agent");
            asm volatile("s_waitcnt vmcnt(0)" ::: "memory");
            const unsigned og = xb_add(&bar[XB_TOP], 1u);
            const unsigned tg = og / nx;
            if (og + 1u == (tg + 1u) * nx) xb_add(&bar[XB_TOPGEN], 1u);
            else XB_SPIN(xb_ld(&bar[XB_TOPGEN]) == tg, bar);
            __builtin_amdgcn_fence(__ATOMIC_ACQUIRE, "agent");
            xb_add(&bar[XB_XGEN(b.x)], 1u);
            asm volatile("s_waitcnt vmcnt(0)" ::: "memory");
        } else {
            XB_SPIN(xb_ld(&bar[XB_XGEN(b.x)]) == gen, bar);
            __builtin_amdgcn_fence(__ATOMIC_ACQUIRE, "agent");
            asm volatile("s_waitcnt vmcnt(0)" ::: "memory");
        }
    }
    __syncthreads();
}
__device__ __forceinline__ unsigned char* ldptr(const LAS unsigned* ptab, int i) {
    const unsigned lo = (unsigned)__builtin_amdgcn_readfirstlane((int)ptab[2 * i]), hi = (unsigned)__builtin_amdgcn_readfirstlane((int)ptab[2 * i + 1]);
    return (unsigned char*)(__attribute__((address_space(1))) unsigned char*)(((unsigned long long)hi << 32) | lo);
}
#ifndef PROBE_REPEAT
#define PROBE_REPEAT -1
#endif
#define NREP(k) ((PROBE_REPEAT == (k)) ? 2 : 1)
#ifndef PROBE_TS
#define PROBE_TS -1
#endif
#define TS_T0(k) unsigned long long ts0_##k = 0; if (PROBE_TS == (k) && blockIdx.x == 0 && threadIdx.x == 0) ts0_##k = __builtin_amdgcn_s_memrealtime();
#define TS_T1(k) if (PROBE_TS == (k) && blockIdx.x == 0 && threadIdx.x == 0) atomicAdd((unsigned*)(ws + WS_CTL) + CW_TS, (unsigned)(__builtin_amdgcn_s_memrealtime() - ts0_##k));
#define GRID_SYNC_T(k) do { if (PROBE_TS == (k)) { PH_BEGIN TS_T0(k) GRID_SYNC(); TS_T1(k) } else { GRID_SYNC(); } } while (0)
#define LDS_BARRIER() do { asm volatile("s_waitcnt lgkmcnt(0)" ::: "memory"); __builtin_amdgcn_s_barrier(); asm volatile("" ::: "memory"); } while (0)
#define GRID_SYNC_CG() do { cg::this_grid().sync(); asm volatile("" ::: "memory"); } while (0)
#define GRID_SYNC() do { unsigned lb_ = (unsigned)(uintptr_t)lds_raw; asm volatile("" : "+s"(lb_)); LAS unsigned char* l_ = (LAS unsigned char*)lb_; \
    XcdBarrier xb_; xb_.bar = (unsigned*)(ldptr((LAS unsigned*)(l_ + MISC_OFF + 8192), 21) + WS_CTL) + CW_BAR; xb_.x = xb_xcc_id(); xb_.st = (volatile LAS unsigned*)(l_ + MISC_OFF + 8448); \
    xcd_barrier(xb_); asm volatile("" ::: "memory"); } while (0)
#define PH_BEGIN \
    unsigned ldsb_ = (unsigned)(uintptr_t)lds_raw; asm volatile("" : "+s"(ldsb_)); \
    LAS unsigned char* lds = (LAS unsigned char*)ldsb_; LAS int* misc = (LAS int*)(lds + MISC_OFF); LAS unsigned* ptab = (LAS unsigned*)(lds + MISC_OFF + 8192); (void)misc; \
    int tid = threadIdx.x; asm volatile("" : "+v"(tid)); \
    const int lane = tid & 63, wave = __builtin_amdgcn_readfirstlane(tid >> 6); \
    int G = gridDim.x, bid = blockIdx.x; asm volatile("" : "+s"(G), "+s"(bid)); const int gw = bid * NWAVES + wave, NGW = G * NWAVES; \
    unsigned char* ws = ldptr(ptab, 21); (void)lane; (void)gw; (void)NGW; (void)ws;
#define INP(i) ((const float*)ldptr(ptab, (i)))

__global__ void __launch_bounds__(NTHREADS, 2) mk_fwd(Args args) {
    extern __shared__ __attribute__((aligned(16))) unsigned char lds_raw[];
    { LAS unsigned* ptab = (LAS unsigned*)((LAS unsigned char*)lds_raw + MISC_OFF + 8192);
    if (threadIdx.x < 22) { const unsigned long long p = threadIdx.x < 20 ? (unsigned long long)args.in[threadIdx.x] : (threadIdx.x == 20 ? (unsigned long long)args.out : (unsigned long long)args.ws);
        ptab[2 * threadIdx.x] = (unsigned)p; ptab[2 * threadIdx.x + 1] = (unsigned)(p >> 32); }
      volatile LAS unsigned* st = (volatile LAS unsigned*)((LAS unsigned char*)lds_raw + MISC_OFF + 8448);
      if (threadIdx.x == 64) { st[0] = 0u; st[1] = 0u; }
      __syncthreads();
      (void)xcd_barrier_post((unsigned*)(args.ws + WS_CTL) + CW_BAR, st); }
    __syncthreads();

    {
        PH_BEGIN TS_T0(100)
        const float* c_in = INP(1); const float* ada_w = INP(2); const float* ada_b = INP(3);
        float* mod = (float*)(ws + WS_MOD); float* ropec = (float*)(ws + WS_ROPE); float* ropes = ropec + S * 32;
        LAS float* ca = (LAS float*)lds;
        LAS float* red = (LAS float*)(lds + 32768);
        for (int i = tid; i < NB * D; i += NTHREADS) { const float v = c_in[i]; ca[i] = v / (1.f + __expf(-v)); }
        __syncthreads();
        for (int it = bid; it < DEPTH * 192; it += G) {
            const int l = it / 192, col0 = (it % 192) * 32, cl = tid & 31, ks = tid >> 5;
            const float* wp = ada_w + ((size_t)l * D + 64 * ks) * (6 * D) + col0 + cl;
            float acc[NB];
#pragma unroll
            for (int b = 0; b < NB; ++b) acc[b] = 0.f;
#pragma unroll 16
            for (int kk = 0; kk < 64; ++kk) { const float wv = wp[(size_t)kk * (6 * D)];
#pragma unroll
                for (int b = 0; b < NB; ++b) acc[b] += ca[b * D + 64 * ks + kk] * wv; }
#pragma unroll
            for (int b = 0; b < NB; ++b) red[(ks * NB + b) * 32 + cl] = acc[b];
            __syncthreads();
            if (tid < 256) { const int b = tid >> 5; float s = 0.f;
#pragma unroll
                for (int k2 = 0; k2 < 16; ++k2) s += red[(k2 * NB + b) * 32 + cl];
                mod[((size_t)l * NB + b) * (6 * D) + col0 + cl] = s + ada_b[l * 6 * D + col0 + cl]; }
            __syncthreads();
        }
        for (int i = bid * NTHREADS + tid; i < S * 32; i += G * NTHREADS) {
            const int t = i >> 5, a = (i >> 4) & 1, p = i & 15;
            const float pos = (float)(a == 0 ? t / GW : t % GW);
            const float ang = pos * exp2f(-(float)p * (13.287712379549449f / 16.f));
            const float kf = rintf(ang * 0.15915494309189535f);
            float r = fmaf(-kf, 6.2831854820251465f, ang); r = fmaf(-kf, -1.7484555314695172e-07f, r);
            ropec[i] = __cosf(r); ropes[i] = __sinf(r);
        }
        { const float* m_wg = INP(13); const float* m_we = INP(15); bf16* wrh = (bf16*)(ws + WS_WRT); bf16* wrl = wrh + DEPTH * 48 * D;
          for (int i = bid * NTHREADS + tid; i < DEPTH * 48 * D; i += G * NTHREADS) {
            const int l = i / (48 * D), o = (i / D) % 48, k = i % D;
            const float v = o < NG ? m_wg[((size_t)l * D + k) * NG + o] : (o < NRT ? m_we[((size_t)l * D + k) * NE + (o - NG)] : 0.f);
            const unsigned hi = f2bf(v); wrh[i] = (bf16)hi; wrl[i] = (bf16)f2bf(v - __uint_as_float(hi << 16));
          } }
        LAS float* scr = (LAS float*)(lds + 49152 + wave * 8704);
        { const float* na_wqkv = INP(6); const float* na_wo = INP(8); const float* gq_wqkv = INP(9); const float* gq_wo = INP(12);
          bf16* Wqkv_na = (bf16*)(ws + WS_WQKV_NA); bf16* Wo_na = (bf16*)(ws + WS_WO_NA); bf16* Wqkv_gq = (bf16*)(ws + WS_WQKV_GQ); bf16* Wo_gq = (bf16*)(ws + WS_WO_GQ);
          constexpr int I_NQ = 16 * 96, I_O = 16 * 32, I_GQ = 16 * 48, I_DENSE = 2 * (I_NQ + I_O + I_GQ + I_O);
          for (int it = gw; it < I_DENSE; it += NGW) {
            int r = it; const int j = r / (I_DENSE / 2); r %= (I_DENSE / 2);
            if (r < I_NQ) { transpose_item(na_wqkv + (size_t)j * D * NQKV_NA, D, NQKV_NA, Wqkv_na + (size_t)j * NQKV_NA * D, 0, scr, r, lane); continue; } r -= I_NQ;
            if (r < I_O) { transpose_item(na_wo + (size_t)j * D * D, D, D, Wo_na + (size_t)j * D * D, 0, scr, r, lane); continue; } r -= I_O;
            if (r < I_GQ) { transpose_item(gq_wqkv + (size_t)j * D * NQKV_GQ, D, NQKV_GQ, Wqkv_gq + (size_t)j * NQKV_GQ * D, 1, scr, r, lane); continue; } r -= I_GQ;
            transpose_item(gq_wo + (size_t)j * D * D, D, D, Wo_gq + (size_t)j * D * D, 0, scr, r, lane);
          } }
        TS_T0(102)
        moe_weight_items(INP(17), INP(18), INP(19), 0, (bf16*)(ws + WS_WGU), (bf16*)(ws + WS_WDN), scr, gw, NGW, CONV_ITEMS, lane);
        TS_T1(102) TS_T1(100)
    }
    GRID_SYNC_CG();
    {
        PH_BEGIN
        const float* x_in = INP(0); const float* mod = (const float*)(ws + WS_MOD); bf16* Hb = (bf16*)(ws + WS_H);
        for (int m = gw; m < M; m += NGW) {
            const float* mb = mod + (size_t)(m >> 11) * (6 * D);
#pragma unroll
            for (int j = 0; j < 4; ++j) { const int d = 4 * lane + 256 * j;
                const f32x4 xv = *(const f32x4*)(x_in + (size_t)m * D + d), sh = *(const f32x4*)(mb + d), sc = *(const f32x4*)(mb + D + d);
                const f32x4 hv = xv * (1.f + sc) + sh; v2u o; o.x = pk2(hv[0], hv[1]); o.y = pk2(hv[2], hv[3]);
                *(v2u*)(Hb + (size_t)m * D + d) = o; }
        }
    }
    GRID_SYNC();

    for (int layer = 0; layer < DEPTH; ++layer) {
        for (int rep_ = 0; rep_ < NREP(0); ++rep_) {
            { PH_BEGIN TS_T0(110)
            const int j2 = layer >> 1;
            bf16* Hb = (bf16*)(ws + WS_H); bf16* Qb = (bf16*)(ws + WS_Q);
            if ((layer & 1) == 0) {
                pg8::Gemm g{Hb, (bf16*)(ws + WS_WQKV_NA) + (size_t)j2 * NQKV_NA * D, M, NQKV_NA, D}; pg8::StaticOrder So; So.init(M, NQKV_NA, G, bid);
                pg8::EpiStore8 E{Qb, D, D, (size_t)(WS_K - WS_Q) / 2, C2, 0x7fffffff};
                pg8::gemm_phase<pg8::EpiStore8, pg8::StaticOrder, true, true>(lds, g, So, E);
            } else {
                pg8::Gemm g{Hb, (bf16*)(ws + WS_WQKV_GQ) + (size_t)j2 * NQKV_GQ * D, M, NQKV_GQ, D}; pg8::StaticOrder So; So.init(M, NQKV_GQ, G, bid);
                const float* ropec = (const float*)(ws + WS_ROPE);
                pg8::EpiGqaQkv E{Qb, (bf16*)(ws + WS_K), (bf16*)(ws + WS_V), INP(10) + j2 * HD, INP(11) + j2 * HD, ropec, ropec + S * 32, C2};
                pg8::gemm_phase<pg8::EpiGqaQkv, pg8::StaticOrder, true, true>(lds, g, So, E);
                if (layer + 1 < DEPTH && G == 256 && bid >= 128) {
                    const int tot = conv_total_a(layer, G);
                    moe_weight_items(INP(17), INP(18), INP(19), layer + 1, (bf16*)(ws + WGU_SET(layer + 1)), (bf16*)(ws + WDN_SET(layer + 1)), (LAS float*)(lds + wave * 8704), (bid - 128) * NWAVES + wave, 128 * NWAVES, tot, lane);
                }
            }
        TS_T1(110) } GRID_SYNC_T(120); }
        for (int rep_ = 0; rep_ < NREP(1); ++rep_) {
            { PH_BEGIN TS_T0(111)
            bf16* Qb = (bf16*)(ws + WS_Q); const bf16* Kb = (const bf16*)(ws + WS_K); const bf16* Vb = (const bf16*)(ws + WS_V);
            bf16* Ob = (PROBE_REPEAT == 1 && rep_ == 0) ? (bf16*)(ws + WS_XS) : Qb;
            TS_T0(150) TS_T0(151)
            if ((layer & 1) == 0) na_body::na_phase((LAS char*)lds, Qb, Kb, Vb, Ob, INP(7) + (size_t)(layer >> 1) * NH * 15 * 31, G, bid, (unsigned*)(ws + WS_CTL) + CW_TS);
            else {
                const attn_body::AttnTensors AT{(const attn_body::bf16*)Qb, (const attn_body::bf16*)Kb, (const attn_body::bf16*)Vb, (attn_body::bf16*)Ob};
                const attn_body::StaticOrder So(G, bid);
                attn_body::attn_phase<attn_body::StaticOrder>((char*)lds, AT, So);
            }
            if ((layer & 1) == 0) { TS_T1(150) } else { TS_T1(151) }
        TS_T1(111) } GRID_SYNC_T(121); }
        for (int rep_ = 0; rep_ < NREP(2); ++rep_) {
            { PH_BEGIN TS_T0(112)
            const bf16* Wo = (const bf16*)(ws + ((layer & 1) == 0 ? WS_WO_NA : WS_WO_GQ)) + (size_t)(layer >> 1) * D * D;
            pg8::Gemm g{(const bf16*)(ws + WS_Q), Wo, M, D, D}; pg8::StaticOrder So; So.init(M, D, G, bid);
            pg8::EpiStore8 E{(bf16*)(ws + WS_Y), D, 0, 0, 1.f, 0x7fffffff};
            pg8::gemm_phase<pg8::EpiStore8, pg8::StaticOrder, true, true>(lds, g, So, E);
        TS_T1(112) } GRID_SYNC_T(122); }
        for (int rep_ = 0; rep_ < NREP(3); ++rep_) {
            { PH_BEGIN TS_T0(113)
            const float* xcur = layer == 0 ? INP(0) : (const float*)(ws + WS_X2);
            const float* modl = (const float*)(ws + WS_MOD) + (size_t)layer * NB * 6 * D;
            const bool dmy_ = (PROBE_REPEAT == 3 && rep_ == 0);
            unsigned* cnt = (unsigned*)(ws + WS_CTL) + CW_CNT + CNT_LAYER_STRIDE * (layer + (dmy_ ? 8 : 0));
            float* X1 = (float*)(ws + WS_X1); bf16* Hb = (bf16*)(ws + WS_H); const bf16* Yb = (const bf16*)(ws + WS_Y);
            int* r_eid = (int*)(ws + (dmy_ ? WS_XS : WS_ROUTE)); int* r_pos = r_eid + 2 * M; float* r_gate = (float*)(r_pos + 2 * M);
            int* tokmap = (int*)(ws + WS_TOKMAP);
            LAS unsigned char* Hhi = lds; LAS unsigned char* Hlo = lds + 33024; LAS float* part = (LAS float*)(lds + 66048); LAS float* lgt = (LAS float*)(lds + 90624);
            LAS float* prm = (LAS float*)(lds + 98304);
            LAS int* hist = (LAS int*)(lds + 93696); LAS int* basee = hist + 32; LAS int* rt_e = hist + 64; LAS int* rt_lp = rt_e + 128; LAS float* rt_g = (LAS float*)(rt_lp + 128);
            const float* lg = INP(4) + (size_t)(layer * 2) * D; const float* lb = INP(5) + (size_t)(layer * 2) * D;
            const bf16* wrh = (const bf16*)(ws + WS_WRT) + (size_t)layer * 48 * D; const bf16* wrl = wrh + (size_t)DEPTH * 48 * D;
            const float* bgp = INP(14) + layer * NG; const float* bep = INP(16) + layer * NE;
            const int fr = lane & 15, fq = lane >> 4;
            for (int ch = bid; ch < M / 64; ch += G) {
                if (tid < 32) hist[tid] = 0;
                { const float* mbc = modl + (size_t)((ch * 64) >> 11) * (6 * D);
                  for (int i = tid; i < D; i += NTHREADS) { prm[i] = 1.f + mbc[2 * D + i]; prm[D + i] = lg[i]; prm[2 * D + i] = lb[i]; prm[3 * D + i] = 1.f + mbc[4 * D + i]; prm[4 * D + i] = mbc[3 * D + i]; } }
                __syncthreads();
                pg8::bf16x8 wfh[4][3];
#pragma unroll
                for (int ks = 0; ks < 4; ++ks)
#pragma unroll
                    for (int nt = 0; nt < 3; ++nt) wfh[ks][nt] = *(const pg8::bf16x8*)(wrh + (size_t)(16 * nt + fr) * D + 128 * wave + 32 * ks + 8 * fq);
                f32x4 xn[2][4]; v2u yn[2][4];
#define LN1_LOAD(PS) do { _Pragma("unroll") for (int tt_ = 0; tt_ < 2; ++tt_) { const size_t mo_ = (size_t)(ch * 64 + (PS) * 16 + 2 * wave + tt_) * D + 4 * lane; \
        _Pragma("unroll") for (int j_ = 0; j_ < 4; ++j_) { xn[tt_][j_] = *(const f32x4*)(xcur + mo_ + 256 * j_); yn[tt_][j_] = *(const v2u*)(Yb + mo_ + 256 * j_); } } } while (0)
                LN1_LOAD(0);
                for (int ps = 0; ps < 4; ++ps) {
                    TS_T0(130)
                    f32x4 xc[2][4]; v2u yc[2][4];
#pragma unroll
                    for (int tt = 0; tt < 2; ++tt)
#pragma unroll
                        for (int j = 0; j < 4; ++j) { xc[tt][j] = xn[tt][j]; yc[tt][j] = yn[tt][j]; }
                    LN1_LOAD(ps < 3 ? ps + 1 : 3);
#pragma unroll
                    for (int tt = 0; tt < 2; ++tt) {
                        const int tl = 2 * wave + tt, m = ch * 64 + ps * 16 + tl;
                        f32x4 v[4]; float sm = 0.f;
#pragma unroll
                        for (int j = 0; j < 4; ++j) { const int d = 4 * lane + 256 * j;
                            const f32x4 xv = xc[tt][j], g1 = *(const LAS f32x4*)(prm + d);
                            const v2u yw = yc[tt][j]; const f32x4 yv = {bflo(yw.x), bfhi(yw.x), bflo(yw.y), bfhi(yw.y)};
                            v[j] = ALPHA * xv + g1 * yv; sm += (v[j][0] + v[j][1]) + (v[j][2] + v[j][3]); }
                        const float mean = wave_sum(sm) * (1.f / D); float q = 0.f;
#pragma unroll
                        for (int j = 0; j < 4; ++j) { v[j] = v[j] - mean; q += (v[j][0] * v[j][0] + v[j][1] * v[j][1]) + (v[j][2] * v[j][2] + v[j][3] * v[j][3]); }
                        const float rstd = rsqrtf(wave_sum(q) * (1.f / D) + LN_EPS);
#pragma unroll
                        for (int j = 0; j < 4; ++j) { const int d = 4 * lane + 256 * j;
                            const f32x4 x1 = v[j] * rstd * *(const LAS f32x4*)(prm + D + d) + *(const LAS f32x4*)(prm + 2 * D + d);
                            *(f32x4*)(X1 + (size_t)m * D + d) = x1;
                            const f32x4 h2 = x1 * *(const LAS f32x4*)(prm + 3 * D + d) + *(const LAS f32x4*)(prm + 4 * D + d);
                            unsigned hb[4], lbv[4];
#pragma unroll
                            for (int e = 0; e < 4; ++e) { hb[e] = f2bf(h2[e]); lbv[e] = f2bf(h2[e] - __uint_as_float(hb[e] << 16)); }
                            v2u oh; oh.x = hb[0] | (hb[1] << 16); oh.y = hb[2] | (hb[3] << 16); v2u ol; ol.x = lbv[0] | (lbv[1] << 16); ol.y = lbv[2] | (lbv[3] << 16);
                            *(v2u*)(Hb + (size_t)m * D + d) = oh;
                            *(LAS v2u*)(Hhi + tl * 2064 + d * 2) = oh; *(LAS v2u*)(Hlo + tl * 2064 + d * 2) = ol; }
                    }
                    pg8::bf16x8 wfl[4][3];
#pragma unroll
                    for (int ks = 0; ks < 4; ++ks)
#pragma unroll
                        for (int nt = 0; nt < 3; ++nt) wfl[ks][nt] = *(const pg8::bf16x8*)(wrl + (size_t)(16 * nt + fr) * D + 128 * wave + 32 * ks + 8 * fq);
                    LDS_BARRIER();
                    TS_T1(130) TS_T0(131)
                    { f32x4 acc[3];
#pragma unroll
                      for (int nt = 0; nt < 3; ++nt) acc[nt] = (f32x4){0.f, 0.f, 0.f, 0.f};
#pragma unroll
                      for (int ks = 0; ks < 4; ++ks) { const int kk = 128 * wave + 32 * ks + 8 * fq;
                          const pg8::bf16x8 hh = *(const LAS pg8::bf16x8*)(Hhi + fr * 2064 + kk * 2), hl = *(const LAS pg8::bf16x8*)(Hlo + fr * 2064 + kk * 2);
#pragma unroll
                          for (int nt = 0; nt < 3; ++nt) { const pg8::bf16x8 wh = wfh[ks][nt], wl = wfl[ks][nt];
                              acc[nt] = __builtin_amdgcn_mfma_f32_16x16x32_bf16(wh, hh, acc[nt], 0, 0, 0);
                              acc[nt] = __builtin_amdgcn_mfma_f32_16x16x32_bf16(wh, hl, acc[nt], 0, 0, 0);
                              acc[nt] = __builtin_amdgcn_mfma_f32_16x16x32_bf16(wl, hh, acc[nt], 0, 0, 0); } }
#pragma unroll
                      for (int nt = 0; nt < 3; ++nt) *(LAS f32x4*)(part + (wave * 16 + fr) * 48 + 16 * nt + 4 * fq) = acc[nt]; }
                    LDS_BARRIER();
                    TS_T1(131) TS_T0(132)
                    for (int idx = tid; idx < 16 * 48; idx += NTHREADS) { const int o = idx % 48; float sacc = o < NG ? bgp[o] : (o < NRT ? bep[o - NG] : 0.f);
#pragma unroll
                        for (int w8 = 0; w8 < 8; ++w8) sacc += part[w8 * 16 * 48 + idx];
                        lgt[idx] = sacc; }
                    LDS_BARRIER();
                    if (tid < 16) { const LAS float* L = lgt + tid * 48; const int tl = ps * 16 + tid;
                        int gi = 0; float gm = L[0];
#pragma unroll
                        for (int o = 1; o < NG; ++o) if (L[o] > gm) { gm = L[o]; gi = o; }
                        float gs = 0.f;
#pragma unroll
                        for (int o = 0; o < NG; ++o) gs += __expf(L[o] - gm);
                        const float gprob = 1.f / gs; const LAS float* E8 = L + NG + gi * EPG;
                        int i0 = 0; float m0 = E8[0];
#pragma unroll
                        for (int e = 1; e < EPG; ++e) if (E8[e] > m0) { m0 = E8[e]; i0 = e; }
                        int i1 = 0; float m1 = -INFINITY;
#pragma unroll
                        for (int e = 0; e < EPG; ++e) if (e != i0 && E8[e] > m1) { m1 = E8[e]; i1 = e; }
                        const float p1 = __expf(m1 - m0), den = 1.f + p1; const int e0 = gi * EPG + i0, e1 = gi * EPG + i1;
                        rt_e[2 * tl] = e0; rt_e[2 * tl + 1] = e1; rt_g[2 * tl] = gprob / den; rt_g[2 * tl + 1] = gprob * p1 / den;
                        rt_lp[2 * tl] = atomicAdd((int*)&hist[e0], 1); rt_lp[2 * tl + 1] = atomicAdd((int*)&hist[e1], 1); }
                    TS_T1(132)
                }
                TS_T0(133)
                __syncthreads();
                if (tid < 32) { const int c = hist[tid]; basee[tid] = c ? (int)__hip_atomic_fetch_add(cnt + 64 * tid, (unsigned)c, RLX_AGENT) : 0; }
                __syncthreads();
                if (tid < 128) { const int e = rt_e[tid], A = ch * 128 + tid, ps_ = basee[e] + rt_lp[tid]; r_eid[A] = e; r_pos[A] = ps_; r_gate[A] = rt_g[tid]; if (!dmy_) tokmap[e * TOKCAP + ps_] = A >> 1; }
                __syncthreads();
                TS_T1(133)
            }
#undef LN1_LOAD
        TS_T1(113) } GRID_SYNC_T(123); }
        for (int rep_ = 0; rep_ < NREP(5); ++rep_) {
            { PH_BEGIN TS_T0(115)
            build_tiles((const unsigned*)(ws + WS_CTL) + CW_CNT + CNT_LAYER_STRIDE * layer, misc, tid);
            const int ntiles = __builtin_amdgcn_readfirstlane(misc[33]);
            pg8::Gemm g{(const bf16*)(ws + WS_H), (const bf16*)(ws + WGU_SET(layer)), ntiles * 256, NE * D, D}; MoeOrder So{ntiles * 4, G, bid, misc + 64, misc + 256, misc + 448, (const int*)(ws + WS_TOKMAP)};
            pg8::EpiSwiglu E{(bf16*)(ws + WS_HMID)};
            pg8::gemm_phase<pg8::EpiSwiglu, MoeOrder, true, true, true>(lds, g, So, E);
            if (layer + 1 < DEPTH) { const int idle = idle_cus(ntiles * 4, G), first = conv_total_a(layer, G);
                if (bid >= G - idle) { int end = first + idle * NWAVES * CQ_B; end = end < CONV_ITEMS ? end : CONV_ITEMS;
                    moe_weight_items(INP(17), INP(18), INP(19), layer + 1, (bf16*)(ws + WGU_SET(layer + 1)), (bf16*)(ws + WDN_SET(layer + 1)), (LAS float*)(lds + wave * 8704), first + (bid - (G - idle)) * NWAVES + wave, idle * NWAVES, end, lane); } }
        TS_T1(115) } GRID_SYNC_T(125); }
        for (int rep_ = 0; rep_ < NREP(6); ++rep_) {
            { PH_BEGIN TS_T0(116)
            const int ntiles = __builtin_amdgcn_readfirstlane(misc[33]);
            pg8::Gemm g{(const bf16*)(ws + WS_HMID), (const bf16*)(ws + WDN_SET(layer)), ntiles * 256, NE * D, DE}; MoeOrder So{ntiles * 4, G, bid, misc + 64, misc + 256, misc + 448, nullptr};
            pg8::EpiStore8 E{(bf16*)(ws + WS_YS), D, 0, 0, 1.f, 3};
            pg8::gemm_phase<pg8::EpiStore8, MoeOrder, true, true>(lds, g, So, E);
            if (layer + 1 < DEPTH) { const int idle = idle_cus(ntiles * 4, G); int first = conv_total_a(layer, G) + idle * NWAVES * CQ_B; first = first < CONV_ITEMS ? first : CONV_ITEMS;
                if (bid >= G - idle) { int end = first + idle * NWAVES * CQ_C; end = end < CONV_ITEMS ? end : CONV_ITEMS;
                    moe_weight_items(INP(17), INP(18), INP(19), layer + 1, (bf16*)(ws + WGU_SET(layer + 1)), (bf16*)(ws + WDN_SET(layer + 1)), (LAS float*)(lds + wave * 8704), first + (bid - (G - idle)) * NWAVES + wave, idle * NWAVES, end, lane); } }
        TS_T1(116) } GRID_SYNC_T(126); }
        for (int rep_ = 0; rep_ < NREP(7); ++rep_) {
            { PH_BEGIN TS_T0(117)
            const float* lg = INP(4) + (size_t)(layer * 2 + 1) * D; const float* lb = INP(5) + (size_t)(layer * 2 + 1) * D;
            const bool last = layer == DEPTH - 1; float* xo = last ? (float*)ldptr(ptab, 20) : (float*)(ws + WS_X2);
            const float tsc = (PROBE_TS >= 0 && last) ? 1.f + (float)__hip_atomic_load((unsigned*)(ws + WS_CTL) + CW_TS, RLX_AGENT) * 1e-6f : 1.f;
            const float* modl = (const float*)(ws + WS_MOD) + (size_t)layer * NB * 6 * D; const float* modn = modl + (size_t)NB * 6 * D;
            const float* X1 = (const float*)(ws + WS_X1); bf16* Hb = (bf16*)(ws + WS_H); const bf16* YS = (const bf16*)(ws + WS_YS);
            const int* r_eid = (const int*)(ws + WS_ROUTE); const int* r_pos = r_eid + 2 * M; const float* r_gate = (const float*)(r_pos + 2 * M);
            TS_T0(140)
            LAS float* prm = (LAS float*)(lds + 98304);
            for (int ch = bid; ch < M / 64; ch += G) {
                __syncthreads();
                { const float* mbc = modl + (size_t)((ch * 64) >> 11) * (6 * D); const float* mnc = modn + (size_t)((ch * 64) >> 11) * (6 * D);
                  for (int i = tid; i < D; i += NTHREADS) { prm[i] = 1.f + mbc[5 * D + i]; prm[D + i] = lg[i]; prm[2 * D + i] = lb[i];
                      prm[3 * D + i] = last ? 0.f : 1.f + mnc[D + i]; prm[4 * D + i] = last ? 0.f : mnc[i]; } }
                __syncthreads();
                const int mbase = ch * 64 + wave * 8;
                int sl0, sl1; float gt0, gt1;
                { const int mi = mbase + (lane & 7); sl0 = misc[r_eid[2 * mi]] * 256 + r_pos[2 * mi]; sl1 = misc[r_eid[2 * mi + 1]] * 256 + r_pos[2 * mi + 1]; gt0 = r_gate[2 * mi]; gt1 = r_gate[2 * mi + 1]; }
                f32x4 xn[4]; v2u yan[4], ybn[4];
#define CMB_LOAD(I) do { const int mi_ = mbase + (I); const int s0_ = __builtin_amdgcn_readlane(sl0, (I)), s1_ = __builtin_amdgcn_readlane(sl1, (I)); \
        _Pragma("unroll") for (int j_ = 0; j_ < 4; ++j_) { const int d_ = 4 * lane + 256 * j_; xn[j_] = *(const f32x4*)(X1 + (size_t)mi_ * D + d_); \
            yan[j_] = *(const v2u*)(YS + (size_t)s0_ * D + d_); ybn[j_] = *(const v2u*)(YS + (size_t)s1_ * D + d_); } } while (0)
                CMB_LOAD(0);
#pragma unroll
                for (int i = 0; i < 8; ++i) {
                    const int m = mbase + i;
                    const float g0 = __builtin_bit_cast(float, __builtin_amdgcn_readlane(__builtin_bit_cast(int, gt0), i)), g1v = __builtin_bit_cast(float, __builtin_amdgcn_readlane(__builtin_bit_cast(int, gt1), i));
                    f32x4 xc[4]; v2u yac[4], ybc[4];
#pragma unroll
                    for (int j = 0; j < 4; ++j) { xc[j] = xn[j]; yac[j] = yan[j]; ybc[j] = ybn[j]; }
                    if (i < 7) CMB_LOAD(i + 1);
                    f32x4 v[4]; float sm = 0.f;
#pragma unroll
                    for (int j = 0; j < 4; ++j) { const int d = 4 * lane + 256 * j;
                        const f32x4 g2 = *(const LAS f32x4*)(prm + d); const v2u ya = yac[j], yb = ybc[j];
                        const f32x4 y0 = {bflo(ya.x), bfhi(ya.x), bflo(ya.y), bfhi(ya.y)}, y1 = {bflo(yb.x), bfhi(yb.x), bflo(yb.y), bfhi(yb.y)};
                        v[j] = ALPHA * xc[j] + g2 * (g0 * y0 + g1v * y1); sm += (v[j][0] + v[j][1]) + (v[j][2] + v[j][3]); }
                    const float mean = wave_sum(sm) * (1.f / D); float q = 0.f;
#pragma unroll
                    for (int j = 0; j < 4; ++j) { v[j] = v[j] - mean; q += (v[j][0] * v[j][0] + v[j][1] * v[j][1]) + (v[j][2] * v[j][2] + v[j][3] * v[j][3]); }
                    const float rstd = rsqrtf(wave_sum(q) * (1.f / D) + LN_EPS);
#pragma unroll
                    for (int j = 0; j < 4; ++j) { const int d = 4 * lane + 256 * j;
                        const f32x4 x2 = v[j] * rstd * *(const LAS f32x4*)(prm + D + d) + *(const LAS f32x4*)(prm + 2 * D + d);
                        *(f32x4*)(xo + (size_t)m * D + d) = x2 * tsc;
                        if (!last) { const f32x4 hn = x2 * *(const LAS f32x4*)(prm + 3 * D + d) + *(const LAS f32x4*)(prm + 4 * D + d);
                            v2u o; o.x = pk2(hn[0], hn[1]); o.y = pk2(hn[2], hn[3]); *(v2u*)(Hb + (size_t)m * D + d) = o; } }
                }
#undef CMB_LOAD
            }
            __syncthreads();
            TS_T1(140) TS_T0(141)
            if (!last) { LAS float* scr = (LAS float*)(lds + wave * 8704); const int idle = idle_cus(__builtin_amdgcn_readfirstlane(misc[33]) * 4, G);
                int first = conv_total_a(layer, G) + idle * NWAVES * (CQ_B + CQ_C); first = first < CONV_ITEMS ? first : CONV_ITEMS;
                moe_weight_items(INP(17), INP(18), INP(19), layer + 1, (bf16*)(ws + WGU_SET(layer + 1)), (bf16*)(ws + WDN_SET(layer + 1)), scr, first + gw, NGW, CONV_ITEMS, lane); }
            TS_T1(141)
        TS_T1(117) } if (layer != DEPTH - 1 || PROBE_REPEAT == 7) GRID_SYNC_T(127); }
    }
}

extern "C" void kernel_launch(void* const* d_in, const int* in_sizes, int n_in, void* d_out, int out_size, void* d_ws, size_t ws_size, hipStream_t stream) {
    static int grid = 0;
    if (grid == 0) {
        if (n_in != 20 || ws_size < WS_END) { fprintf(stderr, "kernel_launch: unexpected inputs (n_in %d, ws %zu)\n", n_in, ws_size); grid = -1; return; }
        int dev = 0, cus = 0, per_cu = 0;
        if (hipGetDevice(&dev) != hipSuccess || hipDeviceGetAttribute(&cus, hipDeviceAttributeMultiprocessorCount, dev) != hipSuccess) { grid = -1; return; }
        if (hipFuncSetAttribute((const void*)mk_fwd, hipFuncAttributeMaxDynamicSharedMemorySize, LDS_BYTES) != hipSuccess) { fprintf(stderr, "kernel_launch: hipFuncSetAttribute failed\n"); grid = -1; return; }
        if (hipOccupancyMaxActiveBlocksPerMultiprocessor(&per_cu, (const void*)mk_fwd, NTHREADS, LDS_BYTES) != hipSuccess || per_cu < 1) { fprintf(stderr, "kernel_launch: occupancy query failed (%d)\n", per_cu); per_cu = 1; }
        (void)hipGetLastError();
        grid = cus * (per_cu < 1 ? 1 : 1);
    }
    if (grid < 0) return;
    (void)in_sizes; (void)out_size;
    if (hipMemsetAsync((char*)d_ws + WS_CTL, 0, CTL_ZERO_BYTES, stream) != hipSuccess) { fprintf(stderr, "kernel_launch: memset failed\n"); return; }
    Args a{};
    for (int i = 0; i < 20; ++i) a.in[i] = (const float*)d_in[i];
    a.out = (float*)d_out; a.ws = (unsigned char*)d_ws;
    void* kargs[] = {&a};
    hipError_t e = hipLaunchCooperativeKernel((const void*)mk_fwd, dim3(grid), dim3(NTHREADS), kargs, LDS_BYTES, stream);
    if (e != hipSuccess) fprintf(stderr, "kernel_launch: cooperative launch failed: %s (grid %d)\n", hipGetErrorString(e), grid);
}
```

```cpp
#include <hip/hip_runtime.h>
#include <hip/hip_cooperative_groups.h>
#include <cstdio>
#include <cstdint>
namespace cg = cooperative_groups;
namespace pg8 {
#define PG8_LAS __attribute__((address_space(3)))
typedef unsigned short bf16_t;
typedef short bf16x8 __attribute__((ext_vector_type(8)));
typedef float f32x4 __attribute__((ext_vector_type(4)));
typedef unsigned u32x4 __attribute__((ext_vector_type(4)));
constexpr int BM = 256, BK = 64, HALF = 128, HTB = HALF * BK * 2  , STAGE_BYTES = 8 * HTB, NXCD = 8, WGM = 8;

__host__ __device__ __forceinline__ int lds_byte(int r, int c) { const int st = (r >> 4) * 2 + (c >> 5), rr = r & 15, cc = c & 31, ob = rr * 64 + cc * 2; return st * 1024 + (ob ^ (((ob >> 9) & 1) << 5)); }
__host__ __device__ __forceinline__ void stage_rc(int b, int& R, int& C) { const int st = b / 1024, sb = b % 1024, swz = sb ^ (((sb >> 9) & 1) << 5); R = (st >> 1) * 16 + swz / 64; C = (st & 1) * 32 + (swz % 64) / 2; }
__host__ __device__ __forceinline__ int perm32(int rho) { const int n = rho >> 4, i = rho & 15; return 8 * (i >> 2) + 4 * n + (i & 3); }

struct Unit { int pm, pn; };
struct Gemm { const bf16_t* A; const bf16_t* Bt; int M, N, K; };

struct StaticOrder {
    int nM, nN, nwg, G, c;
    __host__ __device__ void init(int M, int N, int G_, int c_) { nM = M / BM; nN = N / BM; nwg = nM * nN; G = G_; c = c_; }
    __host__ __device__ bool next(int i, Unit& u) const {
        const long L = (long)i * G + c; if (L >= nwg) return false;
        int wgid = (int)L; { const int q = nwg / NXCD, r = nwg % NXCD, xcd = wgid % NXCD, off = wgid / NXCD; wgid = (xcd < r ? xcd * (q + 1) : r * (q + 1) + (xcd - r) * q) + off; }
        const int nig = WGM * nN, gid = wgid / nig, fm = gid * WGM, gsz = (nM - fm) < WGM ? (nM - fm) : WGM;
        u.pm = fm + ((wgid % nig) % gsz); u.pn = (wgid % nig) / gsz; return true;
    }
    __device__ __forceinline__ void a_ready(const Unit&) const {}
    __device__ __forceinline__ void done(const Unit&) const {}
};

__device__ __forceinline__ unsigned cvt_pk_bf16(float lo, float hi) { unsigned r; asm volatile("v_cvt_pk_bf16_f32 %0, %1, %2" : "=v"(r) : "v"(lo), "v"(hi)); return r; }
__device__ __forceinline__ u32x4 pack8(const f32x4& a, const f32x4& b) { u32x4 w; w.x = cvt_pk_bf16(a[0], a[1]); w.y = cvt_pk_bf16(a[2], a[3]); w.z = cvt_pk_bf16(b[0], b[1]); w.w = cvt_pk_bf16(b[2], b[3]); return w; }

struct EpiStore8 {
    static constexpr bool PERM = false, AFTER_DRAIN = false;
    bf16_t* O; int ldc; int split_cols; size_t split_stride; float scale0; int pn_mask;
    __device__ __forceinline__ void operator()(const f32x4 (&acc)[2][2][4][2], const Unit& u, int wr, int wc, int fr, int fq) const {
        const int row0 = u.pm * BM + wr * 64 + fr; int colt = (u.pn & pn_mask) * BM; bf16_t* base = O;
        float sc = 1.f; if (split_cols) { const int t = colt / split_cols; base += (size_t)t * split_stride; colt -= t * split_cols; if (t == 0) sc = scale0; }
        const int col0 = colt + wc * 32 + 8 * fq;
#pragma unroll
        for (int ai = 0; ai < 2; ++ai)
#pragma unroll
            for (int m = 0; m < 4; ++m) { bf16_t* rowp = base + (size_t)(row0 + ai * HALF + m * 16) * ldc + col0;
#pragma unroll
                for (int bj = 0; bj < 2; ++bj) { const f32x4 v0 = acc[ai][bj][m][0] * sc, v1 = acc[ai][bj][m][1] * sc; *(u32x4*)(rowp + bj * HALF) = pack8(v0, v1); } }
    }
};
__device__ __forceinline__ float silu_f(float g) { return g * __builtin_amdgcn_rcpf(1.f + __expf(-g)); }
struct EpiSwiglu {
    static constexpr bool PERM = false, AFTER_DRAIN = false;
    bf16_t* O;
    __device__ __forceinline__ void operator()(const f32x4 (&acc)[2][2][4][2], const Unit& u, int wr, int wc, int fr, int fq) const {
        const int row0 = u.pm * BM + wr * 64 + fr; const int col0 = (u.pn & 3) * 128 + wc * 32 + 8 * fq;
#pragma unroll
        for (int ai = 0; ai < 2; ++ai)
#pragma unroll
            for (int m = 0; m < 4; ++m) { bf16_t* rowp = O + (size_t)(row0 + ai * HALF + m * 16) * 512 + col0; f32x4 h[2];
#pragma unroll
                for (int n = 0; n < 2; ++n) { const f32x4 g = acc[ai][0][m][n], up = acc[ai][1][m][n];
                    h[n] = (f32x4){silu_f(g[0]) * up[0], silu_f(g[1]) * up[1], silu_f(g[2]) * up[2], silu_f(g[3]) * up[3]}; }
                *(u32x4*)rowp = pack8(h[0], h[1]); }
    }
};
struct EpiGqaQkv {
    static constexpr bool PERM = false, AFTER_DRAIN = false;
    bf16_t *Q, *K, *V; const float* qn; const float* kn; const float* cs; const float* sn; float qscale;
    __device__ __forceinline__ void operator()(const f32x4 (&acc)[2][2][4][2], const Unit& u, int wr, int wc, int fr, int fq) const {
        const int row0 = u.pm * BM + wr * 64 + fr; const int pn = u.pn;
        const int type = pn < 4 ? 0 : (pn == 4 ? 1 : 2);
        bf16_t* base = type == 0 ? Q + (4 * pn + wc) * 64 : (type == 1 ? K : V) + wc * 64; const int ldc = type == 0 ? 1024 : 256;
        const int dlo = 32 * (fq >> 1) + 8 * (fq & 1);
        const int tlo = (fq >> 1) * 16 + 8 * (fq & 1);
        const float* gain = type == 0 ? qn : kn; const float sc = type == 0 ? qscale : 1.f;
        f32x4 gv[2][2];
#pragma unroll
        for (int bj = 0; bj < 2; ++bj)
#pragma unroll
            for (int n = 0; n < 2; ++n) gv[bj][n] = *(const f32x4*)(gain + dlo + 16 * bj + 4 * n) * sc;
#pragma unroll
        for (int ai = 0; ai < 2; ++ai)
#pragma unroll
            for (int m = 0; m < 4; ++m) { const int row = row0 + ai * HALF + m * 16; bf16_t* rowp = base + (size_t)row * ldc + dlo; f32x4 o[2][2];
                if (type < 2) {
                    float ss = 0.f;
#pragma unroll
                    for (int bj = 0; bj < 2; ++bj)
#pragma unroll
                        for (int n = 0; n < 2; ++n) { const f32x4 x = acc[ai][bj][m][n]; ss += (x[0] * x[0] + x[1] * x[1]) + (x[2] * x[2] + x[3] * x[3]); }
                    ss += __shfl_xor(ss, 16); ss += __shfl_xor(ss, 32);
                    const float rinv = rsqrtf(ss * (1.f / 64.f) + 1e-6f);
                    const int t = row & 2047;
#pragma unroll
                    for (int n = 0; n < 2; ++n) { const f32x4 c4 = *(const f32x4*)(cs + t * 32 + tlo + 4 * n), s4 = *(const f32x4*)(sn + t * 32 + tlo + 4 * n);
                        const f32x4 x1 = acc[ai][0][m][n] * rinv * gv[0][n], x2 = acc[ai][1][m][n] * rinv * gv[1][n];
                        o[0][n] = x1 * c4 - x2 * s4; o[1][n] = x2 * c4 + x1 * s4; }
                } else {
#pragma unroll
                    for (int bj = 0; bj < 2; ++bj)
#pragma unroll
                        for (int n = 0; n < 2; ++n) o[bj][n] = acc[ai][bj][m][n];
                }
#pragma unroll
                for (int bj = 0; bj < 2; ++bj) *(u32x4*)(rowp + 16 * bj) = pack8(o[bj][0], o[bj][1]); }
    }
};
template <class Epi, class Sched, bool ALIGN_EPI = false, bool SP2 = false, bool GATHER = false>
__device__ __forceinline__ void gemm_phase(PG8_LAS unsigned char* lds, const Gemm g, const Sched& S, const Epi& E) {
    int tid_ = threadIdx.x; asm volatile("" : "+v"(tid_)); const int tid = tid_, wid = __builtin_amdgcn_readfirstlane(tid >> 6), lane = tid & 63, wr = wid >> 2, wc = wid & 3, fr = lane & 15, fq = lane >> 4;
    const int K = g.K, nt = K / BK;
    unsigned voffA[2], voffB[2];
#pragma unroll
    for (int i = 0; i < 2; ++i) { int R, C; stage_rc(tid * 16 + i * 8192, R, C); const int Rb = Epi::PERM ? ((R & ~31) + perm32(R & 31)) : R;
        voffA[i] = (unsigned)(R * K + C) * 2u; voffB[i] = (unsigned)(Rb * K + C) * 2u; }
    static_assert(!GATHER || SP2, "row gather is wired into the SP2 loop only");
    unsigned vAc[2][2], vAn[2][2], vA2[2][2];
    int gR[2], gC[2];
#pragma unroll
    for (int i = 0; i < 2; ++i) { int R, C; stage_rc(tid * 16 + i * 8192, R, C); gR[i] = R; gC[i] = C; }
#define PG8_ROWOFF(dst, u) do { if constexpr (GATHER) { _Pragma("unroll") for (int h_ = 0; h_ < 2; ++h_) _Pragma("unroll") for (int i_ = 0; i_ < 2; ++i_) \
        dst[h_][i_] = ((unsigned)S.arow(u, h_ * HALF + gR[i_]) * (unsigned)K + (unsigned)gC[i_]) * 2u; } } while (0)
    const size_t kstep = (size_t)(BK * 2);
    const size_t hstep = (size_t)HALF * K * 2;
    const size_t tstep = 2 * hstep;
    const unsigned ldsw = (unsigned)wid * 1024u;
    const int aoff = lds_byte(wr * 64 + fr, fq * 8), boff = lds_byte(wc * 32 + fr, fq * 8);
#define PG8_SA(b, h) (((b) * 2 + (h)) * HTB)
#define PG8_SB(b, h) ((4 + (b) * 2 + (h)) * HTB)
#define PG8_STAGE(bufoff, gbase, voff) do { _Pragma("unroll") for (int _i = 0; _i < 2; ++_i) \
        __builtin_amdgcn_global_load_lds((const unsigned*)((const char*)(gbase) + (voff)[_i]), (PG8_LAS unsigned*)(lds + (bufoff) + ldsw + _i * 8192), 16, 0, 0); } while (0)
#define PG8_STAGE_A(bufoff, base, h, W) do { if constexpr (GATHER) { PG8_STAGE(bufoff, base, W[h]); } else { PG8_STAGE(bufoff, (base) + (h) * hstep, voffA); } } while (0)
#define PG8_LDA(dst, b, h) do { _Pragma("unroll") for (int m = 0; m < 4; ++m) _Pragma("unroll") for (int k = 0; k < 2; ++k) dst[m][k] = *(const PG8_LAS bf16x8*)(lds + PG8_SA(b, h) + aoff + m * 2048 + k * 1024); } while (0)
#define PG8_LDB(dst, b, h) do { _Pragma("unroll") for (int n = 0; n < 2; ++n) _Pragma("unroll") for (int k = 0; k < 2; ++k) dst[n][k] = *(const PG8_LAS bf16x8*)(lds + PG8_SB(b, h) + boff + n * 2048 + k * 1024); } while (0)
#define PG8_MMA(ai, bj, At, Bt) do { __builtin_amdgcn_s_setprio(1); _Pragma("unroll") for (int m = 0; m < 4; ++m) _Pragma("unroll") for (int n = 0; n < 2; ++n) _Pragma("unroll") for (int k = 0; k < 2; ++k) \
        acc[ai][bj][m][n] = __builtin_amdgcn_mfma_f32_16x16x32_bf16(Bt[n][k], At[m][k], acc[ai][bj][m][n], 0, 0, 0); __builtin_amdgcn_s_setprio(0); } while (0)
#define PG8_WAIT_V(n) asm volatile("s_waitcnt vmcnt(" #n ")" ::: "memory")
#define PG8_WAIT_L(n) asm volatile("s_waitcnt lgkmcnt(" #n ")" ::: "memory")
#define PG8_BAR __builtin_amdgcn_s_barrier()
#define PG8_SCHED __builtin_amdgcn_sched_barrier(0)
    Unit cur, nxt; int ui = 0;
    if (!S.next(0, cur)) return;
    f32x4 acc[2][2][4][2];
#pragma unroll
    for (int a = 0; a < 2; ++a)
#pragma unroll
        for (int b = 0; b < 2; ++b)
#pragma unroll
            for (int m = 0; m < 4; ++m)
#pragma unroll
                for (int n = 0; n < 2; ++n) acc[a][b][m][n] = (f32x4){0.f, 0.f, 0.f, 0.f};
    bf16x8 At[4][2], B0[2][2], B1[2][2];
    const char* cA = (const char*)g.A + (GATHER ? (size_t)0 : (size_t)cur.pm * tstep); PG8_ROWOFF(vAc, cur); const char* cB = (const char*)g.Bt + (size_t)cur.pn * tstep;
    S.a_ready(cur);
    if constexpr (SP2) {
        PG8_STAGE(PG8_SB(0, 0), cB, voffB); PG8_STAGE(PG8_SB(0, 1), cB + hstep, voffB); PG8_STAGE_A(PG8_SA(0, 0), cA, 0, vAc); PG8_STAGE_A(PG8_SA(0, 1), cA, 1, vAc);
        if (wr == 1) PG8_BAR;
        PG8_WAIT_V(2); PG8_BAR;
        PG8_STAGE(PG8_SB(1, 0), cB + kstep, voffB); PG8_STAGE_A(PG8_SA(1, 0), cA + kstep, 0, vAc); PG8_STAGE(PG8_SB(1, 1), cB + hstep + kstep, voffB);
        PG8_WAIT_V(6); PG8_BAR;
    } else {
        PG8_STAGE(PG8_SB(0, 0), cB, voffB); PG8_STAGE(PG8_SA(0, 0), cA, voffA); PG8_STAGE(PG8_SB(0, 1), cB + hstep, voffB); PG8_STAGE(PG8_SA(0, 1), cA + hstep, voffA);
        if (wr == 1) PG8_BAR;
        PG8_WAIT_V(4); PG8_BAR;
        PG8_STAGE(PG8_SB(1, 0), cB + kstep, voffB); PG8_STAGE(PG8_SA(1, 0), cA + kstep, voffA); PG8_STAGE(PG8_SB(1, 1), cB + hstep + kstep, voffB);
        PG8_WAIT_V(6); PG8_BAR;
    }
    for (;;) {
        const bool has_next = S.next(ui + 1, nxt);
        const char* nA = has_next ? (const char*)g.A + (GATHER ? (size_t)0 : (size_t)nxt.pm * tstep) : cA;
        if constexpr (GATHER) { if (has_next) { PG8_ROWOFF(vAn, nxt); } else { _Pragma("unroll") for (int h_ = 0; h_ < 2; ++h_) _Pragma("unroll") for (int i_ = 0; i_ < 2; ++i_) vAn[h_][i_] = vAc[h_][i_]; } } const char* nB = has_next ? (const char*)g.Bt + (size_t)nxt.pn * tstep : cB;
        for (int t = 0; t < nt; t += 2) {
            const bool last = (t == nt - 2);
            const char* a1 = cA + (size_t)(t + 1) * kstep;
            const char* a2 = last ? nA : cA + (size_t)(t + 2) * kstep; const char* b2 = last ? nB : cB + (size_t)(t + 2) * kstep;
            const char* a3 = a2 + kstep; const char* b3 = b2 + kstep;
            if constexpr (GATHER) { _Pragma("unroll") for (int h_ = 0; h_ < 2; ++h_) _Pragma("unroll") for (int i_ = 0; i_ < 2; ++i_) vA2[h_][i_] = last ? vAn[h_][i_] : vAc[h_][i_]; }
            if (last && has_next) S.a_ready(nxt);
            if constexpr (SP2) {
            PG8_LDB(B0, 0, 0); PG8_LDB(B1, 0, 1); PG8_SCHED; PG8_LDA(At, 0, 0); PG8_STAGE_A(PG8_SA(1, 1), a1, 1, vAc);
            PG8_WAIT_V(8); PG8_WAIT_L(0); PG8_BAR; PG8_MMA(0, 0, At, B0); PG8_MMA(0, 1, At, B1); PG8_BAR; PG8_SCHED;
            PG8_LDA(At, 0, 1); PG8_STAGE(PG8_SB(0, 0), b2, voffB); PG8_STAGE(PG8_SB(0, 1), b2 + hstep, voffB); PG8_STAGE_A(PG8_SA(0, 0), a2, 0, vA2);
            PG8_WAIT_V(8); PG8_WAIT_L(0); PG8_BAR; PG8_MMA(1, 0, At, B0); PG8_MMA(1, 1, At, B1); PG8_BAR; PG8_SCHED;
            PG8_LDB(B0, 1, 0); PG8_LDB(B1, 1, 1); PG8_SCHED; PG8_LDA(At, 1, 0); PG8_STAGE_A(PG8_SA(0, 1), a2, 1, vA2);
            PG8_WAIT_V(8); PG8_WAIT_L(0); PG8_BAR; PG8_MMA(0, 0, At, B0); PG8_MMA(0, 1, At, B1); PG8_BAR; PG8_SCHED;
            PG8_LDA(At, 1, 1); PG8_STAGE(PG8_SB(1, 0), b3, voffB); PG8_STAGE(PG8_SB(1, 1), b3 + hstep, voffB); PG8_STAGE_A(PG8_SA(1, 0), a3, 0, vA2);
            PG8_WAIT_V(8); PG8_WAIT_L(0); PG8_BAR; PG8_MMA(1, 0, At, B0); PG8_MMA(1, 1, At, B1); PG8_BAR; PG8_SCHED;
            } else {
            PG8_LDB(B0, 0, 0); PG8_SCHED; PG8_LDA(At, 0, 0); PG8_STAGE(PG8_SA(1, 1), a1 + hstep, voffA);
            PG8_WAIT_L(8); PG8_BAR; PG8_WAIT_L(0); PG8_MMA(0, 0, At, B0); PG8_BAR; PG8_SCHED;
            PG8_LDB(B1, 0, 1); PG8_STAGE(PG8_SB(0, 0), b2, voffB);
            PG8_BAR; PG8_WAIT_L(0); PG8_MMA(0, 1, At, B1); PG8_BAR;
            PG8_LDA(At, 0, 1); PG8_STAGE(PG8_SA(0, 0), a2, voffA);
            PG8_BAR; PG8_WAIT_L(0); PG8_MMA(1, 0, At, B0); PG8_BAR; PG8_SCHED;
            PG8_STAGE(PG8_SB(0, 1), b2 + hstep, voffB);
            PG8_WAIT_V(6); PG8_BAR; PG8_MMA(1, 1, At, B1); PG8_BAR;
            PG8_LDB(B0, 1, 0); PG8_SCHED; PG8_LDA(At, 1, 0); PG8_STAGE(PG8_SA(0, 1), a2 + hstep, voffA);
            PG8_WAIT_L(8); PG8_BAR; PG8_WAIT_L(0); PG8_MMA(0, 0, At, B0); PG8_BAR; PG8_SCHED;
            PG8_LDB(B1, 1, 1); PG8_STAGE(PG8_SB(1, 0), b3, voffB);
            PG8_BAR; PG8_WAIT_L(0); PG8_MMA(0, 1, At, B1); PG8_BAR;
            PG8_LDA(At, 1, 1); PG8_STAGE(PG8_SA(1, 0), a3, voffA);
            PG8_BAR; PG8_WAIT_L(0); PG8_MMA(1, 0, At, B0); PG8_BAR; PG8_SCHED;
            PG8_STAGE(PG8_SB(1, 1), b3 + hstep, voffB);
            PG8_WAIT_V(6); PG8_BAR; PG8_MMA(1, 1, At, B1); PG8_BAR;
            }
        }
        if constexpr (ALIGN_EPI) { if (wr == 0) PG8_BAR; }
        if constexpr (!Epi::AFTER_DRAIN) { E(acc, cur, wr, wc, fr, fq); S.done(cur); }
        if (!has_next) break;
#pragma unroll
        for (int a = 0; a < 2; ++a)
#pragma unroll
            for (int b = 0; b < 2; ++b)
#pragma unroll
                for (int m = 0; m < 4; ++m)
#pragma unroll
                    for (int n = 0; n < 2; ++n) acc[a][b][m][n] = (f32x4){0.f, 0.f, 0.f, 0.f};
        cur = nxt; cA = nA; cB = nB; ++ui;
        if constexpr (GATHER) { _Pragma("unroll") for (int h_ = 0; h_ < 2; ++h_) _Pragma("unroll") for (int i_ = 0; i_ < 2; ++i_) vAc[h_][i_] = vAn[h_][i_]; }
        if constexpr (ALIGN_EPI) { if (wr == 1) PG8_BAR; }
    }
    PG8_WAIT_V(0);
    if constexpr (!ALIGN_EPI) { if (wr == 0) PG8_BAR; }
    PG8_BAR;
    if constexpr (Epi::AFTER_DRAIN) { E.fused(acc, cur, wr, wc, fr, fq, lds, wid, lane); S.done(cur); }
#undef PG8_SA
#undef PG8_SB
#undef PG8_STAGE
#undef PG8_STAGE_A
#undef PG8_ROWOFF
#undef PG8_LDA
#undef PG8_LDB
#undef PG8_MMA
#undef PG8_WAIT_V
#undef PG8_WAIT_L
#undef PG8_BAR
#undef PG8_SCHED
}
}
#include <hip/hip_bf16.h>
#include <cmath>
namespace attn_body {
using bf16=__hip_bfloat16;
using bf16x8=__attribute__((ext_vector_type(8)))short;
using s16x4=__attribute__((ext_vector_type(4)))short;
using f32x16=__attribute__((ext_vector_type(16)))float;
using u32x4=__attribute__((ext_vector_type(4)))unsigned;
constexpr int BATCH=8,NHEAD=16,SEQ=2048,D=64,DM=NHEAD*D,KVP=256;
constexpr int NW=8,QBLK=32,QB=QBLK*NW,KVBLK=64,NQB=SEQ/QB;
constexpr int ATTN_PITCH=DM, ATTN_UNIT_ROWS=QB;
__device__ __forceinline__ int crow(int r,int hi){return (r&3)+8*(r>>2)+4*hi;}
#define SBAR() __builtin_amdgcn_sched_barrier(0)
__device__ __forceinline__ void cmask(f32x16&p0,f32x16&p1,int jb,int qrel,int hi){
  const float NEG=-INFINITY; int kb=64*jb+4*hi;
  #pragma unroll
  for(int r=0;r<16;++r){int kv=kb+(r&3)+8*(r>>2); if(kv>qrel)p0[r]=NEG; if(kv+32>qrel)p1[r]=NEG;}
}

constexpr int NSLOT=3, SLOTB=8192;
constexpr int LDS_K=0, LDS_V=NSLOT*SLOTB, LDS_WS=2*NSLOT*SLOTB, LDS_OST=LDS_WS+NW*64*4, LDS_BYTES=LDS_OST+NW*4096;
constexpr float C2=0.125f*1.4426950408889634f;
__device__ __forceinline__ void glds16(const void*gsrc,unsigned lds_dst){unsigned keep;
  asm volatile("s_mov_b32 %0, m0\n\ts_mov_b32 m0, %2\n\ts_nop 0\n\tglobal_load_lds_dwordx4 %1, off\n\ts_mov_b32 m0, %0":"=&s"(keep):"v"(gsrc),"s"(lds_dst):"memory");}
__device__ __forceinline__ float max3f(float a,float b,float c){float r;asm("v_max3_f32 %0, %1, %2, %3":"=v"(r):"v"(a),"v"(b),"v"(c));return r;}
__device__ __forceinline__ float max2f(float a,float b){float r;asm("v_max_f32_e32 %0, %1, %2":"=v"(r):"v"(a),"v"(b));return r;}
__device__ __forceinline__ float fadd_s(float a,float b){float r;asm("v_add_f32_e32 %0, %1, %2":"=v"(r):"v"(a),"v"(b));return r;}
__device__ __forceinline__ float fsub_s(float a,float b){float r;asm("v_sub_f32_e32 %0, %1, %2":"=v"(r):"v"(a),"v"(b));return r;}
typedef float f32x2_t __attribute__((ext_vector_type(2))); typedef __bf16 bf16x2_t __attribute__((ext_vector_type(2)));
__device__ __forceinline__ unsigned cvtpk_s(float lo,float hi){f32x2_t v={lo,hi};bf16x2_t b=__builtin_convertvector(v,bf16x2_t);return __builtin_bit_cast(unsigned,b);}
#define WAIT_BAR(N) asm volatile("s_waitcnt vmcnt(" #N ") lgkmcnt(0)\n\ts_barrier":::"memory")

__device__ __forceinline__ void qkt(f32x16&p0,f32x16&p1,const char*Kslot,const bf16x8*qr,const f32x16&negm,int r32,int hi){
  const char*kb=Kslot+hi*1024+r32*16;
  #pragma unroll
  for(int d0=0;d0<4;++d0){
    const bf16x8 b0=*reinterpret_cast<const bf16x8*>(kb+d0*2048);
    const bf16x8 b1=*reinterpret_cast<const bf16x8*>(kb+d0*2048+512);
    if(d0==0){p0=__builtin_amdgcn_mfma_f32_32x32x16_bf16(b0,qr[0],negm,0,0,0);p1=__builtin_amdgcn_mfma_f32_32x32x16_bf16(b1,qr[0],negm,0,0,0);}
    else{p0=__builtin_amdgcn_mfma_f32_32x32x16_bf16(b0,qr[d0],p0,0,0,0);p1=__builtin_amdgcn_mfma_f32_32x32x16_bf16(b1,qr[d0],p1,0,0,0);}}
}
typedef __attribute__((address_space(3))) const char* lds_cptr;
typedef short v4i16_t __attribute__((ext_vector_type(4)));
__device__ __forceinline__ void kload8(bf16x8*kf,lds_cptr kp){
  kf[0]=*(const __attribute__((address_space(3))) bf16x8*)(kp);      kf[1]=*(const __attribute__((address_space(3))) bf16x8*)(kp+512);
  kf[2]=*(const __attribute__((address_space(3))) bf16x8*)(kp+2048); kf[3]=*(const __attribute__((address_space(3))) bf16x8*)(kp+2560);
  kf[4]=*(const __attribute__((address_space(3))) bf16x8*)(kp+4096); kf[5]=*(const __attribute__((address_space(3))) bf16x8*)(kp+4608);
  kf[6]=*(const __attribute__((address_space(3))) bf16x8*)(kp+6144); kf[7]=*(const __attribute__((address_space(3))) bf16x8*)(kp+6656);
}
__device__ __forceinline__ void kload2(bf16x8*kf,lds_cptr kp,int j){ kf[2*j]=*(const __attribute__((address_space(3))) bf16x8*)(kp+j*2048); kf[2*j+1]=*(const __attribute__((address_space(3))) bf16x8*)(kp+j*2048+512); }
__device__ __forceinline__ s16x4 vtr(lds_cptr p){ return __builtin_bit_cast(s16x4,__builtin_amdgcn_ds_read_tr16_b64_v4i16((__attribute__((address_space(3))) v4i16_t*)p)); }
__device__ __forceinline__ float rowmax(const f32x16&p0,const f32x16&p1){
  float a=max3f(p0[0],p0[1],p1[0]),b=max3f(p0[2],p0[3],p1[1]);a=max3f(a,p1[2],p1[3]);
  #pragma unroll
  for(int r=4;r<16;r+=4){a=max3f(a,p0[r],p0[r+1]);b=max3f(b,p0[r+2],p0[r+3]);a=max3f(a,p1[r],p1[r+1]);b=max3f(b,p1[r+2],p1[r+3]);}
  const float m=max2f(a,b);
  auto rr=__builtin_amdgcn_permlane32_swap(__float_as_uint(m),__float_as_uint(m),false,false);
  return max2f(__uint_as_float(rr[0]),__uint_as_float(rr[1]));
}
__device__ __forceinline__ void pv(f32x16*o,int vb,bf16x8 pa0,bf16x8 pa1,bf16x8 pa2,bf16x8 pa3){
  #pragma unroll
  for(int d0=0;d0<2;++d0){s16x4 lo[4],hi[4];
    #pragma unroll
    for(int ks=0;ks<4;++ks){
      asm volatile("ds_read_b64_tr_b16 %0,%1 offset:%c2":"=&v"(lo[ks]):"v"(vb),"i"(d0*4096+ks*1024):"memory");
      asm volatile("ds_read_b64_tr_b16 %0,%1 offset:%c2":"=&v"(hi[ks]):"v"(vb),"i"(d0*4096+ks*1024+512):"memory");}
    asm volatile("s_waitcnt lgkmcnt(0)":::"memory");SBAR();
    #define PK(k) (bf16x8){lo[k][0],lo[k][1],lo[k][2],lo[k][3],hi[k][0],hi[k][1],hi[k][2],hi[k][3]}
    o[d0]=__builtin_amdgcn_mfma_f32_32x32x16_bf16(pa0,PK(0),o[d0],0,0,0);
    o[d0]=__builtin_amdgcn_mfma_f32_32x32x16_bf16(pa1,PK(1),o[d0],0,0,0);
    o[d0]=__builtin_amdgcn_mfma_f32_32x32x16_bf16(pa2,PK(2),o[d0],0,0,0);
    o[d0]=__builtin_amdgcn_mfma_f32_32x32x16_bf16(pa3,PK(3),o[d0],0,0,0);
    #undef PK
  }
}

#ifndef ATTN_STORE16
#define ATTN_STORE16(p,v) (*(u32x4*)(p)=(v))
#endif
template<int THRL> __device__ __forceinline__ void attn_unit(int b,int h,int qb,const bf16*Q,const bf16*__restrict__ K,const bf16*__restrict__ V,bf16*O,char*shm){
  int tid_=threadIdx.x; asm volatile("":"+v"(tid_)); const int tid=tid_,lane=tid&63,r32=lane&31,hi=lane>>5; const int wid=__builtin_amdgcn_readfirstlane(tid>>6);
  const long rowbase=(long)b*SEQ; const int q0=qb*QB;
  const bf16*Qw=Q+(rowbase+q0+wid*QBLK)*DM+h*D;
  const bf16*Kh=K+rowbase*KVP+(h>>2)*D,*Vh=V+rowbase*KVP+(h>>2)*D;
  const unsigned lds0=(unsigned)(uintptr_t)shm;
  float*wsf=(float*)(shm+LDS_WS)+wid*64;
  const bf16*ksrc=Kh+(long)lane*KVP+wid*8;
  const bf16*vsrc=Vh+(long)(16*(wid&3)+(lane>>2))*KVP+(wid>>2)*32+(lane&3)*8;
  const unsigned kdst=lds0+LDS_K+wid*1024, vdst=lds0+LDS_V+wid*1024;
  #define DMA_K(t,slot) glds16(ksrc+(long)(t)*KVBLK*KVP,(unsigned)__builtin_amdgcn_readfirstlane(kdst+(slot)))
  #define DMA_V(t,slot) glds16(vsrc+(long)(t)*KVBLK*KVP,(unsigned)__builtin_amdgcn_readfirstlane(vdst+(slot)))
  const int vb0=(int)(lds0+LDS_V)+((lane>>4)&1)*32+(lane&3)*8+(4*hi+((lane&15)>>2))*64;
  const char*Kbase=shm+LDS_K; bf16x8 kf[8];
  const lds_cptr shm3=(lds_cptr)shm; const lds_cptr kp0=shm3+LDS_K+hi*1024+r32*16; const lds_cptr vp0=shm3+LDS_V+((lane>>4)&1)*32+(lane&3)*8+(4*hi+((lane&15)>>2))*64;
  const int NT=SEQ/KVBLK;
  DMA_K(0,0);DMA_V(0,0);DMA_K(1,SLOTB);
  bf16x8 qr[4];
  #pragma unroll
  for(int d0=0;d0<4;++d0)qr[d0]=*reinterpret_cast<const bf16x8*>(&Qw[(long)r32*DM+d0*16+hi*8]);
  float mhat=0.f,l_reg=0.f;f32x16 o[2];o[0]=f32x16{};o[1]=f32x16{};f32x16 negm=f32x16{};asm volatile("":"+v"(negm));
  const int qrel=wid*QBLK+r32;
  #define CMASK(P0,P1,t) do{}while(0)
  bool resc=false;
  #define START(P0,P1) do{ const float rm=rowmax(P0,P1); resc=false; \
    { const float dl=rm; mhat=fadd_s(mhat,dl); \
      _Pragma("unroll") for(int r=0;r<16;++r){P0[r]=fsub_s(P0[r],dl);P1[r]=fsub_s(P1[r],dl);} \
      _Pragma("unroll") for(int r=0;r<16;++r)negm[r]=-mhat; asm volatile("":"+v"(negm)); } \
    _Pragma("unroll") for(int r=0;r<16;++r)P0[r]=__builtin_amdgcn_exp2f(P0[r]); }while(0)
  #define RESC() do{ if(resc){ asm volatile("s_waitcnt lgkmcnt(0)":::"memory"); \
      _Pragma("unroll") for(int d_=0;d_<2;++d_) _Pragma("unroll") for(int r=0;r<16;++r)o[d_][r]*=wsf[crow(r,hi)]; } }while(0)
  f32x16 pA0,pA1,pB0,pB1;
  int sl_prev=0,sl_cur=0,sl_next=SLOTB;
  #define ROT() do{sl_prev=sl_cur;sl_cur=sl_next;sl_next=(sl_next==(NSLOT-1)*SLOTB)?0:sl_next+SLOTB;}while(0)
  DMA_K(2,2*SLOTB);
  WAIT_BAR(3);
  qkt(pA0,pA1,Kbase,qr,negm,r32,hi);asm volatile("s_nop 15\n\ts_nop 7":"+v"(pA0),"+v"(pA1));CMASK(pA0,pA1,0);
  START(pA0,pA1);
  _Pragma("unroll") for(int r=0;r<16;++r)pA1[r]=__builtin_amdgcn_exp2f(pA1[r]);
  WAIT_BAR(0);
  DMA_K(3,0);DMA_V(1,SLOTB);
  ROT();
  kload8(kf,kp0+sl_cur);
  WAIT_BAR(2);
  s16x4 vlo[8],vhi[8]; u32x4 pw0,pw1,pw2,pw3;
  #define PKW(P,B) cvtpk_s(P[B],P[B+1])
  #define PAF(k) __builtin_bit_cast(bf16x8,pw##k)
  #define VFR(i) (bf16x8){vlo[i][0],vlo[i][1],vlo[i][2],vlo[i][3],vhi[i][0],vhi[i][1],vhi[i][2],vhi[i][3]}
  #define PIN(x) asm volatile("":"+v"(x))
  #define MX3(a,b,c) __builtin_fmaxf(__builtin_fmaxf((a),(b)),(c))
  #define GAPA(MF,A0,A1,A2,A3,W0,W1,PW) do{ MF; sacc+=A0; sacc+=A1; sacc+=A2; sacc+=A3; PIN(sacc); W0; W1; PIN(PW); SBAR(); }while(0)
  #define EX(v) __builtin_amdgcn_exp2f(v)
  #define GAPB(MF,X,B) do{ MF; X[B]=EX(X[B]); X[B+1]=EX(X[B+1]); X[B+2]=EX(X[B+2]); X[B+3]=EX(X[B+3]); PIN(X); SBAR(); }while(0)
  #define VRD(i) do{ vlo[i]=vtr(vp_+(((i)>>2)*4096+((i)&3)*1024)); vhi[i]=vtr(vp_+(((i)>>2)*4096+((i)&3)*1024+512)); }while(0)
  #define KRD(G,j) do{ if(G){ kload2(kf,kp0+sl_next,j); SBAR(); } }while(0)
  #define STEP(C0,C1,P0,P1,t,GK,GV,GL) do{ SBAR(); \
    const lds_cptr vp_=vp0+sl_prev; \
    VRD(0); SBAR(); float sacc=(P0[0]+P0[1]); \
    GAPA(C0=__builtin_amdgcn_mfma_f32_32x32x16_bf16(kf[0],qr[0],negm,0,0,0), P0[2],P0[3],P0[4],P0[5],     pw0[0]=PKW(P0,0), pw0[1]=PKW(P0,2), pw0); \
    VRD(4); SBAR(); GAPA(C1=__builtin_amdgcn_mfma_f32_32x32x16_bf16(kf[1],qr[0],negm,0,0,0), P0[6],P0[7],P0[8],P0[9],     pw0[2]=PKW(P0,4), pw0[3]=PKW(P0,6), pw0); \
    VRD(1); SBAR(); GAPA(C0=__builtin_amdgcn_mfma_f32_32x32x16_bf16(kf[2],qr[1],C0,0,0,0),   P0[10],P0[11],P0[12],P0[13], pw1[0]=PKW(P0,8), pw1[1]=PKW(P0,10), pw1); \
    VRD(5); SBAR(); GAPA(C1=__builtin_amdgcn_mfma_f32_32x32x16_bf16(kf[3],qr[1],C1,0,0,0),   P0[14],P0[15],P1[0],P1[1],   pw1[2]=PKW(P0,12),pw1[3]=PKW(P0,14), pw1); \
    VRD(2); SBAR(); GAPA(C0=__builtin_amdgcn_mfma_f32_32x32x16_bf16(kf[4],qr[2],C0,0,0,0),   P1[2],P1[3],P1[4],P1[5],     pw2[0]=PKW(P1,0), pw2[1]=PKW(P1,2), pw2); \
    VRD(6); SBAR(); GAPA(C1=__builtin_amdgcn_mfma_f32_32x32x16_bf16(kf[5],qr[2],C1,0,0,0),   P1[6],P1[7],P1[8],P1[9],     pw2[2]=PKW(P1,4), pw2[3]=PKW(P1,6), pw2); \
    VRD(3); SBAR(); GAPA(C0=__builtin_amdgcn_mfma_f32_32x32x16_bf16(kf[6],qr[3],C0,0,0,0),   P1[10],P1[11],P1[12],P1[13], pw3[0]=PKW(P1,8), pw3[1]=PKW(P1,10), pw3); \
    VRD(7); SBAR(); GAPA(C1=__builtin_amdgcn_mfma_f32_32x32x16_bf16(kf[7],qr[3],C1,0,0,0),   P1[14],P1[15],0.f,0.f,       pw3[2]=PKW(P1,12),pw3[3]=PKW(P1,14), pw3); \
    l_reg+=sacc; \
    if(GK){DMA_K((t)+3,sl_cur);} if(GV){DMA_V((t)+1,sl_next);} \
    CMASK(C0,C1,t); \
    { float a=MX3(C0[0],C0[1],C1[0]),b=MX3(C0[2],C0[3],C1[1]); a=MX3(a,C1[2],C1[3]); \
      _Pragma("unroll") for(int r=4;r<16;r+=4){a=MX3(a,C0[r],C0[r+1]);b=MX3(b,C0[r+2],C0[r+3]);a=MX3(a,C1[r],C1[r+1]);b=MX3(b,C1[r+2],C1[r+3]);} \
      float rm=__builtin_fmaxf(a,b); { auto rr=__builtin_amdgcn_permlane32_swap(__float_as_uint(rm),__float_as_uint(rm),false,false); rm=__builtin_fmaxf(__uint_as_float(rr[0]),__uint_as_float(rr[1])); } \
      resc=false; \
      if(__builtin_expect(__any(rm>(float)THRL),0)){ const float dl=__builtin_fmaxf(rm,0.f); mhat+=dl; \
        _Pragma("unroll") for(int r=0;r<16;++r){C0[r]-=dl;C1[r]-=dl;} \
        _Pragma("unroll") for(int r=0;r<16;++r)negm[r]=-mhat; asm volatile("":"+v"(negm)); \
        const float f=__builtin_amdgcn_exp2f(-dl); l_reg*=f; if(hi==0)wsf[r32]=f; resc=true; } } \
    SBAR(); \
    GAPB(o[0]=__builtin_amdgcn_mfma_f32_32x32x16_bf16(PAF(0),VFR(0),o[0],0,0,0), C0,0); \
    GAPB(o[1]=__builtin_amdgcn_mfma_f32_32x32x16_bf16(PAF(0),VFR(4),o[1],0,0,0), C0,4); \
    KRD(GL,0); GAPB(o[0]=__builtin_amdgcn_mfma_f32_32x32x16_bf16(PAF(1),VFR(1),o[0],0,0,0), C0,8); \
    KRD(GL,1); GAPB(o[1]=__builtin_amdgcn_mfma_f32_32x32x16_bf16(PAF(1),VFR(5),o[1],0,0,0), C0,12); \
    KRD(GL,2); GAPB(o[0]=__builtin_amdgcn_mfma_f32_32x32x16_bf16(PAF(2),VFR(2),o[0],0,0,0), C1,0); \
    KRD(GL,3); GAPB(o[1]=__builtin_amdgcn_mfma_f32_32x32x16_bf16(PAF(2),VFR(6),o[1],0,0,0), C1,4); \
    GAPB(o[0]=__builtin_amdgcn_mfma_f32_32x32x16_bf16(PAF(3),VFR(3),o[0],0,0,0), C1,8); \
    GAPB(o[1]=__builtin_amdgcn_mfma_f32_32x32x16_bf16(PAF(3),VFR(7),o[1],0,0,0), C1,12); \
    }while(0)
  int t=1;
  #undef CMASK
  #define CMASK(P0,P1,t) do{}while(0)
  for(;t+5<NT;t+=2){
    STEP(pB0,pB1,pA0,pA1,t,true,true,true);     WAIT_BAR(2); RESC(); ROT();
    STEP(pA0,pA1,pB0,pB1,t+1,true,true,true);   WAIT_BAR(2); RESC(); ROT();
  }
  #undef CMASK
  #define CMASK(P0,P1,t) do{}while(0)
  #define ENDW(tt) do{ if((tt)+3<NT){WAIT_BAR(2);} else if((tt)+2<NT){WAIT_BAR(1);} else {WAIT_BAR(0);} }while(0)
  for(;t+1<NT;t+=2){
    STEP(pB0,pB1,pA0,pA1,t,(t+3<NT),(t+1<NT),(t+1<NT));       ENDW(t);   RESC(); ROT();
    STEP(pA0,pA1,pB0,pB1,t+1,(t+4<NT),(t+2<NT),(t+2<NT));     ENDW(t+1); RESC(); ROT();
  }
  STEP(pB0,pB1,pA0,pA1,NT-1,false,false,false); RESC();
  { float sacc=pB0[0]+pB0[1]; _Pragma("unroll") for(int r=2;r<16;++r)sacc+=pB0[r]; _Pragma("unroll") for(int r=0;r<16;++r)sacc+=pB1[r]; l_reg+=sacc;
    pw0=(u32x4){PKW(pB0,0),PKW(pB0,2),PKW(pB0,4),PKW(pB0,6)};pw1=(u32x4){PKW(pB0,8),PKW(pB0,10),PKW(pB0,12),PKW(pB0,14)};pw2=(u32x4){PKW(pB1,0),PKW(pB1,2),PKW(pB1,4),PKW(pB1,6)};pw3=(u32x4){PKW(pB1,8),PKW(pB1,10),PKW(pB1,12),PKW(pB1,14)};
    SBAR(); pv(o,vb0+sl_cur,PAF(0),PAF(1),PAF(2),PAF(3)); }
  #undef PKW
  #undef PAF
  #undef VFR
  #undef PIN
  #undef MX3
  #undef GAPA
  #undef GAPB
  #undef EX
  #undef VRD
  #undef KRD
  #undef STEP
  #undef ENDW
  {auto rr=__builtin_amdgcn_permlane32_swap(__float_as_uint(l_reg),__float_as_uint(l_reg),false,false);l_reg=__uint_as_float(rr[0])+__uint_as_float(rr[1]);}
  if(hi==0)wsf[32+r32]=l_reg;asm volatile("s_waitcnt lgkmcnt(0)":::"memory");
  float rli[16];
  #pragma unroll
  for(int r=0;r<16;++r)rli[r]=__builtin_amdgcn_rcpf(wsf[32+crow(r,hi)]);
  bf16*Ow=O+(rowbase+q0+wid*QBLK)*DM+h*D;
  { bf16*stg=(bf16*)(shm+LDS_OST)+wid*2048;
    #pragma unroll
    for(int r=0;r<16;++r){const int orow=crow(r,hi);
      #pragma unroll
      for(int d0=0;d0<2;++d0)stg[orow*64+d0*32+r32]=__float2bfloat16(o[d0][r]*rli[r]);}
    asm volatile("s_waitcnt lgkmcnt(0)":::"memory");
    #pragma unroll
    for(int i=0;i<4;++i){const int row=i*8+(lane>>3),ch=lane&7; const u32x4 v=*(const u32x4*)(stg+row*64+ch*8); ATTN_STORE16(Ow+(long)row*DM+ch*8,v);} }
  asm volatile("s_waitcnt lgkmcnt(0)\n\ts_barrier":::"memory");
  #undef DMA_K
  #undef DMA_V
  #undef CMASK
  #undef START
  #undef RESC
  #undef ROT
}
constexpr int ATTN_LDS_BYTES=LDS_BYTES;
struct AttnTensors { const bf16* Q; const bf16* K; const bf16* V; bf16* O; };
struct AttnUnit { int bh; int qb; };
struct StaticOrder {
  int vcu,G;
  __device__ __forceinline__ explicit StaticOrder(int grid,int block):vcu((grid%8==0)?(block%8)*(grid/8)+block/8:block),G(grid){}
  __device__ __forceinline__ bool next(int i,AttnUnit&u)const{ const int L=i*G+vcu; if(L>=1024)return false; const int xg=L>>5,w=L&31; const int grp=(xg&7)*4+(xg>>3); u.bh=(grp>>2)*NHEAD+(grp&3)*4+(w>>3); u.qb=w&7; return true; }
  __device__ __forceinline__ void a_ready(const AttnUnit&)const{}
  __device__ __forceinline__ void done(const AttnUnit&)const{}
};
template<class Sched,int THRL=8> __device__ __forceinline__ void attn_phase(char*lds,const AttnTensors&T,const Sched&S){
  AttnUnit u;
  for(int i=0;S.next(i,u);++i){ S.a_ready(u); attn_unit<THRL>(u.bh/NHEAD,u.bh%NHEAD,u.qb,T.Q,T.K,T.V,T.O,lds); S.done(u); }
}
#undef SBAR
#undef WAIT_BAR
}
namespace na_body {
typedef short bf16x8 __attribute__((ext_vector_type(8)));
typedef short s16x4 __attribute__((ext_vector_type(4)));
typedef float f32x4 __attribute__((ext_vector_type(4)));
typedef unsigned u32x4 __attribute__((ext_vector_type(4)));
typedef unsigned u32x2 __attribute__((ext_vector_type(2)));
#define NA_LAS __attribute__((address_space(3)))
constexpr int VROW = 160, KROW = 144, LDS_V = 0, LDS_BIAS = 9 * 64 * VROW, LDS_K = LDS_BIAS + 15 * 64 * 4, NA_LDS_BYTES = LDS_K + 5 * 64 * KROW;
__device__ __forceinline__ unsigned cvtpk(float lo, float hi) { typedef float f2 __attribute__((ext_vector_type(2))); typedef __bf16 b2 __attribute__((ext_vector_type(2))); f2 v = {lo, hi}; b2 b = __builtin_convertvector(v, b2); return __builtin_bit_cast(unsigned, b); }
__device__ __forceinline__ s16x4 vtr(const NA_LAS char* p) { typedef short v4i16_t __attribute__((ext_vector_type(4))); return __builtin_bit_cast(s16x4, __builtin_amdgcn_ds_read_tr16_b64_v4i16((NA_LAS v4i16_t*)p)); }

__device__ __forceinline__ void na_phase(NA_LAS char* lds, const unsigned short* Qg, const unsigned short* Kg, const unsigned short* Vg, unsigned short* Og, const float* __restrict__ rpb, int G, int bid, unsigned* tsw) {
    int tid_ = threadIdx.x; asm volatile("" : "+v"(tid_));
    const int tid = tid_, lane = tid & 63, wave = __builtin_amdgcn_readfirstlane(tid >> 6), fr = lane & 15, fq = lane >> 4;
    const int vcu = (G % 8 == 0) ? (bid % 8) * (G / 8) + bid / 8 : bid;
    constexpr int NUNITS = 8 * 16 * 16;
    const int per = (NUNITS + G - 1) / G, u_lo = vcu * per, u_hi = (u_lo + per < NUNITS) ? u_lo + per : NUNITS;
    if (u_lo >= u_hi) return;
    (void)tsw;
    u32x4 vr[9], ka[5], kb[5];
    const unsigned loff = (unsigned)((tid >> 3) * 1024 + (tid & 7) * 8);
#define NA_PREF_VA(U) do { const int b_ = (U) >> 8, h_ = ((U) >> 4) & 15, r0_ = 2 * ((U) & 15); const int R0_ = min(max(r0_ - 4, 0), 24); const int nrow_ = 32 - R0_; \
        const unsigned short* vb_ = Vg + ((size_t)(b_ * 2048 + R0_ * 64)) * 1024 + h_ * 64; const unsigned short* kb_ = Kg + ((size_t)(b_ * 2048 + R0_ * 64)) * 1024 + h_ * 64; \
        _Pragma("unroll") for (int i_ = 0; i_ < 9; ++i_) { if (i_ < nrow_) vr[i_] = *(const u32x4*)(vb_ + (size_t)i_ * 65536 + loff); } \
        _Pragma("unroll") for (int i_ = 0; i_ < 5; ++i_) { ka[i_] = *(const u32x4*)(kb_ + (size_t)i_ * 65536 + loff); } } while (0)
#define NA_PREF_B(U) do { const int b_ = (U) >> 8, h_ = ((U) >> 4) & 15, r0_ = 2 * ((U) & 15); const int R0_ = min(max(r0_ - 4, 0), 24); const int nrow_ = 32 - R0_; \
        const unsigned short* kb_ = Kg + ((size_t)(b_ * 2048 + R0_ * 64)) * 1024 + h_ * 64; \
        _Pragma("unroll") for (int i_ = 0; i_ < 5; ++i_) { if (i_ + 4 < nrow_) kb[i_] = *(const u32x4*)(kb_ + (size_t)(i_ + 4) * 65536 + loff); } } while (0)
    NA_PREF_VA(u_lo); NA_PREF_B(u_lo);
    int cur_h = -1;
    for (int U = u_lo; U < u_hi; ++U) {
        const int b = U >> 8, h = (U >> 4) & 15, r0 = 2 * (U & 15); const int R0 = min(max(r0 - 4, 0), 24);
        if (U != u_lo) __syncthreads();
#pragma unroll
        for (int i = 0; i < 9; ++i) { const int idx = tid + 512 * i; *(NA_LAS u32x4*)(lds + LDS_V + (idx >> 3) * VROW + (idx & 7) * 16) = vr[i]; }
#pragma unroll
        for (int i = 0; i < 5; ++i) { const int idx = tid + 512 * i; *(NA_LAS u32x4*)(lds + LDS_K + (idx >> 3) * KROW + (idx & 7) * 16) = ka[i]; }
        if (h != cur_h) { cur_h = h;
            for (int i = tid; i < 15 * 64; i += 512) { const int dr = i >> 6, dc = (i & 63) - 16; ((NA_LAS float*)(lds + LDS_BIAS))[i] = (dc >= 0 && dc < 31) ? rpb[(h * 15 + dr) * 31 + dc] * 1.4426950408889634f : 0.f; } }
        __syncthreads();
        if (U + 1 < u_hi) NA_PREF_VA(U + 1);
        const int r = r0 + (wave >> 2), q0 = 16 * (wave & 3), qcol = q0 + fr;
        const int rs = min(max(r - 4, 0), 24), b0 = min(max(q0 - 8, 0), 32), winlo = min(max(qcol - 8, 0), 48);
        const size_t tokq = (size_t)b * 2048 + r * 64 + qcol;
        bf16x8 qf[2];
#pragma unroll
        for (int ks = 0; ks < 2; ++ks) qf[ks] = *(const bf16x8*)(Qg + tokq * 1024 + h * 64 + 32 * ks + 8 * fq);
        f32x4 am[2];
#pragma unroll
        for (int t = 0; t < 2; ++t)
#pragma unroll
            for (int i = 0; i < 4; ++i) am[t][i] = ((unsigned)(b0 + 16 * t + 4 * fq + i - winlo) < 16u) ? 0.f : -INFINITY;
        const NA_LAS char* bias_l = lds + LDS_BIAS + (b0 - qcol + 15 + 16 + 4 * fq) * 4;
        const NA_LAS char* v_l = lds + LDS_V + (b0 + 4 * fq + (fr >> 2)) * VROW + (fr & 3) * 8;
        const NA_LAS char* k_l = lds + LDS_K + ((rs - R0) * 64 + b0 + fr) * KROW + fq * 16;
        f32x4 sc[8][2];
#pragma unroll
        for (int kr = 0; kr < 4; ++kr)
#pragma unroll
            for (int t = 0; t < 2; ++t) { const bf16x8 k0 = *(const NA_LAS bf16x8*)(k_l + kr * 64 * KROW + t * 16 * KROW), k1 = *(const NA_LAS bf16x8*)(k_l + kr * 64 * KROW + t * 16 * KROW + 64);
                sc[kr][t] = __builtin_amdgcn_mfma_f32_16x16x32_bf16(k0, qf[0], am[t], 0, 0, 0); sc[kr][t] = __builtin_amdgcn_mfma_f32_16x16x32_bf16(k1, qf[1], sc[kr][t], 0, 0, 0); }
        __syncthreads();
#pragma unroll
        for (int i = 0; i < 5; ++i) { const int idx = tid + 512 * i; *(NA_LAS u32x4*)(lds + LDS_K + (idx >> 3) * KROW + (idx & 7) * 16) = kb[i]; }
        if (U + 1 < u_hi) NA_PREF_B(U + 1);
        __syncthreads();
#pragma unroll
        for (int kr = 0; kr < 4; ++kr)
#pragma unroll
            for (int t = 0; t < 2; ++t) { const bf16x8 k0 = *(const NA_LAS bf16x8*)(k_l + kr * 64 * KROW + t * 16 * KROW), k1 = *(const NA_LAS bf16x8*)(k_l + kr * 64 * KROW + t * 16 * KROW + 64);
                sc[4 + kr][t] = __builtin_amdgcn_mfma_f32_16x16x32_bf16(k0, qf[0], am[t], 0, 0, 0); sc[4 + kr][t] = __builtin_amdgcn_mfma_f32_16x16x32_bf16(k1, qf[1], sc[4 + kr][t], 0, 0, 0); }
        float mx = -INFINITY;
#pragma unroll
        for (int kr = 0; kr < 8; ++kr) { const NA_LAS float* bl = (const NA_LAS float*)(bias_l + (rs + kr - r + 7) * 256);
#pragma unroll
            for (int t = 0; t < 2; ++t)
#pragma unroll
                for (int i = 0; i < 4; ++i) { sc[kr][t][i] += bl[16 * t + i]; mx = fmaxf(mx, sc[kr][t][i]); } }
        { auto r16 = __builtin_amdgcn_permlane16_swap(__float_as_uint(mx), __float_as_uint(mx), false, false); mx = fmaxf(__uint_as_float(r16[0]), __uint_as_float(r16[1]));
          auto r32 = __builtin_amdgcn_permlane32_swap(__float_as_uint(mx), __float_as_uint(mx), false, false); mx = fmaxf(__uint_as_float(r32[0]), __uint_as_float(r32[1])); }
        float lsum = 0.f; bf16x8 pb[8];
#pragma unroll
        for (int kr = 0; kr < 8; ++kr) {
#pragma unroll
            for (int t = 0; t < 2; ++t)
#pragma unroll
                for (int i = 0; i < 4; ++i) { sc[kr][t][i] = __builtin_amdgcn_exp2f(sc[kr][t][i] - mx); lsum += sc[kr][t][i]; }
            u32x4 pw; pw.x = cvtpk(sc[kr][0][0], sc[kr][0][1]); pw.y = cvtpk(sc[kr][0][2], sc[kr][0][3]); pw.z = cvtpk(sc[kr][1][0], sc[kr][1][1]); pw.w = cvtpk(sc[kr][1][2], sc[kr][1][3]);
            pb[kr] = __builtin_bit_cast(bf16x8, pw); }
        f32x4 oacc[4];
#pragma unroll
        for (int dt = 0; dt < 4; ++dt) oacc[dt] = (f32x4){0.f, 0.f, 0.f, 0.f};
#pragma unroll
        for (int kr = 0; kr < 8; ++kr) { const NA_LAS char* vp = v_l + (rs + kr - R0) * 64 * VROW;
#pragma unroll
            for (int dt = 0; dt < 4; ++dt) {
                const s16x4 lo = vtr(vp + dt * 32), hi = vtr(vp + 16 * VROW + dt * 32);
                const bf16x8 vf = {lo[0], lo[1], lo[2], lo[3], hi[0], hi[1], hi[2], hi[3]};
                oacc[dt] = __builtin_amdgcn_mfma_f32_16x16x32_bf16(vf, pb[kr], oacc[dt], 0, 0, 0); } }
        { auto r16 = __builtin_amdgcn_permlane16_swap(__float_as_uint(lsum), __float_as_uint(lsum), false, false); lsum = __uint_as_float(r16[0]) + __uint_as_float(r16[1]);
          auto r32 = __builtin_amdgcn_permlane32_swap(__float_as_uint(lsum), __float_as_uint(lsum), false, false); lsum = __uint_as_float(r32[0]) + __uint_as_float(r32[1]); }
        const float rl = 1.f / lsum;
        unsigned short* op = Og + tokq * 1024 + h * 64 + 4 * fq;
#pragma unroll
        for (int dt = 0; dt < 4; ++dt) { u32x2 w; w.x = cvtpk(oacc[dt][0] * rl, oacc[dt][1] * rl); w.y = cvtpk(oacc[dt][2] * rl, oacc[dt][3] * rl); *(u32x2*)(op + 16 * dt) = w; }
    }
#undef NA_PREF_VA
#undef NA_PREF_B
}
}
constexpr int NWAVES = 8, NTHREADS = 512;
constexpr int D = 1024, NB = 8, S = 2048, M = NB * S, DEPTH = 4, NH = 16, HD = 64, GW = 64, ROWS = 32;
constexpr int KVD = 256, NE = 32, NG = 4, EPG = 8, DE = 512, NQKV_NA = 3072, NQKV_GQ = 1536, NRT = 36;
constexpr float ALPHA = 1.6817928305074290f, LN_EPS = 1e-5f;
constexpr float LOG2E = 1.4426950408889634f, C2 = 0.125f * 1.4426950408889634f;
constexpr int MAXTILES = 160;

constexpr size_t MiB = 1u << 20;
constexpr size_t WS_CTL = 0, CTL_ZERO_BYTES = 1 * MiB;
constexpr size_t WS_MOD = 1 * MiB, WS_ROPE = 2 * MiB, WS_WRT = 3 * MiB;
constexpr size_t WS_WQKV_NA = 4 * MiB, WS_WO_NA = 16 * MiB, WS_WQKV_GQ = 20 * MiB, WS_WO_GQ = 26 * MiB;
constexpr size_t WS_WGU = 32 * MiB, WS_WDN = 96 * MiB;
constexpr size_t WS_X1 = 128 * MiB, WS_X2 = 192 * MiB, WS_H = 256 * MiB, WS_Q = 288 * MiB, WS_K = 320 * MiB, WS_V = 352 * MiB, WS_Y = 384 * MiB;
constexpr size_t WS_HMID = 416 * MiB, WS_YS = 464 * MiB, WS_ROUTE = 552 * MiB, WS_TOKMAP = 554 * MiB, WS_WGU2 = 556 * MiB, WS_WDN2 = 620 * MiB, WS_XS = 656 * MiB, WS_END = 736 * MiB;
#define WGU_SET(l) (((l) & 1) ? WS_WGU2 : WS_WGU)
#define WDN_SET(l) (((l) & 1) ? WS_WDN2 : WS_WDN)
constexpr int CW_TS = 60000;
constexpr int CW_BAR = 16384;
constexpr int CW_CNT = 32768, CNT_LAYER_STRIDE = 2048;

constexpr int RING_BYTES = 147456, MISC_OFF = RING_BYTES, LDS_BYTES = 163840;

#define LAS __attribute__((address_space(3)))
typedef unsigned short bf16;
typedef unsigned v4u __attribute__((ext_vector_type(4)));
typedef unsigned v2u __attribute__((ext_vector_type(2)));
typedef float f32x4 __attribute__((ext_vector_type(4)));
#define RLX_AGENT __ATOMIC_RELAXED, __HIP_MEMORY_SCOPE_AGENT
__device__ __forceinline__ unsigned f2bf(float f) { unsigned u = __builtin_bit_cast(unsigned, f); return (u + 0x7fffu + ((u >> 16) & 1u)) >> 16; }
__device__ __forceinline__ unsigned pk2(float lo, float hi) { return f2bf(lo) | (f2bf(hi) << 16); }
__device__ __forceinline__ float bflo(unsigned w) { return __uint_as_float(w << 16); }
__device__ __forceinline__ float bfhi(unsigned w) { return __uint_as_float(w & 0xffff0000u); }
__device__ __forceinline__ float bf2f(bf16 v) { return __uint_as_float((unsigned)v << 16); }
__device__ __forceinline__ float wave_sum(float v) {
    int x = __builtin_bit_cast(int, v);
    v += __builtin_bit_cast(float, __builtin_amdgcn_update_dpp(0, x, 0xB1, 0xF, 0xF, false)); x = __builtin_bit_cast(int, v);
    v += __builtin_bit_cast(float, __builtin_amdgcn_update_dpp(0, x, 0x4E, 0xF, 0xF, false)); x = __builtin_bit_cast(int, v);
    v += __builtin_bit_cast(float, __builtin_amdgcn_update_dpp(0, x, 0x141, 0xF, 0xF, false)); x = __builtin_bit_cast(int, v);
    v += __builtin_bit_cast(float, __builtin_amdgcn_update_dpp(0, x, 0x140, 0xF, 0xF, false)); x = __builtin_bit_cast(int, v);
    const float r0 = __builtin_bit_cast(float, __builtin_amdgcn_readlane(x, 0)), r1 = __builtin_bit_cast(float, __builtin_amdgcn_readlane(x, 16));
    const float r2 = __builtin_bit_cast(float, __builtin_amdgcn_readlane(x, 32)), r3 = __builtin_bit_cast(float, __builtin_amdgcn_readlane(x, 48));
    return (r0 + r1) + (r2 + r3);
}

struct Args { const float* in[20]; float* out; unsigned char* ws; };

__device__ __forceinline__ int rho_p8(int cc) { return (cc & 128) + (cc & 96) + 16 * ((cc >> 2) & 1) + 4 * ((cc >> 3) & 3) + (cc & 3); }
__device__ __forceinline__ int rho_head(int cc) { const int wc = cc >> 6, fq = 2 * ((cc >> 5) & 1) + ((cc >> 3) & 1), bj = (cc >> 4) & 1; return 128 * bj + 32 * wc + 16 * ((cc >> 2) & 1) + 4 * fq + (cc & 3); }
__device__ __forceinline__ int dest_row(int mode, int c) {
    if (mode == 0) return (c & ~255) + rho_p8(c & 255);
    if (mode == 1) return (c & ~255) + rho_head(c & 255);
    const int jj = c & 127; return (c >> 7) * 256 + (mode == 3 ? 128 : 0) + (jj & 96) + 16 * ((jj >> 2) & 1) + 4 * ((jj >> 3) & 3) + (jj & 3);
}
struct TrItem { const float* W; bf16* WT; int K, N, mode, item; };
__device__ __forceinline__ void tr_load(const TrItem& t, f32x4 (&r)[8], int lane) {
    const int nblk = t.N / 32, kb = t.item / nblk, nb = t.item % nblk;
    const float* src = t.W + (size_t)(64 * kb + (lane >> 3)) * t.N + 32 * nb + 4 * (lane & 7);
#pragma unroll
    for (int i = 0; i < 8; ++i) r[i] = __builtin_nontemporal_load((const f32x4*)(src + (size_t)(8 * i) * t.N));
}
__device__ __forceinline__ void tr_store(const TrItem& t, const f32x4 (&r)[8], LAS float* scr, int lane) {
    const int nblk = t.N / 32, kb = t.item / nblk, nb = t.item % nblk, k0 = 64 * kb, n0 = 32 * nb;
#pragma unroll
    for (int i = 0; i < 8; ++i) { LAS float* d = scr + ((lane >> 3) + 8 * i) * 33 + 4 * (lane & 7); d[0] = r[i][0]; d[1] = r[i][1]; d[2] = r[i][2]; d[3] = r[i][3]; }
    asm volatile("s_waitcnt lgkmcnt(0)" ::: "memory");
    const int c = lane & 7;
#pragma unroll
    for (int j = 0; j < 4; ++j) { const int n = (lane >> 3) + 8 * j; const LAS float* sp = scr + (8 * c) * 33 + n;
        v4u o; o.x = pk2(sp[0 * 33], sp[1 * 33]); o.y = pk2(sp[2 * 33], sp[3 * 33]); o.z = pk2(sp[4 * 33], sp[5 * 33]); o.w = pk2(sp[6 * 33], sp[7 * 33]);
        __builtin_nontemporal_store(o, (v4u*)(t.WT + (size_t)dest_row(t.mode, n0 + n) * t.K + k0 + 8 * c)); }
    asm volatile("s_waitcnt lgkmcnt(0)" ::: "memory");
}
__device__ __forceinline__ TrItem moe_item(const float* wgate, const float* wup, const float* wdown, int layer, bf16* Wgu, bf16* Wdn, int it) {
    const int e = it / 768, r = it % 768, which = r >> 8, sub = r & 255; const size_t le = (size_t)layer * NE + e; TrItem t;
    if (which == 0) t = TrItem{wgate + le * D * DE, Wgu + (size_t)e * D * D, D, DE, 2, sub};
    else if (which == 1) t = TrItem{wup + le * D * DE, Wgu + (size_t)e * D * D, D, DE, 3, sub};
    else t = TrItem{wdown + le * DE * D, Wdn + (size_t)e * D * DE, DE, D, 0, sub};
    return t;
}
__device__ __forceinline__ void moe_weight_items(const float* __restrict__ wgate, const float* __restrict__ wup, const float* __restrict__ wdown, int layer,
                                                 bf16* __restrict__ Wgu, bf16* __restrict__ Wdn, LAS float* scr, int first, int stride, int end, int lane) {
    if (first >= end) return;
    f32x4 rn[8]; TrItem tn = moe_item(wgate, wup, wdown, layer, Wgu, Wdn, first); tr_load(tn, rn, lane);
    for (int it = first; it < end; it += stride) {
        f32x4 rc[8]; const TrItem tc = tn;
#pragma unroll
        for (int i = 0; i < 8; ++i) rc[i] = rn[i];
        if (it + stride < end) { tn = moe_item(wgate, wup, wdown, layer, Wgu, Wdn, it + stride); tr_load(tn, rn, lane); }
        tr_store(tc, rc, scr, lane);
    }
}
constexpr int CONV_ITEMS = NE * 768;
constexpr int CQ_A = 10, CQ_B = 7, CQ_C = 4;
__device__ __forceinline__ int conv_total_a(int layer, int G) { return ((layer & 1) && G == 256) ? 128 * NWAVES * CQ_A : 0; }
__device__ __forceinline__ int idle_cus(int nunits, int G) { const int rounds = (nunits + G - 1) / G; return rounds * G - nunits; }
__device__ __forceinline__ void transpose_item(const float* __restrict__ W, int K, int N, bf16* __restrict__ WT, int mode, LAS float* scr, int item, int lane) {
    const TrItem t{W, WT, K, N, mode, item}; f32x4 r[8]; tr_load(t, r, lane); tr_store(t, r, scr, lane);
}

struct MoeOrder {
    int nunits, G, c; const LAS int* tile_e; const LAS int* tbase; const LAS int* trows; const int* tokmap;
    __device__ __forceinline__ bool next(int i, pg8::Unit& u) const {
        const long L = (long)i * G + c; if (L >= nunits) return false;
        const int pm = (int)(L >> 2); u.pm = pm; u.pn = __builtin_amdgcn_readfirstlane(tile_e[pm]) * 4 + (int)(L & 3); return true;
    }
    __device__ __forceinline__ int arow(const pg8::Unit& u, int rr) const {
        const int base = __builtin_amdgcn_readfirstlane(tbase[u.pm]), rows = __builtin_amdgcn_readfirstlane(trows[u.pm]);
        return rr < rows ? tokmap[base + rr] : 0;
    }
    __device__ __forceinline__ void a_ready(const pg8::Unit&) const {}
    __device__ __forceinline__ void done(const pg8::Unit&) const {}
};
constexpr int TOKCAP = 16384;
constexpr int SK_MAX = 0, SK_BASE = MAXTILES * 256;
__device__ __forceinline__ void build_tiles(const unsigned* cnt, LAS int* misc, int tid) {
    if (tid == 0) { int s = 0, so = 0, nsk = 0, nit = 0;
        for (int e = 0; e < NE; ++e) { misc[e] = s; const int c = (int)__hip_atomic_load(cnt + 64 * e, RLX_AGENT); const int full = c >> 8, rem = c & 255; const bool skn = rem <= SK_MAX;
            const int nt = skn ? full : full + 1, nrm = skn ? full * 256 : c, skr = skn ? rem : 0;
            for (int t = 0; t < nt; ++t) if (s + t < MAXTILES) { misc[64 + s + t] = e; misc[256 + s + t] = e * TOKCAP + t * 256; misc[448 + s + t] = (nrm - t * 256) < 256 ? (nrm - t * 256) : 256; }
            misc[640 + e] = nrm; misc[672 + e] = so; misc[704 + e] = skr; if (skr) { misc[736 + nsk] = e; misc[768 + nsk] = nit; nit += 16 * ((skr + 31) >> 5); ++nsk; } so += skr; s += nt; }
        misc[32] = s; misc[33] = s < MAXTILES ? s : MAXTILES; misc[34] = nsk; misc[768 + nsk] = nit; misc[35] = nit; }
    __syncthreads();
}
__device__ __forceinline__ int slot_of(const LAS int* misc, int e, int pos) { const int nrm = misc[640 + e]; return pos < nrm ? misc[e] * 256 + pos : SK_BASE + misc[672 + e] + (pos - nrm); }

__device__ __forceinline__ bool skinny_item(const LAS int* misc, int it, int& e, int& sb, int& c) {
    const int nsk = __builtin_amdgcn_readfirstlane(misc[34]); int se = 0;
    while (se + 1 < nsk && __builtin_amdgcn_readfirstlane(misc[768 + se + 1]) <= it) ++se;
    const int local = it - __builtin_amdgcn_readfirstlane(misc[768 + se]); e = __builtin_amdgcn_readfirstlane(misc[736 + se]); sb = local & 15; c = local >> 4; return true;
}
__device__ __forceinline__ void skinny_gemm1(const bf16* __restrict__ Hb, const bf16* __restrict__ Wgu, bf16* __restrict__ HM, const int* __restrict__ tokmap, const LAS int* misc, LAS unsigned char* lds, int bid, int G, int wave, int lane) {
    const int T = __builtin_amdgcn_readfirstlane(misc[35]), fr = lane & 15, fq = lane >> 4; LAS f32x4* red = (LAS f32x4*)lds;
    for (int it = bid; it < T; it += G) {
        int e, sb, c; skinny_item(misc, it, e, sb, c);
        const int skr = __builtin_amdgcn_readfirstlane(misc[704 + e]), nrm = __builtin_amdgcn_readfirstlane(misc[640 + e]), so = __builtin_amdgcn_readfirstlane(misc[672 + e]);
        const int j0 = 32 * c + fr, j1 = j0 + 16;
        const int tok0 = j0 < skr ? tokmap[e * TOKCAP + nrm + j0] : 0, tok1 = j1 < skr ? tokmap[e * TOKCAP + nrm + j1] : 0;
        const bf16* a0p = Hb + (size_t)tok0 * D + 128 * wave + 8 * fq; const bf16* a1p = Hb + (size_t)tok1 * D + 128 * wave + 8 * fq;
        pg8::bf16x8 a0[4], a1[4], bf[4][4];
#pragma unroll
        for (int ks = 0; ks < 4; ++ks) { a0[ks] = *(const pg8::bf16x8*)(a0p + 32 * ks); a1[ks] = *(const pg8::bf16x8*)(a1p + 32 * ks); }
#pragma unroll
        for (int g = 0; g < 4; ++g) { const bf16* bp = Wgu + ((size_t)e * D + dest_row(fr < 8 ? 2 : 3, 32 * sb + 8 * g + (fr & 7))) * D + 128 * wave + 8 * fq;
#pragma unroll
            for (int ks = 0; ks < 4; ++ks) bf[g][ks] = *(const pg8::bf16x8*)(bp + 32 * ks); }
#pragma unroll
        for (int g = 0; g < 4; ++g) { f32x4 c0 = {0.f, 0.f, 0.f, 0.f}, c1 = {0.f, 0.f, 0.f, 0.f};
#pragma unroll
            for (int ks = 0; ks < 4; ++ks) { c0 = __builtin_amdgcn_mfma_f32_16x16x32_bf16(bf[g][ks], a0[ks], c0, 0, 0, 0); c1 = __builtin_amdgcn_mfma_f32_16x16x32_bf16(bf[g][ks], a1[ks], c1, 0, 0, 0); }
            red[((wave * 4 + g) * 2 + 0) * 64 + lane] = c0; red[((wave * 4 + g) * 2 + 1) * 64 + lane] = c1; }
        __syncthreads();
        { const int g = wave >> 1, t = wave & 1; f32x4 acc = {0.f, 0.f, 0.f, 0.f};
#pragma unroll
          for (int w8 = 0; w8 < 8; ++w8) acc = acc + red[((w8 * 4 + g) * 2 + t) * 64 + lane];
          float h[4];
#pragma unroll
          for (int i = 0; i < 4; ++i) { auto sw = __builtin_amdgcn_permlane32_swap(__float_as_uint(acc[i]), __float_as_uint(acc[i]), false, false); h[i] = pg8::silu_f(acc[i]) * __uint_as_float(sw[1]); }
          const int j = t ? j1 : j0;
          if (fq < 2 && j < skr) { v2u o; o.x = pk2(h[0], h[1]); o.y = pk2(h[2], h[3]); *(v2u*)(HM + (size_t)(SK_BASE + so + j) * DE + 32 * sb + 8 * g + 4 * fq) = o; } }
        __syncthreads();
    }
}
__device__ __forceinline__ void skinny_gemm2(const bf16* __restrict__ HM, const bf16* __restrict__ Wdn, bf16* __restrict__ YS, const LAS int* misc, LAS unsigned char* lds, int bid, int G, int wave, int lane) {
    const int T = __builtin_amdgcn_readfirstlane(misc[35]), fr = lane & 15, fq = lane >> 4; LAS f32x4* red = (LAS f32x4*)lds;
    for (int it = bid; it < T; it += G) {
        int e, sb, c; skinny_item(misc, it, e, sb, c);
        const int skr = __builtin_amdgcn_readfirstlane(misc[704 + e]), so = __builtin_amdgcn_readfirstlane(misc[672 + e]);
        const int j0 = 32 * c + fr, j1 = j0 + 16;
        const size_t s0 = (size_t)(SK_BASE + so + (j0 < skr ? j0 : 0)), s1 = (size_t)(SK_BASE + so + (j1 < skr ? j1 : 0));
        const bf16* a0p = HM + s0 * DE + 64 * wave + 8 * fq; const bf16* a1p = HM + s1 * DE + 64 * wave + 8 * fq;
        pg8::bf16x8 a0[2], a1[2], bf[4][2];
#pragma unroll
        for (int ks = 0; ks < 2; ++ks) { a0[ks] = *(const pg8::bf16x8*)(a0p + 32 * ks); a1[ks] = *(const pg8::bf16x8*)(a1p + 32 * ks); }
#pragma unroll
        for (int g = 0; g < 4; ++g) { const bf16* bp = Wdn + ((size_t)e * D + dest_row(0, 64 * sb + 16 * g + fr)) * DE + 64 * wave + 8 * fq;
#pragma unroll
            for (int ks = 0; ks < 2; ++ks) bf[g][ks] = *(const pg8::bf16x8*)(bp + 32 * ks); }
#pragma unroll
        for (int g = 0; g < 4; ++g) { f32x4 c0 = {0.f, 0.f, 0.f, 0.f}, c1 = {0.f, 0.f, 0.f, 0.f};
#pragma unroll
            for (int ks = 0; ks < 2; ++ks) { c0 = __builtin_amdgcn_mfma_f32_16x16x32_bf16(bf[g][ks], a0[ks], c0, 0, 0, 0); c1 = __builtin_amdgcn_mfma_f32_16x16x32_bf16(bf[g][ks], a1[ks], c1, 0, 0, 0); }
            red[((wave * 4 + g) * 2 + 0) * 64 + lane] = c0; red[((wave * 4 + g) * 2 + 1) * 64 + lane] = c1; }
        __syncthreads();
        { const int g = wave >> 1, t = wave & 1; f32x4 acc = {0.f, 0.f, 0.f, 0.f};
#pragma unroll
          for (int w8 = 0; w8 < 8; ++w8) acc = acc + red[((w8 * 4 + g) * 2 + t) * 64 + lane];
          const int j = t ? j1 : j0; const size_t sl = t ? s1 : s0;
          if (j < skr) { v2u o; o.x = pk2(acc[0], acc[1]); o.y = pk2(acc[2], acc[3]); *(v2u*)(YS + sl * D + 64 * sb + 16 * g + 4 * fq) = o; } }
        __syncthreads();
    }
}

__device__ __forceinline__ void na_attn_simple(const bf16* Qb, const bf16* Kb, const bf16* Vb, bf16* Ob, const float* __restrict__ rpb, int gw, int NGW, int lane) {
    for (int w = gw; w < M * NH; w += NGW) {
        const int m = w >> 4, h = w & 15, b = m >> 11, t = m & 2047, r = t >> 6, c = t & 63;
        const int rs = min(max(r - 4, 0), ROWS - 8), wsx = min(max(c - 8, 0), GW - 16);
        const float q = bf2f(Qb[(size_t)m * D + h * HD + lane]);
        float mx = -INFINITY, l = 0.f, acc = 0.f;
        for (int kr = 0; kr < 8; ++kr)
            for (int kc = 0; kc < 16; ++kc) {
                const int krow = rs + kr, kcol = wsx + kc; const size_t tok = (size_t)b * S + krow * GW + kcol;
                const float kv = bf2f(Kb[tok * D + h * HD + lane]), vv = bf2f(Vb[tok * D + h * HD + lane]);
                const int dr = krow - r + 7, dc = min(max(kcol - c + 15, 0), 30);
                const float s = wave_sum(q * kv) + rpb[(h * 15 + dr) * 31 + dc] * LOG2E;
                const float mn = fmaxf(mx, s), al = __builtin_amdgcn_exp2f(mx - mn), p = __builtin_amdgcn_exp2f(s - mn);
                l = l * al + p; acc = acc * al + p * vv; mx = mn;
            }
        Ob[(size_t)m * D + h * HD + lane] = (bf16)f2bf(acc / l);
    }
}
__device__ __forceinline__ void gqa_attn_simple(const bf16* Qb, const bf16* Kb, const bf16* Vb, bf16* Ob, int gw, int NGW, int lane) {
    for (int w = gw; w < M * NH; w += NGW) {
        const int m = w >> 4, h = w & 15, b = m >> 11, kvh = h >> 2;
        const float q = bf2f(Qb[(size_t)m * D + h * HD + lane]);
        float mx = -INFINITY, l = 0.f, acc = 0.f;
        const bf16* kp = Kb + (size_t)b * S * KVD + kvh * HD + lane; const bf16* vp = Vb + (size_t)b * S * KVD + kvh * HD + lane;
        for (int j = 0; j < S; ++j) {
            const float kv = bf2f(kp[(size_t)j * KVD]), vv = bf2f(vp[(size_t)j * KVD]);
            const float s = wave_sum(q * kv);
            const float mn = fmaxf(mx, s), al = __builtin_amdgcn_exp2f(mx - mn), p = __builtin_amdgcn_exp2f(s - mn);
            l = l * al + p; acc = acc * al + p * vv; mx = mn;
        }
        Ob[(size_t)m * D + h * HD + lane] = (bf16)f2bf(acc / l);
    }
}
#define XB_TMO      128
#define XB_XCNT(j)  (256  + 64 * (j))
#define XB_XSUB(j)  (1280 + 64 * (j))
#define XB_XGEN(j)  (2304 + 64 * (j))
#define XB_TOP      3328
#define XB_TOPGEN   3392
#define XCD_BAR_WORDS 3456
#define XB_SPIN_CAP (1u << 18)

__device__ __forceinline__ unsigned xb_ld(unsigned* p)              { return __hip_atomic_load(p, __ATOMIC_RELAXED, __HIP_MEMORY_SCOPE_AGENT); }
__device__ __forceinline__ unsigned xb_add(unsigned* p, unsigned v) { return __hip_atomic_fetch_add(p, v, __ATOMIC_RELAXED, __HIP_MEMORY_SCOPE_AGENT); }
__device__ __forceinline__ unsigned xb_xcc_id() { return (unsigned)__builtin_amdgcn_s_getreg((3 << 11) | 20) & 0xFu; }
#define XB_SPIN(cond, bar) do { unsigned _sp = 0; while (cond) { __builtin_amdgcn_s_sleep(1); \
    if ((++_sp & 255u) == 0u) { if (xb_ld(&(bar)[XB_TMO])) break; if (_sp > XB_SPIN_CAP) { atomicAdd(&(bar)[XB_TMO], 1u); break; } } } } while (0)

struct XcdBarrier {
    unsigned* bar; unsigned x;
    volatile LAS unsigned* st;
};

__device__ __forceinline__ XcdBarrier xcd_barrier_post(unsigned* bar, volatile LAS unsigned* st) {
    XcdBarrier b; b.bar = bar; b.x = xb_xcc_id(); b.st = st;
    if (threadIdx.x == 0) (void)xb_add(&bar[XB_XCNT(b.x)], 1u);
    return b;
}
__device__ __forceinline__ void xcd_barrier_complete(unsigned* bar, unsigned x, unsigned& nloc, unsigned& nx) {
    const unsigned G = gridDim.x * gridDim.y * gridDim.z;
    unsigned sum, cnt, mine, sp = 0u;
    for (;;) {
        sum = 0u; cnt = 0u; mine = 0u;
#pragma unroll
        for (unsigned j = 0; j < 16; ++j) { const unsigned c = xb_ld(&bar[XB_XCNT(j)]); sum += c; cnt += (c > 0u) ? 1u : 0u; mine = (j == x) ? c : mine; }
        if (sum == G) break;
        __builtin_amdgcn_s_sleep(1);
        if ((++sp & 255u) == 0u) { if (xb_ld(&bar[XB_TMO])) break; if (sp > XB_SPIN_CAP) { atomicAdd(&bar[XB_TMO], 1u); break; } }
    }
    nloc = mine > 0u ? mine : 1u; nx = cnt > 0u ? cnt : 1u;
}

__device__ __forceinline__ void xcd_barrier(const XcdBarrier& b) {
    asm volatile("s_waitcnt vmcnt(0)" ::: "memory");
    __syncthreads();
    if (threadIdx.x == 0) {
        unsigned* bar = b.bar;
        __builtin_amdgcn_s_waitcnt(0);
        unsigned nloc = b.st[0], nx = b.st[1];
        if (nloc == 0u) { xcd_barrier_complete(bar, b.x, nloc, nx); b.st[0] = nloc; b.st[1] = nx; }
        const unsigned old = xb_add(&bar[XB_XSUB(b.x)], 1u);
        const unsigned gen = old / nloc;
        if (old + 1u == (gen + 1u) * nloc) {
            __builtin_amdgcn_fence(__ATOMIC_RELEASE, "agent");
            asm volatile("s_waitcnt vmcnt(0)" ::: "memory");
            const unsigned og = xb_add(&bar[XB_TOP], 1u);
            const unsigned tg = og / nx;
            if (og + 1u == (tg + 1u) * nx) xb_add(&bar[XB_TOPGEN], 1u);
            else XB_SPIN(xb_ld(&bar[XB_TOPGEN]) == tg, bar);
            __builtin_amdgcn_fence(__ATOMIC_ACQUIRE, "agent");
            xb_add(&bar[XB_XGEN(b.x)], 1u);
            asm volatile("s_waitcnt vmcnt(0)" ::: "memory");
        } else {
            XB_SPIN(xb_ld(&bar[XB_XGEN(b.x)]) == gen, bar);
            __builtin_amdgcn_fence(__ATOMIC_ACQUIRE, "agent");
            asm volatile("s_waitcnt vmcnt(0)" ::: "memory");
        }
    }
    __syncthreads();
}
__device__ __forceinline__ unsigned char* ldptr(const LAS unsigned* ptab, int i) {
    const unsigned lo = (unsigned)__builtin_amdgcn_readfirstlane((int)ptab[2 * i]), hi = (unsigned)__builtin_amdgcn_readfirstlane((int)ptab[2 * i + 1]);
    return (unsigned char*)(__attribute__((address_space(1))) unsigned char*)(((unsigned long long)hi << 32) | lo);
}
#ifndef PROBE_REPEAT
#define PROBE_REPEAT -1
#endif
#define NREP(k) ((PROBE_REPEAT == (k)) ? 2 : 1)
#ifndef PROBE_TS
#define PROBE_TS -1
#endif
#define TS_T0(k) unsigned long long ts0_##k = 0; if (PROBE_TS == (k) && blockIdx.x == 0 && threadIdx.x == 0) ts0_##k = __builtin_amdgcn_s_memrealtime();
#define TS_T1(k) if (PROBE_TS == (k) && blockIdx.x == 0 && threadIdx.x == 0) atomicAdd((unsigned*)(ws + WS_CTL) + CW_TS, (unsigned)(__builtin_amdgcn_s_memrealtime() - ts0_##k));
#define GRID_SYNC_T(k) do { if (PROBE_TS == (k)) { PH_BEGIN TS_T0(k) GRID_SYNC(); TS_T1(k) } else { GRID_SYNC(); } } while (0)
#define LDS_BARRIER() do { asm volatile("s_waitcnt lgkmcnt(0)" ::: "memory"); __builtin_amdgcn_s_barrier(); asm volatile("" ::: "memory"); } while (0)
#define GRID_SYNC_CG() do { cg::this_grid().sync(); asm volatile("" ::: "memory"); } while (0)
#define GRID_SYNC() do { unsigned lb_ = (unsigned)(uintptr_t)lds_raw; asm volatile("" : "+s"(lb_)); LAS unsigned char* l_ = (LAS unsigned char*)lb_; \
    XcdBarrier xb_; xb_.bar = (unsigned*)(ldptr((LAS unsigned*)(l_ + MISC_OFF + 8192), 21) + WS_CTL) + CW_BAR; xb_.x = xb_xcc_id(); xb_.st = (volatile LAS unsigned*)(l_ + MISC_OFF + 8448); \
    xcd_barrier(xb_); asm volatile("" ::: "memory"); } while (0)
#define PH_BEGIN \
    unsigned ldsb_ = (unsigned)(uintptr_t)lds_raw; asm volatile("" : "+s"(ldsb_)); \
    LAS unsigned char* lds = (LAS unsigned char*)ldsb_; LAS int* misc = (LAS int*)(lds + MISC_OFF); LAS unsigned* ptab = (LAS unsigned*)(lds + MISC_OFF + 8192); (void)misc; \
    int tid = threadIdx.x; asm volatile("" : "+v"(tid)); \
    const int lane = tid & 63, wave = __builtin_amdgcn_readfirstlane(tid >> 6); \
    int G = gridDim.x, bid = blockIdx.x; asm volatile("" : "+s"(G), "+s"(bid)); const int gw = bid * NWAVES + wave, NGW = G * NWAVES; \
    unsigned char* ws = ldptr(ptab, 21); (void)lane; (void)gw; (void)NGW; (void)ws;
#define INP(i) ((const float*)ldptr(ptab, (i)))

__global__ void __launch_bounds__(NTHREADS, 2) mk_fwd(Args args) {
    extern __shared__ __attribute__((aligned(16))) unsigned char lds_raw[];
    { LAS unsigned* ptab = (LAS unsigned*)((LAS unsigned char*)lds_raw + MISC_OFF + 8192);
    if (threadIdx.x < 22) { const unsigned long long p = threadIdx.x < 20 ? (unsigned long long)args.in[threadIdx.x] : (threadIdx.x == 20 ? (unsigned long long)args.out : (unsigned long long)args.ws);
        ptab[2 * threadIdx.x] = (unsigned)p; ptab[2 * threadIdx.x + 1] = (unsigned)(p >> 32); }
      volatile LAS unsigned* st = (volatile LAS unsigned*)((LAS unsigned char*)lds_raw + MISC_OFF + 8448);
      if (threadIdx.x == 64) { st[0] = 0u; st[1] = 0u; }
      __syncthreads();
      (void)xcd_barrier_post((unsigned*)(args.ws + WS_CTL) + CW_BAR, st); }
    __syncthreads();

    {
        PH_BEGIN TS_T0(100)
        const float* c_in = INP(1); const float* ada_w = INP(2); const float* ada_b = INP(3);
        float* mod = (float*)(ws + WS_MOD); float* ropec = (float*)(ws + WS_ROPE); float* ropes = ropec + S * 32;
        LAS float* ca = (LAS float*)lds;
        LAS float* red = (LAS float*)(lds + 32768);
        for (int i = tid; i < NB * D; i += NTHREADS) { const float v = c_in[i]; ca[i] = v / (1.f + __expf(-v)); }
        __syncthreads();
        for (int it = bid; it < DEPTH * 192; it += G) {
            const int l = it / 192, col0 = (it % 192) * 32, cl = tid & 31, ks = tid >> 5;
            const float* wp = ada_w + ((size_t)l * D + 64 * ks) * (6 * D) + col0 + cl;
            float acc[NB];
#pragma unroll
            for (int b = 0; b < NB; ++b) acc[b] = 0.f;
#pragma unroll 16
            for (int kk = 0; kk < 64; ++kk) { const float wv = wp[(size_t)kk * (6 * D)];
#pragma unroll
                for (int b = 0; b < NB; ++b) acc[b] += ca[b * D + 64 * ks + kk] * wv; }
#pragma unroll
            for (int b = 0; b < NB; ++b) red[(ks * NB + b) * 32 + cl] = acc[b];
            __syncthreads();
            if (tid < 256) { const int b = tid >> 5; float s = 0.f;
#pragma unroll
                for (int k2 = 0; k2 < 16; ++k2) s += red[(k2 * NB + b) * 32 + cl];
                mod[((size_t)l * NB + b) * (6 * D) + col0 + cl] = s + ada_b[l * 6 * D + col0 + cl]; }
            __syncthreads();
        }
        for (int i = bid * NTHREADS + tid; i < S * 32; i += G * NTHREADS) {
            const int t = i >> 5, a = (i >> 4) & 1, p = i & 15;
            const float pos = (float)(a == 0 ? t / GW : t % GW);
            const float ang = pos * exp2f(-(float)p * (13.287712379549449f / 16.f));
            const float kf = rintf(ang * 0.15915494309189535f);
            float r = fmaf(-kf, 6.2831854820251465f, ang); r = fmaf(-kf, -1.7484555314695172e-07f, r);
            ropec[i] = __cosf(r); ropes[i] = __sinf(r);
        }
        { const float* m_wg = INP(13); const float* m_we = INP(15); bf16* wrh = (bf16*)(ws + WS_WRT); bf16* wrl = wrh + DEPTH * 48 * D;
          for (int i = bid * NTHREADS + tid; i < DEPTH * 48 * D; i += G * NTHREADS) {
            const int l = i / (48 * D), o = (i / D) % 48, k = i % D;
            const float v = o < NG ? m_wg[((size_t)l * D + k) * NG + o] : (o < NRT ? m_we[((size_t)l * D + k) * NE + (o - NG)] : 0.f);
            const unsigned hi = f2bf(v); wrh[i] = (bf16)hi; wrl[i] = (bf16)f2bf(v - __uint_as_float(hi << 16));
          } }
        LAS float* scr = (LAS float*)(lds + 49152 + wave * 8704);
        { const float* na_wqkv = INP(6); const float* na_wo = INP(8); const float* gq_wqkv = INP(9); const float* gq_wo = INP(12);
          bf16* Wqkv_na = (bf16*)(ws + WS_WQKV_NA); bf16* Wo_na = (bf16*)(ws + WS_WO_NA); bf16* Wqkv_gq = (bf16*)(ws + WS_WQKV_GQ); bf16* Wo_gq = (bf16*)(ws + WS_WO_GQ);
          constexpr int I_NQ = 16 * 96, I_O = 16 * 32, I_GQ = 16 * 48, I_DENSE = 2 * (I_NQ + I_O + I_GQ + I_O);
          for (int it = gw; it < I_DENSE; it += NGW) {
            int r = it; const int j = r / (I_DENSE / 2); r %= (I_DENSE / 2);
            if (r < I_NQ) { transpose_item(na_wqkv + (size_t)j * D * NQKV_NA, D, NQKV_NA, Wqkv_na + (size_t)j * NQKV_NA * D, 0, scr, r, lane); continue; } r -= I_NQ;
            if (r < I_O) { transpose_item(na_wo + (size_t)j * D * D, D, D, Wo_na + (size_t)j * D * D, 0, scr, r, lane); continue; } r -= I_O;
            if (r < I_GQ) { transpose_item(gq_wqkv + (size_t)j * D * NQKV_GQ, D, NQKV_GQ, Wqkv_gq + (size_t)j * NQKV_GQ * D, 1, scr, r, lane); continue; } r -= I_GQ;
            transpose_item(gq_wo + (size_t)j * D * D, D, D, Wo_gq + (size_t)j * D * D, 0, scr, r, lane);
          } }
        TS_T0(102)
        moe_weight_items(INP(17), INP(18), INP(19), 0, (bf16*)(ws + WS_WGU), (bf16*)(ws + WS_WDN), scr, gw, NGW, CONV_ITEMS, lane);
        TS_T1(102) TS_T1(100)
    }
    if (gridDim.x > 65535u) GRID_SYNC_CG();
    GRID_SYNC();
    {
        PH_BEGIN
        const float* x_in = INP(0); const float* mod = (const float*)(ws + WS_MOD); bf16* Hb = (bf16*)(ws + WS_H); bf16* X2b = (bf16*)(ws + WS_X2);
        for (int m = gw; m < M; m += NGW) {
            const float* mb = mod + (size_t)(m >> 11) * (6 * D);
#pragma unroll
            for (int j = 0; j < 4; ++j) { const int d = 4 * lane + 256 * j;
                const f32x4 xv = *(const f32x4*)(x_in + (size_t)m * D + d), sh = *(const f32x4*)(mb + d), sc = *(const f32x4*)(mb + D + d);
                const f32x4 hv = xv * (1.f + sc) + sh; v2u o; o.x = pk2(hv[0], hv[1]); o.y = pk2(hv[2], hv[3]);
                *(v2u*)(Hb + (size_t)m * D + d) = o; v2u ox; ox.x = pk2(xv[0], xv[1]); ox.y = pk2(xv[2], xv[3]); *(v2u*)(X2b + (size_t)m * D + d) = ox; }
        }
    }
    GRID_SYNC();

    for (int layer = 0; layer < DEPTH; ++layer) {
        for (int rep_ = 0; rep_ < NREP(0); ++rep_) {
            { PH_BEGIN TS_T0(110)
            const int j2 = layer >> 1;
            bf16* Hb = (bf16*)(ws + WS_H); bf16* Qb = (bf16*)(ws + WS_Q);
            if ((layer & 1) == 0) {
                pg8::Gemm g{Hb, (bf16*)(ws + WS_WQKV_NA) + (size_t)j2 * NQKV_NA * D, M, NQKV_NA, D}; pg8::StaticOrder So; So.init(M, NQKV_NA, G, bid);
                pg8::EpiStore8 E{Qb, D, D, (size_t)(WS_K - WS_Q) / 2, C2, 0x7fffffff};
                pg8::gemm_phase<pg8::EpiStore8, pg8::StaticOrder, true, true>(lds, g, So, E);
            } else {
                pg8::Gemm g{Hb, (bf16*)(ws + WS_WQKV_GQ) + (size_t)j2 * NQKV_GQ * D, M, NQKV_GQ, D}; pg8::StaticOrder So; So.init(M, NQKV_GQ, G, bid);
                const float* ropec = (const float*)(ws + WS_ROPE);
                pg8::EpiGqaQkv E{Qb, (bf16*)(ws + WS_K), (bf16*)(ws + WS_V), INP(10) + j2 * HD, INP(11) + j2 * HD, ropec, ropec + S * 32, C2};
                pg8::gemm_phase<pg8::EpiGqaQkv, pg8::StaticOrder, true, true>(lds, g, So, E);
                if (layer + 1 < DEPTH && G == 256 && bid >= 128) {
                    const int tot = conv_total_a(layer, G);
                    moe_weight_items(INP(17), INP(18), INP(19), layer + 1, (bf16*)(ws + WGU_SET(layer + 1)), (bf16*)(ws + WDN_SET(layer + 1)), (LAS float*)(lds + wave * 8704), (bid - 128) * NWAVES + wave, 128 * NWAVES, tot, lane);
                }
            }
        TS_T1(110) } GRID_SYNC_T(120); }
        for (int rep_ = 0; rep_ < NREP(1); ++rep_) {
            { PH_BEGIN TS_T0(111)
            bf16* Qb = (bf16*)(ws + WS_Q); const bf16* Kb = (const bf16*)(ws + WS_K); const bf16* Vb = (const bf16*)(ws + WS_V);
            bf16* Ob = (PROBE_REPEAT == 1 && rep_ == 0) ? (bf16*)(ws + WS_XS) : Qb;
            TS_T0(150) TS_T0(151)
            if ((layer & 1) == 0) na_body::na_phase((LAS char*)lds, Qb, Kb, Vb, Ob, INP(7) + (size_t)(layer >> 1) * NH * 15 * 31, G, bid, (unsigned*)(ws + WS_CTL) + CW_TS);
            else {
                const attn_body::AttnTensors AT{(const attn_body::bf16*)Qb, (const attn_body::bf16*)Kb, (const attn_body::bf16*)Vb, (attn_body::bf16*)Ob};
                const attn_body::StaticOrder So(G, bid);
                attn_body::attn_phase<attn_body::StaticOrder>((char*)lds, AT, So);
            }
            if ((layer & 1) == 0) { TS_T1(150) } else { TS_T1(151) }
        TS_T1(111) } GRID_SYNC_T(121); }
        for (int rep_ = 0; rep_ < NREP(2); ++rep_) {
            { PH_BEGIN TS_T0(112)
            const bf16* Wo = (const bf16*)(ws + ((layer & 1) == 0 ? WS_WO_NA : WS_WO_GQ)) + (size_t)(layer >> 1) * D * D;
            pg8::Gemm g{(const bf16*)(ws + WS_Q), Wo, M, D, D}; pg8::StaticOrder So; So.init(M, D, G, bid);
            pg8::EpiStore8 E{(bf16*)(ws + WS_Y), D, 0, 0, 1.f, 0x7fffffff};
            pg8::gemm_phase<pg8::EpiStore8, pg8::StaticOrder, true, true>(lds, g, So, E);
        TS_T1(112) } GRID_SYNC_T(122); }
        for (int rep_ = 0; rep_ < NREP(3); ++rep_) {
            { PH_BEGIN TS_T0(113)
            const bf16* xcur = (const bf16*)(ws + WS_X2);
            const float* modl = (const float*)(ws + WS_MOD) + (size_t)layer * NB * 6 * D;
            const bool dmy_ = (PROBE_REPEAT == 3 && rep_ == 0);
            unsigned* cnt = (unsigned*)(ws + WS_CTL) + CW_CNT + CNT_LAYER_STRIDE * (layer + (dmy_ ? 8 : 0));
            bf16* X1 = (bf16*)(ws + WS_X1); bf16* Hb = (bf16*)(ws + WS_H); const bf16* Yb = (const bf16*)(ws + WS_Y);
            int* r_eid = (int*)(ws + (dmy_ ? WS_XS : WS_ROUTE)); int* r_pos = r_eid + 2 * M; float* r_gate = (float*)(r_pos + 2 * M);
            int* tokmap = (int*)(ws + WS_TOKMAP);
            LAS unsigned char* Hhi = lds; LAS unsigned char* Hlo = lds + 33024; LAS float* part = (LAS float*)(lds + 66048); LAS float* lgt = (LAS float*)(lds + 90624);
            LAS float* prm = (LAS float*)(lds + 98304);
            LAS int* hist = (LAS int*)(lds + 93696); LAS int* basee = hist + 32; LAS int* rt_e = hist + 64; LAS int* rt_lp = rt_e + 128; LAS float* rt_g = (LAS float*)(rt_lp + 128);
            const float* lg = INP(4) + (size_t)(layer * 2) * D; const float* lb = INP(5) + (size_t)(layer * 2) * D;
            const bf16* wrh = (const bf16*)(ws + WS_WRT) + (size_t)layer * 48 * D; const bf16* wrl = wrh + (size_t)DEPTH * 48 * D;
            const float* bgp = INP(14) + layer * NG; const float* bep = INP(16) + layer * NE;
            const int fr = lane & 15, fq = lane >> 4;
            for (int ch = bid; ch < M / 64; ch += G) {
                if (tid < 32) hist[tid] = 0;
                { const float* mbc = modl + (size_t)((ch * 64) >> 11) * (6 * D);
                  for (int i = tid; i < D; i += NTHREADS) { prm[i] = 1.f + mbc[2 * D + i]; prm[D + i] = lg[i]; prm[2 * D + i] = lb[i]; prm[3 * D + i] = 1.f + mbc[4 * D + i]; prm[4 * D + i] = mbc[3 * D + i]; } }
                __syncthreads();
                pg8::bf16x8 wfh[4][3];
#pragma unroll
                for (int ks = 0; ks < 4; ++ks)
#pragma unroll
                    for (int nt = 0; nt < 3; ++nt) wfh[ks][nt] = *(const pg8::bf16x8*)(wrh + (size_t)(16 * nt + fr) * D + 128 * wave + 32 * ks + 8 * fq);
                v2u xn[2][4]; v2u yn[2][4];
#define LN1_LOAD(PS) do { _Pragma("unroll") for (int tt_ = 0; tt_ < 2; ++tt_) { const size_t mo_ = (size_t)(ch * 64 + (PS) * 16 + 2 * wave + tt_) * D + 4 * lane; \
        _Pragma("unroll") for (int j_ = 0; j_ < 4; ++j_) { xn[tt_][j_] = *(const v2u*)(xcur + mo_ + 256 * j_); yn[tt_][j_] = *(const v2u*)(Yb + mo_ + 256 * j_); } } } while (0)
                LN1_LOAD(0);
                for (int ps = 0; ps < 4; ++ps) {
                    TS_T0(130)
                    v2u xc[2][4]; v2u yc[2][4];
#pragma unroll
                    for (int tt = 0; tt < 2; ++tt)
#pragma unroll
                        for (int j = 0; j < 4; ++j) { xc[tt][j] = xn[tt][j]; yc[tt][j] = yn[tt][j]; }
                    LN1_LOAD(ps < 3 ? ps + 1 : 3);
#pragma unroll
                    for (int tt = 0; tt < 2; ++tt) {
                        const int tl = 2 * wave + tt, m = ch * 64 + ps * 16 + tl;
                        f32x4 v[4]; float sm = 0.f;
#pragma unroll
                        for (int j = 0; j < 4; ++j) { const int d = 4 * lane + 256 * j;
                            const v2u xw = xc[tt][j]; const f32x4 xv = {bflo(xw.x), bfhi(xw.x), bflo(xw.y), bfhi(xw.y)}, g1 = *(const LAS f32x4*)(prm + d);
                            const v2u yw = yc[tt][j]; const f32x4 yv = {bflo(yw.x), bfhi(yw.x), bflo(yw.y), bfhi(yw.y)};
                            v[j] = ALPHA * xv + g1 * yv; sm += (v[j][0] + v[j][1]) + (v[j][2] + v[j][3]); }
                        const float mean = wave_sum(sm) * (1.f / D); float q = 0.f;
#pragma unroll
                        for (int j = 0; j < 4; ++j) { v[j] = v[j] - mean; q += (v[j][0] * v[j][0] + v[j][1] * v[j][1]) + (v[j][2] * v[j][2] + v[j][3] * v[j][3]); }
                        const float rstd = rsqrtf(wave_sum(q) * (1.f / D) + LN_EPS);
#pragma unroll
                        for (int j = 0; j < 4; ++j) { const int d = 4 * lane + 256 * j;
                            const f32x4 x1 = v[j] * rstd * *(const LAS f32x4*)(prm + D + d) + *(const LAS f32x4*)(prm + 2 * D + d);
                            { v2u o1; o1.x = pk2(x1[0], x1[1]); o1.y = pk2(x1[2], x1[3]); *(v2u*)(X1 + (size_t)m * D + d) = o1; }
                            const f32x4 h2 = x1 * *(const LAS f32x4*)(prm + 3 * D + d) + *(const LAS f32x4*)(prm + 4 * D + d);
                            unsigned hb[4], lbv[4];
#pragma unroll
                            for (int e = 0; e < 4; ++e) { hb[e] = f2bf(h2[e]); lbv[e] = f2bf(h2[e] - __uint_as_float(hb[e] << 16)); }
                            v2u oh; oh.x = hb[0] | (hb[1] << 16); oh.y = hb[2] | (hb[3] << 16); v2u ol; ol.x = lbv[0] | (lbv[1] << 16); ol.y = lbv[2] | (lbv[3] << 16);
                            *(v2u*)(Hb + (size_t)m * D + d) = oh;
                            *(LAS v2u*)(Hhi + tl * 2064 + d * 2) = oh; *(LAS v2u*)(Hlo + tl * 2064 + d * 2) = ol; }
                    }
                    pg8::bf16x8 wfl[4][3];
#pragma unroll
                    for (int ks = 0; ks < 4; ++ks)
#pragma unroll
                        for (int nt = 0; nt < 3; ++nt) wfl[ks][nt] = *(const pg8::bf16x8*)(wrl + (size_t)(16 * nt + fr) * D + 128 * wave + 32 * ks + 8 * fq);
                    LDS_BARRIER();
                    TS_T1(130) TS_T0(131)
                    { f32x4 acc[3];
#pragma unroll
                      for (int nt = 0; nt < 3; ++nt) acc[nt] = (f32x4){0.f, 0.f, 0.f, 0.f};
#pragma unroll
                      for (int ks = 0; ks < 4; ++ks) { const int kk = 128 * wave + 32 * ks + 8 * fq;
                          const pg8::bf16x8 hh = *(const LAS pg8::bf16x8*)(Hhi + fr * 2064 + kk * 2), hl = *(const LAS pg8::bf16x8*)(Hlo + fr * 2064 + kk * 2);
#pragma unroll
                          for (int nt = 0; nt < 3; ++nt) { const pg8::bf16x8 wh = wfh[ks][nt], wl = wfl[ks][nt];
                              acc[nt] = __builtin_amdgcn_mfma_f32_16x16x32_bf16(wh, hh, acc[nt], 0, 0, 0);
                              acc[nt] = __builtin_amdgcn_mfma_f32_16x16x32_bf16(wh, hl, acc[nt], 0, 0, 0);
                              acc[nt] = __builtin_amdgcn_mfma_f32_16x16x32_bf16(wl, hh, acc[nt], 0, 0, 0); } }
#pragma unroll
                      for (int nt = 0; nt < 3; ++nt) *(LAS f32x4*)(part + (wave * 16 + fr) * 48 + 16 * nt + 4 * fq) = acc[nt]; }
                    LDS_BARRIER();
                    TS_T1(131) TS_T0(132)
                    for (int idx = tid; idx < 16 * 48; idx += NTHREADS) { const int o = idx % 48; float sacc = o < NG ? bgp[o] : (o < NRT ? bep[o - NG] : 0.f);
#pragma unroll
                        for (int w8 = 0; w8 < 8; ++w8) sacc += part[w8 * 16 * 48 + idx];
                        lgt[idx] = sacc; }
                    LDS_BARRIER();
                    if (tid < 16) { const LAS float* L = lgt + tid * 48; const int tl = ps * 16 + tid;
                        int gi = 0; float gm = L[0];
#pragma unroll
                        for (int o = 1; o < NG; ++o) if (L[o] > gm) { gm = L[o]; gi = o; }
                        float gs = 0.f;
#pragma unroll
                        for (int o = 0; o < NG; ++o) gs += __expf(L[o] - gm);
                        const float gprob = 1.f / gs; const LAS float* E8 = L + NG + gi * EPG;
                        int i0 = 0; float m0 = E8[0];
#pragma unroll
                        for (int e = 1; e < EPG; ++e) if (E8[e] > m0) { m0 = E8[e]; i0 = e; }
                        int i1 = 0; float m1 = -INFINITY;
#pragma unroll
                        for (int e = 0; e < EPG; ++e) if (e != i0 && E8[e] > m1) { m1 = E8[e]; i1 = e; }
                        const float p1 = __expf(m1 - m0), den = 1.f + p1; const int e0 = gi * EPG + i0, e1 = gi * EPG + i1;
                        rt_e[2 * tl] = e0; rt_e[2 * tl + 1] = e1; rt_g[2 * tl] = gprob / den; rt_g[2 * tl + 1] = gprob * p1 / den;
                        rt_lp[2 * tl] = atomicAdd((int*)&hist[e0], 1); rt_lp[2 * tl + 1] = atomicAdd((int*)&hist[e1], 1); }
                    TS_T1(132)
                }
                TS_T0(133)
                __syncthreads();
                if (tid < 32) { const int c = hist[tid]; basee[tid] = c ? (int)__hip_atomic_fetch_add(cnt + 64 * tid, (unsigned)c, RLX_AGENT) : 0; }
                __syncthreads();
                if (tid < 128) { const int e = rt_e[tid], A = ch * 128 + tid, ps_ = basee[e] + rt_lp[tid]; r_eid[A] = e; r_pos[A] = ps_; r_gate[A] = rt_g[tid]; if (!dmy_) tokmap[e * TOKCAP + ps_] = A >> 1; }
                __syncthreads();
                TS_T1(133)
            }
#undef LN1_LOAD
        TS_T1(113) } GRID_SYNC_T(123); }
        for (int rep_ = 0; rep_ < NREP(5); ++rep_) {
            { PH_BEGIN TS_T0(115)
            build_tiles((const unsigned*)(ws + WS_CTL) + CW_CNT + CNT_LAYER_STRIDE * layer, misc, tid);
            const int ntiles = __builtin_amdgcn_readfirstlane(misc[33]);
            pg8::Gemm g{(const bf16*)(ws + WS_H), (const bf16*)(ws + WGU_SET(layer)), ntiles * 256, NE * D, D}; MoeOrder So{ntiles * 4, G, bid, misc + 64, misc + 256, misc + 448, (const int*)(ws + WS_TOKMAP)};
            pg8::EpiSwiglu E{(bf16*)(ws + WS_HMID)};
            pg8::gemm_phase<pg8::EpiSwiglu, MoeOrder, true, true, true>(lds, g, So, E);
            skinny_gemm1((const bf16*)(ws + WS_H), (const bf16*)(ws + WGU_SET(layer)), (bf16*)(ws + WS_HMID), (const int*)(ws + WS_TOKMAP), misc, lds, bid, G, wave, lane);
            if (layer + 1 < DEPTH) { const int idle = idle_cus(ntiles * 4, G), first = conv_total_a(layer, G);
                if (bid >= G - idle) { int end = first + idle * NWAVES * CQ_B; end = end < CONV_ITEMS ? end : CONV_ITEMS;
                    moe_weight_items(INP(17), INP(18), INP(19), layer + 1, (bf16*)(ws + WGU_SET(layer + 1)), (bf16*)(ws + WDN_SET(layer + 1)), (LAS float*)(lds + wave * 8704), first + (bid - (G - idle)) * NWAVES + wave, idle * NWAVES, end, lane); } }
        TS_T1(115) } GRID_SYNC_T(125); }
        for (int rep_ = 0; rep_ < NREP(6); ++rep_) {
            { PH_BEGIN TS_T0(116)
            const int ntiles = __builtin_amdgcn_readfirstlane(misc[33]);
            pg8::Gemm g{(const bf16*)(ws + WS_HMID), (const bf16*)(ws + WDN_SET(layer)), ntiles * 256, NE * D, DE}; MoeOrder So{ntiles * 4, G, bid, misc + 64, misc + 256, misc + 448, nullptr};
            pg8::EpiStore8 E{(bf16*)(ws + WS_YS), D, 0, 0, 1.f, 3};
            pg8::gemm_phase<pg8::EpiStore8, MoeOrder, true, true>(lds, g, So, E);
            skinny_gemm2((const bf16*)(ws + WS_HMID), (const bf16*)(ws + WDN_SET(layer)), (bf16*)(ws + WS_YS), misc, lds, bid, G, wave, lane);
            if (layer + 1 < DEPTH) { const int idle = idle_cus(ntiles * 4, G); int first = conv_total_a(layer, G) + idle * NWAVES * CQ_B; first = first < CONV_ITEMS ? first : CONV_ITEMS;
                if (bid >= G - idle) { int end = first + idle * NWAVES * CQ_C; end = end < CONV_ITEMS ? end : CONV_ITEMS;
                    moe_weight_items(INP(17), INP(18), INP(19), layer + 1, (bf16*)(ws + WGU_SET(layer + 1)), (bf16*)(ws + WDN_SET(layer + 1)), (LAS float*)(lds + wave * 8704), first + (bid - (G - idle)) * NWAVES + wave, idle * NWAVES, end, lane); } }
        TS_T1(116) } GRID_SYNC_T(126); }
        for (int rep_ = 0; rep_ < NREP(7); ++rep_) {
            { PH_BEGIN TS_T0(117)
            const float* lg = INP(4) + (size_t)(layer * 2 + 1) * D; const float* lb = INP(5) + (size_t)(layer * 2 + 1) * D;
            const bool last = layer == DEPTH - 1; float* xo = (float*)ldptr(ptab, 20); bf16* X2b = (bf16*)(ws + WS_X2);
            const float tsc = (PROBE_TS >= 0 && last) ? 1.f + (float)__hip_atomic_load((unsigned*)(ws + WS_CTL) + CW_TS, RLX_AGENT) * 1e-6f : 1.f;
            const float* modl = (const float*)(ws + WS_MOD) + (size_t)layer * NB * 6 * D; const float* modn = modl + (size_t)NB * 6 * D;
            const bf16* X1 = (const bf16*)(ws + WS_X1); bf16* Hb = (bf16*)(ws + WS_H); const bf16* YS = (const bf16*)(ws + WS_YS);
            const int* r_eid = (const int*)(ws + WS_ROUTE); const int* r_pos = r_eid + 2 * M; const float* r_gate = (const float*)(r_pos + 2 * M);
            TS_T0(140)
            LAS float* prm = (LAS float*)(lds + 98304);
            for (int ch = bid; ch < M / 64; ch += G) {
                __syncthreads();
                { const float* mbc = modl + (size_t)((ch * 64) >> 11) * (6 * D); const float* mnc = modn + (size_t)((ch * 64) >> 11) * (6 * D);
                  for (int i = tid; i < D; i += NTHREADS) { prm[i] = 1.f + mbc[5 * D + i]; prm[D + i] = lg[i]; prm[2 * D + i] = lb[i];
                      prm[3 * D + i] = last ? 0.f : 1.f + mnc[D + i]; prm[4 * D + i] = last ? 0.f : mnc[i]; } }
                __syncthreads();
                const int mbase = ch * 64 + wave * 8;
                int sl0, sl1; float gt0, gt1;
                { const int mi = mbase + (lane & 7); sl0 = slot_of(misc, r_eid[2 * mi], r_pos[2 * mi]); sl1 = slot_of(misc, r_eid[2 * mi + 1], r_pos[2 * mi + 1]); gt0 = r_gate[2 * mi]; gt1 = r_gate[2 * mi + 1]; }
                v2u xn[4]; v2u yan[4], ybn[4];
#define CMB_LOAD(I) do { const int mi_ = mbase + (I); const int s0_ = __builtin_amdgcn_readlane(sl0, (I)), s1_ = __builtin_amdgcn_readlane(sl1, (I)); \
        _Pragma("unroll") for (int j_ = 0; j_ < 4; ++j_) { const int d_ = 4 * lane + 256 * j_; xn[j_] = *(const v2u*)(X1 + (size_t)mi_ * D + d_); \
            yan[j_] = *(const v2u*)(YS + (size_t)s0_ * D + d_); ybn[j_] = *(const v2u*)(YS + (size_t)s1_ * D + d_); } } while (0)
                CMB_LOAD(0);
#pragma unroll
                for (int i = 0; i < 8; ++i) {
                    const int m = mbase + i;
                    const float g0 = __builtin_bit_cast(float, __builtin_amdgcn_readlane(__builtin_bit_cast(int, gt0), i)), g1v = __builtin_bit_cast(float, __builtin_amdgcn_readlane(__builtin_bit_cast(int, gt1), i));
                    v2u xc[4]; v2u yac[4], ybc[4];
#pragma unroll
                    for (int j = 0; j < 4; ++j) { xc[j] = xn[j]; yac[j] = yan[j]; ybc[j] = ybn[j]; }
                    if (i < 7) CMB_LOAD(i + 1);
                    f32x4 v[4]; float sm = 0.f;
#pragma unroll
                    for (int j = 0; j < 4; ++j) { const int d = 4 * lane + 256 * j;
                        const f32x4 g2 = *(const LAS f32x4*)(prm + d); const v2u ya = yac[j], yb = ybc[j];
                        const f32x4 y0 = {bflo(ya.x), bfhi(ya.x), bflo(ya.y), bfhi(ya.y)}, y1 = {bflo(yb.x), bfhi(yb.x), bflo(yb.y), bfhi(yb.y)};
                        const f32x4 xv = {bflo(xc[j].x), bfhi(xc[j].x), bflo(xc[j].y), bfhi(xc[j].y)};
                        v[j] = ALPHA * xv + g2 * (g0 * y0 + g1v * y1); sm += (v[j][0] + v[j][1]) + (v[j][2] + v[j][3]); }
                    const float mean = wave_sum(sm) * (1.f / D); float q = 0.f;
#pragma unroll
                    for (int j = 0; j < 4; ++j) { v[j] = v[j] - mean; q += (v[j][0] * v[j][0] + v[j][1] * v[j][1]) + (v[j][2] * v[j][2] + v[j][3] * v[j][3]); }
                    const float rstd = rsqrtf(wave_sum(q) * (1.f / D) + LN_EPS);
#pragma unroll
                    for (int j = 0; j < 4; ++j) { const int d = 4 * lane + 256 * j;
                        const f32x4 x2 = v[j] * rstd * *(const LAS f32x4*)(prm + D + d) + *(const LAS f32x4*)(prm + 2 * D + d);
                        if (last) *(f32x4*)(xo + (size_t)m * D + d) = x2 * tsc;
                        else { v2u o2; o2.x = pk2(x2[0], x2[1]); o2.y = pk2(x2[2], x2[3]); *(v2u*)(X2b + (size_t)m * D + d) = o2; }
                        if (!last) { const f32x4 hn = x2 * *(const LAS f32x4*)(prm + 3 * D + d) + *(const LAS f32x4*)(prm + 4 * D + d);
                            v2u o; o.x = pk2(hn[0], hn[1]); o.y = pk2(hn[2], hn[3]); *(v2u*)(Hb + (size_t)m * D + d) = o; } }
                }
#undef CMB_LOAD
            }
            __syncthreads();
            TS_T1(140) TS_T0(141)
            if (!last) { LAS float* scr = (LAS float*)(lds + wave * 8704); const int idle = idle_cus(__builtin_amdgcn_readfirstlane(misc[33]) * 4, G);
                int first = conv_total_a(layer, G) + idle * NWAVES * (CQ_B + CQ_C); first = first < CONV_ITEMS ? first : CONV_ITEMS;
                moe_weight_items(INP(17), INP(18), INP(19), layer + 1, (bf16*)(ws + WGU_SET(layer + 1)), (bf16*)(ws + WDN_SET(layer + 1)), scr, first + gw, NGW, CONV_ITEMS, lane); }
            TS_T1(141)
        TS_T1(117) } if (layer != DEPTH - 1 || PROBE_REPEAT == 7) GRID_SYNC_T(127); }
    }
}

extern "C" void kernel_launch(void* const* d_in, const int* in_sizes, int n_in, void* d_out, int out_size, void* d_ws, size_t ws_size, hipStream_t stream) {
    static int grid = 0;
    if (grid == 0) {
        if (n_in != 20 || ws_size < WS_END) { fprintf(stderr, "kernel_launch: unexpected inputs (n_in %d, ws %zu)\n", n_in, ws_size); grid = -1; return; }
        int dev = 0, cus = 0, per_cu = 0;
        if (hipGetDevice(&dev) != hipSuccess || hipDeviceGetAttribute(&cus, hipDeviceAttributeMultiprocessorCount, dev) != hipSuccess) { grid = -1; return; }
        if (hipFuncSetAttribute((const void*)mk_fwd, hipFuncAttributeMaxDynamicSharedMemorySize, LDS_BYTES) != hipSuccess) { fprintf(stderr, "kernel_launch: hipFuncSetAttribute failed\n"); grid = -1; return; }
        if (hipOccupancyMaxActiveBlocksPerMultiprocessor(&per_cu, (const void*)mk_fwd, NTHREADS, LDS_BYTES) != hipSuccess || per_cu < 1) { fprintf(stderr, "kernel_launch: occupancy query failed (%d)\n", per_cu); per_cu = 1; }
        (void)hipGetLastError();
        grid = cus * (per_cu < 1 ? 1 : 1);
    }
    if (grid < 0) return;
    (void)in_sizes; (void)out_size;
    if (hipMemsetAsync((char*)d_ws + WS_CTL, 0, CTL_ZERO_BYTES, stream) != hipSuccess) { fprintf(stderr, "kernel_launch: memset failed\n"); return; }
    Args a{};
    for (int i = 0; i < 20; ++i) a.in[i] = (const float*)d_in[i];
    a.out = (float*)d_out; a.ws = (unsigned char*)d_ws;
    void* kargs[] = {&a};
    hipError_t e = hipLaunchCooperativeKernel((const void*)mk_fwd, dim3(grid), dim3(NTHREADS), kargs, LDS_BYTES, stream);
    if (e != hipSuccess) fprintf(stderr, "kernel_launch: cooperative launch failed: %s (grid %d)\n", hipGetErrorString(e), grid);
}
```
